# Optimizing an MI355X kernel written in HIP

```python
import math
import jax, jax.numpy as jnp
from jax import lax
import numpy as np

D_MODEL = 1024
BATCH = 16
SEQ = 2048
DEPTH = 1

PLE_DIM = 256
A_HEADS = 8
A_HEAD_DIM = 64
A_WIDTH = A_HEADS * A_HEAD_DIM
DILATED_PATTERNS = ((128, 1), (512, 4), (2048, 16))
ATT_BLOCK = 128
B_HEADS = 4
B_HEAD_DIM = 128
B_WIDTH = B_HEADS * B_HEAD_DIM
CONV_WIDTH = 4
DELTA_CHUNK = 64
MIX_WIDTH = A_WIDTH + B_WIDTH
IN_SIZES = (A_WIDTH, A_WIDTH, A_WIDTH, B_WIDTH, B_WIDTH, B_WIDTH, B_WIDTH, B_HEADS, B_HEADS)
IN_COLS = sum(IN_SIZES)
N_EXPERTS = 32
TOP_K = 4
D_EXPERT = D_MODEL
SWIGLU_LIMIT = 7.0
SWIGLU_ALPHA = 1.702
MOE_BLOCK = 128
LN_EPS = 1e-5
RMS_EPS = 1e-6
L2_EPS = 1e-6
DEEPNORM_ALPHA = (2.0 * DEPTH) ** 0.25
DEEPNORM_BETA = (8.0 * DEPTH) ** -0.25

kernel_name = "hymba_dilated_deltanet_moe_deepnorm"


def layer_norm(x, g, b):
    xf = x.astype(jnp.float32)
    mu = jnp.mean(xf, axis=-1, keepdims=True)
    xc = xf - mu
    var = jnp.mean(xc * xc, axis=-1, keepdims=True)
    y = xc * lax.rsqrt(var + LN_EPS) * g.astype(jnp.float32) + b.astype(jnp.float32)
    return y.astype(x.dtype)


def _dilated_branch(q, k, v, window, dilation):
    b, s, h, e = q.shape
    n_back = window // dilation
    L = s // dilation
    nb = -(-L // ATT_BLOCK)
    Lp = nb * ATT_BLOCK

    def split(t):
        t = t.reshape(b, L, dilation, h, e).transpose(0, 2, 3, 1, 4)
        return jnp.pad(t, ((0, 0), (0, 0), (0, 0), (0, Lp - L), (0, 0)))

    def band(t):
        t = jnp.pad(t, ((0, 0), (0, 0), (0, 0), (ATT_BLOCK, 0), (0, 0)))
        t = t.reshape(b, dilation, h, nb + 1, ATT_BLOCK, e)
        return jnp.concatenate([t[:, :, :, :-1], t[:, :, :, 1:]], axis=4)

    qb = split(q).reshape(b, dilation, h, nb, ATT_BLOCK, e)
    kb = band(split(k))
    vb = band(split(v))

    qi = jnp.arange(ATT_BLOCK)[:, None]
    kc = jnp.arange(2 * ATT_BLOCK)[None, :]
    dist = ATT_BLOCK + qi - kc
    key_pos = jnp.arange(nb)[:, None, None] * ATT_BLOCK + kc[None] - ATT_BLOCK
    valid = (dist >= 0) & (dist <= n_back) & (key_pos >= 0)

    scores = jnp.einsum('bdhnqe,bdhnke->bdhnqk', qb, kb,
                        preferred_element_type=jnp.float32) * (1.0 / math.sqrt(e))
    scores = jnp.where(valid, scores, -jnp.inf)
    m = jnp.max(scores, axis=-1, keepdims=True)
    pr = jnp.exp(scores - m)
    den = jnp.sum(pr, axis=-1, keepdims=True)
    o = jnp.einsum('bdhnqk,bdhnke->bdhnqe', pr.astype(vb.dtype), vb,
                   preferred_element_type=jnp.float32) / den
    lse = (m + jnp.log(den))[..., 0]

    o = o.reshape(b, dilation, h, Lp, e)[:, :, :, :L].transpose(0, 3, 1, 2, 4).reshape(b, s, h, e)
    lse = lse.reshape(b, dilation, h, Lp)[..., :L].transpose(0, 3, 1, 2).reshape(b, s, h)
    return o, lse


def dilated_attention(q, k, v):
    outs, lses = [], []
    for window, dilation in DILATED_PATTERNS:
        o, lse = _dilated_branch(q, k, v, window, dilation)
        outs.append(o)
        lses.append(lse)
    wts = jax.nn.softmax(jnp.stack(lses, 0), axis=0)
    return jnp.einsum('pbsh,pbshe->bshe', wts, jnp.stack(outs, 0))


def _causal_depthwise_conv(x, w):
    c = x.shape[-1]
    return lax.conv_general_dilated(x, w[:, None, :].astype(x.dtype), window_strides=(1,),
                                    padding=[(CONV_WIDTH - 1, 0)],
                                    dimension_numbers=('NWC', 'WIO', 'NWC'),
                                    feature_group_count=c)


def _l2norm(t):
    return t * lax.rsqrt(jnp.sum(t * t, axis=-1, keepdims=True) + L2_EPS)


def _gated_delta_rule(q, k, v, g, beta):
    b, s, h, dk = q.shape
    dv = v.shape[-1]
    c = DELTA_CHUNK
    n = s // c

    def chunk(t):
        t = t.reshape((b, n, c, h) + t.shape[3:])
        return jnp.moveaxis(t, 3, 1)

    q, k, v, g, beta = [chunk(t) for t in (q, k, v, g, beta)]
    gc = jnp.cumsum(g, axis=-1)
    diff = gc[..., :, None] - gc[..., None, :]
    strict = jnp.tril(jnp.ones((c, c), bool), -1)
    causal = jnp.tril(jnp.ones((c, c), bool))
    decay_strict = jnp.where(strict, jnp.exp(jnp.where(strict, diff, 0.0)), 0.0)
    decay_causal = jnp.where(causal, jnp.exp(jnp.where(causal, diff, 0.0)), 0.0)

    kbeta = k * beta[..., None]
    a_mat = jnp.eye(c, dtype=jnp.float32) + jnp.einsum('bhnid,bhnjd->bhnij', kbeta, k) * decay_strict
    rhs = jnp.concatenate([v * beta[..., None], kbeta * jnp.exp(gc)[..., None]], axis=-1)
    sol = lax.linalg.triangular_solve(a_mat, rhs, left_side=True, lower=True, unit_diagonal=True)
    u, w = sol[..., :dv], sol[..., dv:]

    attn = jnp.einsum('bhnid,bhnjd->bhnij', q, k) * decay_causal
    q_dec = q * jnp.exp(gc)[..., None]
    g_last = gc[..., -1]
    k_dec = k * jnp.exp(g_last[..., None] - gc)[..., None]
    xs = [jnp.moveaxis(t, 2, 0) for t in (u, w, attn, q_dec, k_dec, g_last)]

    def step(state, inp):
        u_n, w_n, attn_n, qd_n, kd_n, gl_n = inp
        v_new = u_n - jnp.einsum('bhck,bhkv->bhcv', w_n, state)
        out = (jnp.einsum('bhck,bhkv->bhcv', qd_n, state)
               + jnp.einsum('bhij,bhjv->bhiv', attn_n, v_new))
        state = state * jnp.exp(gl_n)[..., None, None] + jnp.einsum('bhck,bhcv->bhkv', kd_n, v_new)
        return state, out

    s0 = jnp.zeros((b, h, dk, dv), jnp.float32)
    _, out = lax.scan(step, s0, xs)
    return out.transpose(1, 0, 3, 2, 4).reshape(b, s, h, dv)


def gated_deltanet(qkv, z, b_logit, a_logit, conv_w, a_log, dt_bias, norm_w):
    bsz, s, _ = qkv.shape
    qkv = jax.nn.silu(_causal_depthwise_conv(qkv, conv_w)).astype(jnp.float32)
    q, k, v = jnp.split(qkv, 3, axis=-1)
    q = _l2norm(q.reshape(bsz, s, B_HEADS, B_HEAD_DIM)) * (B_HEAD_DIM ** -0.5)
    k = _l2norm(k.reshape(bsz, s, B_HEADS, B_HEAD_DIM))
    v = v.reshape(bsz, s, B_HEADS, B_HEAD_DIM)
    beta = jax.nn.sigmoid(b_logit.astype(jnp.float32))
    g = -jnp.exp(a_log.astype(jnp.float32)) * jax.nn.softplus(
        a_logit.astype(jnp.float32) + dt_bias.astype(jnp.float32))
    o = _gated_delta_rule(q, k, v, g, beta)
    o = o * lax.rsqrt(jnp.mean(o * o, axis=-1, keepdims=True) + RMS_EPS) * norm_w.astype(jnp.float32)
    o = o * jax.nn.silu(z.astype(jnp.float32).reshape(bsz, s, B_HEADS, B_HEAD_DIM))
    return o.reshape(bsz, s, B_WIDTH)


def moe(x, w_router, b_router, w_gate_up, b_gate_up, w_down, b_down):
    bsz, s, d = x.shape
    t = bsz * s
    xt = x.reshape(t, d)
    logits = jnp.dot(xt, w_router, preferred_element_type=jnp.float32) + b_router.astype(jnp.float32)
    top_val, top_idx = lax.top_k(logits, TOP_K)
    gates = jax.nn.softmax(top_val, axis=-1)

    flat_e = top_idx.reshape(-1).astype(jnp.int32)
    flat_tok = jnp.repeat(jnp.arange(t, dtype=jnp.int32), TOP_K)
    flat_g = gates.reshape(-1)
    order = jnp.argsort(flat_e)
    sorted_e = flat_e[order]
    counts = jnp.bincount(flat_e, length=N_EXPERTS)
    padded = (counts + MOE_BLOCK - 1) // MOE_BLOCK * MOE_BLOCK
    start = jnp.cumsum(counts) - counts
    pad_end = jnp.cumsum(padded)
    pad_start = pad_end - padded
    dest = pad_start[sorted_e] + (jnp.arange(t * TOP_K) - start[sorted_e])

    n_blocks = -(-(t * TOP_K) // MOE_BLOCK) + N_EXPERTS
    n_rows = n_blocks * MOE_BLOCK
    buf_tok = jnp.full((n_rows,), t, jnp.int32).at[dest].set(flat_tok[order])
    buf_gate = jnp.zeros((n_rows,), jnp.float32).at[dest].set(flat_g[order])
    block_e = jnp.minimum(jnp.searchsorted(pad_end, jnp.arange(n_blocks) * MOE_BLOCK, side='right'),
                          N_EXPERTS - 1)

    x_pad = jnp.concatenate([xt, jnp.zeros((1, d), xt.dtype)], axis=0)
    xb = x_pad[buf_tok].reshape(n_blocks, MOE_BLOCK, d)

    def expert_block(args):
        xblk, e = args
        hgu = jnp.dot(xblk, w_gate_up[e]) + b_gate_up[e]
        gate = jnp.minimum(hgu[:, :D_EXPERT], SWIGLU_LIMIT)
        up = jnp.clip(hgu[:, D_EXPERT:], -SWIGLU_LIMIT, SWIGLU_LIMIT)
        act = (up + 1.0) * (gate * jax.nn.sigmoid(SWIGLU_ALPHA * gate))
        return jnp.dot(act, w_down[e]) + b_down[e]

    yb = lax.map(expert_block, (xb, block_e)).reshape(n_rows, d)
    y = jax.ops.segment_sum(yb * buf_gate[:, None].astype(yb.dtype), buf_tok, num_segments=t + 1)[:t]
    return y.reshape(bsz, s, d).astype(x.dtype)


def setup_inputs(seed: int = 0) -> dict:
    key = jax.random.key(seed)
    ks = jax.random.split(key, 24)
    f32 = jnp.float32
    nrm = lambda k, shape, scale: jax.random.normal(k, shape, f32) * scale

    x = jax.random.normal(ks[0], (BATCH, SEQ, D_MODEL), f32)
    p = jax.random.normal(ks[1], (DEPTH, BATCH, SEQ, PLE_DIM), f32)

    w_in = nrm(ks[2], (DEPTH, D_MODEL, IN_COLS), D_MODEL ** -0.5)
    offs = np.cumsum((0,) + IN_SIZES)
    col_scale = np.ones((IN_COLS,), np.float32)
    col_scale[offs[2]:offs[3]] = DEEPNORM_BETA
    col_scale[offs[5]:offs[6]] = DEEPNORM_BETA
    w_in = w_in * jnp.asarray(col_scale)

    conv_w = nrm(ks[3], (DEPTH, CONV_WIDTH, 3 * B_WIDTH), CONV_WIDTH ** -0.5)
    a_log = jnp.log(jax.random.uniform(ks[4], (DEPTH, B_HEADS), f32, 1.0, 16.0))
    dt = jnp.exp(jax.random.uniform(ks[5], (DEPTH, B_HEADS), f32, math.log(1e-3), math.log(1e-1)))
    dt_bias = dt + jnp.log(-jnp.expm1(-dt))
    gnorm_w = 1.0 + nrm(ks[6], (DEPTH, B_HEAD_DIM), 0.02)
    w_out = nrm(ks[7], (DEPTH, MIX_WIDTH, D_MODEL), MIX_WIDTH ** -0.5 * DEEPNORM_BETA)
    ln1_g = 1.0 + nrm(ks[8], (DEPTH, D_MODEL), 0.02)
    ln1_b = nrm(ks[9], (DEPTH, D_MODEL), 0.02)

    w_router = nrm(ks[10], (DEPTH, D_MODEL, N_EXPERTS), D_MODEL ** -0.5)
    b_router = nrm(ks[11], (DEPTH, N_EXPERTS), 0.01)
    w_gate_up = nrm(ks[12], (DEPTH, N_EXPERTS, D_MODEL, 2 * D_EXPERT), D_MODEL ** -0.5)
    b_gate_up = nrm(ks[13], (DEPTH, N_EXPERTS, 2 * D_EXPERT), 0.01)
    w_down = nrm(ks[14], (DEPTH, N_EXPERTS, D_EXPERT, D_MODEL), D_EXPERT ** -0.5 * DEEPNORM_BETA)
    b_down = nrm(ks[15], (DEPTH, N_EXPERTS, D_MODEL), 0.01)

    w_ple_gate = nrm(ks[16], (DEPTH, D_MODEL, D_MODEL), D_MODEL ** -0.5)
    b_ple_gate = nrm(ks[17], (DEPTH, D_MODEL), 0.01)
    w_ple_proj = nrm(ks[18], (DEPTH, PLE_DIM, D_MODEL), PLE_DIM ** -0.5 * DEEPNORM_BETA)
    ln2_g = 1.0 + nrm(ks[19], (DEPTH, D_MODEL), 0.02)
    ln2_b = nrm(ks[20], (DEPTH, D_MODEL), 0.02)

    return {"x": x, "p": p, "w_in": w_in, "conv_w": conv_w, "a_log": a_log, "dt_bias": dt_bias,
            "gnorm_w": gnorm_w, "w_out": w_out, "ln1_g": ln1_g, "ln1_b": ln1_b,
            "w_router": w_router, "b_router": b_router, "w_gate_up": w_gate_up,
            "b_gate_up": b_gate_up, "w_down": w_down, "b_down": b_down,
            "w_ple_gate": w_ple_gate, "b_ple_gate": b_ple_gate, "w_ple_proj": w_ple_proj,
            "ln2_g": ln2_g, "ln2_b": ln2_b}


def reference(x, p, w_in, conv_w, a_log, dt_bias, gnorm_w, w_out, ln1_g, ln1_b,
              w_router, b_router, w_gate_up, b_gate_up, w_down, b_down,
              w_ple_gate, b_ple_gate, w_ple_proj, ln2_g, ln2_b):
    bsz, s, _ = x.shape
    split_at = [int(o) for o in np.cumsum(IN_SIZES)[:-1]]
    for i in range(DEPTH):
        hproj = jnp.dot(x, w_in[i])
        qa, ka, va, qb, kb, vb, zb, bb, ab = jnp.split(hproj, split_at, axis=-1)
        shp = (bsz, s, A_HEADS, A_HEAD_DIM)
        ya = dilated_attention(qa.reshape(shp), ka.reshape(shp), va.reshape(shp))
        ya = ya.reshape(bsz, s, A_WIDTH).astype(x.dtype)
        yb = gated_deltanet(jnp.concatenate([qb, kb, vb], axis=-1), zb, bb, ab,
                            conv_w[i], a_log[i], dt_bias[i], gnorm_w[i]).astype(x.dtype)
        mix = jnp.dot(jnp.concatenate([ya, yb], axis=-1), w_out[i])
        x = layer_norm(DEEPNORM_ALPHA * x + mix, ln1_g[i], ln1_b[i])
        ffn = moe(x, w_router[i], b_router[i], w_gate_up[i], b_gate_up[i], w_down[i], b_down[i])
        ple = jax.nn.sigmoid(jnp.dot(x, w_ple_gate[i]) + b_ple_gate[i]) * jnp.dot(p[i], w_ple_proj[i])
        x = layer_norm(DEEPNORM_ALPHA * x + ffn + ple.astype(x.dtype), ln2_g[i], ln2_b[i])
    return x
```

```cpp
#include <hip/hip_runtime.h>
#include <hip/hip_cooperative_groups.h>
#include <cstdio>
#include <cstdint>
namespace cg = cooperative_groups;

#ifndef ONE_LAUNCH
#define ONE_LAUNCH 0
#endif

#define LAS __attribute__((address_space(3)))
typedef unsigned short bf16_t;
typedef short bf16x8 __attribute__((ext_vector_type(8)));
typedef float f32x4 __attribute__((ext_vector_type(4)));
typedef float f32x16 __attribute__((ext_vector_type(16)));
typedef unsigned u32x4 __attribute__((ext_vector_type(4)));
typedef unsigned u32x2 __attribute__((ext_vector_type(2)));
typedef float f32x2_t __attribute__((ext_vector_type(2)));
typedef __bf16 bf16x2_t __attribute__((ext_vector_type(2)));

constexpr int T_TOK = 32768, DM = 1024, SEQ = 2048, NBATCH = 16;
constexpr int HPW = 3584, INCOLS = 3592;
constexpr int NEXP = 32, LCAP = 32768;
constexpr float ALPHA = 1.189207115002721f;
constexpr float LN_EPS = 1e-5f;
constexpr int NWAVES = 8, NTHREADS = 512;
constexpr int LDS_BYTES = 147456;
constexpr int LDS_MISC = 131072;

constexpr size_t MiB = 1u << 20;
constexpr size_t WS_CTL = 0;
constexpr size_t WS_WGU = 1 * MiB;
constexpr size_t WS_WD = 129 * MiB;
constexpr size_t WS_WIN = 193 * MiB;
constexpr size_t WS_WOUT = 200 * MiB;
constexpr size_t WS_WPG = 202 * MiB;
constexpr size_t WS_WPP = 204 * MiB;
constexpr size_t WS_WRT = 205 * MiB;
constexpr size_t WS_BA = 206 * MiB;
constexpr size_t WS_ROUTE = 207 * MiB;
constexpr size_t WS_LTOK = 208 * MiB;
constexpr size_t WS_LGATE = 212 * MiB;
constexpr size_t WS_X1 = 216 * MiB;
constexpr size_t WS_PLE = 280 * MiB;
constexpr size_t WS_PB = 344 * MiB;
constexpr size_t WS_MIX = 360 * MiB;
constexpr size_t WS_XB = 424 * MiB;
constexpr size_t WS_HP = 488 * MiB;
constexpr size_t WS_DN = 712 * MiB;
constexpr size_t WS_EG = 888 * MiB;
constexpr size_t WS_VT = 889 * MiB;
constexpr size_t WS_ORAW = 985 * MiB;
constexpr size_t WS_ACT = 360 * MiB;
constexpr size_t WS_YB = 632 * MiB;
constexpr size_t WS_END = 1017 * MiB;
constexpr size_t DN_WN = 0, DN_QD = 16384, DN_AT = 32768, DN_KD = 40960, DN_U = 57344, DN_STRIDE = 90112;

__device__ __forceinline__ unsigned cvtpk(float lo, float hi) { f32x2_t v = {lo, hi}; bf16x2_t b = __builtin_convertvector(v, bf16x2_t); return __builtin_bit_cast(unsigned, b); }
__device__ __forceinline__ float bflo(unsigned u) { return __uint_as_float(u << 16); }
__device__ __forceinline__ float bfhi(unsigned u) { return __uint_as_float(u & 0xffff0000u); }
__device__ __forceinline__ bf16_t f2bf(float f) { return (bf16_t)(cvtpk(f, 0.f) & 0xffffu); }
__device__ __forceinline__ float bf2f(bf16_t h) { return __uint_as_float((unsigned)h << 16); }
__device__ __forceinline__ float sigm(float x) { return 1.f / (1.f + __expf(-x)); }
__device__ __forceinline__ int crow(int r, int hi) { return (r & 3) + 8 * (r >> 2) + 4 * hi; }
__device__ __forceinline__ int kperm(int k) { return (k & ~12) | ((k & 4) << 1) | ((k & 8) >> 1); }
__device__ __forceinline__ bf16x8 pack8(const f32x16& x, int b) {
    u32x4 w; w.x = cvtpk(x[b], x[b + 1]); w.y = cvtpk(x[b + 2], x[b + 3]); w.z = cvtpk(x[b + 4], x[b + 5]); w.w = cvtpk(x[b + 6], x[b + 7]);
    return __builtin_bit_cast(bf16x8, w);
}
__device__ __forceinline__ float wave_sum(float v) {
#pragma unroll
    for (int o = 1; o < 64; o <<= 1) v += __shfl_xor(v, o);
    return v;
}

namespace pg8 {
constexpr int BM = 256, BK = 64, HALF = 128, HTB = HALF * BK * 2, STAGE_BYTES = 8 * HTB;
__device__ __forceinline__ int lds_byte(int r, int c) { const int st = (r >> 4) * 2 + (c >> 5), rr = r & 15, cc = c & 31, ob = rr * 64 + cc * 2; return st * 1024 + (ob ^ (((ob >> 9) & 1) << 5)); }
__device__ __forceinline__ void stage_rc(int b, int& R, int& C) { const int st = b / 1024, sb = b % 1024, swz = sb ^ (((sb >> 9) & 1) << 5); R = (st >> 1) * 16 + swz / 64; C = (st & 1) * 32 + (swz % 64) / 2; }
__device__ __forceinline__ int perm32(int rho) { const int n = rho >> 4, i = rho & 15; return 8 * (i >> 2) + 4 * n + (i & 3); }

struct Unit { const char* A; const char* B; int pm, pn, e, rows, pl; };

__device__ __forceinline__ int unit_index(int i, int c, int G) { return (G % 8 == 0) ? (i * 8 + (c & 7)) * (G / 8) + (c >> 3) : i * G + c; }

struct DenseSched {
    const char* Abase; const char* Bbase; int nM, nN, K, c, G;
    __device__ __forceinline__ bool next(int i, Unit& u) const {
        const int L = unit_index(i, c, G); if (L >= nM * nN) return false;
        const int nig = 8 * nN, gid = L / nig, fm = gid * 8, gsz = (nM - fm) < 8 ? (nM - fm) : 8, w = L - gid * nig;
        u.pn = w / gsz; u.pm = fm + w % gsz; u.e = 0; u.rows = 256; u.pl = u.pm;
        u.A = Abase + (size_t)u.pm * 256 * K * 2; u.B = Bbase + (size_t)u.pn * 256 * K * 2; return true;
    }
    static constexpr bool GATHER = false;
    __device__ __forceinline__ size_t hstepA() const { return (size_t)128 * K * 2; }
    __device__ __forceinline__ void avoff(const Unit& u, const int (&R)[2], const int (&C)[2], unsigned (&vo)[2][2]) const {
#pragma unroll
        for (int h = 0; h < 2; ++h)
#pragma unroll
            for (int i = 0; i < 2; ++i) vo[h][i] = (unsigned)(R[i] * K + C[i]) * 2u;
    }
};
template <bool GATHER_> struct MoeSched {
    static constexpr bool GATHER = GATHER_;
    __device__ __forceinline__ size_t hstepA() const { return GATHER_ ? (size_t)0 : (size_t)128 * K * 2; }
    const char* Abase; const char* Bbase; size_t Bstride; const int* ltok; const LAS int* ulist; int K;
    __device__ __forceinline__ bool next(int i, Unit& u) const {
        const int w0 = __builtin_amdgcn_readfirstlane(ulist[4 * i]), w1 = __builtin_amdgcn_readfirstlane(ulist[4 * i + 1]), w2 = __builtin_amdgcn_readfirstlane(ulist[4 * i + 2]), w3 = __builtin_amdgcn_readfirstlane(ulist[4 * i + 3]);
        if (w3 == 0) return false;
        u.e = w0 & 255; u.pn = w0 >> 8; u.pl = w1; u.pm = w2; u.rows = w3;
        u.A = GATHER_ ? Abase : Abase + (size_t)u.pm * 256 * K * 2; u.B = Bbase + (size_t)u.e * Bstride + (size_t)u.pn * 256 * K * 2; return true;
    }
    __device__ __forceinline__ void avoff(const Unit& u, const int (&R)[2], const int (&C)[2], unsigned (&vo)[2][2]) const {
#pragma unroll
        for (int h = 0; h < 2; ++h)
#pragma unroll
            for (int i = 0; i < 2; ++i) {
                if (GATHER_) { const int r = h * 128 + R[i]; int tok = 0; if (r < u.rows) tok = ltok[(size_t)u.e * LCAP + u.pl * 256 + r]; vo[h][i] = (unsigned)(tok * K + C[i]) * 2u; }
                else vo[h][i] = (unsigned)(R[i] * K + C[i]) * 2u;
            }
    }
};

typedef f32x4 Acc[2][2][4][2];

template <class Epi, class Sched>
__device__ __forceinline__ void gemm_phase(LAS unsigned char* lds, const int K, const Sched& S, const Epi& E) {
    const int tid = threadIdx.x, wid = __builtin_amdgcn_readfirstlane(tid >> 6), lane = tid & 63, wr = wid >> 2, wc = wid & 3, fr = lane & 15, fq = lane >> 4;
    const int nt = K / BK;
    int RA[2], CA[2]; unsigned voffB[2];
#pragma unroll
    for (int i = 0; i < 2; ++i) { int R, C; stage_rc(tid * 16 + i * 8192, R, C); RA[i] = R; CA[i] = C; const int Rb = (R & ~31) + perm32(R & 31); voffB[i] = (unsigned)(Rb * K + C) * 2u; }
    const size_t kstep = (size_t)(BK * 2);
    const size_t hstepB = (size_t)HALF * K * 2, hstepA = S.hstepA();
    const unsigned ldsw = (unsigned)wid * 1024u;
    const int aoff = lds_byte(wr * 64 + fr, fq * 8), boff = lds_byte(wc * 32 + fr, fq * 8);
#define PG8_SA(b, h) (((b) * 2 + (h)) * HTB)
#define PG8_SB(b, h) ((4 + (b) * 2 + (h)) * HTB)
#define PG8_GL(gptr, ldsoff) __builtin_amdgcn_global_load_lds((const unsigned*)(gptr), (LAS unsigned*)(lds + (ldsoff)), 16, 0, 0)
#define PG8_STAGE_B(bufoff, gbase) do { PG8_GL((const char*)(gbase) + voffB[0], (bufoff) + ldsw); PG8_GL((const char*)(gbase) + voffB[1], (bufoff) + ldsw + 8192); } while (0)
#define PG8_STAGE_A(bufoff, gbase, o0, o1) do { PG8_GL((const char*)(gbase) + (o0), (bufoff) + ldsw); PG8_GL((const char*)(gbase) + (o1), (bufoff) + ldsw + 8192); } while (0)
#define PG8_LDA(dst, b, h) do { _Pragma("unroll") for (int m = 0; m < 4; ++m) _Pragma("unroll") for (int k = 0; k < 2; ++k) dst[m][k] = *(const LAS bf16x8*)(lds + PG8_SA(b, h) + aoff + m * 2048 + k * 1024); } while (0)
#define PG8_LDB(dst, b, h) do { _Pragma("unroll") for (int n = 0; n < 2; ++n) _Pragma("unroll") for (int k = 0; k < 2; ++k) dst[n][k] = *(const LAS bf16x8*)(lds + PG8_SB(b, h) + boff + n * 2048 + k * 1024); } while (0)
#define PG8_MMA(ai, bj, At, Bt) do { __builtin_amdgcn_s_setprio(1); _Pragma("unroll") for (int m = 0; m < 4; ++m) _Pragma("unroll") for (int n = 0; n < 2; ++n) _Pragma("unroll") for (int k = 0; k < 2; ++k) \
        acc[ai][bj][m][n] = __builtin_amdgcn_mfma_f32_16x16x32_bf16(Bt[n][k], At[m][k], acc[ai][bj][m][n], 0, 0, 0); __builtin_amdgcn_s_setprio(0); } while (0)
#define PG8_WAIT_V(n) asm volatile("s_waitcnt vmcnt(" #n ")" ::: "memory")
#define PG8_WAIT_L(n) asm volatile("s_waitcnt lgkmcnt(" #n ")" ::: "memory")
#define PG8_BAR __builtin_amdgcn_s_barrier()
#define PG8_SCHED __builtin_amdgcn_sched_barrier(0)
    Unit cur, nxt; int ui = 0;
    if (!S.next(0, cur)) return;
    unsigned vc[2][2], vn[2][2];
    S.avoff(cur, RA, CA, vc);
    Acc acc;
#pragma unroll
    for (int a = 0; a < 2; ++a)
#pragma unroll
        for (int b = 0; b < 2; ++b)
#pragma unroll
            for (int m = 0; m < 4; ++m)
#pragma unroll
                for (int n = 0; n < 2; ++n) acc[a][b][m][n] = (f32x4){0.f, 0.f, 0.f, 0.f};
    bf16x8 At[4][2], B0[2][2], B1[2][2];
    const char* cA = cur.A; const char* cB = cur.B;
    PG8_STAGE_B(PG8_SB(0, 0), cB); PG8_STAGE_B(PG8_SB(0, 1), cB + hstepB); PG8_STAGE_A(PG8_SA(0, 0), cA, vc[0][0], vc[0][1]); PG8_STAGE_A(PG8_SA(0, 1), cA + hstepA, vc[1][0], vc[1][1]);
    if (wr == 1) PG8_BAR;
    PG8_WAIT_V(2); PG8_BAR;
    PG8_STAGE_B(PG8_SB(1, 0), cB + kstep); PG8_STAGE_A(PG8_SA(1, 0), cA + kstep, vc[0][0], vc[0][1]); PG8_STAGE_B(PG8_SB(1, 1), cB + hstepB + kstep);
    PG8_WAIT_V(6); PG8_BAR;
    for (;;) {
        const bool has_next = S.next(ui + 1, nxt);
        if (Sched::GATHER && has_next) S.avoff(nxt, RA, CA, vn);
        else {
#pragma unroll
            for (int h = 0; h < 2; ++h)
#pragma unroll
                for (int i = 0; i < 2; ++i) vn[h][i] = vc[h][i];
        }
        const char* nA = has_next ? nxt.A : cA; const char* nB = has_next ? nxt.B : cB;
        for (int t = 0; t < nt; t += 2) {
            const bool last = (t == nt - 2);
            const char* a1 = cA + (size_t)(t + 1) * kstep;
            const char* a2 = last ? nA : cA + (size_t)(t + 2) * kstep; const char* b2 = last ? nB : cB + (size_t)(t + 2) * kstep;
            const char* a3 = a2 + kstep; const char* b3 = b2 + kstep;
            const unsigned o00 = last ? vn[0][0] : vc[0][0], o01 = last ? vn[0][1] : vc[0][1], o10 = last ? vn[1][0] : vc[1][0], o11 = last ? vn[1][1] : vc[1][1];
            PG8_LDB(B0, 0, 0); PG8_LDB(B1, 0, 1); PG8_SCHED; PG8_LDA(At, 0, 0); PG8_STAGE_A(PG8_SA(1, 1), a1 + hstepA, vc[1][0], vc[1][1]);
            PG8_WAIT_V(8); PG8_WAIT_L(0); PG8_BAR; PG8_MMA(0, 0, At, B0); PG8_MMA(0, 1, At, B1); PG8_BAR; PG8_SCHED;
            PG8_LDA(At, 0, 1); PG8_STAGE_B(PG8_SB(0, 0), b2); PG8_STAGE_B(PG8_SB(0, 1), b2 + hstepB); PG8_STAGE_A(PG8_SA(0, 0), a2, o00, o01);
            PG8_WAIT_V(8); PG8_WAIT_L(0); PG8_BAR; PG8_MMA(1, 0, At, B0); PG8_MMA(1, 1, At, B1); PG8_BAR; PG8_SCHED;
            PG8_LDB(B0, 1, 0); PG8_LDB(B1, 1, 1); PG8_SCHED; PG8_LDA(At, 1, 0); PG8_STAGE_A(PG8_SA(0, 1), a2 + hstepA, o10, o11);
            PG8_WAIT_V(8); PG8_WAIT_L(0); PG8_BAR; PG8_MMA(0, 0, At, B0); PG8_MMA(0, 1, At, B1); PG8_BAR; PG8_SCHED;
            PG8_LDA(At, 1, 1); PG8_STAGE_B(PG8_SB(1, 0), b3); PG8_STAGE_B(PG8_SB(1, 1), b3 + hstepB); PG8_STAGE_A(PG8_SA(1, 0), a3, o00, o01);
            PG8_WAIT_V(8); PG8_WAIT_L(0); PG8_BAR; PG8_MMA(1, 0, At, B0); PG8_MMA(1, 1, At, B1); PG8_BAR; PG8_SCHED;
        }
        if (wr == 0) PG8_BAR;
        E(acc, cur, wr, wc, fr, fq);
        if (!has_next) break;
#pragma unroll
        for (int a = 0; a < 2; ++a)
#pragma unroll
            for (int b = 0; b < 2; ++b)
#pragma unroll
                for (int m = 0; m < 4; ++m)
#pragma unroll
                    for (int n = 0; n < 2; ++n) acc[a][b][m][n] = (f32x4){0.f, 0.f, 0.f, 0.f};
        cur = nxt; cA = nA; cB = nB; ++ui;
#pragma unroll
        for (int h = 0; h < 2; ++h)
#pragma unroll
            for (int i = 0; i < 2; ++i) vc[h][i] = vn[h][i];
        if (wr == 1) PG8_BAR;
    }
    PG8_WAIT_V(0);
    PG8_BAR;
#undef PG8_SA
#undef PG8_SB
#undef PG8_GL
#undef PG8_STAGE_A
#undef PG8_STAGE_B
#undef PG8_LDA
#undef PG8_LDB
#undef PG8_MMA
#undef PG8_WAIT_V
#undef PG8_WAIT_L
#undef PG8_BAR
#undef PG8_SCHED
}

__device__ __forceinline__ u32x4 pack_row8(const f32x4& v0, const f32x4& v1) { u32x4 w; w.x = cvtpk(v0[0], v0[1]); w.y = cvtpk(v0[2], v0[3]); w.z = cvtpk(v1[0], v1[1]); w.w = cvtpk(v1[2], v1[3]); return w; }
__device__ __forceinline__ void unpack8(const u32x4& w, f32x4& a, f32x4& b) { a = (f32x4){bflo(w.x), bfhi(w.x), bflo(w.y), bfhi(w.y)}; b = (f32x4){bflo(w.z), bfhi(w.z), bflo(w.w), bfhi(w.w)}; }

struct EpiStore {
    bf16_t* O; int ldc;
    __device__ __forceinline__ void operator()(const Acc& acc, const Unit& u, int wr, int wc, int fr, int fq) const {
        const int row0 = u.pm * BM + wr * 64 + fr, col0 = u.pn * BM + wc * 32 + 8 * fq;
#pragma unroll
        for (int ai = 0; ai < 2; ++ai)
#pragma unroll
            for (int m = 0; m < 4; ++m) { bf16_t* rowp = O + (size_t)(row0 + ai * HALF + m * 16) * ldc + col0;
#pragma unroll
                for (int bj = 0; bj < 2; ++bj) *(u32x4*)(rowp + bj * HALF) = pack_row8(acc[ai][bj][m][0], acc[ai][bj][m][1]); }
    }
};
struct EpiResid {
    bf16_t* O; const bf16_t* X;
    __device__ __forceinline__ void operator()(const Acc& acc, const Unit& u, int wr, int wc, int fr, int fq) const {
        const int row0 = u.pm * BM + wr * 64 + fr, col0 = u.pn * BM + wc * 32 + 8 * fq;
#pragma unroll
        for (int ai = 0; ai < 2; ++ai)
#pragma unroll
            for (int m = 0; m < 4; ++m) { const size_t off = (size_t)(row0 + ai * HALF + m * 16) * DM + col0;
#pragma unroll
                for (int bj = 0; bj < 2; ++bj) { const u32x4 xw = *(const u32x4*)(X + off + bj * HALF); f32x4 xa, xb; unpack8(xw, xa, xb);
                    *(u32x4*)(O + off + bj * HALF) = pack_row8(xa * ALPHA + acc[ai][bj][m][0], xb * ALPHA + acc[ai][bj][m][1]); } }
    }
};
struct EpiAct {
    bf16_t* O; const float* bgu;
    __device__ __forceinline__ void operator()(const Acc& acc, const Unit& u, int wr, int wc, int fr, int fq) const {
        const int cl = u.pn * HALF + wc * 32 + 8 * fq;
        const float* bg = bgu + (size_t)u.e * 2048 + cl; const float* bu = bg + 1024;
#pragma unroll
        for (int ai = 0; ai < 2; ++ai)
#pragma unroll
            for (int m = 0; m < 4; ++m) { const int rl = ai * HALF + wr * 64 + m * 16 + fr;
                f32x4 o[2];
#pragma unroll
                for (int n = 0; n < 2; ++n) { const f32x4 hg = acc[ai][0][m][n] + *(const f32x4*)(bg + 4 * n), hu = acc[ai][1][m][n] + *(const f32x4*)(bu + 4 * n);
#pragma unroll
                    for (int j = 0; j < 4; ++j) { const float g = fminf(hg[j], 7.f), up = fminf(fmaxf(hu[j], -7.f), 7.f); o[n][j] = (up + 1.f) * (g * sigm(1.702f * g)); } }
                if (rl < u.rows) *(u32x4*)(O + (size_t)(u.pm * BM + rl) * DM + cl) = pack_row8(o[0], o[1]); }
    }
};
struct EpiDown {
    bf16_t* O; const float* bd; const float* lgate;
    __device__ __forceinline__ void operator()(const Acc& acc, const Unit& u, int wr, int wc, int fr, int fq) const {
        const int col0 = u.pn * BM + wc * 32 + 8 * fq;
        const float* bp = bd + (size_t)u.e * DM + col0;
#pragma unroll
        for (int ai = 0; ai < 2; ++ai)
#pragma unroll
            for (int m = 0; m < 4; ++m) { const int rl = ai * HALF + wr * 64 + m * 16 + fr;
                if (rl < u.rows) { const float gt = lgate[(size_t)u.e * LCAP + u.pl * BM + rl]; bf16_t* rowp = O + (size_t)(u.pm * BM + rl) * DM + col0;
#pragma unroll
                    for (int bj = 0; bj < 2; ++bj) *(u32x4*)(rowp + bj * HALF) = pack_row8((acc[ai][bj][m][0] + *(const f32x4*)(bp + bj * HALF)) * gt, (acc[ai][bj][m][1] + *(const f32x4*)(bp + bj * HALF + 4)) * gt); } }
    }
};
struct EpiSig {
    bf16_t* O; const float* bias;
    __device__ __forceinline__ void operator()(const Acc& acc, const Unit& u, int wr, int wc, int fr, int fq) const {
        const int row0 = u.pm * BM + wr * 64 + fr, col0 = u.pn * BM + wc * 32 + 8 * fq;
        f32x4 bv[2][2];
#pragma unroll
        for (int bj = 0; bj < 2; ++bj)
#pragma unroll
            for (int n = 0; n < 2; ++n) bv[bj][n] = *(const f32x4*)(bias + col0 + bj * HALF + 4 * n);
#pragma unroll
        for (int ai = 0; ai < 2; ++ai)
#pragma unroll
            for (int m = 0; m < 4; ++m) { bf16_t* rowp = O + (size_t)(row0 + ai * HALF + m * 16) * DM + col0;
#pragma unroll
                for (int bj = 0; bj < 2; ++bj) { f32x4 a = acc[ai][bj][m][0] + bv[bj][0], b = acc[ai][bj][m][1] + bv[bj][1];
#pragma unroll
                    for (int j = 0; j < 4; ++j) { a[j] = sigm(a[j]); b[j] = sigm(b[j]); }
                    *(u32x4*)(rowp + bj * HALF) = pack_row8(a, b); } }
    }
};
struct EpiMul {
    bf16_t* O;
    __device__ __forceinline__ void operator()(const Acc& acc, const Unit& u, int wr, int wc, int fr, int fq) const {
        const int row0 = u.pm * BM + wr * 64 + fr, col0 = u.pn * BM + wc * 32 + 8 * fq;
#pragma unroll
        for (int ai = 0; ai < 2; ++ai)
#pragma unroll
            for (int m = 0; m < 4; ++m) { bf16_t* rowp = O + (size_t)(row0 + ai * HALF + m * 16) * DM + col0;
#pragma unroll
                for (int bj = 0; bj < 2; ++bj) { const u32x4 gw = *(const u32x4*)(rowp + bj * HALF); f32x4 ga, gb; unpack8(gw, ga, gb);
                    *(u32x4*)(rowp + bj * HALF) = pack_row8(ga * acc[ai][bj][m][0], gb * acc[ai][bj][m][1]); } }
    }
};
}

struct Args { const float* in[21]; float* out; unsigned char* ws; int ph_lo, ph_hi; };
struct Frame {
    unsigned char* lds; int tid, lane, wave, G, blk;
    const float *x, *p, *w_in, *conv_w, *a_log, *dt_bias, *gnorm_w, *w_out, *ln1_g, *ln1_b, *w_router, *b_router, *w_gate_up, *b_gate_up, *w_down, *b_down, *w_ple_gate, *b_ple_gate, *w_ple_proj, *ln2_g, *ln2_b;
    float* out; unsigned char* ws;
};
#define WSP(T, off) ((T*)(F.ws + (off)))

__device__ __forceinline__ void p0_transpose_item(const float* W, int ldn, int k0, int n0, bf16_t* WT, int Kd, int drow0, float* scr, int lane) {
#pragma unroll 8
    for (int i = 0; i < 32; ++i) { const int kk = 2 * i + (lane >> 5); scr[kk * 33 + (lane & 31)] = W[(size_t)(k0 + kk) * ldn + n0 + (lane & 31)]; }
    asm volatile("s_waitcnt lgkmcnt(0)" ::: "memory");
    const int c = lane & 7;
#pragma unroll
    for (int j = 0; j < 4; ++j) { const int n = (lane >> 3) + 8 * j; const float* s = scr + (8 * c) * 33 + n;
        u32x4 o; o.x = cvtpk(s[0 * 33], s[1 * 33]); o.y = cvtpk(s[2 * 33], s[3 * 33]); o.z = cvtpk(s[4 * 33], s[5 * 33]); o.w = cvtpk(s[6 * 33], s[7 * 33]);
        *(u32x4*)(WT + (size_t)(drow0 + n) * Kd + k0 + 8 * c) = o; }
    asm volatile("s_waitcnt lgkmcnt(0)" ::: "memory");
}
__device__ __forceinline__ void phase0(const Frame& F) {
    float* scr = (float*)(F.lds + F.wave * 8448);
    float* wba = (float*)(F.lds + 69632);
    for (int i = F.tid; i < 8192; i += NTHREADS) wba[i] = F.w_in[(size_t)(i >> 3) * INCOLS + HPW + (i & 7)];
    __syncthreads();
    const int gw = F.blk * NWAVES + F.wave, NGW = F.G * NWAVES, lane = F.lane;
    constexpr int I_IN = 16 * 112, I_OUT = 16 * 32, I_PG = 16 * 32, I_PP = 4 * 32, I_GU = NEXP * 16 * 64, I_D = NEXP * 16 * 32;
    constexpr int NITEMS = I_IN + I_OUT + I_PG + I_PP + I_GU + I_D;
    for (int it = gw; it < NITEMS; it += NGW) {
        int r = it;
        if (r < I_IN) { const int kb = r / 112, nb = r % 112; p0_transpose_item(F.w_in, INCOLS, 64 * kb, 32 * nb, WSP(bf16_t, WS_WIN), 1024, 32 * nb, scr, lane); continue; } r -= I_IN;
        if (r < I_OUT) { const int kb = r / 32, nb = r % 32; p0_transpose_item(F.w_out, 1024, 64 * kb, 32 * nb, WSP(bf16_t, WS_WOUT), 1024, 32 * nb, scr, lane); continue; } r -= I_OUT;
        if (r < I_PG) { const int kb = r / 32, nb = r % 32; p0_transpose_item(F.w_ple_gate, 1024, 64 * kb, 32 * nb, WSP(bf16_t, WS_WPG), 1024, 32 * nb, scr, lane); continue; } r -= I_PG;
        if (r < I_PP) { const int kb = r / 32, nb = r % 32; p0_transpose_item(F.w_ple_proj, 1024, 64 * kb, 32 * nb, WSP(bf16_t, WS_WPP), 256, 32 * nb, scr, lane); continue; } r -= I_PP;
        if (r < I_GU) { const int e = r / 1024, q = r % 1024, kb = q / 64, nb = q % 64, n0 = 32 * nb;
            const int j0 = n0 & 1023, drow0 = 256 * (j0 >> 7) + (j0 & 127) + ((n0 >= 1024) ? 128 : 0);
            p0_transpose_item(F.w_gate_up + (size_t)e * 1024 * 2048, 2048, 64 * kb, n0, WSP(bf16_t, WS_WGU) + (size_t)e * 2048 * 1024, 1024, drow0, scr, lane); continue; } r -= I_GU;
        { const int e = r / 512, q = r % 512, kb = q / 32, nb = q % 32;
            p0_transpose_item(F.w_down + (size_t)e * 1024 * 1024, 1024, 64 * kb, 32 * nb, WSP(bf16_t, WS_WD) + (size_t)e * 1024 * 1024, 1024, 32 * nb, scr, lane); }
    }
    { float* wrt = WSP(float, WS_WRT); for (int i = F.blk * NTHREADS + F.tid; i < 32768; i += F.G * NTHREADS) wrt[(i & 31) * 1024 + (i >> 5)] = F.w_router[i]; }
    { const f32x4* src = (const f32x4*)F.p; u32x2* dst = WSP(u32x2, WS_PB);
        for (int i = F.blk * NTHREADS + F.tid; i < T_TOK * 256 / 4; i += F.G * NTHREADS) { const f32x4 v = src[i]; u32x2 w; w.x = cvtpk(v[0], v[1]); w.y = cvtpk(v[2], v[3]); dst[i] = w; } }
    bf16_t* XB = WSP(bf16_t, WS_XB); float* BA = WSP(float, WS_BA);
    for (int row = gw; row < T_TOK; row += NGW) {
        const f32x4* xr = (const f32x4*)(F.x + (size_t)row * DM) + lane;
        f32x4 v[4];
#pragma unroll
        for (int j = 0; j < 4; ++j) v[j] = xr[64 * j];
        u32x2* o8 = (u32x2*)(XB + (size_t)row * DM) + lane;
#pragma unroll
        for (int j = 0; j < 4; ++j) { u32x2 w; w.x = cvtpk(v[j][0], v[j][1]); w.y = cvtpk(v[j][2], v[j][3]); o8[64 * j] = w; }
        float a8[8];
#pragma unroll
        for (int q = 0; q < 8; ++q) a8[q] = 0.f;
#pragma unroll
        for (int j = 0; j < 4; ++j)
#pragma unroll
            for (int i = 0; i < 4; ++i) { const float* wr_ = wba + (4 * lane + 256 * j + i) * 8; const f32x4 w0 = *(const f32x4*)wr_, w1 = *(const f32x4*)(wr_ + 4); const float xv = v[j][i];
                a8[0] += xv * w0[0]; a8[1] += xv * w0[1]; a8[2] += xv * w0[2]; a8[3] += xv * w0[3]; a8[4] += xv * w1[0]; a8[5] += xv * w1[1]; a8[6] += xv * w1[2]; a8[7] += xv * w1[3]; }
#pragma unroll
        for (int q = 0; q < 8; ++q) a8[q] = wave_sum(a8[q]);
        if (lane < 8) { float r = a8[0];
#pragma unroll
            for (int q = 1; q < 8; ++q) r = (lane == q) ? a8[q] : r;
            BA[(size_t)row * 8 + lane] = r; }
    }
}

constexpr int QS = 132;
__device__ __forceinline__ void dn_prep_unit(const Frame& F, int ch) {
    int tid = F.tid; asm volatile("" : "+v"(tid));
    const int b = ch >> 7, h = (ch >> 5) & 3, n = ch & 31;
    float* qs = (float*)F.lds; float* ks = qs + 64 * QS; float* vs = ks + 64 * QS; float* Am = vs + 64 * QS;
    float* beta_s = Am + 4096; float* gc_s = beta_s + 64; float* egc_s = gc_s + 64; float* begc_s = egc_s + 64;
    const bf16_t* HP = WSP(const bf16_t, WS_HP);
    const int t0 = 64 * n; const size_t rowb = (size_t)b * SEQ;
#pragma unroll 1
    for (int it = 0; it < 6; ++it) {
        const int idx = it * NTHREADS + tid;
        const int c3 = idx >> 10, rem = idx & 1023, i = rem >> 4, d0 = (rem & 15) * 8;
        const int chn = c3 * 512 + h * 128 + d0;
        float accv[8];
#pragma unroll
        for (int q = 0; q < 8; ++q) accv[q] = 0.f;
#pragma unroll
        for (int j = 0; j < 4; ++j) { const int t = t0 + i - 3 + j;
            if (t >= 0) { const u32x4 w = *(const u32x4*)(HP + (rowb + t) * HPW + 1536 + chn); f32x4 xa, xb; pg8::unpack8(w, xa, xb);
                const f32x4 ca = *(const f32x4*)(F.conv_w + (size_t)j * 1536 + chn), cb = *(const f32x4*)(F.conv_w + (size_t)j * 1536 + chn + 4);
#pragma unroll
                for (int q = 0; q < 4; ++q) { accv[q] += xa[q] * ca[q]; accv[4 + q] += xb[q] * cb[q]; } } }
        float* dst = (c3 == 0 ? qs : (c3 == 1 ? ks : vs)) + i * QS + d0;
#pragma unroll
        for (int q = 0; q < 8; ++q) dst[q] = accv[q] * sigm(accv[q]);
    }
    if (tid < 64) {
        const float* BA = WSP(const float, WS_BA) + (rowb + t0 + tid) * 8;
        const float bl = BA[h], al = BA[4 + h] + F.dt_bias[h];
        const float sp = fmaxf(al, 0.f) + log1pf(__expf(-fabsf(al)));
        float g = -__expf(F.a_log[h]) * sp;
#pragma unroll
        for (int o = 1; o < 64; o <<= 1) { const float up = __shfl_up(g, o); if (tid >= o) g += up; }
        beta_s[tid] = sigm(bl); gc_s[tid] = g; egc_s[tid] = __expf(g); begc_s[tid] = sigm(bl) * __expf(g);
        if (tid == 63) WSP(float, WS_EG)[ch] = __expf(g);
    }
    __syncthreads();
    { const int row = tid >> 2, part = tid & 3; float* base = (row < 64 ? qs + row * QS : ks + (row - 64) * QS) + part * 32;
        float ss = 0.f;
#pragma unroll
        for (int q = 0; q < 32; ++q) ss += base[q] * base[q];
        ss += __shfl_xor(ss, 1); ss += __shfl_xor(ss, 2);
        const float sc = rsqrtf(ss + 1e-6f) * (row < 64 ? 0.08838834764831845f : 1.f);
#pragma unroll
        for (int q = 0; q < 32; ++q) base[q] *= sc; }
    __syncthreads();
    unsigned char* dnb = F.ws + WS_DN + (size_t)ch * DN_STRIDE;
    { const int sel = tid >> 8, ib = (tid & 255) >> 4, jb = tid & 15;
        const float* ar = (sel ? qs : ks) + 4 * ib * QS; const float* br = ks + 4 * jb * QS;
        float c[4][4];
#pragma unroll
        for (int r = 0; r < 4; ++r)
#pragma unroll
            for (int q = 0; q < 4; ++q) c[r][q] = 0.f;
#pragma unroll 4
        for (int d = 0; d < 128; d += 4) { f32x4 a[4], bb[4];
#pragma unroll
            for (int r = 0; r < 4; ++r) { a[r] = *(const f32x4*)(ar + r * QS + d); bb[r] = *(const f32x4*)(br + r * QS + d); }
#pragma unroll
            for (int r = 0; r < 4; ++r)
#pragma unroll
                for (int q = 0; q < 4; ++q) c[r][q] += a[r][0] * bb[q][0] + a[r][1] * bb[q][1] + a[r][2] * bb[q][2] + a[r][3] * bb[q][3]; }
        bf16_t* AT = (bf16_t*)(dnb + DN_AT);
#pragma unroll
        for (int r = 0; r < 4; ++r)
#pragma unroll
            for (int q = 0; q < 4; ++q) { const int i = 4 * ib + r, j = 4 * jb + q; const float dec = __expf(fminf(gc_s[i] - gc_s[j], 0.f));
                if (sel == 0) Am[i * 64 + j] = (j < i) ? beta_s[i] * c[r][q] * dec : 0.f;
                else AT[i * 64 + kperm(j)] = f2bf((j <= i) ? c[r][q] * dec : 0.f); } }
    __syncthreads();
    if (tid < 256) {
        const int c = tid; float sol[64];
        int z; asm volatile("v_mov_b32 %0, 0" : "=v"(z));
        const float* Amz = Am + z;
        const bool isw = c >= 128; const float* src = isw ? (ks + (c - 128)) : (vs + c); const float* mulp = isw ? begc_s : beta_s;
#pragma unroll
        for (int i = 0; i < 64; ++i) sol[i] = 0.f;
#pragma unroll
        for (int i = 0; i < 64; ++i) {
            float a0 = src[i * QS] * mulp[i], a1 = 0.f;
#pragma unroll
            for (int jc = 0; jc < (i + 3) / 4; ++jc) { const f32x4 w = *(const f32x4*)(Amz + i * 64 + 4 * jc);
                a0 -= w[0] * sol[4 * jc]; a1 -= w[1] * sol[4 * jc + 1]; a0 -= w[2] * sol[4 * jc + 2]; a1 -= w[3] * sol[4 * jc + 3]; }
            sol[i] = a0 + a1;
            asm volatile("" : "+v"(sol[i]) :: "memory");
        }
        if (c < 128) { float* U = (float*)(dnb + DN_U);
#pragma unroll
            for (int i = 0; i < 64; ++i) U[i * 128 + c] = sol[i]; }
        else { bf16_t* WN = (bf16_t*)(dnb + DN_WN); const int pc = kperm(c - 128);
#pragma unroll
            for (int i = 0; i < 64; ++i) WN[i * 128 + pc] = f2bf(-sol[i]); }
    } else {
        const int t2 = tid - 256; bf16_t* QD = (bf16_t*)(dnb + DN_QD); bf16_t* KD = (bf16_t*)(dnb + DN_KD);
        const float glast = gc_s[63];
#pragma unroll 1
        for (int it = 0; it < 4; ++it) { const int idx = it * 256 + t2;
            const int i = idx >> 4, p0 = (idx & 15) * 8; float v[8]; const float e = egc_s[i];
#pragma unroll
            for (int q = 0; q < 8; ++q) v[q] = qs[i * QS + kperm(p0 + q)] * e;
            u32x4 w; w.x = cvtpk(v[0], v[1]); w.y = cvtpk(v[2], v[3]); w.z = cvtpk(v[4], v[5]); w.w = cvtpk(v[6], v[7]);
            *(u32x4*)(QD + i * 128 + p0) = w; }
#pragma unroll 1
        for (int it = 0; it < 4; ++it) { const int idx = it * 256 + t2;
            const int d = idx >> 3, p0 = (idx & 7) * 8; float v[8];
#pragma unroll
            for (int q = 0; q < 8; ++q) { const int i = kperm(p0 + q); v[q] = ks[i * QS + d] * __expf(glast - gc_s[i]); }
            u32x4 w; w.x = cvtpk(v[0], v[1]); w.y = cvtpk(v[2], v[3]); w.z = cvtpk(v[4], v[5]); w.w = cvtpk(v[6], v[7]);
            *(u32x4*)(KD + d * 64 + p0) = w; }
    }
    __syncthreads();
}
__device__ __forceinline__ void vt_unit(const Frame& F, int u) {
    int tid = F.tid; asm volatile("" : "+v"(tid));
    const int bh = u >> 3, s0 = (u & 7) * 256, b = bh >> 3, h = bh & 7;
    bf16_t* vt = (bf16_t*)F.lds;
    const bf16_t* HP = WSP(const bf16_t, WS_HP);
#pragma unroll
    for (int it = 0; it < 4; ++it) { const int idx = it * NTHREADS + tid, r = idx >> 3, c8 = (idx & 7) * 8;
        *(u32x4*)(vt + r * 72 + c8) = *(const u32x4*)(HP + ((size_t)b * SEQ + s0 + r) * HPW + 1024 + h * 64 + c8); }
    __syncthreads();
#pragma unroll
    for (int di = 0; di < 3; ++di) { const int d = (di == 0) ? 1 : (di == 1 ? 4 : 16), L = SEQ / d;
        bf16_t* dstb = WSP(bf16_t, WS_VT) + (size_t)di * (T_TOK * 512) + (size_t)bh * d * 64 * L;
#pragma unroll
        for (int it = 0; it < 4; ++it) { const int idx = it * NTHREADS + tid;
            const int nch = 32 / d, c = idx / (64 * nch), rem = idx % (64 * nch), e = rem / nch, k8 = (rem % nch) * 8;
            unsigned w[4];
#pragma unroll
            for (int q = 0; q < 4; ++q) { const unsigned lo = vt[(c + d * (k8 + 2 * q)) * 72 + e], hi2 = vt[(c + d * (k8 + 2 * q + 1)) * 72 + e]; w[q] = lo | (hi2 << 16); }
            *(u32x4*)(dstb + ((size_t)c * 64 + e) * L + s0 / d + k8) = (u32x4){w[0], w[1], w[2], w[3]}; } }
    __syncthreads();
}

#define MFMA32(a, b, c) __builtin_amdgcn_mfma_f32_32x32x16_bf16((a), (b), (c), 0, 0, 0)
__device__ __forceinline__ void scan_unit(const Frame& F, int u) {
    const int lane = F.lane, r32 = lane & 31, hi = lane >> 5;
    const int b = u >> 4, h = (u >> 2) & 3, sl = u & 3;
    f32x16 S[4];
#pragma unroll
    for (int mt = 0; mt < 4; ++mt)
#pragma unroll
        for (int r = 0; r < 16; ++r) S[mt][r] = 0.f;
    bf16_t* ORAW = WSP(bf16_t, WS_ORAW);
#pragma unroll 1
    for (int n = 0; n < 32; ++n) {
        const int ch = (b * 4 + h) * 32 + n;
        const unsigned char* dnb = F.ws + WS_DN + (size_t)ch * DN_STRIDE;
        const bf16_t* WN = (const bf16_t*)(dnb + DN_WN); const bf16_t* QD = (const bf16_t*)(dnb + DN_QD); const bf16_t* AT = (const bf16_t*)(dnb + DN_AT); const bf16_t* KD = (const bf16_t*)(dnb + DN_KD);
        const float* U = (const float*)(dnb + DN_U); const float eg = WSP(const float, WS_EG)[ch];
        bf16x8 Sb[8];
#pragma unroll
        for (int mt = 0; mt < 4; ++mt) { Sb[2 * mt] = pack8(S[mt], 0); Sb[2 * mt + 1] = pack8(S[mt], 8); }
        f32x16 vn[2];
#pragma unroll
        for (int m2 = 0; m2 < 2; ++m2)
#pragma unroll
            for (int r = 0; r < 16; ++r) vn[m2][r] = U[(32 * m2 + crow(r, hi)) * 128 + 32 * sl + r32];
#pragma unroll
        for (int m2 = 0; m2 < 2; ++m2)
#pragma unroll
            for (int s = 0; s < 8; ++s) { const bf16x8 a = *(const bf16x8*)(WN + (32 * m2 + r32) * 128 + 16 * s + 8 * hi); vn[m2] = MFMA32(a, Sb[s], vn[m2]); }
        bf16x8 vb[4];
#pragma unroll
        for (int m2 = 0; m2 < 2; ++m2) { vb[2 * m2] = pack8(vn[m2], 0); vb[2 * m2 + 1] = pack8(vn[m2], 8); }
        f32x16 o[2];
#pragma unroll
        for (int m2 = 0; m2 < 2; ++m2) {
#pragma unroll
            for (int r = 0; r < 16; ++r) o[m2][r] = 0.f;
#pragma unroll
            for (int s = 0; s < 8; ++s) { const bf16x8 a = *(const bf16x8*)(QD + (32 * m2 + r32) * 128 + 16 * s + 8 * hi); o[m2] = MFMA32(a, Sb[s], o[m2]); }
#pragma unroll
            for (int s = 0; s < 4; ++s) { const bf16x8 a = *(const bf16x8*)(AT + (32 * m2 + r32) * 64 + 16 * s + 8 * hi); o[m2] = MFMA32(a, vb[s], o[m2]); }
        }
#pragma unroll
        for (int m2 = 0; m2 < 2; ++m2)
#pragma unroll
            for (int r = 0; r < 16; ++r) ORAW[((size_t)b * SEQ + 64 * n + 32 * m2 + crow(r, hi)) * 512 + h * 128 + 32 * sl + r32] = f2bf(o[m2][r]);
#pragma unroll
        for (int mt = 0; mt < 4; ++mt) {
#pragma unroll
            for (int r = 0; r < 16; ++r) S[mt][r] *= eg;
#pragma unroll
            for (int s = 0; s < 4; ++s) { const bf16x8 a = *(const bf16x8*)(KD + (32 * mt + r32) * 64 + 16 * s + 8 * hi); S[mt] = MFMA32(a, vb[s], S[mt]); }
        }
    }
}
template <int D_>
__device__ __forceinline__ void attn_branch(const Frame& F, int di, int b, int h, int t0, int jq, const bf16x8 (&qr)[4], f32x16 (&o)[2], float& m_run, float& l_run) {
    const int lane = F.lane, r32 = lane & 31, hi = lane >> 5;
    constexpr int L = SEQ / D_, STEP = 16 / D_;
    const int c = t0 % D_, a0 = t0 / D_;
    const int nq = a0 + STEP * (32 * jq + r32);
    const int nq_lo = a0 + STEP * (32 * jq), nq_hi = a0 + STEP * (32 * jq + 31);
    const int n_lo = (nq_lo - 128) > 0 ? (nq_lo - 128) : 0;
    const bf16_t* HP = WSP(const bf16_t, WS_HP);
    const bf16_t* Kb = HP + ((size_t)b * SEQ + c) * HPW + 512 + h * 64 + 8 * hi;
    const bf16_t* VT = WSP(const bf16_t, WS_VT) + (size_t)di * (T_TOK * 512) + ((size_t)((b * 8 + h) * D_ + c) * 64 + r32) * L;
    constexpr float SC = 0.125f * 1.4426950408889634f;
#pragma unroll 1
    for (int nb = n_lo >> 5; nb <= (nq_hi >> 5); ++nb) {
        f32x16 s;
#pragma unroll
        for (int r = 0; r < 16; ++r) s[r] = 0.f;
        const bf16_t* kp = Kb + (size_t)(D_ * (32 * nb + r32)) * HPW;
#pragma unroll
        for (int d0 = 0; d0 < 4; ++d0) { const bf16x8 kf = *(const bf16x8*)(kp + 16 * d0); s = MFMA32(kf, qr[d0], s); }
        float mb = -INFINITY;
#pragma unroll
        for (int r = 0; r < 16; ++r) { const int n = 32 * nb + crow(r, hi); const bool ok = (n <= nq) && (n >= nq - 128); s[r] = ok ? s[r] * SC : -INFINITY; mb = fmaxf(mb, s[r]); }
        mb = fmaxf(mb, __shfl_xor(mb, 32));
        const float mn = fmaxf(m_run, mb), al = exp2f(m_run - mn);
        float ps = 0.f;
#pragma unroll
        for (int r = 0; r < 16; ++r) { s[r] = exp2f(s[r] - mn); ps += s[r]; }
        l_run = l_run * al + ps; m_run = mn;
#pragma unroll
        for (int eb = 0; eb < 2; ++eb)
#pragma unroll
            for (int r = 0; r < 16; ++r) o[eb][r] *= al;
        const bf16x8 pb0 = pack8(s, 0), pb1 = pack8(s, 8);
#pragma unroll
        for (int eb = 0; eb < 2; ++eb)
#pragma unroll
            for (int ks = 0; ks < 2; ++ks) { const bf16_t* vp = VT + (size_t)eb * 32 * L + 32 * nb + 16 * ks + 4 * hi;
                const u32x2 lo = *(const u32x2*)vp, hi2 = *(const u32x2*)(vp + 8);
                const bf16x8 vf = __builtin_bit_cast(bf16x8, (u32x4){lo.x, lo.y, hi2.x, hi2.y});
                o[eb] = MFMA32(vf, ks ? pb1 : pb0, o[eb]); }
    }
}
__device__ __forceinline__ void attn_task(const Frame& F, int a) {
    const int lane = F.lane, r32 = lane & 31, hi = lane >> 5;
    const int jq = 3 - (a >> 11), rem = a & 2047, bh = rem >> 4, t0 = rem & 15, b = bh >> 3, h = bh & 7;
    const int tq = t0 + 16 * (32 * jq + r32);
    const bf16_t* HP = WSP(const bf16_t, WS_HP);
    bf16x8 qr[4];
#pragma unroll
    for (int d0 = 0; d0 < 4; ++d0) qr[d0] = *(const bf16x8*)(HP + ((size_t)b * SEQ + tq) * HPW + h * 64 + 16 * d0 + 8 * hi);
    f32x16 o[2];
#pragma unroll
    for (int eb = 0; eb < 2; ++eb)
#pragma unroll
        for (int r = 0; r < 16; ++r) o[eb][r] = 0.f;
    float m_run = -1e30f, l_run = 0.f;
    attn_branch<1>(F, 0, b, h, t0, jq, qr, o, m_run, l_run);
    attn_branch<4>(F, 1, b, h, t0, jq, qr, o, m_run, l_run);
    attn_branch<16>(F, 2, b, h, t0, jq, qr, o, m_run, l_run);
    const float lt = l_run + __shfl_xor(l_run, 32), inv = 1.f / lt;
    bf16_t* dst = WSP(bf16_t, WS_MIX) + ((size_t)b * SEQ + tq) * DM + h * 64;
#pragma unroll
    for (int eb = 0; eb < 2; ++eb)
#pragma unroll
        for (int g = 0; g < 4; ++g) { u32x2 w; w.x = cvtpk(o[eb][4 * g] * inv, o[eb][4 * g + 1] * inv); w.y = cvtpk(o[eb][4 * g + 2] * inv, o[eb][4 * g + 3] * inv);
            *(u32x2*)(dst + 32 * eb + 8 * g + 4 * hi) = w; }
}
__device__ __forceinline__ void phase3(const Frame& F) {
    if (F.wave == 0) for (int u = F.blk; u < 256; u += F.G) scan_unit(F, u);
    unsigned* ctr = WSP(unsigned, WS_CTL) + 64;
    for (;;) {
        unsigned a = 0; if (F.lane == 0) a = atomicAdd(ctr, 1u);
        a = (unsigned)__builtin_amdgcn_readfirstlane((int)a);
        if (a >= 8192u) break;
        attn_task(F, (int)a);
    }
}

__device__ __forceinline__ void phase4(const Frame& F) {
    const int gw = F.blk * NWAVES + F.wave, NGW = F.G * NWAVES, lane = F.lane;
    const bf16_t* ORAW = WSP(const bf16_t, WS_ORAW); const bf16_t* HP = WSP(const bf16_t, WS_HP); bf16_t* MIX = WSP(bf16_t, WS_MIX);
    const f32x4 gw0 = *(const f32x4*)(F.gnorm_w + (lane & 15) * 8), gw1 = *(const f32x4*)(F.gnorm_w + (lane & 15) * 8 + 4);
    for (int row = gw; row < T_TOK; row += NGW) {
        const u32x4 ow = *(const u32x4*)(ORAW + (size_t)row * 512 + lane * 8), zw = *(const u32x4*)(HP + (size_t)row * HPW + 3072 + lane * 8);
        f32x4 oa, ob, za, zb; pg8::unpack8(ow, oa, ob); pg8::unpack8(zw, za, zb);
        float ss = oa[0] * oa[0] + oa[1] * oa[1] + oa[2] * oa[2] + oa[3] * oa[3] + ob[0] * ob[0] + ob[1] * ob[1] + ob[2] * ob[2] + ob[3] * ob[3];
        ss += __shfl_xor(ss, 1); ss += __shfl_xor(ss, 2); ss += __shfl_xor(ss, 4); ss += __shfl_xor(ss, 8);
        const float r = rsqrtf(ss * (1.f / 128.f) + 1e-6f);
        f32x4 ya, yb;
#pragma unroll
        for (int j = 0; j < 4; ++j) { ya[j] = oa[j] * r * gw0[j] * (za[j] * sigm(za[j])); yb[j] = ob[j] * r * gw1[j] * (zb[j] * sigm(zb[j])); }
        *(u32x4*)(MIX + (size_t)row * DM + 512 + lane * 8) = pg8::pack_row8(ya, yb);
    }
}

__device__ __forceinline__ void phase6(const Frame& F) {
    float* wrt = (float*)F.lds;
    { const f32x4* src = WSP(const f32x4, WS_WRT); f32x4* dst = (f32x4*)wrt; for (int i = F.tid; i < 8192; i += NTHREADS) dst[i] = src[i]; }
    __syncthreads();
    const int gw = F.blk * NWAVES + F.wave, NGW = F.G * NWAVES, lane = F.lane;
    bf16_t* X1 = WSP(bf16_t, WS_X1);
    unsigned* cnt = WSP(unsigned, WS_CTL); int* rt_e = WSP(int, WS_ROUTE); int* rt_s = rt_e + T_TOK * 4; int* ltok = WSP(int, WS_LTOK); float* lgate = WSP(float, WS_LGATE);
    f32x4 lg[4], lb[4];
#pragma unroll
    for (int j = 0; j < 4; ++j) { lg[j] = *(const f32x4*)(F.ln1_g + 4 * lane + 256 * j); lb[j] = *(const f32x4*)(F.ln1_b + 4 * lane + 256 * j); }
    const float brl = F.b_router[((lane >> 5) & 1) * 16 + ((lane >> 4) & 1) * 8 + ((lane >> 3) & 1) * 4 + ((lane >> 2) & 1) * 2 + ((lane >> 1) & 1)];
    for (int row = gw; row < T_TOK; row += NGW) {
        u32x2* xr = (u32x2*)(X1 + (size_t)row * DM) + lane;
        f32x4 v[4]; float s = 0.f;
#pragma unroll
        for (int j = 0; j < 4; ++j) { const u32x2 w = xr[64 * j]; v[j] = (f32x4){bflo(w.x), bfhi(w.x), bflo(w.y), bfhi(w.y)}; s += (v[j][0] + v[j][1]) + (v[j][2] + v[j][3]); }
        const float mean = wave_sum(s) * (1.f / DM); float s2 = 0.f;
#pragma unroll
        for (int j = 0; j < 4; ++j) { v[j] = v[j] - mean; s2 += (v[j][0] * v[j][0] + v[j][1] * v[j][1]) + (v[j][2] * v[j][2] + v[j][3] * v[j][3]); }
        const float rstd = rsqrtf(wave_sum(s2) * (1.f / DM) + LN_EPS);
#pragma unroll
        for (int j = 0; j < 4; ++j) { v[j] = v[j] * rstd * lg[j] + lb[j]; u32x2 w; w.x = cvtpk(v[j][0], v[j][1]); w.y = cvtpk(v[j][2], v[j][3]); xr[64 * j] = w; }
        float pl[32];
#pragma unroll
        for (int e = 0; e < 32; ++e) { float a = 0.f;
#pragma unroll
            for (int j = 0; j < 4; ++j) { const f32x4 w = *(const f32x4*)(wrt + e * 1024 + 4 * lane + 256 * j); a += v[j][0] * w[0] + v[j][1] * w[1] + v[j][2] * w[2] + v[j][3] * w[3]; }
            pl[e] = a; if ((e & 3) == 3) asm volatile("" ::: "memory"); }
        float q16[16], q8[8], q4[4], q2[2];
        { const bool up = (lane & 32) != 0;
#pragma unroll
            for (int k = 0; k < 16; ++k) { const float keep = up ? pl[k + 16] : pl[k], send = up ? pl[k] : pl[k + 16]; q16[k] = keep + __shfl_xor(send, 32); } }
        { const bool up = (lane & 16) != 0;
#pragma unroll
            for (int k = 0; k < 8; ++k) { const float keep = up ? q16[k + 8] : q16[k], send = up ? q16[k] : q16[k + 8]; q8[k] = keep + __shfl_xor(send, 16); } }
        { const bool up = (lane & 8) != 0;
#pragma unroll
            for (int k = 0; k < 4; ++k) { const float keep = up ? q8[k + 4] : q8[k], send = up ? q8[k] : q8[k + 4]; q4[k] = keep + __shfl_xor(send, 8); } }
        { const bool up = (lane & 4) != 0;
#pragma unroll
            for (int k = 0; k < 2; ++k) { const float keep = up ? q4[k + 2] : q4[k], send = up ? q4[k] : q4[k + 2]; q2[k] = keep + __shfl_xor(send, 4); } }
        float lgt;
        { const bool up = (lane & 2) != 0; const float keep = up ? q2[1] : q2[0], send = up ? q2[0] : q2[1]; lgt = keep + __shfl_xor(send, 2); }
        lgt += __shfl_xor(lgt, 1);
        const int my_e = ((lane >> 5) & 1) * 16 + ((lane >> 4) & 1) * 8 + ((lane >> 3) & 1) * 4 + ((lane >> 2) & 1) * 2 + ((lane >> 1) & 1);
        lgt += brl;
        float tv[4]; int te[4]; float cur = lgt;
#pragma unroll
        for (int k = 0; k < 4; ++k) { float bv = cur; int be = my_e;
#pragma unroll
            for (int o = 1; o < 64; o <<= 1) { const float ov = __shfl_xor(bv, o); const int oe = __shfl_xor(be, o); if (ov > bv || (ov == bv && oe < be)) { bv = ov; be = oe; } }
            tv[k] = bv; te[k] = be; if (my_e == be) cur = -INFINITY; }
        const float e1 = __expf(tv[1] - tv[0]), e2 = __expf(tv[2] - tv[0]), e3 = __expf(tv[3] - tv[0]), inv = 1.f / (1.f + e1 + e2 + e3);
        if (lane < 4) { const int ek = lane == 0 ? te[0] : (lane == 1 ? te[1] : (lane == 2 ? te[2] : te[3]));
            const float gk = (lane == 0 ? 1.f : (lane == 1 ? e1 : (lane == 2 ? e2 : e3))) * inv;
            const unsigned slot = atomicAdd(cnt + ek, 1u);
            ltok[(size_t)ek * LCAP + slot] = row; lgate[(size_t)ek * LCAP + slot] = gk; rt_e[row * 4 + lane] = ek; rt_s[row * 4 + lane] = (int)slot; }
    }
}
constexpr int ULIST_OFF = LDS_MISC + 1024, ULIST_MAX = 60;
__device__ __forceinline__ void build_tpre(const Frame& F, int nN) {
    int* tpre = (int*)(F.lds + LDS_MISC); int* cnts = tpre + 64; int* ulist = (int*)(F.lds + ULIST_OFF);
    __syncthreads();
    if (F.tid == 0) { const unsigned* cnt = WSP(const unsigned, WS_CTL); int acc = 0;
        for (int e = 0; e < NEXP; ++e) { const int c = (int)__hip_atomic_load(cnt + e, __ATOMIC_RELAXED, __HIP_MEMORY_SCOPE_AGENT); tpre[e] = acc; cnts[e] = c; acc += (c + 255) >> 8; }
        tpre[NEXP] = acc;
        if (nN > 0) { const int total = acc * nN; int i = 0;
            for (; i < ULIST_MAX; ++i) { const int L = pg8::unit_index(i, F.blk, F.G); if (L >= total) break;
                int e = 0; for (int k = 1; k < NEXP; ++k) if (L >= tpre[k] * nN) e = k;
                const int tp0 = tpre[e], tiles = tpre[e + 1] - tp0, l = L - tp0 * nN, nig = 8 * nN, gid = l / nig, fm = gid * 8, gsz = (tiles - fm) < 8 ? (tiles - fm) : 8, w = l - gid * nig;
                const int pn = w / gsz, pl = fm + w % gsz, rr = cnts[e] - 256 * pl;
                ulist[4 * i] = e | (pn << 8); ulist[4 * i + 1] = pl; ulist[4 * i + 2] = tp0 + pl; ulist[4 * i + 3] = rr < 256 ? rr : 256; }
            ulist[4 * i + 3] = 0; }
    }
    __syncthreads();
}

__device__ __forceinline__ void phase9(const Frame& F) {
    build_tpre(F, 0);
    const int* tpre = (const int*)(F.lds + LDS_MISC);
    const int gw = F.blk * NWAVES + F.wave, NGW = F.G * NWAVES, lane = F.lane;
    const bf16_t* X1 = WSP(const bf16_t, WS_X1); const bf16_t* PLE = WSP(const bf16_t, WS_PLE); const bf16_t* YB = WSP(const bf16_t, WS_YB);
    const int* rt_e = WSP(const int, WS_ROUTE); const int* rt_s = rt_e + T_TOK * 4;
    f32x4 lg[4], lb[4];
#pragma unroll
    for (int j = 0; j < 4; ++j) { lg[j] = *(const f32x4*)(F.ln2_g + 4 * lane + 256 * j); lb[j] = *(const f32x4*)(F.ln2_b + 4 * lane + 256 * j); }
    for (int row = gw; row < T_TOK; row += NGW) {
        const u32x2* xr = (const u32x2*)(X1 + (size_t)row * DM) + lane; const u32x2* pr = (const u32x2*)(PLE + (size_t)row * DM) + lane;
        f32x4 v[4];
#pragma unroll
        for (int j = 0; j < 4; ++j) { const u32x2 w = xr[64 * j], q = pr[64 * j];
            v[j] = (f32x4){bflo(w.x), bfhi(w.x), bflo(w.y), bfhi(w.y)} * ALPHA + (f32x4){bflo(q.x), bfhi(q.x), bflo(q.y), bfhi(q.y)}; }
#pragma unroll
        for (int k = 0; k < 4; ++k) { const int e = rt_e[row * 4 + k], sl = rt_s[row * 4 + k]; const size_t R = (size_t)tpre[e] * 256 + sl;
            const u32x2* yr = (const u32x2*)(YB + R * DM) + lane;
#pragma unroll
            for (int j = 0; j < 4; ++j) { const u32x2 w = yr[64 * j]; v[j] = v[j] + (f32x4){bflo(w.x), bfhi(w.x), bflo(w.y), bfhi(w.y)}; } }
        float s = 0.f;
#pragma unroll
        for (int j = 0; j < 4; ++j) s += (v[j][0] + v[j][1]) + (v[j][2] + v[j][3]);
        const float mean = wave_sum(s) * (1.f / DM); float s2 = 0.f;
#pragma unroll
        for (int j = 0; j < 4; ++j) { v[j] = v[j] - mean; s2 += (v[j][0] * v[j][0] + v[j][1] * v[j][1]) + (v[j][2] * v[j][2] + v[j][3] * v[j][3]); }
        const float rstd = rsqrtf(wave_sum(s2) * (1.f / DM) + LN_EPS);
        f32x4* orow = (f32x4*)(F.out + (size_t)row * DM) + lane;
#pragma unroll
        for (int j = 0; j < 4; ++j) orow[64 * j] = v[j] * rstd * lg[j] + lb[j];
    }
}

constexpr int N_PHASES = 10;
__global__ void __launch_bounds__(NTHREADS, 2) fwd_kernel(Args args) {
    extern __shared__ __attribute__((aligned(16))) unsigned char lds_raw[];
    Frame F;
    F.lds = lds_raw; F.tid = threadIdx.x; F.lane = F.tid & 63; F.wave = __builtin_amdgcn_readfirstlane(F.tid >> 6); F.G = gridDim.x; F.blk = blockIdx.x;
    F.x = args.in[0]; F.p = args.in[1]; F.w_in = args.in[2]; F.conv_w = args.in[3]; F.a_log = args.in[4]; F.dt_bias = args.in[5]; F.gnorm_w = args.in[6]; F.w_out = args.in[7];
    F.ln1_g = args.in[8]; F.ln1_b = args.in[9]; F.w_router = args.in[10]; F.b_router = args.in[11]; F.w_gate_up = args.in[12]; F.b_gate_up = args.in[13]; F.w_down = args.in[14]; F.b_down = args.in[15];
    F.w_ple_gate = args.in[16]; F.b_ple_gate = args.in[17]; F.w_ple_proj = args.in[18]; F.ln2_g = args.in[19]; F.ln2_b = args.in[20];
    F.out = args.out; F.ws = args.ws;
    LAS unsigned char* lds3 = (LAS unsigned char*)lds_raw;
    const int lo = args.ph_lo, hi = args.ph_hi;
#if ONE_LAUNCH
    cg::grid_group grid = cg::this_grid();
#define SEAM(k) do { if (lo <= (k) && (k) + 1 < hi) grid.sync(); } while (0)
#else
#define SEAM(k) do { } while (0)
#endif
#ifndef PHASE_MASK
#define PHASE_MASK 0x3ff
#endif
#define IN(k) (((PHASE_MASK >> (k)) & 1) && lo <= (k) && (k) < hi)
    if (IN(0)) { phase0(F); SEAM(0); }
    if (IN(1)) {
        pg8::DenseSched S{(const char*)WSP(bf16_t, WS_XB), (const char*)WSP(bf16_t, WS_WIN), T_TOK / 256, HPW / 256, 1024, F.blk, F.G};
        pg8::EpiStore E{WSP(bf16_t, WS_HP), HPW};
        pg8::gemm_phase(lds3, 1024, S, E);
        SEAM(1);
    }
    if (IN(2)) {
        for (int u = F.blk; u < 2048 + 1024; u += F.G) { if (u < 2048) dn_prep_unit(F, u); else vt_unit(F, u - 2048); }
        SEAM(2);
    }
    if (IN(3)) { phase3(F); SEAM(3); }
    if (IN(4)) { phase4(F); SEAM(4); }
    if (IN(5)) {
        pg8::DenseSched S{(const char*)WSP(bf16_t, WS_MIX), (const char*)WSP(bf16_t, WS_WOUT), T_TOK / 256, DM / 256, 1024, F.blk, F.G};
        pg8::EpiResid E{WSP(bf16_t, WS_X1), WSP(const bf16_t, WS_XB)};
        pg8::gemm_phase(lds3, 1024, S, E);
        SEAM(5);
    }
    if (IN(6)) { phase6(F); SEAM(6); }
    if (IN(7)) {
        build_tpre(F, 8);
        { pg8::MoeSched<true> S{(const char*)WSP(bf16_t, WS_X1), (const char*)WSP(bf16_t, WS_WGU), (size_t)2048 * 1024 * 2, WSP(const int, WS_LTOK), (const LAS int*)(lds3 + ULIST_OFF), 1024};
          pg8::EpiAct E{WSP(bf16_t, WS_ACT), F.b_gate_up};
          pg8::gemm_phase(lds3, 1024, S, E); }
        { pg8::DenseSched S{(const char*)WSP(bf16_t, WS_X1), (const char*)WSP(bf16_t, WS_WPG), T_TOK / 256, DM / 256, 1024, F.blk, F.G};
          pg8::EpiSig E{WSP(bf16_t, WS_PLE), F.b_ple_gate};
          pg8::gemm_phase(lds3, 1024, S, E); }
        SEAM(7);
    }
    if (IN(8)) {
        build_tpre(F, 4);
        { pg8::MoeSched<false> S{(const char*)WSP(bf16_t, WS_ACT), (const char*)WSP(bf16_t, WS_WD), (size_t)1024 * 1024 * 2, nullptr, (const LAS int*)(lds3 + ULIST_OFF), 1024};
          pg8::EpiDown E{WSP(bf16_t, WS_YB), F.b_down, WSP(const float, WS_LGATE)};
          pg8::gemm_phase(lds3, 1024, S, E); }
        { pg8::DenseSched S{(const char*)WSP(bf16_t, WS_PB), (const char*)WSP(bf16_t, WS_WPP), T_TOK / 256, DM / 256, 256, F.blk, F.G};
          pg8::EpiMul E{WSP(bf16_t, WS_PLE)};
          pg8::gemm_phase(lds3, 256, S, E); }
        SEAM(8);
    }
    if (IN(9)) { phase9(F); }
}

extern "C" void kernel_launch(void* const* d_in, const int* in_sizes, int n_in, void* d_out, int out_size, void* d_ws, size_t ws_size, hipStream_t stream) {
    static int grid = 0;
    if (grid == 0) {
        if (n_in != 21 || out_size != T_TOK * DM || ws_size < WS_END) { fprintf(stderr, "kernel_launch: unexpected problem (n_in %d, out %d, ws %zu)\n", n_in, out_size, ws_size); grid = -1; return; }
        int dev = 0, cus = 0, per_cu = 0;
        hipGetDevice(&dev); hipDeviceGetAttribute(&cus, hipDeviceAttributeMultiprocessorCount, dev);
        if (hipFuncSetAttribute((const void*)fwd_kernel, hipFuncAttributeMaxDynamicSharedMemorySize, LDS_BYTES) != hipSuccess) { fprintf(stderr, "kernel_launch: hipFuncSetAttribute failed\n"); grid = -1; return; }
        hipOccupancyMaxActiveBlocksPerMultiprocessor(&per_cu, (const void*)fwd_kernel, NTHREADS, LDS_BYTES);
        (void)hipGetLastError();
        if (per_cu < 1) fprintf(stderr, "kernel_launch: occupancy query says %d blocks per CU\n", per_cu);
        grid = cus;
    }
    if (grid < 0) return;
    hipMemsetAsync((char*)d_ws + WS_CTL, 0, 4096, stream);
    Args a{};
    for (int i = 0; i < 21; ++i) a.in[i] = (const float*)d_in[i];
    a.out = (float*)d_out; a.ws = (unsigned char*)d_ws;
#if ONE_LAUNCH
    a.ph_lo = 0; a.ph_hi = N_PHASES;
    void* kargs[] = {&a};
    hipError_t e = hipLaunchCooperativeKernel((const void*)fwd_kernel, dim3(grid), dim3(NTHREADS), kargs, LDS_BYTES, stream);
    if (e != hipSuccess) fprintf(stderr, "cooperative launch failed: %s (grid %d)\n", hipGetErrorString(e), grid);
#else
    for (int ph = 0; ph < N_PHASES; ++ph) { a.ph_lo = ph; a.ph_hi = ph + 1; hipLaunchKernelGGL(fwd_kernel, dim3(grid), dim3(NTHREADS), LDS_BYTES, stream, a); }
#endif
}
```

```cpp
#include <hip/hip_runtime.h>
#include <hip/hip_cooperative_groups.h>
#include <cstdio>
#include <cstdint>
namespace cg = cooperative_groups;

#ifndef PROBE_PH
#define PROBE_PH -1
#endif
#ifndef PROBE_FLAGS
#define PROBE_FLAGS 0
#endif
#ifndef ONE_LAUNCH
#define ONE_LAUNCH 1
#endif

#define LAS __attribute__((address_space(3)))
typedef unsigned short bf16_t;
typedef short bf16x8 __attribute__((ext_vector_type(8)));
typedef float f32x4 __attribute__((ext_vector_type(4)));
typedef float f32x16 __attribute__((ext_vector_type(16)));
typedef unsigned u32x4 __attribute__((ext_vector_type(4)));
typedef unsigned u32x2 __attribute__((ext_vector_type(2)));
typedef float f32x2_t __attribute__((ext_vector_type(2)));
typedef __bf16 bf16x2_t __attribute__((ext_vector_type(2)));

constexpr int T_TOK = 32768, DM = 1024, SEQ = 2048, NBATCH = 16;
constexpr int HPW = 3584, INCOLS = 3592;
constexpr int NEXP = 32, LCAP = 32768;
constexpr float ALPHA = 1.189207115002721f;
constexpr float LN_EPS = 1e-5f;
constexpr int NWAVES = 8, NTHREADS = 512;
constexpr int LDS_BYTES = 163840;
constexpr int LDS_MISC = 147456;

constexpr size_t MiB = 1u << 20;
constexpr size_t WS_CTL = 0;
constexpr size_t WS_WGU = 1 * MiB;
constexpr size_t WS_WD = 129 * MiB;
constexpr size_t WS_WIN = 193 * MiB;
constexpr size_t WS_WOUT = 200 * MiB;
constexpr size_t WS_WPG = 202 * MiB;
constexpr size_t WS_WPP = 204 * MiB;
constexpr size_t WS_WRT = 205 * MiB;
constexpr size_t WS_BA = 206 * MiB;
constexpr size_t WS_ROUTE = 207 * MiB;
constexpr size_t WS_LTOK = 208 * MiB;
constexpr size_t WS_LGATE = 212 * MiB;
constexpr size_t WS_X1 = 216 * MiB;
constexpr size_t WS_PLE = 280 * MiB;
constexpr size_t WS_PB = 344 * MiB;
constexpr size_t WS_MIX = 360 * MiB;
constexpr size_t WS_XB = 424 * MiB;
constexpr size_t WS_HP = 488 * MiB;
constexpr size_t WS_DN = 712 * MiB;
constexpr size_t WS_EG = 888 * MiB;
constexpr size_t WS_VT = 889 * MiB;
constexpr size_t WS_KF = 216 * MiB;
constexpr size_t WS_ORAW = 985 * MiB;
constexpr size_t WS_ACT = 360 * MiB;
constexpr size_t WS_X1F = 632 * MiB;
constexpr size_t WS_YB = 672 * MiB;
constexpr size_t WS_END = 1017 * MiB;
constexpr size_t DN_WN = 0, DN_QD = 16384, DN_AT = 32768, DN_KD = 40960, DN_U = 57344, DN_STRIDE = 73728;

__device__ __forceinline__ unsigned cvtpk(float lo, float hi) { f32x2_t v = {lo, hi}; bf16x2_t b = __builtin_convertvector(v, bf16x2_t); return __builtin_bit_cast(unsigned, b); }
typedef int v8i __attribute__((ext_vector_type(8)));
__device__ __forceinline__ unsigned pk4_fp8(float a, float b, float c, float d) { int w = __builtin_amdgcn_cvt_pk_fp8_f32(a, b, 0, false); w = __builtin_amdgcn_cvt_pk_fp8_f32(c, d, w, true); return (unsigned)w; }
__device__ __forceinline__ float bflo(unsigned u) { return __uint_as_float(u << 16); }
__device__ __forceinline__ float bfhi(unsigned u) { return __uint_as_float(u & 0xffff0000u); }
__device__ __forceinline__ bf16_t f2bf(float f) { return (bf16_t)(cvtpk(f, 0.f) & 0xffffu); }
__device__ __forceinline__ float bf2f(bf16_t h) { return __uint_as_float((unsigned)h << 16); }
__device__ __forceinline__ float sigm(float x) { return __builtin_amdgcn_rcpf(1.f + __expf(-x)); }
__device__ __forceinline__ int crow(int r, int hi) { return (r & 3) + 8 * (r >> 2) + 4 * hi; }
__device__ __forceinline__ int kperm(int k) { return (k & ~12) | ((k & 4) << 1) | ((k & 8) >> 1); }
__device__ __forceinline__ bf16x8 pack8(const f32x16& x, int b) {
    u32x4 w; w.x = cvtpk(x[b], x[b + 1]); w.y = cvtpk(x[b + 2], x[b + 3]); w.z = cvtpk(x[b + 4], x[b + 5]); w.w = cvtpk(x[b + 6], x[b + 7]);
    return __builtin_bit_cast(bf16x8, w);
}
__device__ __forceinline__ float wave_sum(float v) {
#pragma unroll
    for (int o = 1; o < 64; o <<= 1) v += __shfl_xor(v, o);
    return v;
}

namespace pg8 {
constexpr int BM = 256, BK = 64, HALF = 128, HTB = HALF * BK * 2, STAGE_BYTES = 8 * HTB;
__device__ __forceinline__ int lds_byte(int r, int c) { const int st = (r >> 4) * 2 + (c >> 5), rr = r & 15, cc = c & 31, ob = rr * 64 + cc * 2; return st * 1024 + (ob ^ (((ob >> 9) & 1) << 5)); }
__device__ __forceinline__ void stage_rc(int b, int& R, int& C) { const int st = b / 1024, sb = b % 1024, swz = sb ^ (((sb >> 9) & 1) << 5); R = (st >> 1) * 16 + swz / 64; C = (st & 1) * 32 + (swz % 64) / 2; }
__device__ __forceinline__ int perm32(int rho) { const int n = rho >> 4, i = rho & 15; return 8 * (i >> 2) + 4 * n + (i & 3); }

struct Unit { const char* A; const char* B; int pm, pn, e, rows, pl; };

__device__ __forceinline__ int unit_index(int i, int c, int G, int total) {
    if (G % 8 != 0) { const int L = i * G + c; return L < total ? L : -1; }
    const int x = c & 7, per = G >> 3, li = i * per + (c >> 3), q = total >> 3, r = total & 7;
    const int start = x * q + (x < r ? x : r), size = q + (x < r ? 1 : 0);
    return li < size ? start + li : -1;
}

struct DenseSched {
    const char* Abase; const char* Bbase; int nM, nN, K, c, G;
    __device__ __forceinline__ bool next(int i, Unit& u) const {
        const int L = unit_index(i, c, G, nM * nN); if (L < 0) return false;
        const int nig = 8 * nN, gid = L / nig, fm = gid * 8, gsz = (nM - fm) < 8 ? (nM - fm) : 8, w = L - gid * nig;
        u.pn = w / gsz; u.pm = fm + w % gsz; u.e = 0; u.rows = 256; u.pl = u.pm;
        u.A = Abase + (size_t)u.pm * 256 * K * 2; u.B = Bbase + (size_t)u.pn * 256 * K * 2; return true;
    }
    static constexpr bool GATHER = false;
    __device__ __forceinline__ size_t hstepA() const { return (size_t)128 * K * 2; }
    __device__ __forceinline__ void avoff(const Unit& u, const int (&R)[2], const int (&C)[2], unsigned (&vo)[2][2]) const {
#pragma unroll
        for (int h = 0; h < 2; ++h)
#pragma unroll
            for (int i = 0; i < 2; ++i) vo[h][i] = (unsigned)(R[i] * K + C[i]) * 2u;
    }
};
template <bool GATHER_> struct MoeSched {
    static constexpr bool GATHER = GATHER_;
    __device__ __forceinline__ size_t hstepA() const { return GATHER_ ? (size_t)0 : (size_t)128 * K; }
    const char* Abase; const char* Bbase; size_t Bstride; const int* ltok; const LAS int* ulist; int K; const char* Bdense;
    __device__ __forceinline__ bool next(int i, Unit& u) const {
        const int w0 = __builtin_amdgcn_readfirstlane(ulist[4 * i]), w1 = __builtin_amdgcn_readfirstlane(ulist[4 * i + 1]), w2 = __builtin_amdgcn_readfirstlane(ulist[4 * i + 2]), w3 = __builtin_amdgcn_readfirstlane(ulist[4 * i + 3]);
        if (w3 == 0) return false;
        u.e = w0 & 255; u.pn = w0 >> 8; u.pl = w1; u.pm = w2; u.rows = w3;
        u.A = GATHER_ ? Abase : Abase + (size_t)u.pm * 256 * K; u.B = (u.e == 255 ? Bdense : Bbase + (size_t)u.e * Bstride) + (size_t)u.pn * 256 * K; return true;
    }
    __device__ __forceinline__ void avoff(const Unit& u, const int (&R)[2], const int (&C)[2], unsigned (&vo)[2][2]) const {
#pragma unroll
        for (int h = 0; h < 2; ++h)
#pragma unroll
            for (int i = 0; i < 2; ++i) {
                if (GATHER_) { const int r = h * 128 + R[i]; int tok = 0; if (u.e == 255) tok = u.pm * 256 + r; else if (r < u.rows) tok = ltok[(size_t)u.e * LCAP + u.pl * 256 + r]; vo[h][i] = (unsigned)(tok * K + C[i] * 2); }
                else vo[h][i] = (unsigned)(R[i] * K + C[i] * 2);
            }
    }
};

typedef f32x4 Acc[2][2][4][2];

template <bool FP8, class Epi, class Sched>
__device__ __forceinline__ void gemm_phase(LAS unsigned char* lds, const int K, const Sched& S, const Epi& E) {
    const int tid = threadIdx.x, wid = __builtin_amdgcn_readfirstlane(tid >> 6), lane = tid & 63, wr = wid >> 2, wc = wid & 3, fr = lane & 15, fq = lane >> 4;
    const int RB = FP8 ? K : 2 * K;
    const int nt = RB / 128;
    int RA[2], CA[2]; unsigned voffB[2];
#pragma unroll
    for (int i = 0; i < 2; ++i) { int R, C; stage_rc(tid * 16 + i * 8192, R, C); RA[i] = R; CA[i] = C; const int Rb = (R & ~31) + perm32(R & 31); voffB[i] = (unsigned)(Rb * RB + C * 2); }
    const size_t kstep = (size_t)(BK * 2);
    const size_t hstepB = (size_t)HALF * RB, hstepA = S.hstepA();
    const unsigned ldsw = (unsigned)wid * 1024u;
    const int aoff = lds_byte(wr * 64 + fr, fq * 8), boff = lds_byte(wc * 32 + fr, fq * 8);
#define PG8_SA(b, h) (((b) * 2 + (h)) * HTB)
#define PG8_SB(b, h) ((4 + (b) * 2 + (h)) * HTB)
#define PG8_GL(gptr, ldsoff) __builtin_amdgcn_global_load_lds((const unsigned*)(gptr), (LAS unsigned*)(lds + (ldsoff)), 16, 0, 0)
#define PG8_STAGE_B(bufoff, gbase) do { PG8_GL((const char*)(gbase) + voffB[0], (bufoff) + ldsw); PG8_GL((const char*)(gbase) + voffB[1], (bufoff) + ldsw + 8192); } while (0)
#define PG8_STAGE_A(bufoff, gbase, o0, o1) do { PG8_GL((const char*)(gbase) + (o0), (bufoff) + ldsw); PG8_GL((const char*)(gbase) + (o1), (bufoff) + ldsw + 8192); } while (0)
#define PG8_LDA(dst, b, h) do { _Pragma("unroll") for (int m = 0; m < 4; ++m) { \
        if constexpr (FP8) { const u32x4 l_ = *(const LAS u32x4*)(lds + PG8_SA(b, h) + aoff + m * 2048), h_ = *(const LAS u32x4*)(lds + PG8_SA(b, h) + aoff + m * 2048 + 1024); \
            dst##8[m] = (v8i){(int)l_.x, (int)l_.y, (int)l_.z, (int)l_.w, (int)h_.x, (int)h_.y, (int)h_.z, (int)h_.w}; } \
        else { _Pragma("unroll") for (int k = 0; k < 2; ++k) dst[m][k] = *(const LAS bf16x8*)(lds + PG8_SA(b, h) + aoff + m * 2048 + k * 1024); } } } while (0)
#define PG8_LDB(dst, b, h) do { _Pragma("unroll") for (int n = 0; n < 2; ++n) { \
        if constexpr (FP8) { const u32x4 l_ = *(const LAS u32x4*)(lds + PG8_SB(b, h) + boff + n * 2048), h_ = *(const LAS u32x4*)(lds + PG8_SB(b, h) + boff + n * 2048 + 1024); \
            dst##8[n] = (v8i){(int)l_.x, (int)l_.y, (int)l_.z, (int)l_.w, (int)h_.x, (int)h_.y, (int)h_.z, (int)h_.w}; } \
        else { _Pragma("unroll") for (int k = 0; k < 2; ++k) dst[n][k] = *(const LAS bf16x8*)(lds + PG8_SB(b, h) + boff + n * 2048 + k * 1024); } } } while (0)
#define PG8_MMA(ai, bj, At, Bt) do { __builtin_amdgcn_s_setprio(1); \
        if constexpr (FP8) { _Pragma("unroll") for (int m = 0; m < 4; ++m) _Pragma("unroll") for (int n = 0; n < 2; ++n) \
            asm volatile("s_nop 1\n\tv_mfma_scale_f32_16x16x128_f8f6f4 %0, %1, %2, %0, %3, %4 op_sel_hi:[0,0,0]" : "+v"(acc[ai][bj][m][n]) : "v"(Bt##8[n]), "v"(At##8[m]), "v"(sc_w), "v"(sc_a)); } \
        else { _Pragma("unroll") for (int m = 0; m < 4; ++m) _Pragma("unroll") for (int n = 0; n < 2; ++n) _Pragma("unroll") for (int k = 0; k < 2; ++k) \
            acc[ai][bj][m][n] = __builtin_amdgcn_mfma_f32_16x16x32_bf16(Bt[n][k], At[m][k], acc[ai][bj][m][n], 0, 0, 0); } \
        __builtin_amdgcn_s_setprio(0); } while (0)
#define PG8_WAIT_V(n) asm volatile("s_waitcnt vmcnt(" #n ")" ::: "memory")
#define PG8_WAIT_L(n) asm volatile("s_waitcnt lgkmcnt(" #n ")" ::: "memory")
#define PG8_BAR __builtin_amdgcn_s_barrier()
#define PG8_SCHED __builtin_amdgcn_sched_barrier(0)
    Unit cur, nxt; int ui = 0;
    if (!S.next(0, cur)) return;
    unsigned vc[2][2], vn[2][2];
    S.avoff(cur, RA, CA, vc);
    Acc acc;
#pragma unroll
    for (int a = 0; a < 2; ++a)
#pragma unroll
        for (int b = 0; b < 2; ++b)
#pragma unroll
            for (int m = 0; m < 4; ++m)
#pragma unroll
                for (int n = 0; n < 2; ++n) acc[a][b][m][n] = (f32x4){0.f, 0.f, 0.f, 0.f};
    const int sc_w = 122, sc_a = 127;
    bf16x8 At[4][2], B0[2][2], B1[2][2]; v8i At8[4], B08[2], B18[2];
    const char* cA = cur.A; const char* cB = cur.B;
    PG8_STAGE_B(PG8_SB(0, 0), cB); PG8_STAGE_B(PG8_SB(0, 1), cB + hstepB); PG8_STAGE_A(PG8_SA(0, 0), cA, vc[0][0], vc[0][1]); PG8_STAGE_A(PG8_SA(0, 1), cA + hstepA, vc[1][0], vc[1][1]);
    if (wr == 1) PG8_BAR;
    PG8_WAIT_V(2); PG8_BAR;
    PG8_STAGE_B(PG8_SB(1, 0), cB + kstep); PG8_STAGE_A(PG8_SA(1, 0), cA + kstep, vc[0][0], vc[0][1]); PG8_STAGE_B(PG8_SB(1, 1), cB + hstepB + kstep);
    PG8_WAIT_V(6); PG8_BAR;
    for (;;) {
        const bool has_next = S.next(ui + 1, nxt);
        if (Sched::GATHER && has_next) S.avoff(nxt, RA, CA, vn);
        else {
#pragma unroll
            for (int h = 0; h < 2; ++h)
#pragma unroll
                for (int i = 0; i < 2; ++i) vn[h][i] = vc[h][i];
        }
        const char* nA = has_next ? nxt.A : cA; const char* nB = has_next ? nxt.B : cB;
#pragma unroll 1
        for (int t = 0; t < nt; t += 2) {
            const bool last = (t == nt - 2);
            const char* a1 = cA + (size_t)(t + 1) * kstep;
            const char* a2 = last ? nA : cA + (size_t)(t + 2) * kstep; const char* b2 = last ? nB : cB + (size_t)(t + 2) * kstep;
            const char* a3 = a2 + kstep; const char* b3 = b2 + kstep;
            const unsigned o00 = last ? vn[0][0] : vc[0][0], o01 = last ? vn[0][1] : vc[0][1], o10 = last ? vn[1][0] : vc[1][0], o11 = last ? vn[1][1] : vc[1][1];
            PG8_LDB(B0, 0, 0); PG8_LDB(B1, 0, 1); PG8_SCHED; PG8_LDA(At, 0, 0); PG8_STAGE_A(PG8_SA(1, 1), a1 + hstepA, vc[1][0], vc[1][1]);
            PG8_WAIT_V(8); PG8_WAIT_L(0); PG8_BAR; PG8_MMA(0, 0, At, B0); PG8_MMA(0, 1, At, B1); PG8_BAR; PG8_SCHED;
            PG8_LDA(At, 0, 1); PG8_STAGE_B(PG8_SB(0, 0), b2); PG8_STAGE_B(PG8_SB(0, 1), b2 + hstepB); PG8_STAGE_A(PG8_SA(0, 0), a2, o00, o01);
            PG8_WAIT_V(8); PG8_WAIT_L(0); PG8_BAR; PG8_MMA(1, 0, At, B0); PG8_MMA(1, 1, At, B1); PG8_BAR; PG8_SCHED;
            PG8_LDB(B0, 1, 0); PG8_LDB(B1, 1, 1); PG8_SCHED; PG8_LDA(At, 1, 0); PG8_STAGE_A(PG8_SA(0, 1), a2 + hstepA, o10, o11);
            PG8_WAIT_V(8); PG8_WAIT_L(0); PG8_BAR; PG8_MMA(0, 0, At, B0); PG8_MMA(0, 1, At, B1); PG8_BAR; PG8_SCHED;
            PG8_LDA(At, 1, 1); PG8_STAGE_B(PG8_SB(1, 0), b3); PG8_STAGE_B(PG8_SB(1, 1), b3 + hstepB); PG8_STAGE_A(PG8_SA(1, 0), a3, o00, o01);
            PG8_WAIT_V(8); PG8_WAIT_L(0); PG8_BAR; PG8_MMA(1, 0, At, B0); PG8_MMA(1, 1, At, B1); PG8_BAR; PG8_SCHED;
        }
        if (wr == 0) PG8_BAR;
        if constexpr (FP8) asm volatile("s_nop 15\n\ts_nop 15" ::: "memory");
        E(acc, cur, wr, wc, fr, fq);
        if (!has_next) break;
#pragma unroll
        for (int a = 0; a < 2; ++a)
#pragma unroll
            for (int b = 0; b < 2; ++b)
#pragma unroll
                for (int m = 0; m < 4; ++m)
#pragma unroll
                    for (int n = 0; n < 2; ++n) acc[a][b][m][n] = (f32x4){0.f, 0.f, 0.f, 0.f};
        cur = nxt; cA = nA; cB = nB; ++ui;
#pragma unroll
        for (int h = 0; h < 2; ++h)
#pragma unroll
            for (int i = 0; i < 2; ++i) vc[h][i] = vn[h][i];
        if (wr == 1) PG8_BAR;
    }
    PG8_WAIT_V(0);
    PG8_BAR;
#undef PG8_SA
#undef PG8_SB
#undef PG8_GL
#undef PG8_STAGE_A
#undef PG8_STAGE_B
#undef PG8_LDA
#undef PG8_LDB
#undef PG8_MMA
#undef PG8_WAIT_V
#undef PG8_WAIT_L
#undef PG8_BAR
#undef PG8_SCHED
}

__device__ __forceinline__ u32x4 pack_row8(const f32x4& v0, const f32x4& v1) { u32x4 w; w.x = cvtpk(v0[0], v0[1]); w.y = cvtpk(v0[2], v0[3]); w.z = cvtpk(v1[0], v1[1]); w.w = cvtpk(v1[2], v1[3]); return w; }
__device__ __forceinline__ void unpack8(const u32x4& w, f32x4& a, f32x4& b) { a = (f32x4){bflo(w.x), bfhi(w.x), bflo(w.y), bfhi(w.y)}; b = (f32x4){bflo(w.z), bfhi(w.z), bflo(w.w), bfhi(w.w)}; }

struct EpiStore {
    bf16_t* O; int ldc;
    __device__ __forceinline__ void operator()(const Acc& acc, const Unit& u, int wr, int wc, int fr, int fq) const {
        const int row0 = u.pm * BM + wr * 64 + fr, col0 = u.pn * BM + wc * 32 + 8 * fq;
#pragma unroll
        for (int ai = 0; ai < 2; ++ai)
#pragma unroll
            for (int m = 0; m < 4; ++m) { bf16_t* rowp = O + (size_t)(row0 + ai * HALF + m * 16) * ldc + col0;
#pragma unroll
                for (int bj = 0; bj < 2; ++bj) *(u32x4*)(rowp + bj * HALF) = pack_row8(acc[ai][bj][m][0], acc[ai][bj][m][1]); }
    }
};
struct EpiResid {
    bf16_t* O; const bf16_t* X;
    __device__ __forceinline__ void operator()(const Acc& acc, const Unit& u, int wr, int wc, int fr, int fq) const {
        const int row0 = u.pm * BM + wr * 64 + fr, col0 = u.pn * BM + wc * 32 + 8 * fq;
#pragma unroll
        for (int ai = 0; ai < 2; ++ai)
#pragma unroll
            for (int m = 0; m < 4; ++m) { const size_t off = (size_t)(row0 + ai * HALF + m * 16) * DM + col0;
#pragma unroll
                for (int bj = 0; bj < 2; ++bj) { const u32x4 xw = *(const u32x4*)(X + off + bj * HALF); f32x4 xa, xb; unpack8(xw, xa, xb);
                    *(u32x4*)(O + off + bj * HALF) = pack_row8(xa * ALPHA + acc[ai][bj][m][0], xb * ALPHA + acc[ai][bj][m][1]); }
                if (m & 1) asm volatile("" ::: "memory"); }
    }
};
struct EpiAct {
    unsigned char* O; const float* bgu;
    __device__ __forceinline__ void operator()(const Acc& acc, const Unit& u, int wr, int wc, int fr, int fq) const {
        const int cl = u.pn * HALF + wc * 32 + 8 * fq;
        const float* bg = bgu + (size_t)u.e * 2048 + cl;
        const f32x4 g0 = *(const f32x4*)bg, g1 = *(const f32x4*)(bg + 4), u0 = *(const f32x4*)(bg + 1024), u1 = *(const f32x4*)(bg + 1028);
        unsigned char* obase = O + (size_t)(u.pm * BM + wr * 64 + fr) * DM + cl;
        const int rl0 = wr * 64 + fr;
#pragma unroll
        for (int ai = 0; ai < 2; ++ai)
#pragma unroll
            for (int m = 0; m < 4; ++m) { const int rl = ai * HALF + m * 16 + rl0;
                unsigned w[2];
#pragma unroll
                for (int n = 0; n < 2; ++n) { const f32x4 hg = acc[ai][0][m][n] + (n ? g1 : g0), hu = acc[ai][1][m][n] + (n ? u1 : u0); float o4[4];
#pragma unroll
                    for (int j = 0; j < 4; ++j) { const float g = fminf(hg[j], 7.f), up = fminf(fmaxf(hu[j], -7.f), 7.f);
                        o4[j] = (up + 1.f) * g * __builtin_amdgcn_rcpf(1.f + __builtin_amdgcn_exp2f(-2.4554669595930157f * g)); }
                    w[n] = pk4_fp8(o4[0], o4[1], o4[2], o4[3]); asm volatile("" : "+v"(w[n])); }
                if (rl < u.rows) *(u32x2*)(obase + (size_t)(ai * HALF + m * 16) * DM) = (u32x2){w[0], w[1]};
                asm volatile("" ::: "memory"); }
    }
};
struct EpiDown {
    unsigned char* O; const float* bd; const float* lgate;
    __device__ __forceinline__ void operator()(const Acc& acc, const Unit& u, int wr, int wc, int fr, int fq) const {
        const int col0 = u.pn * BM + wc * 32 + 8 * fq;
        const float* bp = bd + (size_t)u.e * DM + col0;
#pragma unroll
        for (int ai = 0; ai < 2; ++ai)
#pragma unroll
            for (int m = 0; m < 4; ++m) { const int rl = ai * HALF + wr * 64 + m * 16 + fr;
                if (rl < u.rows) { const float gt = lgate[(size_t)u.e * LCAP + u.pl * BM + rl]; unsigned char* rowp = O + (size_t)(u.pm * BM + rl) * DM + col0;
#pragma unroll
                    for (int bj = 0; bj < 2; ++bj) { const f32x4 a = (acc[ai][bj][m][0] + *(const f32x4*)(bp + bj * HALF)) * gt, b = (acc[ai][bj][m][1] + *(const f32x4*)(bp + bj * HALF + 4)) * gt;
                        *(u32x2*)(rowp + bj * HALF) = (u32x2){pk4_fp8(a[0], a[1], a[2], a[3]), pk4_fp8(b[0], b[1], b[2], b[3])}; } }
                asm volatile("" ::: "memory"); }
    }
};
struct EpiSig {
    bf16_t* O; const float* bias;
    __device__ __forceinline__ void operator()(const Acc& acc, const Unit& u, int wr, int wc, int fr, int fq) const {
        const int row0 = u.pm * BM + wr * 64 + fr, col0 = u.pn * BM + wc * 32 + 8 * fq;
        f32x4 bv[2][2];
#pragma unroll
        for (int bj = 0; bj < 2; ++bj)
#pragma unroll
            for (int n = 0; n < 2; ++n) bv[bj][n] = *(const f32x4*)(bias + col0 + bj * HALF + 4 * n);
#pragma unroll
        for (int ai = 0; ai < 2; ++ai)
#pragma unroll
            for (int m = 0; m < 4; ++m) { bf16_t* rowp = O + (size_t)(row0 + ai * HALF + m * 16) * DM + col0;
#pragma unroll
                for (int bj = 0; bj < 2; ++bj) { f32x4 a = acc[ai][bj][m][0] + bv[bj][0], b = acc[ai][bj][m][1] + bv[bj][1];
#pragma unroll
                    for (int j = 0; j < 4; ++j) { a[j] = sigm(a[j]); b[j] = sigm(b[j]); }
                    *(u32x4*)(rowp + bj * HALF) = pack_row8(a, b); }
                asm volatile("" ::: "memory"); }
    }
};
struct EpiActSig {
    EpiAct a; EpiSig g;
    __device__ __forceinline__ void operator()(const Acc& acc, const Unit& u, int wr, int wc, int fr, int fq) const { if (u.e == 255) g(acc, u, wr, wc, fr, fq); else a(acc, u, wr, wc, fr, fq); }
};
struct EpiMul {
    bf16_t* O;
    __device__ __forceinline__ void operator()(const Acc& acc, const Unit& u, int wr, int wc, int fr, int fq) const {
        const int row0 = u.pm * BM + wr * 64 + fr, col0 = u.pn * BM + wc * 32 + 8 * fq;
#pragma unroll
        for (int ai = 0; ai < 2; ++ai)
#pragma unroll
            for (int m = 0; m < 4; ++m) { bf16_t* rowp = O + (size_t)(row0 + ai * HALF + m * 16) * DM + col0;
#pragma unroll
                for (int bj = 0; bj < 2; ++bj) { const u32x4 gw = *(const u32x4*)(rowp + bj * HALF); f32x4 ga, gb; unpack8(gw, ga, gb);
                    *(u32x4*)(rowp + bj * HALF) = pack_row8(ga * acc[ai][bj][m][0], gb * acc[ai][bj][m][1]); }
                if (m & 1) asm volatile("" ::: "memory"); }
    }
};
}

#define XB_TMO      128
#define XB_XCNT(j)  (256  + 64 * (j))
#define XB_XSUB(j)  (1280 + 64 * (j))
#define XB_XGEN(j)  (2304 + 64 * (j))
#define XB_TOP      3328
#define XB_TOPGEN   3392
#define XCD_BAR_WORDS 3456
#define XB_SPIN_CAP (1u << 22)
constexpr int CW_BAR = 4096;
constexpr int LDS_BARST = LDS_MISC + 2048;
__device__ __forceinline__ unsigned xb_ld(unsigned* p)              { return __hip_atomic_load(p, __ATOMIC_RELAXED, __HIP_MEMORY_SCOPE_AGENT); }
__device__ __forceinline__ unsigned xb_add(unsigned* p, unsigned v) { return __hip_atomic_fetch_add(p, v, __ATOMIC_RELAXED, __HIP_MEMORY_SCOPE_AGENT); }
__device__ __forceinline__ unsigned xb_xcc_id() { return (unsigned)__builtin_amdgcn_s_getreg((3 << 11) | 20) & 0xFu; }
#define XB_SPIN(cond, bar) do { unsigned _sp = 0; while (cond) { __builtin_amdgcn_s_sleep(1); \
    if ((++_sp & 255u) == 0u) { if (xb_ld(&(bar)[XB_TMO])) break; if (_sp > XB_SPIN_CAP) { atomicAdd(&(bar)[XB_TMO], 1u); break; } } } } while (0)
struct XcdBarrier { unsigned* bar; unsigned x; volatile LAS unsigned* st; };
__device__ __forceinline__ XcdBarrier xcd_barrier_post(unsigned* bar, volatile LAS unsigned* st) {
    XcdBarrier b; b.bar = bar; b.x = xb_xcc_id(); b.st = st;
    if (threadIdx.x == 0) (void)xb_add(&bar[XB_XCNT(b.x)], 1u);
    return b;
}
__device__ __forceinline__ void xcd_barrier_complete(unsigned* bar, unsigned x, unsigned& nloc, unsigned& nx) {
    const unsigned G = gridDim.x * gridDim.y * gridDim.z;
    unsigned sum, cnt, mine, sp = 0u;
    for (;;) {
        sum = 0u; cnt = 0u; mine = 0u;
#pragma unroll
        for (unsigned j = 0; j < 16; ++j) { const unsigned c = xb_ld(&bar[XB_XCNT(j)]); sum += c; cnt += (c > 0u) ? 1u : 0u; mine = (j == x) ? c : mine; }
        if (sum == G) break;
        __builtin_amdgcn_s_sleep(1);
        if ((++sp & 255u) == 0u) { if (xb_ld(&bar[XB_TMO])) break; if (sp > XB_SPIN_CAP) { atomicAdd(&bar[XB_TMO], 1u); break; } }
    }
    nloc = mine > 0u ? mine : 1u; nx = cnt > 0u ? cnt : 1u;
}
__device__ __forceinline__ void xcd_barrier(const XcdBarrier& b) {
    asm volatile("s_waitcnt vmcnt(0)" ::: "memory");
    __syncthreads();
    if (threadIdx.x == 0) {
        unsigned* bar = b.bar;
        __builtin_amdgcn_s_waitcnt(0);
        unsigned nloc = b.st[0], nx = b.st[1];
        if (nloc == 0u) { xcd_barrier_complete(bar, b.x, nloc, nx); b.st[0] = nloc; b.st[1] = nx; }
        const unsigned old = xb_add(&bar[XB_XSUB(b.x)], 1u);
        const unsigned gen = old / nloc;
        if (old + 1u == (gen + 1u) * nloc) {
            __builtin_amdgcn_fence(__ATOMIC_RELEASE, "agent");
            asm volatile("s_waitcnt vmcnt(0)" ::: "memory");
            const unsigned og = xb_add(&bar[XB_TOP], 1u);
            const unsigned tg = og / nx;
            if (og + 1u == (tg + 1u) * nx) xb_add(&bar[XB_TOPGEN], 1u);
            else XB_SPIN(xb_ld(&bar[XB_TOPGEN]) == tg, bar);
            __builtin_amdgcn_fence(__ATOMIC_ACQUIRE, "agent");
            xb_add(&bar[XB_XGEN(b.x)], 1u);
            asm volatile("s_waitcnt vmcnt(0)" ::: "memory");
        } else {
            XB_SPIN(xb_ld(&bar[XB_XGEN(b.x)]) == gen, bar);
            __builtin_amdgcn_fence(__ATOMIC_ACQUIRE, "agent");
            asm volatile("s_waitcnt vmcnt(0)" ::: "memory");
        }
    }
    __syncthreads();
}

struct Args { const float* in[21]; float* out; unsigned char* ws; int ph_lo, ph_hi; int flags, pad; };
#define THREAD_IDS() int tid = threadIdx.x; asm volatile("" : "+v"(tid)); const int lane = tid & 63; const int wave = __builtin_amdgcn_readfirstlane(tid >> 6); (void)lane; (void)wave
struct Frame {
    unsigned char* lds; int G, blk;
    float* out; unsigned char* ws;
};
__device__ __forceinline__ const float* inptr(int k) {
    const char* ka = (const char*)__builtin_amdgcn_kernarg_segment_ptr(); asm volatile("" : "+s"(ka));
    return *(const float* const*)(ka + 8 * k);
}
#define WSP(T, off) ((T*)(F.ws + (off)))

constexpr int MOE_TILES = NEXP * 16 * 32 + NEXP * 16 * 16;
struct WTile { const float* src; unsigned char* dst; int ldn; };
__device__ __forceinline__ WTile moe_tile_addr(const Frame& F, int r, const float* w_gate_up, const float* w_down, int lane) {
    constexpr int I_GU = NEXP * 16 * 32; const int q4 = lane >> 4, c = lane & 15; WTile t;
    if (r < I_GU) { const int e = r / 512, q = r % 512, kb = q / 32, nb = q % 32, n0 = 64 * nb;
        const int j0 = n0 & 1023, drow0 = 256 * (j0 >> 7) + (j0 & 127) + ((n0 >= 1024) ? 128 : 0);
        t.src = w_gate_up + (size_t)e * 1024 * 2048 + (size_t)(64 * kb + 16 * q4) * 2048 + n0 + 4 * c; t.ldn = 2048;
        t.dst = WSP(unsigned char, WS_WGU) + (size_t)e * 2048 * 1024 + (size_t)(drow0 + 4 * c) * 1024 + 64 * kb + 16 * q4; }
    else { r -= I_GU; const int e = r / 256, q = r % 256, kb = q / 16, nb = q % 16;
        t.src = w_down + (size_t)e * 1024 * 1024 + (size_t)(64 * kb + 16 * q4) * 1024 + 64 * nb + 4 * c; t.ldn = 1024;
        t.dst = WSP(unsigned char, WS_WD) + (size_t)e * 1024 * 1024 + (size_t)(64 * nb + 4 * c) * 1024 + 64 * kb + 16 * q4; }
    return t;
}
__device__ __forceinline__ void wtile_load(f32x4 (&v)[16], const WTile& t) {
#pragma unroll
    for (int i = 0; i < 16; ++i) v[i] = *(const f32x4*)(t.src + (size_t)i * t.ldn);
}
__device__ __forceinline__ void wtile_store(const f32x4 (&v)[16], const WTile& t) {
#pragma unroll
    for (int j = 0; j < 4; ++j) {
        u32x4 o;
        o.x = pk4_fp8(v[0][j] * 32.f, v[1][j] * 32.f, v[2][j] * 32.f, v[3][j] * 32.f); o.y = pk4_fp8(v[4][j] * 32.f, v[5][j] * 32.f, v[6][j] * 32.f, v[7][j] * 32.f);
        o.z = pk4_fp8(v[8][j] * 32.f, v[9][j] * 32.f, v[10][j] * 32.f, v[11][j] * 32.f); o.w = pk4_fp8(v[12][j] * 32.f, v[13][j] * 32.f, v[14][j] * 32.f, v[15][j] * 32.f);
        *(u32x4*)(t.dst + (size_t)j * 1024) = o;
    }
}
__device__ __forceinline__ void moe_weight_batch3(const Frame& F, int r0, int stride, const float* w_gate_up, const float* w_down, int lane) {
    const WTile t0 = moe_tile_addr(F, r0, w_gate_up, w_down, lane), t1 = moe_tile_addr(F, r0 + stride, w_gate_up, w_down, lane), t2 = moe_tile_addr(F, r0 + 2 * stride, w_gate_up, w_down, lane);
    f32x4 va[16], vb[16];
    wtile_load(va, t0); wtile_load(vb, t1);
    wtile_store(va, t0); wtile_load(va, t2);
    wtile_store(vb, t1); wtile_store(va, t2);
}

__device__ __forceinline__ void p0_transpose_tile(const float* W, int ldn, int k0, int n0, bf16_t* WT, int Kd, int drow0, int lane) {
    const int q = lane >> 4, c = lane & 15;
    const float* src = W + (size_t)(k0 + 16 * q) * ldn + n0 + 4 * c;
    f32x4 v[16];
#pragma unroll
    for (int i = 0; i < 16; ++i) v[i] = *(const f32x4*)(src + (size_t)i * ldn);
    bf16_t* dst = WT + (size_t)(drow0 + 4 * c) * Kd + k0 + 16 * q;
#pragma unroll
    for (int j = 0; j < 4; ++j) {
        u32x4 o0, o1;
        o0.x = cvtpk(v[0][j], v[1][j]); o0.y = cvtpk(v[2][j], v[3][j]); o0.z = cvtpk(v[4][j], v[5][j]); o0.w = cvtpk(v[6][j], v[7][j]);
        o1.x = cvtpk(v[8][j], v[9][j]); o1.y = cvtpk(v[10][j], v[11][j]); o1.z = cvtpk(v[12][j], v[13][j]); o1.w = cvtpk(v[14][j], v[15][j]);
        *(u32x4*)(dst + (size_t)j * Kd) = o0; *(u32x4*)(dst + (size_t)j * Kd + 8) = o1;
    }
}
__device__ __forceinline__ void phase0(const Frame& F) {
    THREAD_IDS();
    const float* in_x = inptr(0); const float* in_p = inptr(1); const float* in_w_in = inptr(2); const float* in_w_out = inptr(7); const float* in_w_router = inptr(10); const float* in_w_ple_gate = inptr(16); const float* in_w_ple_proj = inptr(18);
    float* wba = (float*)F.lds;
    for (int i = tid; i < 8192; i += NTHREADS) wba[(i & 7) * 1024 + (i >> 3)] = in_w_in[(size_t)(i >> 3) * INCOLS + HPW + (i & 7)];
    __syncthreads();
    const int gw = F.blk * NWAVES + wave, NGW = F.G * NWAVES;
    bf16_t* XB = WSP(bf16_t, WS_XB); float* BA = WSP(float, WS_BA);
    for (int row = gw; row < T_TOK; row += NGW) {
        const f32x4* xr = (const f32x4*)(in_x + (size_t)row * DM) + lane;
        f32x4 v[4];
#pragma unroll
        for (int j = 0; j < 4; ++j) v[j] = xr[64 * j];
        u32x2* o8 = (u32x2*)(XB + (size_t)row * DM) + lane;
#pragma unroll
        for (int j = 0; j < 4; ++j) { u32x2 w; w.x = cvtpk(v[j][0], v[j][1]); w.y = cvtpk(v[j][2], v[j][3]); o8[64 * j] = w; }
        float a8[8];
#pragma unroll
        for (int q = 0; q < 8; ++q) { float a = 0.f;
#pragma unroll
            for (int j = 0; j < 4; ++j) { const f32x4 w = *(const f32x4*)(wba + q * 1024 + 4 * lane + 256 * j); a += v[j][0] * w[0] + v[j][1] * w[1] + v[j][2] * w[2] + v[j][3] * w[3]; }
            a8[q] = a; }
        float r4[4], r2[2], r1;
        { const bool up = (lane & 32) != 0;
#pragma unroll
            for (int k = 0; k < 4; ++k) { const float keep = up ? a8[k + 4] : a8[k], send = up ? a8[k] : a8[k + 4]; r4[k] = keep + __shfl_xor(send, 32); } }
        { const bool up = (lane & 16) != 0;
#pragma unroll
            for (int k = 0; k < 2; ++k) { const float keep = up ? r4[k + 2] : r4[k], send = up ? r4[k] : r4[k + 2]; r2[k] = keep + __shfl_xor(send, 16); } }
        { const bool up = (lane & 8) != 0; const float keep = up ? r2[1] : r2[0], send = up ? r2[0] : r2[1]; r1 = keep + __shfl_xor(send, 8); }
        r1 += __shfl_xor(r1, 4); r1 += __shfl_xor(r1, 2); r1 += __shfl_xor(r1, 1);
        if ((lane & 7) == 0) BA[(size_t)row * 8 + ((lane >> 5) & 1) * 4 + ((lane >> 4) & 1) * 2 + ((lane >> 3) & 1)] = r1;
    }
    { const f32x4* src = (const f32x4*)in_p; u32x2* dst = WSP(u32x2, WS_PB);
        for (int i = F.blk * NTHREADS + tid; i < T_TOK * 256 / 4; i += F.G * NTHREADS) { const f32x4 v = src[i]; u32x2 w; w.x = cvtpk(v[0], v[1]); w.y = cvtpk(v[2], v[3]); dst[i] = w; } }
    { float* wrt = WSP(float, WS_WRT); for (int i = F.blk * NTHREADS + tid; i < 32768; i += F.G * NTHREADS) wrt[(i & 31) * 1024 + (i >> 5)] = in_w_router[i]; }
    constexpr int I_IN = 16 * 56, I_OUT = 16 * 16, I_PG = 16 * 16, I_PP = 4 * 16;
    constexpr int NITEMS = I_IN + I_OUT + I_PG + I_PP;
    for (int it = gw; it < NITEMS; it += NGW) {
        int r = it;
        if (r < I_IN) { const int kb = r / 56, nb = r % 56; p0_transpose_tile(in_w_in, INCOLS, 64 * kb, 64 * nb, WSP(bf16_t, WS_WIN), 1024, 64 * nb, lane); continue; } r -= I_IN;
        if (r < I_OUT) { const int kb = r / 16, nb = r % 16; p0_transpose_tile(in_w_out, 1024, 64 * kb, 64 * nb, WSP(bf16_t, WS_WOUT), 1024, 64 * nb, lane); continue; } r -= I_OUT;
        if (r < I_PG) { const int kb = r / 16, nb = r % 16, q4 = lane >> 4, c = lane & 15; WTile t; f32x4 v[16];
            t.src = in_w_ple_gate + (size_t)(64 * kb + 16 * q4) * 1024 + 64 * nb + 4 * c; t.ldn = 1024; t.dst = WSP(unsigned char, WS_WPG) + (size_t)(64 * nb + 4 * c) * 1024 + 64 * kb + 16 * q4;
            wtile_load(v, t); wtile_store(v, t); continue; } r -= I_PG;
        { const int kb = r / 16, nb = r % 16; p0_transpose_tile(in_w_ple_proj, 1024, 64 * kb, 64 * nb, WSP(bf16_t, WS_WPP), 256, 64 * nb, lane); }
    }
}
#define MFMA32(a, b, c) __builtin_amdgcn_mfma_f32_32x32x16_bf16((a), (b), (c), 0, 0, 0)
constexpr int QR_S = 136, KT_S = 72, NM_S = 68;
constexpr int L_QR = 0, L_KR = 17408, L_KT = 34816, L_VT = 53248, L_NM = 71680, L_TM = 89088, L_PM = 106496, L_TU = 111104, L_TW = 120320, L_SC = 129536;
struct DnPre { u32x4 xr[2][7]; };
__device__ __forceinline__ void dn_prefetch(const Frame& F, int ch, DnPre& pre) {
    const int tid = threadIdx.x; const int b = ch >> 7, h = (ch >> 5) & 3, n = ch & 31, t0 = 64 * n; const size_t rowb = (size_t)b * SEQ;
    const bf16_t* HP = WSP(const bf16_t, WS_HP);
#pragma unroll
    for (int it = 0; it < 2; ++it) { const int idx = it * NTHREADS + tid;
        if (idx < 768) { const int c3 = idx >> 8, rem = idx & 255, tg = rem >> 4, d0 = (rem & 15) * 8, chn = c3 * 512 + h * 128 + d0;
#pragma unroll
            for (int r = 0; r < 7; ++r) { const int t = t0 + 4 * tg - 3 + r; const int tc = t < 0 ? 0 : t; pre.xr[it][r] = *(const u32x4*)(HP + (rowb + tc) * HPW + 1536 + chn); } } }
}
__device__ __forceinline__ void dn_prep_unit(const Frame& F, int ch, const DnPre& pre, int pflags = 0) {
    int tid = threadIdx.x; asm volatile("" : "+v"(tid));
    const int lane = tid & 63, wave = __builtin_amdgcn_readfirstlane(tid >> 6), r32 = lane & 31, hi = lane >> 5;
    const float* in_conv_w = inptr(3); const float* in_a_log = inptr(4); const float* in_dt_bias = inptr(5);
    const int b = ch >> 7, h = (ch >> 5) & 3, n = ch & 31;
    bf16_t* Qr = (bf16_t*)(F.lds + L_QR); bf16_t* Kr = (bf16_t*)(F.lds + L_KR); bf16_t* KT = (bf16_t*)(F.lds + L_KT); bf16_t* VT = (bf16_t*)(F.lds + L_VT);
    float* Nm = (float*)(F.lds + L_NM); float* Tm = (float*)(F.lds + L_TM); float* Pm = (float*)(F.lds + L_PM);
    bf16_t* Tu = (bf16_t*)(F.lds + L_TU); bf16_t* Tw = (bf16_t*)(F.lds + L_TW);
    float* beta_s = (float*)(F.lds + L_SC); float* gc_s = beta_s + 64; float* egc_s = gc_s + 64; float* begc_s = egc_s + 64;
    const bf16_t* HP = WSP(const bf16_t, WS_HP);
    const int t0 = 64 * n; const size_t rowb = (size_t)b * SEQ;
    unsigned char* dnb = F.ws + WS_DN + (size_t)ch * DN_STRIDE;
#pragma unroll
    for (int it = 0; it < 2; ++it) {
        const int idx = it * NTHREADS + tid;
        if (idx < 768) {
        const int c3 = idx >> 8, rem = idx & 255, tg = rem >> 4, d0 = (rem & 15) * 8;
        const int chn = c3 * 512 + h * 128 + d0;
        f32x4 cw[4][2];
#pragma unroll
        for (int j = 0; j < 4; ++j) { cw[j][0] = *(const f32x4*)(in_conv_w + (size_t)j * 1536 + chn); cw[j][1] = *(const f32x4*)(in_conv_w + (size_t)j * 1536 + chn + 4); }
        u32x4 xr[7];
#pragma unroll
        for (int r = 0; r < 7; ++r) xr[r] = pre.xr[it][r];
        float y[4][8];
#pragma unroll
        for (int q = 0; q < 4; ++q)
#pragma unroll
            for (int c = 0; c < 8; ++c) y[q][c] = 0.f;
#pragma unroll
        for (int r = 0; r < 7; ++r) { const int t = t0 + 4 * tg - 3 + r; const float msk = t < 0 ? 0.f : 1.f; f32x4 xa, xb; pg8::unpack8(xr[r], xa, xb); xa = xa * msk; xb = xb * msk;
#pragma unroll
            for (int q = 0; q < 4; ++q) { const int j = r - q; if (j >= 0 && j < 4) {
#pragma unroll
                for (int c = 0; c < 4; ++c) { y[q][c] += xa[c] * cw[j][0][c]; y[q][4 + c] += xb[c] * cw[j][1][c]; } } } }
        unsigned pk[4][4];
#pragma unroll
        for (int q = 0; q < 4; ++q) { float ss = 0.f;
#pragma unroll
            for (int c = 0; c < 8; ++c) { y[q][c] = y[q][c] * sigm(y[q][c]); ss += y[q][c] * y[q][c]; }
            ss += __shfl_xor(ss, 1); ss += __shfl_xor(ss, 2); ss += __shfl_xor(ss, 4); ss += __shfl_xor(ss, 8);
            const float sc = (c3 == 2) ? 1.f : rsqrtf(ss + 1e-6f) * (c3 == 0 ? 0.08838834764831845f : 1.f);
#pragma unroll
            for (int c = 0; c < 4; ++c) pk[q][c] = cvtpk(y[q][2 * c] * sc, y[q][2 * c + 1] * sc); }
        const int i0 = 4 * tg;
        if (c3 < 2) { bf16_t* dst = (c3 == 0 ? Qr : Kr) + i0 * QR_S + d0;
#pragma unroll
            for (int q = 0; q < 4; ++q) *(u32x4*)(dst + q * QR_S) = (u32x4){pk[q][0], pk[q][1], pk[q][2], pk[q][3]}; }
        if (c3 >= 1) { bf16_t* dt = (c3 == 1 ? KT : VT) + d0 * KT_S + i0;
#pragma unroll
            for (int c = 0; c < 4; ++c) {
                u32x2 lo, hi2; lo.x = (pk[0][c] & 0xffffu) | (pk[1][c] << 16); lo.y = (pk[2][c] & 0xffffu) | (pk[3][c] << 16);
                hi2.x = (pk[0][c] >> 16) | (pk[1][c] & 0xffff0000u); hi2.y = (pk[2][c] >> 16) | (pk[3][c] & 0xffff0000u);
                *(u32x2*)(dt + (2 * c) * KT_S) = lo; *(u32x2*)(dt + (2 * c + 1) * KT_S) = hi2; } }
        }
    }
    if (tid < 64) {
        const float* BA = WSP(const float, WS_BA) + (rowb + t0 + tid) * 8;
        const float bl = BA[h], al = BA[4 + h] + in_dt_bias[h];
        const float sp = fmaxf(al, 0.f) + log1pf(__expf(-fabsf(al)));
        float g = -__expf(in_a_log[h]) * sp;
#pragma unroll
        for (int o = 1; o < 64; o <<= 1) { const float up = __shfl_up(g, o); if (tid >= o) g += up; }
        const float bt = sigm(bl), eg = __expf(g);
        beta_s[tid] = bt; gc_s[tid] = g; egc_s[tid] = eg; begc_s[tid] = bt * eg;
        if (tid == 63) WSP(float, WS_EG)[ch] = eg;
    }
    __syncthreads();
    if (pflags & 32) return;
    {
        const int sel = wave >> 2, tq = wave & 3, mt = (tq == 0) ? 0 : 1, nt = (tq == 3) ? 1 : (tq == 2 ? 1 : 0);
        const int amt = sel ? ((tq == 1) ? 0 : mt) : mt, ant = sel ? ((tq == 1) ? 1 : nt) : nt;
        f32x16 c;
#pragma unroll
        for (int r = 0; r < 16; ++r) c[r] = 0.f;
        if (tq != 3) {
            const bf16_t* ap = Kr + (32 * amt + r32) * QR_S + 8 * hi; const bf16_t* bp = (sel ? Qr : Kr) + (32 * ant + r32) * QR_S + 8 * hi;
#pragma unroll
            for (int s = 0; s < 8; ++s) c = MFMA32(*(const bf16x8*)(ap + 16 * s), *(const bf16x8*)(bp + 16 * s), c);
        }
        if (sel == 0) {
            const int mtt = (tq == 3) ? 0 : mt, ntt = (tq == 3) ? 1 : nt, j = 32 * ntt + r32; const float gj = gc_s[j];
#pragma unroll
            for (int r = 0; r < 16; ++r) { const int i = 32 * mtt + crow(r, hi); Nm[i * NM_S + j] = (j < i) ? beta_s[i] * c[r] * __expf(gc_s[i] - gj) : 0.f; }
        } else {
            const int jt = (tq == 3) ? 1 : amt, itile = (tq == 3) ? 0 : ant, i = 32 * itile + r32; const float gi = gc_s[i];
#pragma unroll
            for (int r = 0; r < 16; ++r) { const int j = 32 * jt + crow(r, hi); c[r] = (j <= i) ? c[r] * __expf(gi - gc_s[j]) : 0.f; }
            bf16_t* AT = (bf16_t*)(dnb + DN_AT);
            *(bf16x8*)(AT + ((itile * 4 + 2 * jt) * 64 + lane) * 8) = pack8(c, 0); *(bf16x8*)(AT + ((itile * 4 + 2 * jt + 1) * 64 + lane) * 8) = pack8(c, 8);
        }
        bf16_t* QD = (bf16_t*)(dnb + DN_QD); bf16_t* KD = (bf16_t*)(dnb + DN_KD); const float glast = gc_s[63];
#pragma unroll
        for (int k2 = 0; k2 < 2; ++k2) { const int f = 2 * wave + k2, m2 = f >> 3, s = f & 7, tok = 32 * m2 + r32; const float e = egc_s[tok];
            const u32x2 lo = *(const u32x2*)(Qr + tok * QR_S + 16 * s + 4 * hi), hi2 = *(const u32x2*)(Qr + tok * QR_S + 16 * s + 8 + 4 * hi);
            u32x4 w; w.x = cvtpk(bflo(lo.x) * e, bfhi(lo.x) * e); w.y = cvtpk(bflo(lo.y) * e, bfhi(lo.y) * e); w.z = cvtpk(bflo(hi2.x) * e, bfhi(hi2.x) * e); w.w = cvtpk(bflo(hi2.y) * e, bfhi(hi2.y) * e);
            *(u32x4*)(QD + (f * 64 + lane) * 8) = w; }
#pragma unroll
        for (int k2 = 0; k2 < 2; ++k2) { const int f = 2 * wave + k2, mt2 = f >> 2, s = f & 3, dk = 32 * mt2 + r32, tk = 16 * s + 4 * hi;
            const u32x2 lo = *(const u32x2*)(KT + dk * KT_S + tk), hi2 = *(const u32x2*)(KT + dk * KT_S + tk + 8);
            float e[8];
#pragma unroll
            for (int q = 0; q < 4; ++q) { e[q] = __expf(glast - gc_s[tk + q]); e[4 + q] = __expf(glast - gc_s[tk + 8 + q]); }
            u32x4 w; w.x = cvtpk(bflo(lo.x) * e[0], bfhi(lo.x) * e[1]); w.y = cvtpk(bflo(lo.y) * e[2], bfhi(lo.y) * e[3]); w.z = cvtpk(bflo(hi2.x) * e[4], bfhi(hi2.x) * e[5]); w.w = cvtpk(bflo(hi2.y) * e[6], bfhi(hi2.y) * e[7]);
            *(u32x4*)(KD + (f * 64 + lane) * 8) = w; }
    }
    __syncthreads();
    if (pflags & 64) return;
    if (tid < 64) { const int blk = tid >> 4, col = tid & 15, o = 16 * blk; float x[16];
#pragma unroll
        for (int i = 0; i < 16; ++i) { float a = (i == col) ? 1.f : 0.f;
#pragma unroll
            for (int j = 0; j < i; ++j) a -= Nm[(o + i) * NM_S + o + j] * x[j];
            x[i] = a; }
#pragma unroll
        for (int i = 0; i < 16; ++i) { Tm[(o + i) * NM_S + o + col] = x[i]; if (!(blk & 1)) Tm[(o + i) * NM_S + o + 16 + col] = 0.f; } }
    __syncthreads();
    { const int pb = tid >> 8, r = (tid >> 4) & 15, c = tid & 15, oi = 32 * pb + 16, oj = 32 * pb; float a = 0.f;
#pragma unroll
        for (int k = 0; k < 16; ++k) a += Nm[(oi + r) * NM_S + oj + k] * Tm[(oj + k) * NM_S + oj + c];
        Pm[pb * 272 + r * 17 + c] = a; }
    __syncthreads();
    { const int pb = tid >> 8, r = (tid >> 4) & 15, c = tid & 15, oi = 32 * pb + 16, oj = 32 * pb; float a = 0.f;
#pragma unroll
        for (int k = 0; k < 16; ++k) a -= Tm[(oi + r) * NM_S + oi + k] * Pm[pb * 272 + k * 17 + c];
        Tm[(oi + r) * NM_S + oj + c] = a; }
    __syncthreads();
    { const int r = tid >> 4, c = tid & 15; float a0 = 0.f, a1 = 0.f;
#pragma unroll 8
        for (int k = 0; k < 32; ++k) { const float nv = Nm[(32 + r) * NM_S + k]; a0 += nv * Tm[k * NM_S + c]; a1 += nv * Tm[k * NM_S + c + 16]; }
        Pm[r * 36 + c] = a0; Pm[r * 36 + c + 16] = a1; }
    __syncthreads();
    { const int r = tid >> 4, c = tid & 15; float a0 = 0.f, a1 = 0.f;
#pragma unroll 8
        for (int k = 0; k < 32; ++k) { const float tv = Tm[(32 + r) * NM_S + 32 + k]; a0 -= tv * Pm[k * 36 + c]; a1 -= tv * Pm[k * 36 + c + 16]; }
        Tm[(32 + r) * NM_S + c] = a0; Tm[(32 + r) * NM_S + c + 16] = a1; }
    __syncthreads();
    { const int i = tid >> 3, j0 = (tid & 7) * 8; float tu[8], tw[8];
#pragma unroll
        for (int q = 0; q < 8; ++q) { const int j = j0 + q; const float t = (i < 32 && j >= 32) ? 0.f : Tm[i * NM_S + j]; tu[q] = t * beta_s[j]; tw[q] = t * begc_s[j]; }
        *(u32x4*)(Tu + i * KT_S + j0) = (u32x4){cvtpk(tu[0], tu[1]), cvtpk(tu[2], tu[3]), cvtpk(tu[4], tu[5]), cvtpk(tu[6], tu[7])};
        *(u32x4*)(Tw + i * KT_S + j0) = (u32x4){cvtpk(tw[0], tw[1]), cvtpk(tw[2], tw[3]), cvtpk(tw[4], tw[5]), cvtpk(tw[6], tw[7])}; }
    __syncthreads();
    if (pflags & 128) return;
    { const int mt = wave >> 2, nt = wave & 3;
        f32x16 c;
#pragma unroll
        for (int r = 0; r < 16; ++r) c[r] = 0.f;
        const bf16_t* ap = Tu + (32 * mt + r32) * KT_S + 8 * hi; const bf16_t* bp = VT + (32 * nt + r32) * KT_S + 8 * hi;
#pragma unroll
        for (int s = 0; s < 4; ++s) c = MFMA32(*(const bf16x8*)(ap + 16 * s), *(const bf16x8*)(bp + 16 * s), c);
        bf16_t* U = (bf16_t*)(dnb + DN_U);
        *(bf16x8*)(U + ((nt * 4 + mt * 2) * 64 + lane) * 8) = pack8(c, 0); *(bf16x8*)(U + ((nt * 4 + mt * 2 + 1) * 64 + lane) * 8) = pack8(c, 8);
    }
    { const int mt = wave >> 1, nt = wave & 1;
        f32x16 c;
#pragma unroll
        for (int r = 0; r < 16; ++r) c[r] = 0.f;
        const bf16_t* ap = KT + (32 * mt + r32) * KT_S + 8 * hi; const bf16_t* bp = Tw + (32 * nt + r32) * KT_S + 8 * hi;
#pragma unroll
        for (int s = 0; s < 4; ++s) c = MFMA32(*(const bf16x8*)(ap + 16 * s), *(const bf16x8*)(bp + 16 * s), c);
#pragma unroll
        for (int r = 0; r < 16; ++r) c[r] = -c[r];
        bf16_t* WN = (bf16_t*)(dnb + DN_WN);
        *(bf16x8*)(WN + ((nt * 8 + 2 * mt) * 64 + lane) * 8) = pack8(c, 0); *(bf16x8*)(WN + ((nt * 8 + 2 * mt + 1) * 64 + lane) * 8) = pack8(c, 8);
    }
    __syncthreads();
}
__device__ __forceinline__ void kv_unit(const Frame& F, int u) {
    THREAD_IDS();
    const int bh = u >> 2, s0 = (u & 3) * 512, b = bh >> 3, h = bh & 7;
    bf16_t* kt = (bf16_t*)F.lds; bf16_t* vt = kt + 512 * 64;
    const bf16_t* HP = WSP(const bf16_t, WS_HP);
#pragma unroll
    for (int it = 0; it < 8; ++it) { const int idx = it * NTHREADS + tid, r = idx >> 3, c8 = (idx & 7) * 8;
        const bf16_t* src = HP + ((size_t)b * SEQ + s0 + r) * HPW + h * 64 + c8;
        const int sw = r * 64 + (((c8 >> 3) ^ (r & 7)) << 3);
        *(u32x4*)(kt + sw) = *(const u32x4*)(src + 512); *(u32x4*)(vt + sw) = *(const u32x4*)(src + 1024); }
    __syncthreads();
    const int r32 = lane & 31, hi = lane >> 5;
#pragma unroll 1
    for (int it = 0; it < 6; ++it) { const int q = it * NWAVES + wave;
        const int di = q >> 4, bi = q & 15, d = (di == 0) ? 1 : (di == 1 ? 4 : 16), nbd = 64 / d, per = 16 / d;
        const int c = bi / per, nbl = bi % per, nb = (s0 / d) / 32 + nbl;
        const size_t fbase = ((size_t)di * (T_TOK * 512)) + (((size_t)bh * 64 + c * nbd + nb) * 4) * 512 + lane * 8;
        bf16_t* kf = WSP(bf16_t, WS_KF) + fbase; bf16_t* vf = WSP(bf16_t, WS_VT) + fbase;
        const int prow = c + d * (32 * nbl + r32);
#pragma unroll
        for (int d0 = 0; d0 < 4; ++d0) *(u32x4*)(kf + d0 * 512) = *(const u32x4*)(kt + prow * 64 + (((2 * d0 + hi) ^ (prow & 7)) << 3));
#pragma unroll
        for (int eb = 0; eb < 2; ++eb)
#pragma unroll
            for (int ks = 0; ks < 2; ++ks) { unsigned w[4];
#pragma unroll
                for (int jj = 0; jj < 4; ++jj) { const int j0 = 2 * jj, j1 = 2 * jj + 1;
                    const int n0 = 32 * nbl + 16 * ks + 8 * (j0 >> 2) + 4 * hi + (j0 & 3), n1 = 32 * nbl + 16 * ks + 8 * (j1 >> 2) + 4 * hi + (j1 & 3);
                    const int ra = c + d * n0, rb = c + d * n1, ech = 4 * eb + (r32 >> 3);
                    const unsigned lo = vt[ra * 64 + ((ech ^ (ra & 7)) << 3) + (r32 & 7)], hi2 = vt[rb * 64 + ((ech ^ (rb & 7)) << 3) + (r32 & 7)]; w[jj] = lo | (hi2 << 16); }
                *(u32x4*)(vf + (eb * 2 + ks) * 512) = (u32x4){w[0], w[1], w[2], w[3]}; }
    }
    __syncthreads();
}

constexpr int SCAN_BUF = 73728;
__device__ __forceinline__ void scan_stage4(const unsigned char* dnb, int wv, LAS unsigned char* buf, int lane) {
    const unsigned char* src = dnb + wv * 18432 + lane * 16; LAS unsigned char* dst = buf + wv * 18432;
#pragma unroll 1
    for (int f = 0; f < 18; ++f) __builtin_amdgcn_global_load_lds((const unsigned*)(src + f * 1024), (LAS unsigned*)(dst + f * 1024), 16, 0, 0);
}
__device__ __forceinline__ void scan_unit4(const Frame& F, int bh, int sl) {
    THREAD_IDS();
    const int r32 = lane & 31, hi = lane >> 5;
    const int b = bh >> 2, h = bh & 3;
    LAS unsigned char* lds3 = (LAS unsigned char*)F.lds;
    volatile LAS unsigned* sbar = (volatile LAS unsigned*)(lds3 + LDS_MISC + 4096 + 64);
    f32x16 S[4];
#pragma unroll
    for (int mt = 0; mt < 4; ++mt)
#pragma unroll
        for (int r = 0; r < 16; ++r) S[mt][r] = 0.f;
    bf16_t* ORAW = WSP(bf16_t, WS_ORAW);
    const int ch0 = bh * 32;
    scan_stage4(F.ws + WS_DN + (size_t)ch0 * DN_STRIDE, sl, lds3, lane);
#pragma unroll 1
    for (int n = 0; n < 32; ++n) {
        const int ch = ch0 + n;
        LAS unsigned char* buf = lds3 + (n & 1) * SCAN_BUF;
        float eg = WSP(const float, WS_EG)[ch];
        asm volatile("s_waitcnt vmcnt(0) lgkmcnt(0)" : "+v"(eg) :: "memory");
        if (lane == 0) __hip_atomic_fetch_add((LAS unsigned*)sbar, 1u, __ATOMIC_RELAXED, __HIP_MEMORY_SCOPE_WORKGROUP);
        { const unsigned want = 4u * (unsigned)(n + 1); while (*sbar < want) __builtin_amdgcn_s_sleep(1); }
        asm volatile("" ::: "memory");
        if (n + 1 < 32) scan_stage4(F.ws + WS_DN + (size_t)(ch + 1) * DN_STRIDE, sl, lds3 + ((n + 1) & 1) * SCAN_BUF, lane);
        const LAS unsigned char* fb = buf + lane * 16;
        bf16x8 Sb[8];
#pragma unroll
        for (int mt = 0; mt < 4; ++mt) { Sb[2 * mt] = pack8(S[mt], 0); Sb[2 * mt + 1] = pack8(S[mt], 8); }
        f32x16 vn[2], o[2];
#pragma unroll
        for (int m2 = 0; m2 < 2; ++m2) {
#pragma unroll
            for (int r8 = 0; r8 < 2; ++r8) { const u32x4 uu = *(const LAS u32x4*)(fb + 57344 + (sl * 4 + m2 * 2 + r8) * 1024);
                vn[m2][8 * r8] = bflo(uu.x); vn[m2][8 * r8 + 1] = bfhi(uu.x); vn[m2][8 * r8 + 2] = bflo(uu.y); vn[m2][8 * r8 + 3] = bfhi(uu.y);
                vn[m2][8 * r8 + 4] = bflo(uu.z); vn[m2][8 * r8 + 5] = bfhi(uu.z); vn[m2][8 * r8 + 6] = bflo(uu.w); vn[m2][8 * r8 + 7] = bfhi(uu.w); }
#pragma unroll
            for (int s = 0; s < 8; ++s) { const bf16x8 a = *(const LAS bf16x8*)(fb + (m2 * 8 + s) * 1024); vn[m2] = MFMA32(a, Sb[s], vn[m2]); }
            __builtin_amdgcn_sched_barrier(0);
#pragma unroll
            for (int r = 0; r < 16; ++r) o[m2][r] = 0.f;
#pragma unroll
            for (int s = 0; s < 8; ++s) { const bf16x8 a = *(const LAS bf16x8*)(fb + 16384 + (m2 * 8 + s) * 1024); o[m2] = MFMA32(a, Sb[s], o[m2]); }
            __builtin_amdgcn_sched_barrier(0);
        }
        bf16x8 vb[4];
#pragma unroll
        for (int m2 = 0; m2 < 2; ++m2) { vb[2 * m2] = pack8(vn[m2], 0); vb[2 * m2 + 1] = pack8(vn[m2], 8); }
#pragma unroll
        for (int m2 = 0; m2 < 2; ++m2) {
#pragma unroll
            for (int s = 0; s < 4; ++s) { const bf16x8 a = *(const LAS bf16x8*)(fb + 32768 + (m2 * 4 + s) * 1024); o[m2] = MFMA32(a, vb[s], o[m2]); }
#pragma unroll
            for (int r = 0; r < 16; ++r) ORAW[((size_t)b * SEQ + 64 * n + 32 * m2 + crow(r, hi)) * 512 + h * 128 + 32 * sl + r32] = f2bf(o[m2][r]);
            __builtin_amdgcn_sched_barrier(0);
        }
#pragma unroll
        for (int mt = 0; mt < 4; ++mt) {
#pragma unroll
            for (int r = 0; r < 16; ++r) S[mt][r] *= eg;
#pragma unroll
            for (int s = 0; s < 4; ++s) { const bf16x8 a = *(const LAS bf16x8*)(fb + 40960 + (mt * 4 + s) * 1024); S[mt] = MFMA32(a, vb[s], S[mt]); }
            if (mt & 1) __builtin_amdgcn_sched_barrier(0);
        }
    }
    asm volatile("s_waitcnt vmcnt(0) lgkmcnt(0)" ::: "memory");
}
__device__ __forceinline__ void attn_block(const bf16x8 (&kc)[4], const bf16x8 (&vc)[4], const bf16x8 (&qr)[4], f32x16 (&o)[2], float& m_run, float& l_run, int dn0  ) {
    f32x16 s;
#pragma unroll
    for (int r = 0; r < 16; ++r) s[r] = 0.f;
#pragma unroll
    for (int d0 = 0; d0 < 4; ++d0) s = MFMA32(kc[d0], qr[d0], s);
#pragma unroll
    for (int r = 0; r < 16; ++r) { const unsigned dlt = (unsigned)(dn0 - ((r & 3) + 8 * (r >> 2))); s[r] = (dlt <= 128u) ? s[r] : -INFINITY; }
    float mb = fmaxf(fmaxf(s[0], s[1]), fmaxf(s[2], s[3]));
#pragma unroll
    for (int r = 4; r < 16; r += 4) mb = fmaxf(mb, fmaxf(fmaxf(s[r], s[r + 1]), fmaxf(s[r + 2], s[r + 3])));
    mb = fmaxf(mb, __shfl_xor(mb, 32));
    const float mn = fmaxf(m_run, mb);
    {
        const float al = __builtin_amdgcn_exp2f(m_run - mn);
        l_run *= al; m_run = mn;
#pragma unroll
        for (int eb = 0; eb < 2; ++eb)
#pragma unroll
            for (int r = 0; r < 16; ++r) o[eb][r] *= al;
    }
    float ps = 0.f;
#pragma unroll
    for (int r = 0; r < 16; ++r) { s[r] = __builtin_amdgcn_exp2f(s[r] - mn); ps += s[r]; }
    l_run += ps;
    const bf16x8 pb0 = pack8(s, 0), pb1 = pack8(s, 8);
#pragma unroll
    for (int eb = 0; eb < 2; ++eb)
#pragma unroll
        for (int ks = 0; ks < 2; ++ks) o[eb] = MFMA32(vc[eb * 2 + ks], ks ? pb1 : pb0, o[eb]);
}
template <int D_>
__device__ __forceinline__ void attn_branch(const Frame& F, int di, int b, int h, int t0, int jq, const bf16x8 (&qr)[4], f32x16 (&o)[2], float& m_run, float& l_run) {
    THREAD_IDS();
    const int r32 = lane & 31, hi = lane >> 5;
    constexpr int STEP = 16 / D_, NBD = 64 / D_;
    const int c = t0 % D_, a0 = t0 / D_;
    const int nq = a0 + STEP * (32 * jq + r32);
    const int nq_lo = a0 + STEP * (32 * jq), nq_hi = a0 + STEP * (32 * jq + 31);
    const int n_lo = (nq_lo - 128) > 0 ? (nq_lo - 128) : 0;
    const size_t fbase = ((size_t)di * (T_TOK * 512)) + (((size_t)(b * 8 + h) * 64 + c * NBD) * 4) * 512;
    const unsigned char* KF = (const unsigned char*)(WSP(const bf16_t, WS_KF) + fbase); const unsigned char* VF = (const unsigned char*)(WSP(const bf16_t, WS_VT) + fbase);
    const unsigned loff = (unsigned)lane * 16u;
    const int nb0 = n_lo >> 5, nb1 = nq_hi >> 5;
    const int dq = nq - 4 * hi;
#define ATT_LOAD(KX, VX, NB) do { const int nb_ = (NB) < nb1 ? (NB) : nb1; _Pragma("unroll") for (int f = 0; f < 4; ++f) { const unsigned off = (unsigned)nb_ * 4096u + loff + f * 1024; KX[f] = *(const bf16x8*)(KF + off); VX[f] = *(const bf16x8*)(VF + off); } } while (0)
    bf16x8 kA[4], vA[4], kB[4], vB[4], kC[4], vC[4];
    ATT_LOAD(kA, vA, nb0); ATT_LOAD(kB, vB, nb0 + 1);
#pragma unroll 1
    for (int nb = nb0; nb <= nb1; nb += 3) {
        ATT_LOAD(kC, vC, nb + 2);
        attn_block(kA, vA, qr, o, m_run, l_run, dq - 32 * nb);
        if (nb + 1 > nb1) break;
        ATT_LOAD(kA, vA, nb + 3);
        attn_block(kB, vB, qr, o, m_run, l_run, dq - 32 * (nb + 1));
        if (nb + 2 > nb1) break;
        ATT_LOAD(kB, vB, nb + 4);
        attn_block(kC, vC, qr, o, m_run, l_run, dq - 32 * (nb + 2));
    }
#undef ATT_LOAD
}
__device__ __forceinline__ void attn_task(const Frame& F, int a) {
    THREAD_IDS();
    const int r32 = lane & 31, hi = lane >> 5;
    const int x = F.blk & 7, bh = x + 8 * (a >> 6), tw = a & 63, t0 = tw & 15, jq = 3 - (tw >> 4), b = bh >> 3, h = bh & 7;
    const int tq = t0 + 16 * (32 * jq + r32);
    const bf16_t* HP = WSP(const bf16_t, WS_HP);
    bf16x8 qr[4];
#pragma unroll
    for (int d0 = 0; d0 < 4; ++d0) { const u32x4 qw = *(const u32x4*)(HP + ((size_t)b * SEQ + tq) * HPW + h * 64 + 16 * d0 + 8 * hi);
        constexpr float SCQ = 0.125f * 1.4426950408889634f; u32x4 w;
        w.x = cvtpk(bflo(qw.x) * SCQ, bfhi(qw.x) * SCQ); w.y = cvtpk(bflo(qw.y) * SCQ, bfhi(qw.y) * SCQ); w.z = cvtpk(bflo(qw.z) * SCQ, bfhi(qw.z) * SCQ); w.w = cvtpk(bflo(qw.w) * SCQ, bfhi(qw.w) * SCQ);
        qr[d0] = __builtin_bit_cast(bf16x8, w); }
    f32x16 o[2];
#pragma unroll
    for (int eb = 0; eb < 2; ++eb)
#pragma unroll
        for (int r = 0; r < 16; ++r) o[eb][r] = 0.f;
    float m_run = -1e30f, l_run = 0.f;
    attn_branch<1>(F, 0, b, h, t0, jq, qr, o, m_run, l_run);
    attn_branch<4>(F, 1, b, h, t0, jq, qr, o, m_run, l_run);
    attn_branch<16>(F, 2, b, h, t0, jq, qr, o, m_run, l_run);
    const float lt = l_run + __shfl_xor(l_run, 32), inv = 1.f / lt;
    bf16_t* dst = WSP(bf16_t, WS_MIX) + ((size_t)b * SEQ + tq) * DM + h * 64;
#pragma unroll
    for (int eb = 0; eb < 2; ++eb)
#pragma unroll
        for (int g = 0; g < 4; ++g) { u32x2 w; w.x = cvtpk(o[eb][4 * g] * inv, o[eb][4 * g + 1] * inv); w.y = cvtpk(o[eb][4 * g + 2] * inv, o[eb][4 * g + 3] * inv);
            *(u32x2*)(dst + 32 * eb + 8 * g + 4 * hi) = w; }
}
__device__ __forceinline__ void phase3(const Frame& F, int flags) {
    THREAD_IDS();
    if (tid == 0) *(volatile LAS unsigned*)((LAS unsigned char*)F.lds + LDS_MISC + 4096 + 64) = 0u;
    __syncthreads();
    if (F.blk < 64 && wave < 4 && !(flags & 1)) scan_unit4(F, F.blk, wave);
    unsigned* qctr = WSP(unsigned, WS_CTL) + 1024 + (F.blk & 7) * 32;
    const float* w_gate_up = inptr(12); const float* w_down = inptr(14);
    const int gw = F.blk * NWAVES + wave, NGW = F.G * NWAVES;
    bool more_a = !(flags & 2); int wi = 0;
    while (more_a || wi < 4) {
        if (more_a) { unsigned a = 0; if (lane == 0) a = atomicAdd(qctr, 1u);
            a = (unsigned)__builtin_amdgcn_readfirstlane((int)a);
            if (a >= 1024u) more_a = false; else attn_task(F, (int)a); }
        if (wi < 4) { if (gw + (3 * wi + 2) * NGW < MOE_TILES) moe_weight_batch3(F, gw + 3 * wi * NGW, NGW, w_gate_up, w_down, lane); ++wi; }
    }
}

__device__ __forceinline__ void phase4(const Frame& F) {
    THREAD_IDS();
    const float* in_gnorm_w = inptr(6);
    const int gw = F.blk * NWAVES + wave, NGW = F.G * NWAVES;
    const bf16_t* ORAW = WSP(const bf16_t, WS_ORAW); const bf16_t* HP = WSP(const bf16_t, WS_HP); bf16_t* MIX = WSP(bf16_t, WS_MIX);
    const f32x4 gw0 = *(const f32x4*)(in_gnorm_w + (lane & 15) * 8), gw1 = *(const f32x4*)(in_gnorm_w + (lane & 15) * 8 + 4);
    for (int row = gw; row < T_TOK; row += NGW) {
        const u32x4 ow = *(const u32x4*)(ORAW + (size_t)row * 512 + lane * 8), zw = *(const u32x4*)(HP + (size_t)row * HPW + 3072 + lane * 8);
        f32x4 oa, ob, za, zb; pg8::unpack8(ow, oa, ob); pg8::unpack8(zw, za, zb);
        float ss = oa[0] * oa[0] + oa[1] * oa[1] + oa[2] * oa[2] + oa[3] * oa[3] + ob[0] * ob[0] + ob[1] * ob[1] + ob[2] * ob[2] + ob[3] * ob[3];
        ss += __shfl_xor(ss, 1); ss += __shfl_xor(ss, 2); ss += __shfl_xor(ss, 4); ss += __shfl_xor(ss, 8);
        const float r = rsqrtf(ss * (1.f / 128.f) + 1e-6f);
        f32x4 ya, yb;
#pragma unroll
        for (int j = 0; j < 4; ++j) { ya[j] = oa[j] * r * gw0[j] * (za[j] * sigm(za[j])); yb[j] = ob[j] * r * gw1[j] * (zb[j] * sigm(zb[j])); }
        *(u32x4*)(MIX + (size_t)row * DM + 512 + lane * 8) = pg8::pack_row8(ya, yb);
    }
}

__device__ __forceinline__ void phase6(const Frame& F) {
    THREAD_IDS();
    const float* in_ln1_g = inptr(8); const float* in_ln1_b = inptr(9); const float* in_b_router = inptr(11);
    float* wrt = (float*)F.lds;
    { const f32x4* src = WSP(const f32x4, WS_WRT); f32x4* dst = (f32x4*)wrt; for (int i = tid; i < 8192; i += NTHREADS) dst[i] = src[i]; }
    __syncthreads();
    const int gw = F.blk * NWAVES + wave, NGW = F.G * NWAVES;
    bf16_t* X1 = WSP(bf16_t, WS_X1);
    unsigned* cnt = WSP(unsigned, WS_CTL); int* rt_e = WSP(int, WS_ROUTE); int* rt_s = rt_e + T_TOK * 4; int* ltok = WSP(int, WS_LTOK); float* lgate = WSP(float, WS_LGATE);
    int* s_cnt = (int*)(F.lds + LDS_MISC + 4096); int* s_base = s_cnt + 32; int* s_e = s_base + 32; float* s_g = (float*)(s_e + 512); int* s_li = (int*)(s_g + 512);
    if (tid < 32) s_cnt[tid] = 0;
    __syncthreads();
    int irow = 0;
    f32x4 lg[4], lb[4];
#pragma unroll
    for (int j = 0; j < 4; ++j) { lg[j] = *(const f32x4*)(in_ln1_g + 4 * lane + 256 * j); lb[j] = *(const f32x4*)(in_ln1_b + 4 * lane + 256 * j); }
    const float brl = in_b_router[((lane >> 5) & 1) * 16 + ((lane >> 4) & 1) * 8 + ((lane >> 3) & 1) * 4 + ((lane >> 2) & 1) * 2 + ((lane >> 1) & 1)];
    for (int row = gw; row < T_TOK && irow < 16; row += NGW, ++irow) {
        u32x2* xr = (u32x2*)(X1 + (size_t)row * DM) + lane;
        f32x4 v[4]; float s = 0.f;
#pragma unroll
        for (int j = 0; j < 4; ++j) { const u32x2 w = xr[64 * j]; v[j] = (f32x4){bflo(w.x), bfhi(w.x), bflo(w.y), bfhi(w.y)}; s += (v[j][0] + v[j][1]) + (v[j][2] + v[j][3]); }
        const float mean = wave_sum(s) * (1.f / DM); float s2 = 0.f;
#pragma unroll
        for (int j = 0; j < 4; ++j) { v[j] = v[j] - mean; s2 += (v[j][0] * v[j][0] + v[j][1] * v[j][1]) + (v[j][2] * v[j][2] + v[j][3] * v[j][3]); }
        const float rstd = rsqrtf(wave_sum(s2) * (1.f / DM) + LN_EPS);
#pragma unroll
        for (int j = 0; j < 4; ++j) { v[j] = v[j] * rstd * lg[j] + lb[j]; u32x2 w; w.x = cvtpk(v[j][0], v[j][1]); w.y = cvtpk(v[j][2], v[j][3]); xr[64 * j] = w;
            (WSP(unsigned, WS_X1F) + (size_t)row * 256)[lane + 64 * j] = pk4_fp8(v[j][0], v[j][1], v[j][2], v[j][3]); }
        float pl[32];
#pragma unroll
        for (int e = 0; e < 32; ++e) { float a = 0.f;
#pragma unroll
            for (int j = 0; j < 4; ++j) { const f32x4 w = *(const f32x4*)(wrt + e * 1024 + 4 * lane + 256 * j); a += v[j][0] * w[0] + v[j][1] * w[1] + v[j][2] * w[2] + v[j][3] * w[3]; }
            pl[e] = a; if ((e & 3) == 3) asm volatile("" ::: "memory"); }
        float q16[16], q8[8], q4[4], q2[2];
        { const bool up = (lane & 32) != 0;
#pragma unroll
            for (int k = 0; k < 16; ++k) { const float keep = up ? pl[k + 16] : pl[k], send = up ? pl[k] : pl[k + 16]; q16[k] = keep + __shfl_xor(send, 32); } }
        { const bool up = (lane & 16) != 0;
#pragma unroll
            for (int k = 0; k < 8; ++k) { const float keep = up ? q16[k + 8] : q16[k], send = up ? q16[k] : q16[k + 8]; q8[k] = keep + __shfl_xor(send, 16); } }
        { const bool up = (lane & 8) != 0;
#pragma unroll
            for (int k = 0; k < 4; ++k) { const float keep = up ? q8[k + 4] : q8[k], send = up ? q8[k] : q8[k + 4]; q4[k] = keep + __shfl_xor(send, 8); } }
        { const bool up = (lane & 4) != 0;
#pragma unroll
            for (int k = 0; k < 2; ++k) { const float keep = up ? q4[k + 2] : q4[k], send = up ? q4[k] : q4[k + 2]; q2[k] = keep + __shfl_xor(send, 4); } }
        float lgt;
        { const bool up = (lane & 2) != 0; const float keep = up ? q2[1] : q2[0], send = up ? q2[0] : q2[1]; lgt = keep + __shfl_xor(send, 2); }
        lgt += __shfl_xor(lgt, 1);
        const int my_e = ((lane >> 5) & 1) * 16 + ((lane >> 4) & 1) * 8 + ((lane >> 3) & 1) * 4 + ((lane >> 2) & 1) * 2 + ((lane >> 1) & 1);
        lgt += brl;
        int rank = 0;
#pragma unroll
        for (int e = 0; e < 32; ++e) { const int src = ((e >> 4) & 1) * 32 + ((e >> 3) & 1) * 16 + ((e >> 2) & 1) * 8 + ((e >> 1) & 1) * 4 + (e & 1) * 2;
            const float ve = __uint_as_float((unsigned)__builtin_amdgcn_readlane((int)__float_as_uint(lgt), src));
            rank += (ve > lgt || (ve == lgt && e < my_e)) ? 1 : 0;
            if ((e & 7) == 7) __builtin_amdgcn_sched_barrier(0); }
        float tv[4]; int te[4];
#pragma unroll
        for (int k = 0; k < 4; ++k) { const unsigned long long mk = __ballot(rank == k && (lane & 1) == 0); const int src = (int)__builtin_ctzll(mk);
            tv[k] = __uint_as_float((unsigned)__builtin_amdgcn_readlane((int)__float_as_uint(lgt), src)); te[k] = __builtin_amdgcn_readlane(my_e, src); }
        const float e1 = __expf(tv[1] - tv[0]), e2 = __expf(tv[2] - tv[0]), e3 = __expf(tv[3] - tv[0]), inv = 1.f / (1.f + e1 + e2 + e3);
        if (lane < 4) { const int ek = lane == 0 ? te[0] : (lane == 1 ? te[1] : (lane == 2 ? te[2] : te[3]));
            const float gk = (lane == 0 ? 1.f : (lane == 1 ? e1 : (lane == 2 ? e2 : e3))) * inv;
            const int li = atomicAdd(s_cnt + ek, 1);
            const int q = (wave * 16 + irow) * 4 + lane; s_e[q] = ek; s_g[q] = gk; s_li[q] = li; }
    }
    __syncthreads();
    if (tid < 32) s_base[tid] = (int)atomicAdd(cnt + tid * 32, (unsigned)s_cnt[tid]);
    __syncthreads();
    { const int lr = tid >> 2, k = tid & 3, wv = lr >> 4, i = lr & 15;
        const int row = (F.blk * NWAVES + wv) + i * NGW;
        if (row < T_TOK) { const int ek = s_e[tid], slot = s_base[ek] + s_li[tid];
            ltok[(size_t)ek * LCAP + slot] = row; lgate[(size_t)ek * LCAP + slot] = s_g[tid]; rt_e[row * 4 + k] = ek; rt_s[row * 4 + k] = slot; } }
}
constexpr int ULIST_OFF = LDS_MISC + 1024, ULIST_MAX = 60;
__device__ __forceinline__ void build_tpre(const Frame& F, int nN, int ndense = 0) {
    THREAD_IDS();
    int* tpre = (int*)(F.lds + LDS_MISC); int* cnts = tpre + 64; int* ulist = (int*)(F.lds + ULIST_OFF);
    __syncthreads();
    if (tid == 0) { const unsigned* cnt = WSP(const unsigned, WS_CTL); int acc = 0;
        for (int e = 0; e < NEXP; ++e) { const int c = (int)__hip_atomic_load(cnt + e * 32, __ATOMIC_RELAXED, __HIP_MEMORY_SCOPE_AGENT); tpre[e] = acc; cnts[e] = c; acc += (c + 255) >> 8; }
        tpre[NEXP] = acc;
        if (nN > 0) { const int totale = acc * nN, total = totale + ndense; int i = 0;
            for (; i < ULIST_MAX; ++i) { const int L = pg8::unit_index(i, F.blk, F.G, total); if (L < 0) break;
                if (L >= totale) { const int l = L - totale, gid = l / 32, w = l - gid * 32;
                    ulist[4 * i] = 255 | ((w / 8) << 8); ulist[4 * i + 1] = gid * 8 + w % 8; ulist[4 * i + 2] = gid * 8 + w % 8; ulist[4 * i + 3] = 256; continue; }
                int e = 0; for (int k = 1; k < NEXP; ++k) if (L >= tpre[k] * nN) e = k;
                const int tp0 = tpre[e], tiles = tpre[e + 1] - tp0, l = L - tp0 * nN, nig = 8 * nN, gid = l / nig, fm = gid * 8, gsz = (tiles - fm) < 8 ? (tiles - fm) : 8, w = l - gid * nig;
                const int pn = w / gsz, pl = fm + w % gsz, rr = cnts[e] - 256 * pl;
                ulist[4 * i] = e | (pn << 8); ulist[4 * i + 1] = pl; ulist[4 * i + 2] = tp0 + pl; ulist[4 * i + 3] = rr < 256 ? rr : 256; }
            ulist[4 * i + 3] = 0; }
    }
    __syncthreads();
}

__device__ __forceinline__ void phase9(const Frame& F) {
    THREAD_IDS();
    const float* in_ln2_g = inptr(19); const float* in_ln2_b = inptr(20);
    build_tpre(F, 0);
    const int* tpre = (const int*)(F.lds + LDS_MISC);
    const int gw = F.blk * NWAVES + wave, NGW = F.G * NWAVES;
    const bf16_t* X1 = WSP(const bf16_t, WS_X1); const bf16_t* PLE = WSP(const bf16_t, WS_PLE); const unsigned char* YB = WSP(const unsigned char, WS_YB);
    const int* rt_e = WSP(const int, WS_ROUTE); const int* rt_s = rt_e + T_TOK * 4;
    f32x4 lg[4], lb[4];
#pragma unroll
    for (int j = 0; j < 4; ++j) { lg[j] = *(const f32x4*)(in_ln2_g + 4 * lane + 256 * j); lb[j] = *(const f32x4*)(in_ln2_b + 4 * lane + 256 * j); }
    for (int row = gw; row < T_TOK; row += NGW) {
        const u32x2* xr = (const u32x2*)(X1 + (size_t)row * DM) + lane; const u32x2* pr = (const u32x2*)(PLE + (size_t)row * DM) + lane;
        f32x4 v[4];
#pragma unroll
        for (int j = 0; j < 4; ++j) { const u32x2 w = xr[64 * j], q = pr[64 * j];
            v[j] = (f32x4){bflo(w.x), bfhi(w.x), bflo(w.y), bfhi(w.y)} * ALPHA + (f32x4){bflo(q.x), bfhi(q.x), bflo(q.y), bfhi(q.y)}; }
#pragma unroll
        for (int k = 0; k < 4; ++k) { const int e = rt_e[row * 4 + k], sl = rt_s[row * 4 + k]; const size_t R = (size_t)tpre[e] * 256 + sl;
            const unsigned* yr = (const unsigned*)(YB + R * DM) + lane;
#pragma unroll
            for (int j = 0; j < 4; ++j) { const int w = (int)yr[64 * j]; const f32x2_t lo = __builtin_amdgcn_cvt_pk_f32_fp8(w, false), hi2 = __builtin_amdgcn_cvt_pk_f32_fp8(w, true); v[j] = v[j] + (f32x4){lo[0], lo[1], hi2[0], hi2[1]}; } }
        float s = 0.f;
#pragma unroll
        for (int j = 0; j < 4; ++j) s += (v[j][0] + v[j][1]) + (v[j][2] + v[j][3]);
        const float mean = wave_sum(s) * (1.f / DM); float s2 = 0.f;
#pragma unroll
        for (int j = 0; j < 4; ++j) { v[j] = v[j] - mean; s2 += (v[j][0] * v[j][0] + v[j][1] * v[j][1]) + (v[j][2] * v[j][2] + v[j][3] * v[j][3]); }
        const float rstd = rsqrtf(wave_sum(s2) * (1.f / DM) + LN_EPS);
        f32x4* orow = (f32x4*)(F.out + (size_t)row * DM) + lane;
#pragma unroll
        for (int j = 0; j < 4; ++j) orow[64 * j] = v[j] * rstd * lg[j] + lb[j];
    }
}

constexpr int N_PHASES = 10;
__global__ void __launch_bounds__(NTHREADS, 2) fwd_kernel(Args args) {
    extern __shared__ __attribute__((aligned(16))) unsigned char lds_raw[];
    Frame F;
    F.lds = lds_raw; F.G = gridDim.x; F.blk = blockIdx.x;
    F.out = args.out; F.ws = args.ws;
    LAS unsigned char* lds3 = (LAS unsigned char*)lds_raw;
    const int lo = args.ph_lo, hi = args.ph_hi;
#if ONE_LAUNCH
    cg::grid_group grid = cg::this_grid();
    if (threadIdx.x < 2) ((LAS unsigned*)(lds3 + LDS_BARST))[threadIdx.x] = 0u;
    __syncthreads();
    XcdBarrier xbar = xcd_barrier_post(WSP(unsigned, WS_CTL) + CW_BAR, (volatile LAS unsigned*)(lds3 + LDS_BARST));
#define SEAM(k) do { if (lo <= (k) && (k) + 1 < hi) { if ((k) == 0) grid.sync(); else xcd_barrier(xbar); } } while (0)
#else
#define SEAM(k) do { } while (0)
#endif
#ifndef PHASE_MASK
#define PHASE_MASK 0x3ff
#endif
#define IN(k) (((PHASE_MASK >> (k)) & 1) && lo <= (k) && (k) < hi)
#define REPS(k) 1
#if ONE_LAUNCH
#define REPSYNC() xcd_barrier(xbar)
#else
#define REPSYNC() do { } while (0)
#endif
    if (IN(0)) { for (int rep = 0; rep < REPS(0); ++rep) { if (rep) REPSYNC(); phase0(F); } SEAM(0); }
    if (IN(1)) {
        for (int rep = 0; rep < REPS(1); ++rep) { if (rep) REPSYNC();
        pg8::DenseSched S{(const char*)WSP(bf16_t, WS_XB), (const char*)WSP(bf16_t, WS_WIN), T_TOK / 256, HPW / 256, 1024, F.blk, F.G};
        pg8::EpiStore E{WSP(bf16_t, WS_HP), HPW};
        pg8::gemm_phase<false>(lds3, 1024, S, E); }
        SEAM(1);
    }
    if (IN(2)) {
        for (int rep = 0; rep < REPS(2); ++rep) { if (rep) REPSYNC();
        const int nkv = (512 - F.blk + F.G - 1) / F.G, ndn = (2048 - F.blk + F.G - 1) / F.G; const bool kvfirst = !(F.blk & 1);
        if (kvfirst && !(args.flags & 8)) for (int k = 0; k < nkv; ++k) kv_unit(F, F.blk + k * F.G);
        if (!(args.flags & 4)) { DnPre cur; if (ndn > 0) dn_prefetch(F, F.blk, cur);
            for (int k = 0; k < ndn; ++k) { DnPre nxt; if (k + 1 < ndn) dn_prefetch(F, F.blk + (k + 1) * F.G, nxt); else nxt = cur;
                dn_prep_unit(F, F.blk + k * F.G, cur, args.flags); cur = nxt; } }
        if (!kvfirst && !(args.flags & 8)) for (int k = 0; k < nkv; ++k) kv_unit(F, F.blk + k * F.G); }
        SEAM(2);
    }
    if (IN(3)) { for (int rep = 0; rep < REPS(3); ++rep) { if (rep) { REPSYNC(); if (F.blk == 0 && threadIdx.x == 0) __hip_atomic_store(WSP(unsigned, WS_CTL) + 64, 0u, __ATOMIC_RELAXED, __HIP_MEMORY_SCOPE_AGENT); REPSYNC(); } phase3(F, args.flags); } SEAM(3); }
    if (IN(4)) { for (int rep = 0; rep < REPS(4); ++rep) { if (rep) REPSYNC(); phase4(F); } SEAM(4); }
    if (IN(5)) {
        for (int rep = 0; rep < REPS(5); ++rep) { if (rep) REPSYNC();
        pg8::DenseSched S{(const char*)WSP(bf16_t, WS_MIX), (const char*)WSP(bf16_t, WS_WOUT), T_TOK / 256, DM / 256, 1024, F.blk, F.G};
        pg8::EpiResid E{WSP(bf16_t, WS_X1), WSP(const bf16_t, WS_XB)};
        pg8::gemm_phase<false>(lds3, 1024, S, E); }
        SEAM(5);
    }
    if (IN(6)) { phase6(F); SEAM(6); }
    if (IN(7)) {
        build_tpre(F, 8, 512);
        for (int rep = 0; rep < REPS(7); ++rep) { if (rep) REPSYNC();
        { pg8::MoeSched<true> S{(const char*)WSP(unsigned char, WS_X1F), (const char*)WSP(unsigned char, WS_WGU), (size_t)2048 * 1024, WSP(const int, WS_LTOK), (const LAS int*)(lds3 + ULIST_OFF), 1024, (const char*)WSP(unsigned char, WS_WPG)};
          pg8::EpiActSig E{{WSP(unsigned char, WS_ACT), inptr(13)}, {WSP(bf16_t, WS_PLE), inptr(17)}};
          pg8::gemm_phase<true>(lds3, 1024, S, E); } }
        SEAM(7);
    }
    if (IN(8)) {
        build_tpre(F, 4);
        for (int rep = 0; rep < REPS(8); ++rep) { if (rep) REPSYNC();
        { pg8::MoeSched<false> S{(const char*)WSP(unsigned char, WS_ACT), (const char*)WSP(unsigned char, WS_WD), (size_t)1024 * 1024, nullptr, (const LAS int*)(lds3 + ULIST_OFF), 1024, nullptr};
          pg8::EpiDown E{WSP(unsigned char, WS_YB), inptr(15), WSP(const float, WS_LGATE)};
          pg8::gemm_phase<true>(lds3, 1024, S, E); } }
        { pg8::DenseSched S{(const char*)WSP(bf16_t, WS_PB), (const char*)WSP(bf16_t, WS_WPP), T_TOK / 256, DM / 256, 256, F.blk, F.G};
          pg8::EpiMul E{WSP(bf16_t, WS_PLE)};
          pg8::gemm_phase<false>(lds3, 256, S, E); }
        SEAM(8);
    }
    if (IN(9)) { for (int rep = 0; rep < REPS(9); ++rep) { if (rep) REPSYNC(); phase9(F); } }
}

extern "C" void kernel_launch(void* const* d_in, const int* in_sizes, int n_in, void* d_out, int out_size, void* d_ws, size_t ws_size, hipStream_t stream) {
    static int grid = 0;
    if (grid == 0) {
        if (n_in != 21 || out_size != T_TOK * DM || ws_size < WS_END) { fprintf(stderr, "kernel_launch: unexpected problem (n_in %d, out %d, ws %zu)\n", n_in, out_size, ws_size); grid = -1; return; }
        int dev = 0, cus = 0, per_cu = 0;
        (void)hipGetDevice(&dev); (void)hipDeviceGetAttribute(&cus, hipDeviceAttributeMultiprocessorCount, dev);
        if (hipFuncSetAttribute((const void*)fwd_kernel, hipFuncAttributeMaxDynamicSharedMemorySize, LDS_BYTES) != hipSuccess) { fprintf(stderr, "kernel_launch: hipFuncSetAttribute failed\n"); grid = -1; return; }
        (void)hipOccupancyMaxActiveBlocksPerMultiprocessor(&per_cu, (const void*)fwd_kernel, NTHREADS, LDS_BYTES);
        (void)hipGetLastError();
        if (per_cu < 1) fprintf(stderr, "kernel_launch: occupancy query says %d blocks per CU\n", per_cu);
        grid = cus;
        if (cus != 256) fprintf(stderr, "kernel_launch: built for a 256-CU device (got %d CUs)\n", cus);
    }
    if (grid < 0) return;
    (void)hipMemsetAsync((char*)d_ws + WS_CTL, 0, 32768, stream);
    Args a{};
    for (int i = 0; i < 21; ++i) a.in[i] = (const float*)d_in[i];
    a.out = (float*)d_out; a.ws = (unsigned char*)d_ws;
#if ONE_LAUNCH
    a.ph_lo = 0; a.ph_hi = N_PHASES;
    void* kargs[] = {&a};
    hipError_t e = hipLaunchCooperativeKernel((const void*)fwd_kernel, dim3(grid), dim3(NTHREADS), kargs, LDS_BYTES, stream);
    if (e != hipSuccess) fprintf(stderr, "cooperative launch failed: %s (grid %d)\n", hipGetErrorString(e), grid);
#else
    for (int ph = 0; ph < N_PHASES; ++ph) { a.ph_lo = ph; a.ph_hi = ph + 1;
        if (ph == (PROBE_PH)) { a.flags = PROBE_FLAGS; hipLaunchKernelGGL(fwd_kernel, dim3(grid), dim3(NTHREADS), LDS_BYTES, stream, a); a.flags = 0;
            if (ph == 3) (void)hipMemsetAsync((char*)d_ws + WS_CTL + 4096, 0, 2048, stream); }
        hipLaunchKernelGGL(fwd_kernel, dim3(grid), dim3(NTHREADS), LDS_BYTES, stream, a); }
#endif
}
```

```cpp
#include <hip/hip_runtime.h>
#include <hip/hip_cooperative_groups.h>
#include <cstdio>
#include <cstdint>
namespace cg = cooperative_groups;

#ifndef PROBE_PH
#define PROBE_PH -1
#endif
#ifndef PROBE_FLAGS
#define PROBE_FLAGS 0
#endif
#ifndef ONE_LAUNCH
#define ONE_LAUNCH 1
#endif

#define LAS __attribute__((address_space(3)))
typedef unsigned short bf16_t;
typedef short bf16x8 __attribute__((ext_vector_type(8)));
typedef float f32x4 __attribute__((ext_vector_type(4)));
typedef float f32x16 __attribute__((ext_vector_type(16)));
typedef unsigned u32x4 __attribute__((ext_vector_type(4)));
typedef unsigned u32x2 __attribute__((ext_vector_type(2)));
typedef float f32x2_t __attribute__((ext_vector_type(2)));
typedef __bf16 bf16x2_t __attribute__((ext_vector_type(2)));

constexpr int T_TOK = 32768, DM = 1024, SEQ = 2048, NBATCH = 16;
constexpr int HPW = 3584, INCOLS = 3592;
constexpr int NEXP = 32, LCAP = 32768;
constexpr float ALPHA = 1.189207115002721f;
constexpr float LN_EPS = 1e-5f;
constexpr int NWAVES = 8, NTHREADS = 512;
constexpr int LDS_BYTES = 163840;
constexpr int LDS_MISC = 147456;

constexpr size_t MiB = 1u << 20;
constexpr size_t WS_CTL = 0;
constexpr size_t WS_WGU = 1 * MiB;
constexpr size_t WS_WD = 129 * MiB;
constexpr size_t WS_WIN = 193 * MiB;
constexpr size_t WS_WOUT = 200 * MiB;
constexpr size_t WS_WPG = 202 * MiB;
constexpr size_t WS_WPP = 204 * MiB;
constexpr size_t WS_WRT = 205 * MiB;
constexpr size_t WS_BA = 206 * MiB;
constexpr size_t WS_ROUTE = 207 * MiB;
constexpr size_t WS_LTOK = 208 * MiB;
constexpr size_t WS_LGATE = 212 * MiB;
constexpr size_t WS_X1 = 216 * MiB;
constexpr size_t WS_PLE = 280 * MiB;
constexpr size_t WS_PB = 344 * MiB;
constexpr size_t WS_MIX = 360 * MiB;
constexpr size_t WS_XB = 424 * MiB;
constexpr size_t WS_HP = 488 * MiB;
constexpr size_t WS_DN = 712 * MiB;
constexpr size_t WS_EG = 888 * MiB;
constexpr size_t WS_VT = 889 * MiB;
constexpr size_t WS_KF = 216 * MiB;
constexpr size_t WS_ORAW = 985 * MiB;
constexpr size_t WS_ACT = 360 * MiB;
constexpr size_t WS_X1F = 632 * MiB;
constexpr size_t WS_YB = 672 * MiB;
constexpr size_t WS_END = 1017 * MiB;
constexpr size_t DN_WN = 0, DN_QD = 16384, DN_AT = 32768, DN_KD = 40960, DN_U = 57344, DN_STRIDE = 73728;

__device__ __forceinline__ unsigned cvtpk(float lo, float hi) { f32x2_t v = {lo, hi}; bf16x2_t b = __builtin_convertvector(v, bf16x2_t); return __builtin_bit_cast(unsigned, b); }
typedef int v8i __attribute__((ext_vector_type(8)));
__device__ __forceinline__ unsigned pk4_fp8(float a, float b, float c, float d) { int w = __builtin_amdgcn_cvt_pk_fp8_f32(a, b, 0, false); w = __builtin_amdgcn_cvt_pk_fp8_f32(c, d, w, true); return (unsigned)w; }
__device__ __forceinline__ float bflo(unsigned u) { return __uint_as_float(u << 16); }
__device__ __forceinline__ float bfhi(unsigned u) { return __uint_as_float(u & 0xffff0000u); }
__device__ __forceinline__ bf16_t f2bf(float f) { return (bf16_t)(cvtpk(f, 0.f) & 0xffffu); }
__device__ __forceinline__ float bf2f(bf16_t h) { return __uint_as_float((unsigned)h << 16); }
__device__ __forceinline__ float sigm(float x) { return __builtin_amdgcn_rcpf(1.f + __expf(-x)); }
__device__ __forceinline__ int crow(int r, int hi) { return (r & 3) + 8 * (r >> 2) + 4 * hi; }
__device__ __forceinline__ int kperm(int k) { return (k & ~12) | ((k & 4) << 1) | ((k & 8) >> 1); }
__device__ __forceinline__ bf16x8 pack8(const f32x16& x, int b) {
    u32x4 w; w.x = cvtpk(x[b], x[b + 1]); w.y = cvtpk(x[b + 2], x[b + 3]); w.z = cvtpk(x[b + 4], x[b + 5]); w.w = cvtpk(x[b + 6], x[b + 7]);
    return __builtin_bit_cast(bf16x8, w);
}
__device__ __forceinline__ float wave_sum(float v) {
#pragma unroll
    for (int o = 1; o < 64; o <<= 1) v += __shfl_xor(v, o);
    return v;
}

namespace pg8 {
constexpr int BM = 256, BK = 64, HALF = 128, HTB = HALF * BK * 2, STAGE_BYTES = 8 * HTB;
__device__ __forceinline__ int lds_byte(int r, int c) { const int st = (r >> 4) * 2 + (c >> 5), rr = r & 15, cc = c & 31, ob = rr * 64 + cc * 2; return st * 1024 + (ob ^ (((ob >> 9) & 1) << 5)); }
__device__ __forceinline__ void stage_rc(int b, int& R, int& C) { const int st = b / 1024, sb = b % 1024, swz = sb ^ (((sb >> 9) & 1) << 5); R = (st >> 1) * 16 + swz / 64; C = (st & 1) * 32 + (swz % 64) / 2; }
__device__ __forceinline__ int perm32(int rho) { const int n = rho >> 4, i = rho & 15; return 8 * (i >> 2) + 4 * n + (i & 3); }

struct Unit { const char* A; const char* B; int pm, pn, e, rows, pl; };

__device__ __forceinline__ int unit_index(int i, int c, int G, int total) {
    if (G % 8 != 0) { const int L = i * G + c; return L < total ? L : -1; }
    const int x = c & 7, per = G >> 3, li = i * per + (c >> 3), q = total >> 3, r = total & 7;
    const int start = x * q + (x < r ? x : r), size = q + (x < r ? 1 : 0);
    return li < size ? start + li : -1;
}

struct DenseSched {
    const char* Abase; const char* Bbase; int nM, nN, K, c, G;
    __device__ __forceinline__ bool next(int i, Unit& u) const {
        const int L = unit_index(i, c, G, nM * nN); if (L < 0) return false;
        const int nig = 8 * nN, gid = L / nig, fm = gid * 8, gsz = (nM - fm) < 8 ? (nM - fm) : 8, w = L - gid * nig;
        u.pn = w / gsz; u.pm = fm + w % gsz; u.e = 0; u.rows = 256; u.pl = u.pm;
        u.A = Abase + (size_t)u.pm * 256 * K * 2; u.B = Bbase + (size_t)u.pn * 256 * K * 2; return true;
    }
    static constexpr bool GATHER = false;
    __device__ __forceinline__ size_t hstepA() const { return (size_t)128 * K * 2; }
    __device__ __forceinline__ void avoff(const Unit& u, const int (&R)[2], const int (&C)[2], unsigned (&vo)[2][2]) const {
#pragma unroll
        for (int h = 0; h < 2; ++h)
#pragma unroll
            for (int i = 0; i < 2; ++i) vo[h][i] = (unsigned)(R[i] * K + C[i]) * 2u;
    }
};
template <bool GATHER_> struct MoeSched {
    static constexpr bool GATHER = GATHER_;
    __device__ __forceinline__ size_t hstepA() const { return GATHER_ ? (size_t)0 : (size_t)128 * K; }
    const char* Abase; const char* Bbase; size_t Bstride; const int* ltok; const LAS int* ulist; int K; const char* Bdense;
    __device__ __forceinline__ bool next(int i, Unit& u) const {
        const int w0 = __builtin_amdgcn_readfirstlane(ulist[4 * i]), w1 = __builtin_amdgcn_readfirstlane(ulist[4 * i + 1]), w2 = __builtin_amdgcn_readfirstlane(ulist[4 * i + 2]), w3 = __builtin_amdgcn_readfirstlane(ulist[4 * i + 3]);
        if (w3 == 0) return false;
        u.e = w0 & 255; u.pn = w0 >> 8; u.pl = w1; u.pm = w2; u.rows = w3;
        u.A = GATHER_ ? Abase : Abase + (size_t)u.pm * 256 * K; u.B = (u.e == 255 ? Bdense : Bbase + (size_t)u.e * Bstride) + (size_t)u.pn * 256 * K; return true;
    }
    __device__ __forceinline__ void avoff(const Unit& u, const int (&R)[2], const int (&C)[2], unsigned (&vo)[2][2]) const {
#pragma unroll
        for (int h = 0; h < 2; ++h)
#pragma unroll
            for (int i = 0; i < 2; ++i) {
                if (GATHER_) { const int r = h * 128 + R[i]; int tok = 0; if (u.e == 255) tok = u.pm * 256 + r; else if (r < u.rows) tok = ltok[(size_t)u.e * LCAP + u.pl * 256 + r]; vo[h][i] = (unsigned)(tok * K + C[i] * 2); }
                else vo[h][i] = (unsigned)(R[i] * K + C[i] * 2);
            }
    }
};

typedef f32x4 Acc[2][2][4][2];

template <bool FP8, class Epi, class Sched>
__device__ __forceinline__ void gemm_phase(LAS unsigned char* lds, const int K, const Sched& S, const Epi& E) {
    const int tid = threadIdx.x, wid = __builtin_amdgcn_readfirstlane(tid >> 6), lane = tid & 63, wr = wid >> 2, wc = wid & 3, fr = lane & 15, fq = lane >> 4;
    const int RB = FP8 ? K : 2 * K;
    const int nt = RB / 128;
    int RA[2], CA[2]; unsigned voffB[2];
#pragma unroll
    for (int i = 0; i < 2; ++i) { int R, C; stage_rc(tid * 16 + i * 8192, R, C); RA[i] = R; CA[i] = C; const int Rb = (R & ~31) + perm32(R & 31); voffB[i] = (unsigned)(Rb * RB + C * 2); }
    const size_t kstep = (size_t)(BK * 2);
    const size_t hstepB = (size_t)HALF * RB, hstepA = S.hstepA();
    const unsigned ldsw = (unsigned)wid * 1024u;
    const int aoff = lds_byte(wr * 64 + fr, fq * 8), boff = lds_byte(wc * 32 + fr, fq * 8);
#define PG8_SA(b, h) (((b) * 2 + (h)) * HTB)
#define PG8_SB(b, h) ((4 + (b) * 2 + (h)) * HTB)
#define PG8_GL(gptr, ldsoff) __builtin_amdgcn_global_load_lds((const unsigned*)(gptr), (LAS unsigned*)(lds + (ldsoff)), 16, 0, 0)
#define PG8_STAGE_B(bufoff, gbase) do { PG8_GL((const char*)(gbase) + voffB[0], (bufoff) + ldsw); PG8_GL((const char*)(gbase) + voffB[1], (bufoff) + ldsw + 8192); } while (0)
#define PG8_STAGE_A(bufoff, gbase, o0, o1) do { PG8_GL((const char*)(gbase) + (o0), (bufoff) + ldsw); PG8_GL((const char*)(gbase) + (o1), (bufoff) + ldsw + 8192); } while (0)
#define PG8_LDA(dst, b, h) do { _Pragma("unroll") for (int m = 0; m < 4; ++m) { \
        if constexpr (FP8) { const u32x4 l_ = *(const LAS u32x4*)(lds + PG8_SA(b, h) + aoff + m * 2048), h_ = *(const LAS u32x4*)(lds + PG8_SA(b, h) + aoff + m * 2048 + 1024); \
            dst##8[m] = (v8i){(int)l_.x, (int)l_.y, (int)l_.z, (int)l_.w, (int)h_.x, (int)h_.y, (int)h_.z, (int)h_.w}; } \
        else { _Pragma("unroll") for (int k = 0; k < 2; ++k) dst[m][k] = *(const LAS bf16x8*)(lds + PG8_SA(b, h) + aoff + m * 2048 + k * 1024); } } } while (0)
#define PG8_LDB(dst, b, h) do { _Pragma("unroll") for (int n = 0; n < 2; ++n) { \
        if constexpr (FP8) { const u32x4 l_ = *(const LAS u32x4*)(lds + PG8_SB(b, h) + boff + n * 2048), h_ = *(const LAS u32x4*)(lds + PG8_SB(b, h) + boff + n * 2048 + 1024); \
            dst##8[n] = (v8i){(int)l_.x, (int)l_.y, (int)l_.z, (int)l_.w, (int)h_.x, (int)h_.y, (int)h_.z, (int)h_.w}; } \
        else { _Pragma("unroll") for (int k = 0; k < 2; ++k) dst[n][k] = *(const LAS bf16x8*)(lds + PG8_SB(b, h) + boff + n * 2048 + k * 1024); } } } while (0)
#define PG8_MMA(ai, bj, At, Bt) do { __builtin_amdgcn_s_setprio(1); \
        if constexpr (FP8) { _Pragma("unroll") for (int m = 0; m < 4; ++m) _Pragma("unroll") for (int n = 0; n < 2; ++n) \
            asm volatile("s_nop 1\n\tv_mfma_scale_f32_16x16x128_f8f6f4 %0, %1, %2, %0, %3, %4 op_sel_hi:[0,0,0]" : "+v"(acc[ai][bj][m][n]) : "v"(Bt##8[n]), "v"(At##8[m]), "v"(sc_w), "v"(sc_a)); } \
        else { _Pragma("unroll") for (int m = 0; m < 4; ++m) _Pragma("unroll") for (int n = 0; n < 2; ++n) _Pragma("unroll") for (int k = 0; k < 2; ++k) \
            acc[ai][bj][m][n] = __builtin_amdgcn_mfma_f32_16x16x32_bf16(Bt[n][k], At[m][k], acc[ai][bj][m][n], 0, 0, 0); } \
        __builtin_amdgcn_s_setprio(0); } while (0)
#define PG8_WAIT_V(n) asm volatile("s_waitcnt vmcnt(" #n ")" ::: "memory")
#define PG8_WAIT_L(n) asm volatile("s_waitcnt lgkmcnt(" #n ")" ::: "memory")
#define PG8_BAR __builtin_amdgcn_s_barrier()
#define PG8_SCHED __builtin_amdgcn_sched_barrier(0)
    Unit cur, nxt; int ui = 0;
    if (!S.next(0, cur)) return;
    unsigned vc[2][2], vn[2][2];
    S.avoff(cur, RA, CA, vc);
    Acc acc;
#pragma unroll
    for (int a = 0; a < 2; ++a)
#pragma unroll
        for (int b = 0; b < 2; ++b)
#pragma unroll
            for (int m = 0; m < 4; ++m)
#pragma unroll
                for (int n = 0; n < 2; ++n) acc[a][b][m][n] = (f32x4){0.f, 0.f, 0.f, 0.f};
    const int sc_w = 122, sc_a = 127;
    bf16x8 At[4][2], B0[2][2], B1[2][2]; v8i At8[4], B08[2], B18[2];
    const char* cA = cur.A; const char* cB = cur.B;
    PG8_STAGE_B(PG8_SB(0, 0), cB); PG8_STAGE_B(PG8_SB(0, 1), cB + hstepB); PG8_STAGE_A(PG8_SA(0, 0), cA, vc[0][0], vc[0][1]); PG8_STAGE_A(PG8_SA(0, 1), cA + hstepA, vc[1][0], vc[1][1]);
    if (wr == 1) PG8_BAR;
    PG8_WAIT_V(2); PG8_BAR;
    PG8_STAGE_B(PG8_SB(1, 0), cB + kstep); PG8_STAGE_A(PG8_SA(1, 0), cA + kstep, vc[0][0], vc[0][1]); PG8_STAGE_B(PG8_SB(1, 1), cB + hstepB + kstep);
    PG8_WAIT_V(6); PG8_BAR;
    for (;;) {
        const bool has_next = S.next(ui + 1, nxt);
        if (Sched::GATHER && has_next) S.avoff(nxt, RA, CA, vn);
        else {
#pragma unroll
            for (int h = 0; h < 2; ++h)
#pragma unroll
                for (int i = 0; i < 2; ++i) vn[h][i] = vc[h][i];
        }
        const char* nA = has_next ? nxt.A : cA; const char* nB = has_next ? nxt.B : cB;
#pragma unroll 1
        for (int t = 0; t < nt; t += 2) {
            const bool last = (t == nt - 2);
            const char* a1 = cA + (size_t)(t + 1) * kstep;
            const char* a2 = last ? nA : cA + (size_t)(t + 2) * kstep; const char* b2 = last ? nB : cB + (size_t)(t + 2) * kstep;
            const char* a3 = a2 + kstep; const char* b3 = b2 + kstep;
            const unsigned o00 = last ? vn[0][0] : vc[0][0], o01 = last ? vn[0][1] : vc[0][1], o10 = last ? vn[1][0] : vc[1][0], o11 = last ? vn[1][1] : vc[1][1];
            PG8_LDB(B0, 0, 0); PG8_LDB(B1, 0, 1); PG8_SCHED; PG8_LDA(At, 0, 0); PG8_STAGE_A(PG8_SA(1, 1), a1 + hstepA, vc[1][0], vc[1][1]);
            PG8_WAIT_V(8); PG8_WAIT_L(0); PG8_BAR; PG8_MMA(0, 0, At, B0); PG8_MMA(0, 1, At, B1); PG8_BAR; PG8_SCHED;
            PG8_LDA(At, 0, 1); PG8_STAGE_B(PG8_SB(0, 0), b2); PG8_STAGE_B(PG8_SB(0, 1), b2 + hstepB); PG8_STAGE_A(PG8_SA(0, 0), a2, o00, o01);
            PG8_WAIT_V(8); PG8_WAIT_L(0); PG8_BAR; PG8_MMA(1, 0, At, B0); PG8_MMA(1, 1, At, B1); PG8_BAR; PG8_SCHED;
            PG8_LDB(B0, 1, 0); PG8_LDB(B1, 1, 1); PG8_SCHED; PG8_LDA(At, 1, 0); PG8_STAGE_A(PG8_SA(0, 1), a2 + hstepA, o10, o11);
            PG8_WAIT_V(8); PG8_WAIT_L(0); PG8_BAR; PG8_MMA(0, 0, At, B0); PG8_MMA(0, 1, At, B1); PG8_BAR; PG8_SCHED;
            PG8_LDA(At, 1, 1); PG8_STAGE_B(PG8_SB(1, 0), b3); PG8_STAGE_B(PG8_SB(1, 1), b3 + hstepB); PG8_STAGE_A(PG8_SA(1, 0), a3, o00, o01);
            PG8_WAIT_V(8); PG8_WAIT_L(0); PG8_BAR; PG8_MMA(1, 0, At, B0); PG8_MMA(1, 1, At, B1); PG8_BAR; PG8_SCHED;
        }
        if (wr == 0) PG8_BAR;
        if constexpr (FP8) asm volatile("s_nop 15\n\ts_nop 15" ::: "memory");
        E(acc, cur, wr, wc, fr, fq);
        if (!has_next) break;
#pragma unroll
        for (int a = 0; a < 2; ++a)
#pragma unroll
            for (int b = 0; b < 2; ++b)
#pragma unroll
                for (int m = 0; m < 4; ++m)
#pragma unroll
                    for (int n = 0; n < 2; ++n) acc[a][b][m][n] = (f32x4){0.f, 0.f, 0.f, 0.f};
        cur = nxt; cA = nA; cB = nB; ++ui;
#pragma unroll
        for (int h = 0; h < 2; ++h)
#pragma unroll
            for (int i = 0; i < 2; ++i) vc[h][i] = vn[h][i];
        if (wr == 1) PG8_BAR;
    }
    PG8_WAIT_V(0);
    PG8_BAR;
#undef PG8_SA
#undef PG8_SB
#undef PG8_GL
#undef PG8_STAGE_A
#undef PG8_STAGE_B
#undef PG8_LDA
#undef PG8_LDB
#undef PG8_MMA
#undef PG8_WAIT_V
#undef PG8_WAIT_L
#undef PG8_BAR
#undef PG8_SCHED
}

__device__ __forceinline__ u32x4 pack_row8(const f32x4& v0, const f32x4& v1) { u32x4 w; w.x = cvtpk(v0[0], v0[1]); w.y = cvtpk(v0[2], v0[3]); w.z = cvtpk(v1[0], v1[1]); w.w = cvtpk(v1[2], v1[3]); return w; }
__device__ __forceinline__ void unpack8(const u32x4& w, f32x4& a, f32x4& b) { a = (f32x4){bflo(w.x), bfhi(w.x), bflo(w.y), bfhi(w.y)}; b = (f32x4){bflo(w.z), bfhi(w.z), bflo(w.w), bfhi(w.w)}; }

struct EpiStore {
    bf16_t* O; int ldc;
    __device__ __forceinline__ void operator()(const Acc& acc, const Unit& u, int wr, int wc, int fr, int fq) const {
        const int row0 = u.pm * BM + wr * 64 + fr, col0 = u.pn * BM + wc * 32 + 8 * fq;
#pragma unroll
        for (int ai = 0; ai < 2; ++ai)
#pragma unroll
            for (int m = 0; m < 4; ++m) { bf16_t* rowp = O + (size_t)(row0 + ai * HALF + m * 16) * ldc + col0;
#pragma unroll
                for (int bj = 0; bj < 2; ++bj) *(u32x4*)(rowp + bj * HALF) = pack_row8(acc[ai][bj][m][0], acc[ai][bj][m][1]); }
    }
};
struct EpiResid {
    bf16_t* O; const bf16_t* X;
    __device__ __forceinline__ void operator()(const Acc& acc, const Unit& u, int wr, int wc, int fr, int fq) const {
        const int row0 = u.pm * BM + wr * 64 + fr, col0 = u.pn * BM + wc * 32 + 8 * fq;
#pragma unroll
        for (int ai = 0; ai < 2; ++ai)
#pragma unroll
            for (int m = 0; m < 4; ++m) { const size_t off = (size_t)(row0 + ai * HALF + m * 16) * DM + col0;
#pragma unroll
                for (int bj = 0; bj < 2; ++bj) { const u32x4 xw = *(const u32x4*)(X + off + bj * HALF); f32x4 xa, xb; unpack8(xw, xa, xb);
                    *(u32x4*)(O + off + bj * HALF) = pack_row8(xa * ALPHA + acc[ai][bj][m][0], xb * ALPHA + acc[ai][bj][m][1]); }
                if (m & 1) asm volatile("" ::: "memory"); }
    }
};
struct EpiAct {
    unsigned char* O; const float* bgu;
    __device__ __forceinline__ void operator()(const Acc& acc, const Unit& u, int wr, int wc, int fr, int fq) const {
        const int cl = u.pn * HALF + wc * 32 + 8 * fq;
        const float* bg = bgu + (size_t)u.e * 2048 + cl;
        const f32x4 g0 = *(const f32x4*)bg, g1 = *(const f32x4*)(bg + 4), u0 = *(const f32x4*)(bg + 1024), u1 = *(const f32x4*)(bg + 1028);
        unsigned char* obase = O + (size_t)(u.pm * BM + wr * 64 + fr) * DM + cl;
        const int rl0 = wr * 64 + fr;
#pragma unroll
        for (int ai = 0; ai < 2; ++ai)
#pragma unroll
            for (int m = 0; m < 4; ++m) { const int rl = ai * HALF + m * 16 + rl0;
                unsigned w[2];
#pragma unroll
                for (int n = 0; n < 2; ++n) { const f32x4 hg = acc[ai][0][m][n] + (n ? g1 : g0), hu = acc[ai][1][m][n] + (n ? u1 : u0); float o4[4];
#pragma unroll
                    for (int j = 0; j < 4; ++j) { const float g = fminf(hg[j], 7.f), up = fminf(fmaxf(hu[j], -7.f), 7.f);
                        o4[j] = (up + 1.f) * g * __builtin_amdgcn_rcpf(1.f + __builtin_amdgcn_exp2f(-2.4554669595930157f * g)); }
                    w[n] = pk4_fp8(o4[0], o4[1], o4[2], o4[3]); asm volatile("" : "+v"(w[n])); }
                if (rl < u.rows) *(u32x2*)(obase + (size_t)(ai * HALF + m * 16) * DM) = (u32x2){w[0], w[1]};
                asm volatile("" ::: "memory"); }
    }
};
struct EpiDown {
    unsigned char* O; const float* bd; const float* lgate;
    __device__ __forceinline__ void operator()(const Acc& acc, const Unit& u, int wr, int wc, int fr, int fq) const {
        const int col0 = u.pn * BM + wc * 32 + 8 * fq;
        const float* bp = bd + (size_t)u.e * DM + col0;
#pragma unroll
        for (int ai = 0; ai < 2; ++ai)
#pragma unroll
            for (int m = 0; m < 4; ++m) { const int rl = ai * HALF + wr * 64 + m * 16 + fr;
                if (rl < u.rows) { const float gt = lgate[(size_t)u.e * LCAP + u.pl * BM + rl]; unsigned char* rowp = O + (size_t)(u.pm * BM + rl) * DM + col0;
#pragma unroll
                    for (int bj = 0; bj < 2; ++bj) { const f32x4 a = (acc[ai][bj][m][0] + *(const f32x4*)(bp + bj * HALF)) * gt, b = (acc[ai][bj][m][1] + *(const f32x4*)(bp + bj * HALF + 4)) * gt;
                        *(u32x2*)(rowp + bj * HALF) = (u32x2){pk4_fp8(a[0], a[1], a[2], a[3]), pk4_fp8(b[0], b[1], b[2], b[3])}; } }
                asm volatile("" ::: "memory"); }
    }
};
struct EpiSig {
    bf16_t* O; const float* bias;
    __device__ __forceinline__ void operator()(const Acc& acc, const Unit& u, int wr, int wc, int fr, int fq) const {
        const int row0 = u.pm * BM + wr * 64 + fr, col0 = u.pn * BM + wc * 32 + 8 * fq;
        f32x4 bv[2][2];
#pragma unroll
        for (int bj = 0; bj < 2; ++bj)
#pragma unroll
            for (int n = 0; n < 2; ++n) bv[bj][n] = *(const f32x4*)(bias + col0 + bj * HALF + 4 * n);
#pragma unroll
        for (int ai = 0; ai < 2; ++ai)
#pragma unroll
            for (int m = 0; m < 4; ++m) { bf16_t* rowp = O + (size_t)(row0 + ai * HALF + m * 16) * DM + col0;
#pragma unroll
                for (int bj = 0; bj < 2; ++bj) { f32x4 a = acc[ai][bj][m][0] + bv[bj][0], b = acc[ai][bj][m][1] + bv[bj][1];
#pragma unroll
                    for (int j = 0; j < 4; ++j) { a[j] = sigm(a[j]); b[j] = sigm(b[j]); }
                    *(u32x4*)(rowp + bj * HALF) = pack_row8(a, b); }
                asm volatile("" ::: "memory"); }
    }
};
struct EpiActSig {
    EpiAct a; EpiSig g;
    __device__ __forceinline__ void operator()(const Acc& acc, const Unit& u, int wr, int wc, int fr, int fq) const { if (u.e == 255) g(acc, u, wr, wc, fr, fq); else a(acc, u, wr, wc, fr, fq); }
};
struct EpiMul {
    bf16_t* O;
    __device__ __forceinline__ void operator()(const Acc& acc, const Unit& u, int wr, int wc, int fr, int fq) const {
        const int row0 = u.pm * BM + wr * 64 + fr, col0 = u.pn * BM + wc * 32 + 8 * fq;
#pragma unroll
        for (int ai = 0; ai < 2; ++ai)
#pragma unroll
            for (int m = 0; m < 4; ++m) { bf16_t* rowp = O + (size_t)(row0 + ai * HALF + m * 16) * DM + col0;
#pragma unroll
                for (int bj = 0; bj < 2; ++bj) { const u32x4 gw = *(const u32x4*)(rowp + bj * HALF); f32x4 ga, gb; unpack8(gw, ga, gb);
                    *(u32x4*)(rowp + bj * HALF) = pack_row8(ga * acc[ai][bj][m][0], gb * acc[ai][bj][m][1]); }
                if (m & 1) asm volatile("" ::: "memory"); }
    }
};
}

#define XB_TMO      128
#define XB_XCNT(j)  (256  + 64 * (j))
#define XB_XSUB(j)  (1280 + 64 * (j))
#define XB_XGEN(j)  (2304 + 64 * (j))
#define XB_TOP      3328
#define XB_TOPGEN   3392
#define XCD_BAR_WORDS 3456
#define XB_SPIN_CAP (1u << 22)
constexpr int CW_BAR = 4096;
constexpr int LDS_BARST = LDS_MISC + 2048;
__device__ __forceinline__ unsigned xb_ld(unsigned* p)              { return __hip_atomic_load(p, __ATOMIC_RELAXED, __HIP_MEMORY_SCOPE_AGENT); }
__device__ __forceinline__ unsigned xb_add(unsigned* p, unsigned v) { return __hip_atomic_fetch_add(p, v, __ATOMIC_RELAXED, __HIP_MEMORY_SCOPE_AGENT); }
__device__ __forceinline__ unsigned xb_xcc_id() { return (unsigned)__builtin_amdgcn_s_getreg((3 << 11) | 20) & 0xFu; }
#define XB_SPIN(cond, bar) do { unsigned _sp = 0; while (cond) { __builtin_amdgcn_s_sleep(1); \
    if ((++_sp & 255u) == 0u) { if (xb_ld(&(bar)[XB_TMO])) break; if (_sp > XB_SPIN_CAP) { atomicAdd(&(bar)[XB_TMO], 1u); break; } } } } while (0)
struct XcdBarrier { unsigned* bar; unsigned x; volatile LAS unsigned* st; };
__device__ __forceinline__ XcdBarrier xcd_barrier_post(unsigned* bar, volatile LAS unsigned* st) {
    XcdBarrier b; b.bar = bar; b.x = xb_xcc_id(); b.st = st;
    if (threadIdx.x == 0) (void)xb_add(&bar[XB_XCNT(b.x)], 1u);
    return b;
}
__device__ __forceinline__ void xcd_barrier_complete(unsigned* bar, unsigned x, unsigned& nloc, unsigned& nx) {
    const unsigned G = gridDim.x * gridDim.y * gridDim.z;
    unsigned sum, cnt, mine, sp = 0u;
    for (;;) {
        sum = 0u; cnt = 0u; mine = 0u;
#pragma unroll
        for (unsigned j = 0; j < 16; ++j) { const unsigned c = xb_ld(&bar[XB_XCNT(j)]); sum += c; cnt += (c > 0u) ? 1u : 0u; mine = (j == x) ? c : mine; }
        if (sum == G) break;
        __builtin_amdgcn_s_sleep(1);
        if ((++sp & 255u) == 0u) { if (xb_ld(&bar[XB_TMO])) break; if (sp > XB_SPIN_CAP) { atomicAdd(&bar[XB_TMO], 1u); break; } }
    }
    nloc = mine > 0u ? mine : 1u; nx = cnt > 0u ? cnt : 1u;
}
__device__ __forceinline__ void xcd_barrier(const XcdBarrier& b) {
    asm volatile("s_waitcnt vmcnt(0)" ::: "memory");
    __syncthreads();
    if (threadIdx.x == 0) {
        unsigned* bar = b.bar;
        __builtin_amdgcn_s_waitcnt(0);
        unsigned nloc = b.st[0], nx = b.st[1];
        if (nloc == 0u) { xcd_barrier_complete(bar, b.x, nloc, nx); b.st[0] = nloc; b.st[1] = nx; }
        const unsigned old = xb_add(&bar[XB_XSUB(b.x)], 1u);
        const unsigned gen = old / nloc;
        if (old + 1u == (gen + 1u) * nloc) {
            __builtin_amdgcn_fence(__ATOMIC_RELEASE, "agent");
            asm volatile("s_waitcnt vmcnt(0)" ::: "memory");
            const unsigned og = xb_add(&bar[XB_TOP], 1u);
            const unsigned tg = og / nx;
            if (og + 1u == (tg + 1u) * nx) xb_add(&bar[XB_TOPGEN], 1u);
            else XB_SPIN(xb_ld(&bar[XB_TOPGEN]) == tg, bar);
            __builtin_amdgcn_fence(__ATOMIC_ACQUIRE, "agent");
            xb_add(&bar[XB_XGEN(b.x)], 1u);
            asm volatile("s_waitcnt vmcnt(0)" ::: "memory");
        } else {
            XB_SPIN(xb_ld(&bar[XB_XGEN(b.x)]) == gen, bar);
            __builtin_amdgcn_fence(__ATOMIC_ACQUIRE, "agent");
            asm volatile("s_waitcnt vmcnt(0)" ::: "memory");
        }
    }
    __syncthreads();
}

struct Args { const float* in[21]; float* out; unsigned char* ws; int ph_lo, ph_hi; int flags, pad; };
#define THREAD_IDS() int tid = threadIdx.x; asm volatile("" : "+v"(tid)); const int lane = tid & 63; const int wave = __builtin_amdgcn_readfirstlane(tid >> 6); (void)lane; (void)wave
struct Frame {
    unsigned char* lds; int G, blk;
    float* out; unsigned char* ws;
};
__device__ __forceinline__ const float* inptr(int k) {
    const char* ka = (const char*)__builtin_amdgcn_kernarg_segment_ptr(); asm volatile("" : "+s"(ka));
    return *(const float* const*)(ka + 8 * k);
}
#define WSP(T, off) ((T*)(F.ws + (off)))

constexpr int MOE_TILES = NEXP * 16 * 32 + NEXP * 16 * 16;
struct WTile { const float* src; unsigned char* dst; int ldn; };
__device__ __forceinline__ WTile moe_tile_addr(const Frame& F, int r, const float* w_gate_up, const float* w_down, int lane) {
    constexpr int I_GU = NEXP * 16 * 32; const int q4 = lane >> 4, c = lane & 15; WTile t;
    if (r < I_GU) { const int e = r / 512, q = r % 512, kb = q / 32, nb = q % 32, n0 = 64 * nb;
        const int j0 = n0 & 1023, drow0 = 256 * (j0 >> 7) + (j0 & 127) + ((n0 >= 1024) ? 128 : 0);
        t.src = w_gate_up + (size_t)e * 1024 * 2048 + (size_t)(64 * kb + 16 * q4) * 2048 + n0 + 4 * c; t.ldn = 2048;
        t.dst = WSP(unsigned char, WS_WGU) + (size_t)e * 2048 * 1024 + (size_t)(drow0 + 4 * c) * 1024 + 64 * kb + 16 * q4; }
    else { r -= I_GU; const int e = r / 256, q = r % 256, kb = q / 16, nb = q % 16;
        t.src = w_down + (size_t)e * 1024 * 1024 + (size_t)(64 * kb + 16 * q4) * 1024 + 64 * nb + 4 * c; t.ldn = 1024;
        t.dst = WSP(unsigned char, WS_WD) + (size_t)e * 1024 * 1024 + (size_t)(64 * nb + 4 * c) * 1024 + 64 * kb + 16 * q4; }
    return t;
}
__device__ __forceinline__ void wtile_load(f32x4 (&v)[16], const WTile& t) {
#pragma unroll
    for (int i = 0; i < 16; ++i) v[i] = *(const f32x4*)(t.src + (size_t)i * t.ldn);
}
__device__ __forceinline__ void wtile_store(const f32x4 (&v)[16], const WTile& t) {
#pragma unroll
    for (int j = 0; j < 4; ++j) {
        u32x4 o;
        o.x = pk4_fp8(v[0][j] * 32.f, v[1][j] * 32.f, v[2][j] * 32.f, v[3][j] * 32.f); o.y = pk4_fp8(v[4][j] * 32.f, v[5][j] * 32.f, v[6][j] * 32.f, v[7][j] * 32.f);
        o.z = pk4_fp8(v[8][j] * 32.f, v[9][j] * 32.f, v[10][j] * 32.f, v[11][j] * 32.f); o.w = pk4_fp8(v[12][j] * 32.f, v[13][j] * 32.f, v[14][j] * 32.f, v[15][j] * 32.f);
        *(u32x4*)(t.dst + (size_t)j * 1024) = o;
    }
}
__device__ __forceinline__ void moe_weight_batch3(const Frame& F, int r0, int stride, const float* w_gate_up, const float* w_down, int lane) {
    const WTile t0 = moe_tile_addr(F, r0, w_gate_up, w_down, lane), t1 = moe_tile_addr(F, r0 + stride, w_gate_up, w_down, lane), t2 = moe_tile_addr(F, r0 + 2 * stride, w_gate_up, w_down, lane);
    f32x4 va[16], vb[16];
    wtile_load(va, t0); wtile_load(vb, t1);
    wtile_store(va, t0); wtile_load(va, t2);
    wtile_store(vb, t1); wtile_store(va, t2);
}

__device__ __forceinline__ void p0_transpose_tile(const float* W, int ldn, int k0, int n0, bf16_t* WT, int Kd, int drow0, int lane) {
    const int q = lane >> 4, c = lane & 15;
    const float* src = W + (size_t)(k0 + 16 * q) * ldn + n0 + 4 * c;
    f32x4 v[16];
#pragma unroll
    for (int i = 0; i < 16; ++i) v[i] = *(const f32x4*)(src + (size_t)i * ldn);
    bf16_t* dst = WT + (size_t)(drow0 + 4 * c) * Kd + k0 + 16 * q;
#pragma unroll
    for (int j = 0; j < 4; ++j) {
        u32x4 o0, o1;
        o0.x = cvtpk(v[0][j], v[1][j]); o0.y = cvtpk(v[2][j], v[3][j]); o0.z = cvtpk(v[4][j], v[5][j]); o0.w = cvtpk(v[6][j], v[7][j]);
        o1.x = cvtpk(v[8][j], v[9][j]); o1.y = cvtpk(v[10][j], v[11][j]); o1.z = cvtpk(v[12][j], v[13][j]); o1.w = cvtpk(v[14][j], v[15][j]);
        *(u32x4*)(dst + (size_t)j * Kd) = o0; *(u32x4*)(dst + (size_t)j * Kd + 8) = o1;
    }
}
__device__ __forceinline__ void phase0(const Frame& F) {
    THREAD_IDS();
    const float* in_x = inptr(0); const float* in_p = inptr(1); const float* in_w_in = inptr(2); const float* in_w_out = inptr(7); const float* in_w_router = inptr(10); const float* in_w_ple_gate = inptr(16); const float* in_w_ple_proj = inptr(18);
    float* wba = (float*)F.lds;
    for (int i = tid; i < 8192; i += NTHREADS) wba[(i & 7) * 1024 + (i >> 3)] = in_w_in[(size_t)(i >> 3) * INCOLS + HPW + (i & 7)];
    __syncthreads();
    const int gw = F.blk * NWAVES + wave, NGW = F.G * NWAVES;
    bf16_t* XB = WSP(bf16_t, WS_XB); float* BA = WSP(float, WS_BA);
    for (int row = gw; row < T_TOK; row += NGW) {
        const f32x4* xr = (const f32x4*)(in_x + (size_t)row * DM) + lane;
        f32x4 v[4];
#pragma unroll
        for (int j = 0; j < 4; ++j) v[j] = xr[64 * j];
        u32x2* o8 = (u32x2*)(XB + (size_t)row * DM) + lane;
#pragma unroll
        for (int j = 0; j < 4; ++j) { u32x2 w; w.x = cvtpk(v[j][0], v[j][1]); w.y = cvtpk(v[j][2], v[j][3]); o8[64 * j] = w; }
        float a8[8];
#pragma unroll
        for (int q = 0; q < 8; ++q) { float a = 0.f;
#pragma unroll
            for (int j = 0; j < 4; ++j) { const f32x4 w = *(const f32x4*)(wba + q * 1024 + 4 * lane + 256 * j); a += v[j][0] * w[0] + v[j][1] * w[1] + v[j][2] * w[2] + v[j][3] * w[3]; }
            a8[q] = a; }
        float r4[4], r2[2], r1;
        { const bool up = (lane & 32) != 0;
#pragma unroll
            for (int k = 0; k < 4; ++k) { const float keep = up ? a8[k + 4] : a8[k], send = up ? a8[k] : a8[k + 4]; r4[k] = keep + __shfl_xor(send, 32); } }
        { const bool up = (lane & 16) != 0;
#pragma unroll
            for (int k = 0; k < 2; ++k) { const float keep = up ? r4[k + 2] : r4[k], send = up ? r4[k] : r4[k + 2]; r2[k] = keep + __shfl_xor(send, 16); } }
        { const bool up = (lane & 8) != 0; const float keep = up ? r2[1] : r2[0], send = up ? r2[0] : r2[1]; r1 = keep + __shfl_xor(send, 8); }
        r1 += __shfl_xor(r1, 4); r1 += __shfl_xor(r1, 2); r1 += __shfl_xor(r1, 1);
        if ((lane & 7) == 0) BA[(size_t)row * 8 + ((lane >> 5) & 1) * 4 + ((lane >> 4) & 1) * 2 + ((lane >> 3) & 1)] = r1;
    }
    { const f32x4* src = (const f32x4*)in_p; u32x2* dst = WSP(u32x2, WS_PB);
        for (int i = F.blk * NTHREADS + tid; i < T_TOK * 256 / 4; i += F.G * NTHREADS) { const f32x4 v = src[i]; u32x2 w; w.x = cvtpk(v[0], v[1]); w.y = cvtpk(v[2], v[3]); dst[i] = w; } }
    { float* wrt = WSP(float, WS_WRT); for (int i = F.blk * NTHREADS + tid; i < 32768; i += F.G * NTHREADS) wrt[(i & 31) * 1024 + (i >> 5)] = in_w_router[i]; }
    constexpr int I_IN = 16 * 56, I_OUT = 16 * 16, I_PG = 16 * 16, I_PP = 4 * 16;
    constexpr int NITEMS = I_IN + I_OUT + I_PG + I_PP;
    for (int it = gw; it < NITEMS; it += NGW) {
        int r = it;
        if (r < I_IN) { const int kb = r / 56, nb = r % 56; p0_transpose_tile(in_w_in, INCOLS, 64 * kb, 64 * nb, WSP(bf16_t, WS_WIN), 1024, 64 * nb, lane); continue; } r -= I_IN;
        if (r < I_OUT) { const int kb = r / 16, nb = r % 16; p0_transpose_tile(in_w_out, 1024, 64 * kb, 64 * nb, WSP(bf16_t, WS_WOUT), 1024, 64 * nb, lane); continue; } r -= I_OUT;
        if (r < I_PG) { const int kb = r / 16, nb = r % 16, q4 = lane >> 4, c = lane & 15; WTile t; f32x4 v[16];
            t.src = in_w_ple_gate + (size_t)(64 * kb + 16 * q4) * 1024 + 64 * nb + 4 * c; t.ldn = 1024; t.dst = WSP(unsigned char, WS_WPG) + (size_t)(64 * nb + 4 * c) * 1024 + 64 * kb + 16 * q4;
            wtile_load(v, t); wtile_store(v, t); continue; } r -= I_PG;
        { const int kb = r / 16, nb = r % 16; p0_transpose_tile(in_w_ple_proj, 1024, 64 * kb, 64 * nb, WSP(bf16_t, WS_WPP), 256, 64 * nb, lane); }
    }
}
__device__ __forceinline__ void moe_weight_stream(const Frame& F, int cw, int ncw, int lane) {
    const float* w_gate_up = inptr(12); const float* w_down = inptr(14);
    f32x4 va[16], vb[16];
    int r = cw; if (r >= MOE_TILES) return;
    WTile ta = moe_tile_addr(F, r, w_gate_up, w_down, lane); wtile_load(va, ta);
#pragma unroll 1
    for (;;) {
        const int r1 = r + ncw; WTile tb{}; const bool hb = r1 < MOE_TILES;
        if (hb) { tb = moe_tile_addr(F, r1, w_gate_up, w_down, lane); wtile_load(vb, tb); }
        wtile_store(va, ta);
        if (!hb) break;
        const int r2 = r1 + ncw; const bool ha = r2 < MOE_TILES;
        if (ha) { ta = moe_tile_addr(F, r2, w_gate_up, w_down, lane); wtile_load(va, ta); }
        wtile_store(vb, tb);
        if (!ha) break;
        r = r2;
    }
}
#define MFMA32(a, b, c) __builtin_amdgcn_mfma_f32_32x32x16_bf16((a), (b), (c), 0, 0, 0)
constexpr int QR_S = 136, KT_S = 72, NM_S = 68;
constexpr int L_QR = 0, L_KR = 17408, L_KT = 34816, L_VT = 53248, L_NM = 71680, L_TM = 89088, L_PM = 106496, L_TU = 111104, L_TW = 120320, L_SC = 129536;
__device__ __forceinline__ void dn_prep_unit(const Frame& F, int ch) {
    int tid = threadIdx.x; asm volatile("" : "+v"(tid));
    const int lane = tid & 63, wave = __builtin_amdgcn_readfirstlane(tid >> 6), r32 = lane & 31, hi = lane >> 5;
    const float* in_conv_w = inptr(3); const float* in_a_log = inptr(4); const float* in_dt_bias = inptr(5);
    const int b = ch >> 7, h = (ch >> 5) & 3, n = ch & 31;
    bf16_t* Qr = (bf16_t*)(F.lds + L_QR); bf16_t* Kr = (bf16_t*)(F.lds + L_KR); bf16_t* KT = (bf16_t*)(F.lds + L_KT); bf16_t* VT = (bf16_t*)(F.lds + L_VT);
    float* Nm = (float*)(F.lds + L_NM); float* Tm = (float*)(F.lds + L_TM); float* Pm = (float*)(F.lds + L_PM);
    bf16_t* Tu = (bf16_t*)(F.lds + L_TU); bf16_t* Tw = (bf16_t*)(F.lds + L_TW);
    float* beta_s = (float*)(F.lds + L_SC); float* gc_s = beta_s + 64; float* egc_s = gc_s + 64; float* begc_s = egc_s + 64;
    const bf16_t* HP = WSP(const bf16_t, WS_HP);
    const int t0 = 64 * n; const size_t rowb = (size_t)b * SEQ;
    unsigned char* dnb = F.ws + WS_DN + (size_t)ch * DN_STRIDE;
#pragma unroll
    for (int it = 0; it < 2; ++it) {
        const int idx = it * NTHREADS + tid;
        if (idx < 768) {
        const int c3 = idx >> 8, rem = idx & 255, tg = rem >> 4, d0 = (rem & 15) * 8;
        const int chn = c3 * 512 + h * 128 + d0;
        f32x4 cw[4][2];
#pragma unroll
        for (int j = 0; j < 4; ++j) { cw[j][0] = *(const f32x4*)(in_conv_w + (size_t)j * 1536 + chn); cw[j][1] = *(const f32x4*)(in_conv_w + (size_t)j * 1536 + chn + 4); }
        u32x4 xr[7];
#pragma unroll
        for (int r = 0; r < 7; ++r) { const int t = t0 + 4 * tg - 3 + r; const int tc = t < 0 ? 0 : t; xr[r] = *(const u32x4*)(HP + (rowb + tc) * HPW + 1536 + chn); }
        float y[4][8];
#pragma unroll
        for (int q = 0; q < 4; ++q)
#pragma unroll
            for (int c = 0; c < 8; ++c) y[q][c] = 0.f;
#pragma unroll
        for (int r = 0; r < 7; ++r) { const int t = t0 + 4 * tg - 3 + r; const float msk = t < 0 ? 0.f : 1.f; f32x4 xa, xb; pg8::unpack8(xr[r], xa, xb); xa = xa * msk; xb = xb * msk;
#pragma unroll
            for (int q = 0; q < 4; ++q) { const int j = r - q; if (j >= 0 && j < 4) {
#pragma unroll
                for (int c = 0; c < 4; ++c) { y[q][c] += xa[c] * cw[j][0][c]; y[q][4 + c] += xb[c] * cw[j][1][c]; } } } }
        unsigned pk[4][4];
#pragma unroll
        for (int q = 0; q < 4; ++q) { float ss = 0.f;
#pragma unroll
            for (int c = 0; c < 8; ++c) { y[q][c] = y[q][c] * sigm(y[q][c]); ss += y[q][c] * y[q][c]; }
            ss += __shfl_xor(ss, 1); ss += __shfl_xor(ss, 2); ss += __shfl_xor(ss, 4); ss += __shfl_xor(ss, 8);
            const float sc = (c3 == 2) ? 1.f : rsqrtf(ss + 1e-6f) * (c3 == 0 ? 0.08838834764831845f : 1.f);
#pragma unroll
            for (int c = 0; c < 4; ++c) pk[q][c] = cvtpk(y[q][2 * c] * sc, y[q][2 * c + 1] * sc); }
        const int i0 = 4 * tg;
        if (c3 < 2) { bf16_t* dst = (c3 == 0 ? Qr : Kr) + i0 * QR_S + d0;
#pragma unroll
            for (int q = 0; q < 4; ++q) *(u32x4*)(dst + q * QR_S) = (u32x4){pk[q][0], pk[q][1], pk[q][2], pk[q][3]}; }
        if (c3 >= 1) { bf16_t* dt = (c3 == 1 ? KT : VT) + d0 * KT_S + i0;
#pragma unroll
            for (int c = 0; c < 4; ++c) {
                u32x2 lo, hi2; lo.x = (pk[0][c] & 0xffffu) | (pk[1][c] << 16); lo.y = (pk[2][c] & 0xffffu) | (pk[3][c] << 16);
                hi2.x = (pk[0][c] >> 16) | (pk[1][c] & 0xffff0000u); hi2.y = (pk[2][c] >> 16) | (pk[3][c] & 0xffff0000u);
                *(u32x2*)(dt + (2 * c) * KT_S) = lo; *(u32x2*)(dt + (2 * c + 1) * KT_S) = hi2; } }
        }
    }
    if (tid < 64) {
        const float* BA = WSP(const float, WS_BA) + (rowb + t0 + tid) * 8;
        const float bl = BA[h], al = BA[4 + h] + in_dt_bias[h];
        const float sp = fmaxf(al, 0.f) + log1pf(__expf(-fabsf(al)));
        float g = -__expf(in_a_log[h]) * sp;
#pragma unroll
        for (int o = 1; o < 64; o <<= 1) { const float up = __shfl_up(g, o); if (tid >= o) g += up; }
        const float bt = sigm(bl), eg = __expf(g);
        beta_s[tid] = bt; gc_s[tid] = g; egc_s[tid] = eg; begc_s[tid] = bt * eg;
        if (tid == 63) WSP(float, WS_EG)[ch] = eg;
    }
    __syncthreads();
    {
        const int sel = wave >> 2, tq = wave & 3, mt = (tq == 0) ? 0 : 1, nt = (tq == 3) ? 1 : (tq == 2 ? 1 : 0);
        const int amt = sel ? ((tq == 1) ? 0 : mt) : mt, ant = sel ? ((tq == 1) ? 1 : nt) : nt;
        f32x16 c;
#pragma unroll
        for (int r = 0; r < 16; ++r) c[r] = 0.f;
        if (tq != 3) {
            const bf16_t* ap = Kr + (32 * amt + r32) * QR_S + 8 * hi; const bf16_t* bp = (sel ? Qr : Kr) + (32 * ant + r32) * QR_S + 8 * hi;
#pragma unroll
            for (int s = 0; s < 8; ++s) c = MFMA32(*(const bf16x8*)(ap + 16 * s), *(const bf16x8*)(bp + 16 * s), c);
        }
        if (sel == 0) {
            const int mtt = (tq == 3) ? 0 : mt, ntt = (tq == 3) ? 1 : nt, j = 32 * ntt + r32; const float gj = gc_s[j];
#pragma unroll
            for (int r = 0; r < 16; ++r) { const int i = 32 * mtt + crow(r, hi); Nm[i * NM_S + j] = (j < i) ? beta_s[i] * c[r] * __expf(gc_s[i] - gj) : 0.f; }
        } else {
            const int jt = (tq == 3) ? 1 : amt, itile = (tq == 3) ? 0 : ant, i = 32 * itile + r32; const float gi = gc_s[i];
#pragma unroll
            for (int r = 0; r < 16; ++r) { const int j = 32 * jt + crow(r, hi); c[r] = (j <= i) ? c[r] * __expf(gi - gc_s[j]) : 0.f; }
            bf16_t* AT = (bf16_t*)(dnb + DN_AT);
            *(bf16x8*)(AT + ((itile * 4 + 2 * jt) * 64 + lane) * 8) = pack8(c, 0); *(bf16x8*)(AT + ((itile * 4 + 2 * jt + 1) * 64 + lane) * 8) = pack8(c, 8);
        }
        bf16_t* QD = (bf16_t*)(dnb + DN_QD); bf16_t* KD = (bf16_t*)(dnb + DN_KD); const float glast = gc_s[63];
#pragma unroll
        for (int k2 = 0; k2 < 2; ++k2) { const int f = 2 * wave + k2, m2 = f >> 3, s = f & 7, tok = 32 * m2 + r32; const float e = egc_s[tok];
            const u32x2 lo = *(const u32x2*)(Qr + tok * QR_S + 16 * s + 4 * hi), hi2 = *(const u32x2*)(Qr + tok * QR_S + 16 * s + 8 + 4 * hi);
            u32x4 w; w.x = cvtpk(bflo(lo.x) * e, bfhi(lo.x) * e); w.y = cvtpk(bflo(lo.y) * e, bfhi(lo.y) * e); w.z = cvtpk(bflo(hi2.x) * e, bfhi(hi2.x) * e); w.w = cvtpk(bflo(hi2.y) * e, bfhi(hi2.y) * e);
            *(u32x4*)(QD + (f * 64 + lane) * 8) = w; }
#pragma unroll
        for (int k2 = 0; k2 < 2; ++k2) { const int f = 2 * wave + k2, mt2 = f >> 2, s = f & 3, dk = 32 * mt2 + r32, tk = 16 * s + 4 * hi;
            const u32x2 lo = *(const u32x2*)(KT + dk * KT_S + tk), hi2 = *(const u32x2*)(KT + dk * KT_S + tk + 8);
            float e[8];
#pragma unroll
            for (int q = 0; q < 4; ++q) { e[q] = __expf(glast - gc_s[tk + q]); e[4 + q] = __expf(glast - gc_s[tk + 8 + q]); }
            u32x4 w; w.x = cvtpk(bflo(lo.x) * e[0], bfhi(lo.x) * e[1]); w.y = cvtpk(bflo(lo.y) * e[2], bfhi(lo.y) * e[3]); w.z = cvtpk(bflo(hi2.x) * e[4], bfhi(hi2.x) * e[5]); w.w = cvtpk(bflo(hi2.y) * e[6], bfhi(hi2.y) * e[7]);
            *(u32x4*)(KD + (f * 64 + lane) * 8) = w; }
    }
    __syncthreads();
    if (tid < 64) { const int blk = tid >> 4, col = tid & 15, o = 16 * blk; float x[16];
#pragma unroll
        for (int i = 0; i < 16; ++i) { float a = (i == col) ? 1.f : 0.f;
#pragma unroll
            for (int j = 0; j < i; ++j) a -= Nm[(o + i) * NM_S + o + j] * x[j];
            x[i] = a; }
#pragma unroll
        for (int i = 0; i < 16; ++i) { Tm[(o + i) * NM_S + o + col] = x[i]; if (!(blk & 1)) Tm[(o + i) * NM_S + o + 16 + col] = 0.f; } }
    __syncthreads();
    { const int pb = tid >> 8, r = (tid >> 4) & 15, c = tid & 15, oi = 32 * pb + 16, oj = 32 * pb; float a = 0.f;
#pragma unroll
        for (int k = 0; k < 16; ++k) a += Nm[(oi + r) * NM_S + oj + k] * Tm[(oj + k) * NM_S + oj + c];
        Pm[pb * 272 + r * 17 + c] = a; }
    __syncthreads();
    { const int pb = tid >> 8, r = (tid >> 4) & 15, c = tid & 15, oi = 32 * pb + 16, oj = 32 * pb; float a = 0.f;
#pragma unroll
        for (int k = 0; k < 16; ++k) a -= Tm[(oi + r) * NM_S + oi + k] * Pm[pb * 272 + k * 17 + c];
        Tm[(oi + r) * NM_S + oj + c] = a; }
    __syncthreads();
    { const int r = tid >> 4, c = tid & 15; float a0 = 0.f, a1 = 0.f;
#pragma unroll 8
        for (int k = 0; k < 32; ++k) { const float nv = Nm[(32 + r) * NM_S + k]; a0 += nv * Tm[k * NM_S + c]; a1 += nv * Tm[k * NM_S + c + 16]; }
        Pm[r * 36 + c] = a0; Pm[r * 36 + c + 16] = a1; }
    __syncthreads();
    { const int r = tid >> 4, c = tid & 15; float a0 = 0.f, a1 = 0.f;
#pragma unroll 8
        for (int k = 0; k < 32; ++k) { const float tv = Tm[(32 + r) * NM_S + 32 + k]; a0 -= tv * Pm[k * 36 + c]; a1 -= tv * Pm[k * 36 + c + 16]; }
        Tm[(32 + r) * NM_S + c] = a0; Tm[(32 + r) * NM_S + c + 16] = a1; }
    __syncthreads();
    { const int i = tid >> 3, j0 = (tid & 7) * 8; float tu[8], tw[8];
#pragma unroll
        for (int q = 0; q < 8; ++q) { const int j = j0 + q; const float t = (i < 32 && j >= 32) ? 0.f : Tm[i * NM_S + j]; tu[q] = t * beta_s[j]; tw[q] = t * begc_s[j]; }
        *(u32x4*)(Tu + i * KT_S + j0) = (u32x4){cvtpk(tu[0], tu[1]), cvtpk(tu[2], tu[3]), cvtpk(tu[4], tu[5]), cvtpk(tu[6], tu[7])};
        *(u32x4*)(Tw + i * KT_S + j0) = (u32x4){cvtpk(tw[0], tw[1]), cvtpk(tw[2], tw[3]), cvtpk(tw[4], tw[5]), cvtpk(tw[6], tw[7])}; }
    __syncthreads();
    { const int mt = wave >> 2, nt = wave & 3;
        f32x16 c;
#pragma unroll
        for (int r = 0; r < 16; ++r) c[r] = 0.f;
        const bf16_t* ap = Tu + (32 * mt + r32) * KT_S + 8 * hi; const bf16_t* bp = VT + (32 * nt + r32) * KT_S + 8 * hi;
#pragma unroll
        for (int s = 0; s < 4; ++s) c = MFMA32(*(const bf16x8*)(ap + 16 * s), *(const bf16x8*)(bp + 16 * s), c);
        bf16_t* U = (bf16_t*)(dnb + DN_U);
        *(bf16x8*)(U + ((nt * 4 + mt * 2) * 64 + lane) * 8) = pack8(c, 0); *(bf16x8*)(U + ((nt * 4 + mt * 2 + 1) * 64 + lane) * 8) = pack8(c, 8);
    }
    { const int mt = wave >> 1, nt = wave & 1;
        f32x16 c;
#pragma unroll
        for (int r = 0; r < 16; ++r) c[r] = 0.f;
        const bf16_t* ap = KT + (32 * mt + r32) * KT_S + 8 * hi; const bf16_t* bp = Tw + (32 * nt + r32) * KT_S + 8 * hi;
#pragma unroll
        for (int s = 0; s < 4; ++s) c = MFMA32(*(const bf16x8*)(ap + 16 * s), *(const bf16x8*)(bp + 16 * s), c);
#pragma unroll
        for (int r = 0; r < 16; ++r) c[r] = -c[r];
        bf16_t* WN = (bf16_t*)(dnb + DN_WN);
        *(bf16x8*)(WN + ((nt * 8 + 2 * mt) * 64 + lane) * 8) = pack8(c, 0); *(bf16x8*)(WN + ((nt * 8 + 2 * mt + 1) * 64 + lane) * 8) = pack8(c, 8);
    }
    __syncthreads();
}
__device__ __forceinline__ void kv_unit(const Frame& F, int u) {
    THREAD_IDS();
    const int bh = u >> 2, s0 = (u & 3) * 512, b = bh >> 3, h = bh & 7;
    bf16_t* kt = (bf16_t*)F.lds; bf16_t* vt = kt + 512 * 64;
    const bf16_t* HP = WSP(const bf16_t, WS_HP);
#pragma unroll
    for (int it = 0; it < 8; ++it) { const int idx = it * NTHREADS + tid, r = idx >> 3, c8 = (idx & 7) * 8;
        const bf16_t* src = HP + ((size_t)b * SEQ + s0 + r) * HPW + h * 64 + c8;
        const int sw = r * 64 + (((c8 >> 3) ^ (r & 7)) << 3);
        *(u32x4*)(kt + sw) = *(const u32x4*)(src + 512); *(u32x4*)(vt + sw) = *(const u32x4*)(src + 1024); }
    __syncthreads();
    const int r32 = lane & 31, hi = lane >> 5;
#pragma unroll 1
    for (int it = 0; it < 6; ++it) { const int q = it * NWAVES + wave;
        const int di = q >> 4, bi = q & 15, d = (di == 0) ? 1 : (di == 1 ? 4 : 16), nbd = 64 / d, per = 16 / d;
        const int c = bi / per, nbl = bi % per, nb = (s0 / d) / 32 + nbl;
        const size_t fbase = ((size_t)di * (T_TOK * 512)) + (((size_t)bh * 64 + c * nbd + nb) * 4) * 512 + lane * 8;
        bf16_t* kf = WSP(bf16_t, WS_KF) + fbase; bf16_t* vf = WSP(bf16_t, WS_VT) + fbase;
        const int prow = c + d * (32 * nbl + r32);
#pragma unroll
        for (int d0 = 0; d0 < 4; ++d0) *(u32x4*)(kf + d0 * 512) = *(const u32x4*)(kt + prow * 64 + (((2 * d0 + hi) ^ (prow & 7)) << 3));
#pragma unroll
        for (int eb = 0; eb < 2; ++eb)
#pragma unroll
            for (int ks = 0; ks < 2; ++ks) { unsigned w[4];
#pragma unroll
                for (int jj = 0; jj < 4; ++jj) { const int j0 = 2 * jj, j1 = 2 * jj + 1;
                    const int n0 = 32 * nbl + 16 * ks + 8 * (j0 >> 2) + 4 * hi + (j0 & 3), n1 = 32 * nbl + 16 * ks + 8 * (j1 >> 2) + 4 * hi + (j1 & 3);
                    const int ra = c + d * n0, rb = c + d * n1, ech = 4 * eb + (r32 >> 3);
                    const unsigned lo = vt[ra * 64 + ((ech ^ (ra & 7)) << 3) + (r32 & 7)], hi2 = vt[rb * 64 + ((ech ^ (rb & 7)) << 3) + (r32 & 7)]; w[jj] = lo | (hi2 << 16); }
                *(u32x4*)(vf + (eb * 2 + ks) * 512) = (u32x4){w[0], w[1], w[2], w[3]}; }
    }
    __syncthreads();
}

constexpr int SCAN_BUF = 73728;
__device__ __forceinline__ void scan_stage4(const unsigned char* dnb, int wv, LAS unsigned char* buf, int lane) {
    const unsigned char* src = dnb + wv * 18432 + lane * 16; LAS unsigned char* dst = buf + wv * 18432;
#pragma unroll 1
    for (int f = 0; f < 18; ++f) __builtin_amdgcn_global_load_lds((const unsigned*)(src + f * 1024), (LAS unsigned*)(dst + f * 1024), 16, 0, 0);
}
__device__ __forceinline__ void scan_unit4(const Frame& F, int bh, int sl) {
    THREAD_IDS();
    const int r32 = lane & 31, hi = lane >> 5;
    const int b = bh >> 2, h = bh & 3;
    LAS unsigned char* lds3 = (LAS unsigned char*)F.lds;
    volatile LAS unsigned* sbar = (volatile LAS unsigned*)(lds3 + LDS_MISC + 4096 + 64);
    f32x16 S[4];
#pragma unroll
    for (int mt = 0; mt < 4; ++mt)
#pragma unroll
        for (int r = 0; r < 16; ++r) S[mt][r] = 0.f;
    bf16_t* ORAW = WSP(bf16_t, WS_ORAW);
    const int ch0 = bh * 32;
    scan_stage4(F.ws + WS_DN + (size_t)ch0 * DN_STRIDE, sl, lds3, lane);
#pragma unroll 1
    for (int n = 0; n < 32; ++n) {
        const int ch = ch0 + n;
        LAS unsigned char* buf = lds3 + (n & 1) * SCAN_BUF;
        float eg = WSP(const float, WS_EG)[ch];
        asm volatile("s_waitcnt vmcnt(0) lgkmcnt(0)" : "+v"(eg) :: "memory");
        if (lane == 0) __hip_atomic_fetch_add((LAS unsigned*)sbar, 1u, __ATOMIC_RELAXED, __HIP_MEMORY_SCOPE_WORKGROUP);
        { const unsigned want = 4u * (unsigned)(n + 1); while (*sbar < want) __builtin_amdgcn_s_sleep(1); }
        asm volatile("" ::: "memory");
        if (n + 1 < 32) scan_stage4(F.ws + WS_DN + (size_t)(ch + 1) * DN_STRIDE, sl, lds3 + ((n + 1) & 1) * SCAN_BUF, lane);
        const LAS unsigned char* fb = buf + lane * 16;
        bf16x8 Sb[8];
#pragma unroll
        for (int mt = 0; mt < 4; ++mt) { Sb[2 * mt] = pack8(S[mt], 0); Sb[2 * mt + 1] = pack8(S[mt], 8); }
        f32x16 vn[2], o[2];
#pragma unroll
        for (int m2 = 0; m2 < 2; ++m2) {
#pragma unroll
            for (int r8 = 0; r8 < 2; ++r8) { const u32x4 uu = *(const LAS u32x4*)(fb + 57344 + (sl * 4 + m2 * 2 + r8) * 1024);
                vn[m2][8 * r8] = bflo(uu.x); vn[m2][8 * r8 + 1] = bfhi(uu.x); vn[m2][8 * r8 + 2] = bflo(uu.y); vn[m2][8 * r8 + 3] = bfhi(uu.y);
                vn[m2][8 * r8 + 4] = bflo(uu.z); vn[m2][8 * r8 + 5] = bfhi(uu.z); vn[m2][8 * r8 + 6] = bflo(uu.w); vn[m2][8 * r8 + 7] = bfhi(uu.w); }
#pragma unroll
            for (int s = 0; s < 8; ++s) { const bf16x8 a = *(const LAS bf16x8*)(fb + (m2 * 8 + s) * 1024); vn[m2] = MFMA32(a, Sb[s], vn[m2]); }
            __builtin_amdgcn_sched_barrier(0);
#pragma unroll
            for (int r = 0; r < 16; ++r) o[m2][r] = 0.f;
#pragma unroll
            for (int s = 0; s < 8; ++s) { const bf16x8 a = *(const LAS bf16x8*)(fb + 16384 + (m2 * 8 + s) * 1024); o[m2] = MFMA32(a, Sb[s], o[m2]); }
            __builtin_amdgcn_sched_barrier(0);
        }
        bf16x8 vb[4];
#pragma unroll
        for (int m2 = 0; m2 < 2; ++m2) { vb[2 * m2] = pack8(vn[m2], 0); vb[2 * m2 + 1] = pack8(vn[m2], 8); }
#pragma unroll
        for (int m2 = 0; m2 < 2; ++m2) {
#pragma unroll
            for (int s = 0; s < 4; ++s) { const bf16x8 a = *(const LAS bf16x8*)(fb + 32768 + (m2 * 4 + s) * 1024); o[m2] = MFMA32(a, vb[s], o[m2]); }
#pragma unroll
            for (int r = 0; r < 16; ++r) ORAW[((size_t)b * SEQ + 64 * n + 32 * m2 + crow(r, hi)) * 512 + h * 128 + 32 * sl + r32] = f2bf(o[m2][r]);
            __builtin_amdgcn_sched_barrier(0);
        }
#pragma unroll
        for (int mt = 0; mt < 4; ++mt) {
#pragma unroll
            for (int r = 0; r < 16; ++r) S[mt][r] *= eg;
#pragma unroll
            for (int s = 0; s < 4; ++s) { const bf16x8 a = *(const LAS bf16x8*)(fb + 40960 + (mt * 4 + s) * 1024); S[mt] = MFMA32(a, vb[s], S[mt]); }
            if (mt & 1) __builtin_amdgcn_sched_barrier(0);
        }
    }
    asm volatile("s_waitcnt vmcnt(0) lgkmcnt(0)" ::: "memory");
}
__device__ __forceinline__ void attn_block(const bf16x8 (&kc)[4], const bf16x8 (&vc)[4], const bf16x8 (&qr)[4], f32x16 (&o)[2], float& m_run, float& l_run, int dn0  ) {
    f32x16 s;
#pragma unroll
    for (int r = 0; r < 16; ++r) s[r] = 0.f;
#pragma unroll
    for (int d0 = 0; d0 < 4; ++d0) s = MFMA32(kc[d0], qr[d0], s);
#pragma unroll
    for (int r = 0; r < 16; ++r) { const unsigned dlt = (unsigned)(dn0 - ((r & 3) + 8 * (r >> 2))); s[r] = (dlt <= 128u) ? s[r] : -INFINITY; }
    float mb = fmaxf(fmaxf(s[0], s[1]), fmaxf(s[2], s[3]));
#pragma unroll
    for (int r = 4; r < 16; r += 4) mb = fmaxf(mb, fmaxf(fmaxf(s[r], s[r + 1]), fmaxf(s[r + 2], s[r + 3])));
    mb = fmaxf(mb, __shfl_xor(mb, 32));
    const float mn = fmaxf(m_run, mb);
    {
        const float al = __builtin_amdgcn_exp2f(m_run - mn);
        l_run *= al; m_run = mn;
#pragma unroll
        for (int eb = 0; eb < 2; ++eb)
#pragma unroll
            for (int r = 0; r < 16; ++r) o[eb][r] *= al;
    }
    float ps = 0.f;
#pragma unroll
    for (int r = 0; r < 16; ++r) { s[r] = __builtin_amdgcn_exp2f(s[r] - mn); ps += s[r]; }
    l_run += ps;
    const bf16x8 pb0 = pack8(s, 0), pb1 = pack8(s, 8);
#pragma unroll
    for (int eb = 0; eb < 2; ++eb)
#pragma unroll
        for (int ks = 0; ks < 2; ++ks) o[eb] = MFMA32(vc[eb * 2 + ks], ks ? pb1 : pb0, o[eb]);
}
template <int D_>
__device__ __forceinline__ void attn_branch(const Frame& F, int di, int b, int h, int t0, int jq, const bf16x8 (&qr)[4], f32x16 (&o)[2], float& m_run, float& l_run) {
    THREAD_IDS();
    const int r32 = lane & 31, hi = lane >> 5;
    constexpr int STEP = 16 / D_, NBD = 64 / D_;
    const int c = t0 % D_, a0 = t0 / D_;
    const int nq = a0 + STEP * (32 * jq + r32);
    const int nq_lo = a0 + STEP * (32 * jq), nq_hi = a0 + STEP * (32 * jq + 31);
    const int n_lo = (nq_lo - 128) > 0 ? (nq_lo - 128) : 0;
    const size_t fbase = ((size_t)di * (T_TOK * 512)) + (((size_t)(b * 8 + h) * 64 + c * NBD) * 4) * 512;
    const unsigned char* KF = (const unsigned char*)(WSP(const bf16_t, WS_KF) + fbase); const unsigned char* VF = (const unsigned char*)(WSP(const bf16_t, WS_VT) + fbase);
    const unsigned loff = (unsigned)lane * 16u;
    const int nb0 = n_lo >> 5, nb1 = nq_hi >> 5;
    const int dq = nq - 4 * hi;
#define ATT_LOAD(KX, VX, NB) do { const int nb_ = (NB) < nb1 ? (NB) : nb1; _Pragma("unroll") for (int f = 0; f < 4; ++f) { const unsigned off = (unsigned)nb_ * 4096u + loff + f * 1024; KX[f] = *(const bf16x8*)(KF + off); VX[f] = *(const bf16x8*)(VF + off); } } while (0)
    bf16x8 kA[4], vA[4], kB[4], vB[4], kC[4], vC[4];
    ATT_LOAD(kA, vA, nb0); ATT_LOAD(kB, vB, nb0 + 1);
#pragma unroll 1
    for (int nb = nb0; nb <= nb1; nb += 3) {
        ATT_LOAD(kC, vC, nb + 2);
        attn_block(kA, vA, qr, o, m_run, l_run, dq - 32 * nb);
        if (nb + 1 > nb1) break;
        ATT_LOAD(kA, vA, nb + 3);
        attn_block(kB, vB, qr, o, m_run, l_run, dq - 32 * (nb + 1));
        if (nb + 2 > nb1) break;
        ATT_LOAD(kB, vB, nb + 4);
        attn_block(kC, vC, qr, o, m_run, l_run, dq - 32 * (nb + 2));
    }
#undef ATT_LOAD
}
__device__ __forceinline__ void attn_task(const Frame& F, int a) {
    THREAD_IDS();
    const int r32 = lane & 31, hi = lane >> 5;
    const int x = F.blk & 7, bh = x + 8 * (a >> 6), tw = a & 63, t0 = tw & 15, jq = 3 - (tw >> 4), b = bh >> 3, h = bh & 7;
    const int tq = t0 + 16 * (32 * jq + r32);
    const bf16_t* HP = WSP(const bf16_t, WS_HP);
    bf16x8 qr[4];
#pragma unroll
    for (int d0 = 0; d0 < 4; ++d0) { const u32x4 qw = *(const u32x4*)(HP + ((size_t)b * SEQ + tq) * HPW + h * 64 + 16 * d0 + 8 * hi);
        constexpr float SCQ = 0.125f * 1.4426950408889634f; u32x4 w;
        w.x = cvtpk(bflo(qw.x) * SCQ, bfhi(qw.x) * SCQ); w.y = cvtpk(bflo(qw.y) * SCQ, bfhi(qw.y) * SCQ); w.z = cvtpk(bflo(qw.z) * SCQ, bfhi(qw.z) * SCQ); w.w = cvtpk(bflo(qw.w) * SCQ, bfhi(qw.w) * SCQ);
        qr[d0] = __builtin_bit_cast(bf16x8, w); }
    f32x16 o[2];
#pragma unroll
    for (int eb = 0; eb < 2; ++eb)
#pragma unroll
        for (int r = 0; r < 16; ++r) o[eb][r] = 0.f;
    float m_run = -1e30f, l_run = 0.f;
    attn_branch<1>(F, 0, b, h, t0, jq, qr, o, m_run, l_run);
    attn_branch<4>(F, 1, b, h, t0, jq, qr, o, m_run, l_run);
    attn_branch<16>(F, 2, b, h, t0, jq, qr, o, m_run, l_run);
    const float lt = l_run + __shfl_xor(l_run, 32), inv = 1.f / lt;
    bf16_t* dst = WSP(bf16_t, WS_MIX) + ((size_t)b * SEQ + tq) * DM + h * 64;
#pragma unroll
    for (int eb = 0; eb < 2; ++eb)
#pragma unroll
        for (int g = 0; g < 4; ++g) { u32x2 w; w.x = cvtpk(o[eb][4 * g] * inv, o[eb][4 * g + 1] * inv); w.y = cvtpk(o[eb][4 * g + 2] * inv, o[eb][4 * g + 3] * inv);
            *(u32x2*)(dst + 32 * eb + 8 * g + 4 * hi) = w; }
}
__device__ __forceinline__ void phase3(const Frame& F, int flags) {
    THREAD_IDS();
    if (tid == 0) *(volatile LAS unsigned*)((LAS unsigned char*)F.lds + LDS_MISC + 4096 + 64) = 0u;
    __syncthreads();
    if (F.blk < 64 && wave < 4 && !(flags & 1)) scan_unit4(F, F.blk, wave);
    unsigned* qctr = WSP(unsigned, WS_CTL) + 1024 + (F.blk & 7) * 32;
    if (wave == 7) { moe_weight_stream(F, F.blk, F.G, lane); return; }
    if (flags & 2) return;
    for (;;) {
        unsigned a = 0; if (lane == 0) a = atomicAdd(qctr, 1u);
        a = (unsigned)__builtin_amdgcn_readfirstlane((int)a);
        if (a >= 1024u) break;
        attn_task(F, (int)a);
    }
}

__device__ __forceinline__ void phase4(const Frame& F) {
    THREAD_IDS();
    const float* in_gnorm_w = inptr(6);
    const int gw = F.blk * NWAVES + wave, NGW = F.G * NWAVES;
    const bf16_t* ORAW = WSP(const bf16_t, WS_ORAW); const bf16_t* HP = WSP(const bf16_t, WS_HP); bf16_t* MIX = WSP(bf16_t, WS_MIX);
    const f32x4 gw0 = *(const f32x4*)(in_gnorm_w + (lane & 15) * 8), gw1 = *(const f32x4*)(in_gnorm_w + (lane & 15) * 8 + 4);
    for (int row = gw; row < T_TOK; row += NGW) {
        const u32x4 ow = *(const u32x4*)(ORAW + (size_t)row * 512 + lane * 8), zw = *(const u32x4*)(HP + (size_t)row * HPW + 3072 + lane * 8);
        f32x4 oa, ob, za, zb; pg8::unpack8(ow, oa, ob); pg8::unpack8(zw, za, zb);
        float ss = oa[0] * oa[0] + oa[1] * oa[1] + oa[2] * oa[2] + oa[3] * oa[3] + ob[0] * ob[0] + ob[1] * ob[1] + ob[2] * ob[2] + ob[3] * ob[3];
        ss += __shfl_xor(ss, 1); ss += __shfl_xor(ss, 2); ss += __shfl_xor(ss, 4); ss += __shfl_xor(ss, 8);
        const float r = rsqrtf(ss * (1.f / 128.f) + 1e-6f);
        f32x4 ya, yb;
#pragma unroll
        for (int j = 0; j < 4; ++j) { ya[j] = oa[j] * r * gw0[j] * (za[j] * sigm(za[j])); yb[j] = ob[j] * r * gw1[j] * (zb[j] * sigm(zb[j])); }
        *(u32x4*)(MIX + (size_t)row * DM + 512 + lane * 8) = pg8::pack_row8(ya, yb);
    }
}

__device__ __forceinline__ void phase6(const Frame& F) {
    THREAD_IDS();
    const float* in_ln1_g = inptr(8); const float* in_ln1_b = inptr(9); const float* in_b_router = inptr(11);
    float* wrt = (float*)F.lds;
    { const f32x4* src = WSP(const f32x4, WS_WRT); f32x4* dst = (f32x4*)wrt; for (int i = tid; i < 8192; i += NTHREADS) dst[i] = src[i]; }
    __syncthreads();
    const int gw = F.blk * NWAVES + wave, NGW = F.G * NWAVES;
    bf16_t* X1 = WSP(bf16_t, WS_X1);
    unsigned* cnt = WSP(unsigned, WS_CTL); int* rt_e = WSP(int, WS_ROUTE); int* rt_s = rt_e + T_TOK * 4; int* ltok = WSP(int, WS_LTOK); float* lgate = WSP(float, WS_LGATE);
    int* s_cnt = (int*)(F.lds + LDS_MISC + 4096); int* s_base = s_cnt + 32; int* s_e = s_base + 32; float* s_g = (float*)(s_e + 512); int* s_li = (int*)(s_g + 512);
    if (tid < 32) s_cnt[tid] = 0;
    __syncthreads();
    int irow = 0;
    f32x4 lg[4], lb[4];
#pragma unroll
    for (int j = 0; j < 4; ++j) { lg[j] = *(const f32x4*)(in_ln1_g + 4 * lane + 256 * j); lb[j] = *(const f32x4*)(in_ln1_b + 4 * lane + 256 * j); }
    const float brl = in_b_router[((lane >> 5) & 1) * 16 + ((lane >> 4) & 1) * 8 + ((lane >> 3) & 1) * 4 + ((lane >> 2) & 1) * 2 + ((lane >> 1) & 1)];
    for (int row = gw; row < T_TOK && irow < 16; row += NGW, ++irow) {
        u32x2* xr = (u32x2*)(X1 + (size_t)row * DM) + lane;
        f32x4 v[4]; float s = 0.f;
#pragma unroll
        for (int j = 0; j < 4; ++j) { const u32x2 w = xr[64 * j]; v[j] = (f32x4){bflo(w.x), bfhi(w.x), bflo(w.y), bfhi(w.y)}; s += (v[j][0] + v[j][1]) + (v[j][2] + v[j][3]); }
        const float mean = wave_sum(s) * (1.f / DM); float s2 = 0.f;
#pragma unroll
        for (int j = 0; j < 4; ++j) { v[j] = v[j] - mean; s2 += (v[j][0] * v[j][0] + v[j][1] * v[j][1]) + (v[j][2] * v[j][2] + v[j][3] * v[j][3]); }
        const float rstd = rsqrtf(wave_sum(s2) * (1.f / DM) + LN_EPS);
#pragma unroll
        for (int j = 0; j < 4; ++j) { v[j] = v[j] * rstd * lg[j] + lb[j]; u32x2 w; w.x = cvtpk(v[j][0], v[j][1]); w.y = cvtpk(v[j][2], v[j][3]); xr[64 * j] = w;
            (WSP(unsigned, WS_X1F) + (size_t)row * 256)[lane + 64 * j] = pk4_fp8(v[j][0], v[j][1], v[j][2], v[j][3]); }
        float pl[32];
#pragma unroll
        for (int e = 0; e < 32; ++e) { float a = 0.f;
#pragma unroll
            for (int j = 0; j < 4; ++j) { const f32x4 w = *(const f32x4*)(wrt + e * 1024 + 4 * lane + 256 * j); a += v[j][0] * w[0] + v[j][1] * w[1] + v[j][2] * w[2] + v[j][3] * w[3]; }
            pl[e] = a; if ((e & 3) == 3) asm volatile("" ::: "memory"); }
        float q16[16], q8[8], q4[4], q2[2];
        { const bool up = (lane & 32) != 0;
#pragma unroll
            for (int k = 0; k < 16; ++k) { const float keep = up ? pl[k + 16] : pl[k], send = up ? pl[k] : pl[k + 16]; q16[k] = keep + __shfl_xor(send, 32); } }
        { const bool up = (lane & 16) != 0;
#pragma unroll
            for (int k = 0; k < 8; ++k) { const float keep = up ? q16[k + 8] : q16[k], send = up ? q16[k] : q16[k + 8]; q8[k] = keep + __shfl_xor(send, 16); } }
        { const bool up = (lane & 8) != 0;
#pragma unroll
            for (int k = 0; k < 4; ++k) { const float keep = up ? q8[k + 4] : q8[k], send = up ? q8[k] : q8[k + 4]; q4[k] = keep + __shfl_xor(send, 8); } }
        { const bool up = (lane & 4) != 0;
#pragma unroll
            for (int k = 0; k < 2; ++k) { const float keep = up ? q4[k + 2] : q4[k], send = up ? q4[k] : q4[k + 2]; q2[k] = keep + __shfl_xor(send, 4); } }
        float lgt;
        { const bool up = (lane & 2) != 0; const float keep = up ? q2[1] : q2[0], send = up ? q2[0] : q2[1]; lgt = keep + __shfl_xor(send, 2); }
        lgt += __shfl_xor(lgt, 1);
        const int my_e = ((lane >> 5) & 1) * 16 + ((lane >> 4) & 1) * 8 + ((lane >> 3) & 1) * 4 + ((lane >> 2) & 1) * 2 + ((lane >> 1) & 1);
        lgt += brl;
        int rank = 0;
#pragma unroll
        for (int e = 0; e < 32; ++e) { const int src = ((e >> 4) & 1) * 32 + ((e >> 3) & 1) * 16 + ((e >> 2) & 1) * 8 + ((e >> 1) & 1) * 4 + (e & 1) * 2;
            const float ve = __uint_as_float((unsigned)__builtin_amdgcn_readlane((int)__float_as_uint(lgt), src));
            rank += (ve > lgt || (ve == lgt && e < my_e)) ? 1 : 0;
            if ((e & 7) == 7) __builtin_amdgcn_sched_barrier(0); }
        float tv[4]; int te[4];
#pragma unroll
        for (int k = 0; k < 4; ++k) { const unsigned long long mk = __ballot(rank == k && (lane & 1) == 0); const int src = (int)__builtin_ctzll(mk);
            tv[k] = __uint_as_float((unsigned)__builtin_amdgcn_readlane((int)__float_as_uint(lgt), src)); te[k] = __builtin_amdgcn_readlane(my_e, src); }
        const float e1 = __expf(tv[1] - tv[0]), e2 = __expf(tv[2] - tv[0]), e3 = __expf(tv[3] - tv[0]), inv = 1.f / (1.f + e1 + e2 + e3);
        if (lane < 4) { const int ek = lane == 0 ? te[0] : (lane == 1 ? te[1] : (lane == 2 ? te[2] : te[3]));
            const float gk = (lane == 0 ? 1.f : (lane == 1 ? e1 : (lane == 2 ? e2 : e3))) * inv;
            const int li = atomicAdd(s_cnt + ek, 1);
            const int q = (wave * 16 + irow) * 4 + lane; s_e[q] = ek; s_g[q] = gk; s_li[q] = li; }
    }
    __syncthreads();
    if (tid < 32) s_base[tid] = (int)atomicAdd(cnt + tid * 32, (unsigned)s_cnt[tid]);
    __syncthreads();
    { const int lr = tid >> 2, k = tid & 3, wv = lr >> 4, i = lr & 15;
        const int row = (F.blk * NWAVES + wv) + i * NGW;
        if (row < T_TOK) { const int ek = s_e[tid], slot = s_base[ek] + s_li[tid];
            ltok[(size_t)ek * LCAP + slot] = row; lgate[(size_t)ek * LCAP + slot] = s_g[tid]; rt_e[row * 4 + k] = ek; rt_s[row * 4 + k] = slot; } }
}
constexpr int ULIST_OFF = LDS_MISC + 1024, ULIST_MAX = 60;
__device__ __forceinline__ void build_tpre(const Frame& F, int nN, int ndense = 0) {
    THREAD_IDS();
    int* tpre = (int*)(F.lds + LDS_MISC); int* cnts = tpre + 64; int* ulist = (int*)(F.lds + ULIST_OFF);
    __syncthreads();
    if (tid == 0) { const unsigned* cnt = WSP(const unsigned, WS_CTL); int acc = 0;
        for (int e = 0; e < NEXP; ++e) { const int c = (int)__hip_atomic_load(cnt + e * 32, __ATOMIC_RELAXED, __HIP_MEMORY_SCOPE_AGENT); tpre[e] = acc; cnts[e] = c; acc += (c + 255) >> 8; }
        tpre[NEXP] = acc;
        if (nN > 0) { const int totale = acc * nN, total = totale + ndense; int i = 0;
            for (; i < ULIST_MAX; ++i) { const int L = pg8::unit_index(i, F.blk, F.G, total); if (L < 0) break;
                if (L >= totale) { const int l = L - totale, gid = l / 32, w = l - gid * 32;
                    ulist[4 * i] = 255 | ((w / 8) << 8); ulist[4 * i + 1] = gid * 8 + w % 8; ulist[4 * i + 2] = gid * 8 + w % 8; ulist[4 * i + 3] = 256; continue; }
                int e = 0; for (int k = 1; k < NEXP; ++k) if (L >= tpre[k] * nN) e = k;
                const int tp0 = tpre[e], tiles = tpre[e + 1] - tp0, l = L - tp0 * nN, nig = 8 * nN, gid = l / nig, fm = gid * 8, gsz = (tiles - fm) < 8 ? (tiles - fm) : 8, w = l - gid * nig;
                const int pn = w / gsz, pl = fm + w % gsz, rr = cnts[e] - 256 * pl;
                ulist[4 * i] = e | (pn << 8); ulist[4 * i + 1] = pl; ulist[4 * i + 2] = tp0 + pl; ulist[4 * i + 3] = rr < 256 ? rr : 256; }
            ulist[4 * i + 3] = 0; }
    }
    __syncthreads();
}

__device__ __forceinline__ void phase9(const Frame& F) {
    THREAD_IDS();
    const float* in_ln2_g = inptr(19); const float* in_ln2_b = inptr(20);
    build_tpre(F, 0);
    const int* tpre = (const int*)(F.lds + LDS_MISC);
    const int gw = F.blk * NWAVES + wave, NGW = F.G * NWAVES;
    const bf16_t* X1 = WSP(const bf16_t, WS_X1); const bf16_t* PLE = WSP(const bf16_t, WS_PLE); const unsigned char* YB = WSP(const unsigned char, WS_YB);
    const int* rt_e = WSP(const int, WS_ROUTE); const int* rt_s = rt_e + T_TOK * 4;
    f32x4 lg[4], lb[4];
#pragma unroll
    for (int j = 0; j < 4; ++j) { lg[j] = *(const f32x4*)(in_ln2_g + 4 * lane + 256 * j); lb[j] = *(const f32x4*)(in_ln2_b + 4 * lane + 256 * j); }
    for (int row = gw; row < T_TOK; row += NGW) {
        const u32x2* xr = (const u32x2*)(X1 + (size_t)row * DM) + lane; const u32x2* pr = (const u32x2*)(PLE + (size_t)row * DM) + lane;
        f32x4 v[4];
#pragma unroll
        for (int j = 0; j < 4; ++j) { const u32x2 w = xr[64 * j], q = pr[64 * j];
            v[j] = (f32x4){bflo(w.x), bfhi(w.x), bflo(w.y), bfhi(w.y)} * ALPHA + (f32x4){bflo(q.x), bfhi(q.x), bflo(q.y), bfhi(q.y)}; }
#pragma unroll
        for (int k = 0; k < 4; ++k) { const int e = rt_e[row * 4 + k], sl = rt_s[row * 4 + k]; const size_t R = (size_t)tpre[e] * 256 + sl;
            const unsigned* yr = (const unsigned*)(YB + R * DM) + lane;
#pragma unroll
            for (int j = 0; j < 4; ++j) { const int w = (int)yr[64 * j]; const f32x2_t lo = __builtin_amdgcn_cvt_pk_f32_fp8(w, false), hi2 = __builtin_amdgcn_cvt_pk_f32_fp8(w, true); v[j] = v[j] + (f32x4){lo[0], lo[1], hi2[0], hi2[1]}; } }
        float s = 0.f;
#pragma unroll
        for (int j = 0; j < 4; ++j) s += (v[j][0] + v[j][1]) + (v[j][2] + v[j][3]);
        const float mean = wave_sum(s) * (1.f / DM); float s2 = 0.f;
#pragma unroll
        for (int j = 0; j < 4; ++j) { v[j] = v[j] - mean; s2 += (v[j][0] * v[j][0] + v[j][1] * v[j][1]) + (v[j][2] * v[j][2] + v[j][3] * v[j][3]); }
        const float rstd = rsqrtf(wave_sum(s2) * (1.f / DM) + LN_EPS);
        f32x4* orow = (f32x4*)(F.out + (size_t)row * DM) + lane;
#pragma unroll
        for (int j = 0; j < 4; ++j) orow[64 * j] = v[j] * rstd * lg[j] + lb[j];
    }
}

constexpr int N_PHASES = 10;
__global__ void __launch_bounds__(NTHREADS, 2) fwd_kernel(Args args) {
    extern __shared__ __attribute__((aligned(16))) unsigned char lds_raw[];
    Frame F;
    F.lds = lds_raw; F.G = gridDim.x; F.blk = blockIdx.x;
    F.out = args.out; F.ws = args.ws;
    LAS unsigned char* lds3 = (LAS unsigned char*)lds_raw;
    const int lo = args.ph_lo, hi = args.ph_hi;
#if ONE_LAUNCH
    cg::grid_group grid = cg::this_grid();
    if (threadIdx.x < 2) ((LAS unsigned*)(lds3 + LDS_BARST))[threadIdx.x] = 0u;
    __syncthreads();
    XcdBarrier xbar = xcd_barrier_post(WSP(unsigned, WS_CTL) + CW_BAR, (volatile LAS unsigned*)(lds3 + LDS_BARST));
#define SEAM(k) do { if (lo <= (k) && (k) + 1 < hi) { if ((k) == 0) grid.sync(); else xcd_barrier(xbar); } } while (0)
#else
#define SEAM(k) do { } while (0)
#endif
#ifndef PHASE_MASK
#define PHASE_MASK 0x3ff
#endif
#define IN(k) (((PHASE_MASK >> (k)) & 1) && lo <= (k) && (k) < hi)
#define REPS(k) 1
#if ONE_LAUNCH
#define REPSYNC() xcd_barrier(xbar)
#else
#define REPSYNC() do { } while (0)
#endif
    if (IN(0)) { for (int rep = 0; rep < REPS(0); ++rep) { if (rep) REPSYNC(); phase0(F); } SEAM(0); }
    if (IN(1)) {
        for (int rep = 0; rep < REPS(1); ++rep) { if (rep) REPSYNC();
        pg8::DenseSched S{(const char*)WSP(bf16_t, WS_XB), (const char*)WSP(bf16_t, WS_WIN), T_TOK / 256, HPW / 256, 1024, F.blk, F.G};
        pg8::EpiStore E{WSP(bf16_t, WS_HP), HPW};
        pg8::gemm_phase<false>(lds3, 1024, S, E); }
        SEAM(1);
    }
    if (IN(2)) {
        for (int rep = 0; rep < REPS(2); ++rep) { if (rep) REPSYNC();
        for (int u = F.blk; u < 2048 + 512; u += F.G) { if (u < 2048) { if (!(args.flags & 4)) dn_prep_unit(F, u); } else if (!(args.flags & 8)) kv_unit(F, u - 2048); } }
        SEAM(2);
    }
    if (IN(3)) { for (int rep = 0; rep < REPS(3); ++rep) { if (rep) { REPSYNC(); if (F.blk == 0 && threadIdx.x == 0) __hip_atomic_store(WSP(unsigned, WS_CTL) + 64, 0u, __ATOMIC_RELAXED, __HIP_MEMORY_SCOPE_AGENT); REPSYNC(); } phase3(F, args.flags); } SEAM(3); }
    if (IN(4)) { for (int rep = 0; rep < REPS(4); ++rep) { if (rep) REPSYNC(); phase4(F); } SEAM(4); }
    if (IN(5)) {
        for (int rep = 0; rep < REPS(5); ++rep) { if (rep) REPSYNC();
        pg8::DenseSched S{(const char*)WSP(bf16_t, WS_MIX), (const char*)WSP(bf16_t, WS_WOUT), T_TOK / 256, DM / 256, 1024, F.blk, F.G};
        pg8::EpiResid E{WSP(bf16_t, WS_X1), WSP(const bf16_t, WS_XB)};
        pg8::gemm_phase<false>(lds3, 1024, S, E); }
        SEAM(5);
    }
    if (IN(6)) { phase6(F); SEAM(6); }
    if (IN(7)) {
        build_tpre(F, 8, 512);
        for (int rep = 0; rep < REPS(7); ++rep) { if (rep) REPSYNC();
        { pg8::MoeSched<true> S{(const char*)WSP(unsigned char, WS_X1F), (const char*)WSP(unsigned char, WS_WGU), (size_t)2048 * 1024, WSP(const int, WS_LTOK), (const LAS int*)(lds3 + ULIST_OFF), 1024, (const char*)WSP(unsigned char, WS_WPG)};
          pg8::EpiActSig E{{WSP(unsigned char, WS_ACT), inptr(13)}, {WSP(bf16_t, WS_PLE), inptr(17)}};
          pg8::gemm_phase<true>(lds3, 1024, S, E); } }
        SEAM(7);
    }
    if (IN(8)) {
        build_tpre(F, 4);
        for (int rep = 0; rep < REPS(8); ++rep) { if (rep) REPSYNC();
        { pg8::MoeSched<false> S{(const char*)WSP(unsigned char, WS_ACT), (const char*)WSP(unsigned char, WS_WD), (size_t)1024 * 1024, nullptr, (const LAS int*)(lds3 + ULIST_OFF), 1024, nullptr};
          pg8::EpiDown E{WSP(unsigned char, WS_YB), inptr(15), WSP(const float, WS_LGATE)};
          pg8::gemm_phase<true>(lds3, 1024, S, E); } }
        { pg8::DenseSched S{(const char*)WSP(bf16_t, WS_PB), (const char*)WSP(bf16_t, WS_WPP), T_TOK / 256, DM / 256, 256, F.blk, F.G};
          pg8::EpiMul E{WSP(bf16_t, WS_PLE)};
          pg8::gemm_phase<false>(lds3, 256, S, E); }
        SEAM(8);
    }
    if (IN(9)) { for (int rep = 0; rep < REPS(9); ++rep) { if (rep) REPSYNC(); phase9(F); } }
}

extern "C" void kernel_launch(void* const* d_in, const int* in_sizes, int n_in, void* d_out, int out_size, void* d_ws, size_t ws_size, hipStream_t stream) {
    static int grid = 0;
    if (grid == 0) {
        if (n_in != 21 || out_size != T_TOK * DM || ws_size < WS_END) { fprintf(stderr, "kernel_launch: unexpected problem (n_in %d, out %d, ws %zu)\n", n_in, out_size, ws_size); grid = -1; return; }
        int dev = 0, cus = 0, per_cu = 0;
        (void)hipGetDevice(&dev); (void)hipDeviceGetAttribute(&cus, hipDeviceAttributeMultiprocessorCount, dev);
        if (hipFuncSetAttribute((const void*)fwd_kernel, hipFuncAttributeMaxDynamicSharedMemorySize, LDS_BYTES) != hipSuccess) { fprintf(stderr, "kernel_launch: hipFuncSetAttribute failed\n"); grid = -1; return; }
        (void)hipOccupancyMaxActiveBlocksPerMultiprocessor(&per_cu, (const void*)fwd_kernel, NTHREADS, LDS_BYTES);
        (void)hipGetLastError();
        if (per_cu < 1) fprintf(stderr, "kernel_launch: occupancy query says %d blocks per CU\n", per_cu);
        grid = cus;
        if (cus != 256) fprintf(stderr, "kernel_launch: built for a 256-CU device (got %d CUs)\n", cus);
    }
    if (grid < 0) return;
    (void)hipMemsetAsync((char*)d_ws + WS_CTL, 0, 32768, stream);
    Args a{};
    for (int i = 0; i < 21; ++i) a.in[i] = (const float*)d_in[i];
    a.out = (float*)d_out; a.ws = (unsigned char*)d_ws;
#if ONE_LAUNCH
    a.ph_lo = 0; a.ph_hi = N_PHASES;
    void* kargs[] = {&a};
    hipError_t e = hipLaunchCooperativeKernel((const void*)fwd_kernel, dim3(grid), dim3(NTHREADS), kargs, LDS_BYTES, stream);
    if (e != hipSuccess) fprintf(stderr, "cooperative launch failed: %s (grid %d)\n", hipGetErrorString(e), grid);
#else
    for (int ph = 0; ph < N_PHASES; ++ph) { a.ph_lo = ph; a.ph_hi = ph + 1; hipLaunchKernelGGL(fwd_kernel, dim3(grid), dim3(NTHREADS), LDS_BYTES, stream, a);
        if (ph == (PROBE_PH)) { a.flags = PROBE_FLAGS; if (ph == 3) (void)hipMemsetAsync((char*)d_ws + WS_CTL + 4096, 0, 2048, stream); hipLaunchKernelGGL(fwd_kernel, dim3(grid), dim3(NTHREADS), LDS_BYTES, stream, a); a.flags = 0; } }
#endif
}
```

```cpp
#include <hip/hip_runtime.h>
#include <hip/hip_cooperative_groups.h>
#include <cstdio>
#include <cstdint>
namespace cg = cooperative_groups;

#ifndef PROBE_PH
#define PROBE_PH -1
#endif
#ifndef PROBE_FLAGS
#define PROBE_FLAGS 0
#endif
#ifndef ONE_LAUNCH
#define ONE_LAUNCH 1
#endif

#define LAS __attribute__((address_space(3)))
typedef unsigned short bf16_t;
typedef short bf16x8 __attribute__((ext_vector_type(8)));
typedef float f32x4 __attribute__((ext_vector_type(4)));
typedef float f32x16 __attribute__((ext_vector_type(16)));
typedef unsigned u32x4 __attribute__((ext_vector_type(4)));
typedef unsigned u32x2 __attribute__((ext_vector_type(2)));
typedef float f32x2_t __attribute__((ext_vector_type(2)));
typedef __bf16 bf16x2_t __attribute__((ext_vector_type(2)));

constexpr int T_TOK = 32768, DM = 1024, SEQ = 2048, NBATCH = 16;
constexpr int HPW = 3584, INCOLS = 3592;
constexpr int NEXP = 32, LCAP = 32768;
constexpr float ALPHA = 1.189207115002721f;
constexpr float LN_EPS = 1e-5f;
constexpr int NWAVES = 8, NTHREADS = 512;
constexpr int LDS_BYTES = 163840;
constexpr int LDS_MISC = 147456;

constexpr size_t MiB = 1u << 20;
constexpr size_t WS_CTL = 0;
constexpr size_t WS_WGU = 1 * MiB;
constexpr size_t WS_WD = 129 * MiB;
constexpr size_t WS_WIN = 193 * MiB;
constexpr size_t WS_WOUT = 200 * MiB;
constexpr size_t WS_WPG = 202 * MiB;
constexpr size_t WS_WPP = 204 * MiB;
constexpr size_t WS_WRT = 205 * MiB;
constexpr size_t WS_BA = 206 * MiB;
constexpr size_t WS_ROUTE = 207 * MiB;
constexpr size_t WS_LTOK = 208 * MiB;
constexpr size_t WS_LGATE = 212 * MiB;
constexpr size_t WS_X1 = 216 * MiB;
constexpr size_t WS_PLE = 280 * MiB;
constexpr size_t WS_PB = 344 * MiB;
constexpr size_t WS_MIX = 360 * MiB;
constexpr size_t WS_XB = 424 * MiB;
constexpr size_t WS_HP = 488 * MiB;
constexpr size_t WS_DN = 712 * MiB;
constexpr size_t WS_EG = 888 * MiB;
constexpr size_t WS_VT = 889 * MiB;
constexpr size_t WS_KF = 216 * MiB;
constexpr size_t WS_ORAW = 985 * MiB;
constexpr size_t WS_ACT = 360 * MiB;
constexpr size_t WS_X1F = 632 * MiB;
constexpr size_t WS_YB = 672 * MiB;
constexpr size_t WS_END = 1017 * MiB;
constexpr size_t DN_WN = 0, DN_QD = 16384, DN_AT = 32768, DN_KD = 40960, DN_U = 57344, DN_STRIDE = 73728;

__device__ __forceinline__ unsigned cvtpk(float lo, float hi) { f32x2_t v = {lo, hi}; bf16x2_t b = __builtin_convertvector(v, bf16x2_t); return __builtin_bit_cast(unsigned, b); }
typedef int v8i __attribute__((ext_vector_type(8)));
__device__ __forceinline__ unsigned pk4_fp8(float a, float b, float c, float d) { int w = __builtin_amdgcn_cvt_pk_fp8_f32(a, b, 0, false); w = __builtin_amdgcn_cvt_pk_fp8_f32(c, d, w, true); return (unsigned)w; }
__device__ __forceinline__ float bflo(unsigned u) { return __uint_as_float(u << 16); }
__device__ __forceinline__ float bfhi(unsigned u) { return __uint_as_float(u & 0xffff0000u); }
__device__ __forceinline__ bf16_t f2bf(float f) { return (bf16_t)(cvtpk(f, 0.f) & 0xffffu); }
__device__ __forceinline__ float bf2f(bf16_t h) { return __uint_as_float((unsigned)h << 16); }
__device__ __forceinline__ float sigm(float x) { return __builtin_amdgcn_rcpf(1.f + __expf(-x)); }
__device__ __forceinline__ int crow(int r, int hi) { return (r & 3) + 8 * (r >> 2) + 4 * hi; }
__device__ __forceinline__ int kperm(int k) { return (k & ~12) | ((k & 4) << 1) | ((k & 8) >> 1); }
__device__ __forceinline__ bf16x8 pack8(const f32x16& x, int b) {
    u32x4 w; w.x = cvtpk(x[b], x[b + 1]); w.y = cvtpk(x[b + 2], x[b + 3]); w.z = cvtpk(x[b + 4], x[b + 5]); w.w = cvtpk(x[b + 6], x[b + 7]);
    return __builtin_bit_cast(bf16x8, w);
}
__device__ __forceinline__ float wave_sum(float v) {
#pragma unroll
    for (int o = 1; o < 64; o <<= 1) v += __shfl_xor(v, o);
    return v;
}

namespace pg8 {
constexpr int BM = 256, BK = 64, HALF = 128, HTB = HALF * BK * 2, STAGE_BYTES = 8 * HTB;
__device__ __forceinline__ int lds_byte(int r, int c) { const int st = (r >> 4) * 2 + (c >> 5), rr = r & 15, cc = c & 31, ob = rr * 64 + cc * 2; return st * 1024 + (ob ^ (((ob >> 9) & 1) << 5)); }
__device__ __forceinline__ void stage_rc(int b, int& R, int& C) { const int st = b / 1024, sb = b % 1024, swz = sb ^ (((sb >> 9) & 1) << 5); R = (st >> 1) * 16 + swz / 64; C = (st & 1) * 32 + (swz % 64) / 2; }
__device__ __forceinline__ int perm32(int rho) { const int n = rho >> 4, i = rho & 15; return 8 * (i >> 2) + 4 * n + (i & 3); }

struct Unit { const char* A; const char* B; int pm, pn, e, rows, pl; };

__device__ __forceinline__ int unit_index(int i, int c, int G, int total) {
    if (G % 8 != 0) { const int L = i * G + c; return L < total ? L : -1; }
    const int x = c & 7, per = G >> 3, li = i * per + (c >> 3), q = total >> 3, r = total & 7;
    const int start = x * q + (x < r ? x : r), size = q + (x < r ? 1 : 0);
    return li < size ? start + li : -1;
}

struct DenseSched {
    const char* Abase; const char* Bbase; int nM, nN, K, c, G;
    __device__ __forceinline__ bool next(int i, Unit& u) const {
        const int L = unit_index(i, c, G, nM * nN); if (L < 0) return false;
        const int nig = 8 * nN, gid = L / nig, fm = gid * 8, gsz = (nM - fm) < 8 ? (nM - fm) : 8, w = L - gid * nig;
        u.pn = w / gsz; u.pm = fm + w % gsz; u.e = 0; u.rows = 256; u.pl = u.pm;
        u.A = Abase + (size_t)u.pm * 256 * K * 2; u.B = Bbase + (size_t)u.pn * 256 * K * 2; return true;
    }
    static constexpr bool GATHER = false;
    __device__ __forceinline__ size_t hstepA() const { return (size_t)128 * K * 2; }
    __device__ __forceinline__ void avoff(const Unit& u, const int (&R)[2], const int (&C)[2], unsigned (&vo)[2][2]) const {
#pragma unroll
        for (int h = 0; h < 2; ++h)
#pragma unroll
            for (int i = 0; i < 2; ++i) vo[h][i] = (unsigned)(R[i] * K + C[i]) * 2u;
    }
};
template <bool GATHER_> struct MoeSched {
    static constexpr bool GATHER = GATHER_;
    __device__ __forceinline__ size_t hstepA() const { return GATHER_ ? (size_t)0 : (size_t)128 * K; }
    const char* Abase; const char* Bbase; size_t Bstride; const int* ltok; const LAS int* ulist; int K; const char* Bdense;
    __device__ __forceinline__ bool next(int i, Unit& u) const {
        const int w0 = __builtin_amdgcn_readfirstlane(ulist[4 * i]), w1 = __builtin_amdgcn_readfirstlane(ulist[4 * i + 1]), w2 = __builtin_amdgcn_readfirstlane(ulist[4 * i + 2]), w3 = __builtin_amdgcn_readfirstlane(ulist[4 * i + 3]);
        if (w3 == 0) return false;
        u.e = w0 & 255; u.pn = w0 >> 8; u.pl = w1; u.pm = w2; u.rows = w3;
        u.A = GATHER_ ? Abase : Abase + (size_t)u.pm * 256 * K; u.B = (u.e == 255 ? Bdense : Bbase + (size_t)u.e * Bstride) + (size_t)u.pn * 256 * K; return true;
    }
    __device__ __forceinline__ void avoff(const Unit& u, const int (&R)[2], const int (&C)[2], unsigned (&vo)[2][2]) const {
#pragma unroll
        for (int h = 0; h < 2; ++h)
#pragma unroll
            for (int i = 0; i < 2; ++i) {
                if (GATHER_) { const int r = h * 128 + R[i]; int tok = 0; if (u.e == 255) tok = u.pm * 256 + r; else if (r < u.rows) tok = ltok[(size_t)u.e * LCAP + u.pl * 256 + r]; vo[h][i] = (unsigned)(tok * K + C[i] * 2); }
                else vo[h][i] = (unsigned)(R[i] * K + C[i] * 2);
            }
    }
};

typedef f32x4 Acc[2][2][4][2];

template <bool FP8, class Epi, class Sched>
__device__ __forceinline__ void gemm_phase(LAS unsigned char* lds, const int K, const Sched& S, const Epi& E) {
    const int tid = threadIdx.x, wid = __builtin_amdgcn_readfirstlane(tid >> 6), lane = tid & 63, wr = wid >> 2, wc = wid & 3, fr = lane & 15, fq = lane >> 4;
    const int RB = FP8 ? K : 2 * K;
    const int nt = RB / 128;
    int RA[2], CA[2]; unsigned voffB[2];
#pragma unroll
    for (int i = 0; i < 2; ++i) { int R, C; stage_rc(tid * 16 + i * 8192, R, C); RA[i] = R; CA[i] = C; const int Rb = (R & ~31) + perm32(R & 31); voffB[i] = (unsigned)(Rb * RB + C * 2); }
    const size_t kstep = (size_t)(BK * 2);
    const size_t hstepB = (size_t)HALF * RB, hstepA = S.hstepA();
    const unsigned ldsw = (unsigned)wid * 1024u;
    const int aoff = lds_byte(wr * 64 + fr, fq * 8), boff = lds_byte(wc * 32 + fr, fq * 8);
#define PG8_SA(b, h) (((b) * 2 + (h)) * HTB)
#define PG8_SB(b, h) ((4 + (b) * 2 + (h)) * HTB)
#define PG8_GL(gptr, ldsoff) __builtin_amdgcn_global_load_lds((const unsigned*)(gptr), (LAS unsigned*)(lds + (ldsoff)), 16, 0, 0)
#define PG8_STAGE_B(bufoff, gbase) do { PG8_GL((const char*)(gbase) + voffB[0], (bufoff) + ldsw); PG8_GL((const char*)(gbase) + voffB[1], (bufoff) + ldsw + 8192); } while (0)
#define PG8_STAGE_A(bufoff, gbase, o0, o1) do { PG8_GL((const char*)(gbase) + (o0), (bufoff) + ldsw); PG8_GL((const char*)(gbase) + (o1), (bufoff) + ldsw + 8192); } while (0)
#define PG8_LDA(dst, b, h) do { _Pragma("unroll") for (int m = 0; m < 4; ++m) { \
        if constexpr (FP8) { const u32x4 l_ = *(const LAS u32x4*)(lds + PG8_SA(b, h) + aoff + m * 2048), h_ = *(const LAS u32x4*)(lds + PG8_SA(b, h) + aoff + m * 2048 + 1024); \
            dst##8[m] = (v8i){(int)l_.x, (int)l_.y, (int)l_.z, (int)l_.w, (int)h_.x, (int)h_.y, (int)h_.z, (int)h_.w}; } \
        else { _Pragma("unroll") for (int k = 0; k < 2; ++k) dst[m][k] = *(const LAS bf16x8*)(lds + PG8_SA(b, h) + aoff + m * 2048 + k * 1024); } } } while (0)
#define PG8_LDB(dst, b, h) do { _Pragma("unroll") for (int n = 0; n < 2; ++n) { \
        if constexpr (FP8) { const u32x4 l_ = *(const LAS u32x4*)(lds + PG8_SB(b, h) + boff + n * 2048), h_ = *(const LAS u32x4*)(lds + PG8_SB(b, h) + boff + n * 2048 + 1024); \
            dst##8[n] = (v8i){(int)l_.x, (int)l_.y, (int)l_.z, (int)l_.w, (int)h_.x, (int)h_.y, (int)h_.z, (int)h_.w}; } \
        else { _Pragma("unroll") for (int k = 0; k < 2; ++k) dst[n][k] = *(const LAS bf16x8*)(lds + PG8_SB(b, h) + boff + n * 2048 + k * 1024); } } } while (0)
#define PG8_MMA(ai, bj, At, Bt) do { __builtin_amdgcn_s_setprio(1); \
        if constexpr (FP8) { _Pragma("unroll") for (int m = 0; m < 4; ++m) _Pragma("unroll") for (int n = 0; n < 2; ++n) \
            asm volatile("s_nop 1\n\tv_mfma_scale_f32_16x16x128_f8f6f4 %0, %1, %2, %0, %3, %4 op_sel_hi:[0,0,0]" : "+v"(acc[ai][bj][m][n]) : "v"(Bt##8[n]), "v"(At##8[m]), "v"(sc_w), "v"(sc_a)); } \
        else { _Pragma("unroll") for (int m = 0; m < 4; ++m) _Pragma("unroll") for (int n = 0; n < 2; ++n) _Pragma("unroll") for (int k = 0; k < 2; ++k) \
            acc[ai][bj][m][n] = __builtin_amdgcn_mfma_f32_16x16x32_bf16(Bt[n][k], At[m][k], acc[ai][bj][m][n], 0, 0, 0); } \
        __builtin_amdgcn_s_setprio(0); } while (0)
#define PG8_WAIT_V(n) asm volatile("s_waitcnt vmcnt(" #n ")" ::: "memory")
#define PG8_WAIT_L(n) asm volatile("s_waitcnt lgkmcnt(" #n ")" ::: "memory")
#define PG8_BAR __builtin_amdgcn_s_barrier()
#define PG8_SCHED __builtin_amdgcn_sched_barrier(0)
    Unit cur, nxt; int ui = 0;
    if (!S.next(0, cur)) return;
    unsigned vc[2][2], vn[2][2];
    S.avoff(cur, RA, CA, vc);
    Acc acc;
#pragma unroll
    for (int a = 0; a < 2; ++a)
#pragma unroll
        for (int b = 0; b < 2; ++b)
#pragma unroll
            for (int m = 0; m < 4; ++m)
#pragma unroll
                for (int n = 0; n < 2; ++n) acc[a][b][m][n] = (f32x4){0.f, 0.f, 0.f, 0.f};
    const int sc_w = 122, sc_a = 127;
    bf16x8 At[4][2], B0[2][2], B1[2][2]; v8i At8[4], B08[2], B18[2];
    const char* cA = cur.A; const char* cB = cur.B;
    PG8_STAGE_B(PG8_SB(0, 0), cB); PG8_STAGE_B(PG8_SB(0, 1), cB + hstepB); PG8_STAGE_A(PG8_SA(0, 0), cA, vc[0][0], vc[0][1]); PG8_STAGE_A(PG8_SA(0, 1), cA + hstepA, vc[1][0], vc[1][1]);
    if (wr == 1) PG8_BAR;
    PG8_WAIT_V(2); PG8_BAR;
    PG8_STAGE_B(PG8_SB(1, 0), cB + kstep); PG8_STAGE_A(PG8_SA(1, 0), cA + kstep, vc[0][0], vc[0][1]); PG8_STAGE_B(PG8_SB(1, 1), cB + hstepB + kstep);
    PG8_WAIT_V(6); PG8_BAR;
    for (;;) {
        const bool has_next = S.next(ui + 1, nxt);
        if (Sched::GATHER && has_next) S.avoff(nxt, RA, CA, vn);
        else {
#pragma unroll
            for (int h = 0; h < 2; ++h)
#pragma unroll
                for (int i = 0; i < 2; ++i) vn[h][i] = vc[h][i];
        }
        const char* nA = has_next ? nxt.A : cA; const char* nB = has_next ? nxt.B : cB;
#pragma unroll 1
        for (int t = 0; t < nt; t += 2) {
            const bool last = (t == nt - 2);
            const char* a1 = cA + (size_t)(t + 1) * kstep;
            const char* a2 = last ? nA : cA + (size_t)(t + 2) * kstep; const char* b2 = last ? nB : cB + (size_t)(t + 2) * kstep;
            const char* a3 = a2 + kstep; const char* b3 = b2 + kstep;
            const unsigned o00 = last ? vn[0][0] : vc[0][0], o01 = last ? vn[0][1] : vc[0][1], o10 = last ? vn[1][0] : vc[1][0], o11 = last ? vn[1][1] : vc[1][1];
            PG8_LDB(B0, 0, 0); PG8_LDB(B1, 0, 1); PG8_SCHED; PG8_LDA(At, 0, 0); PG8_STAGE_A(PG8_SA(1, 1), a1 + hstepA, vc[1][0], vc[1][1]);
            PG8_WAIT_V(8); PG8_WAIT_L(0); PG8_BAR; PG8_MMA(0, 0, At, B0); PG8_MMA(0, 1, At, B1); PG8_BAR; PG8_SCHED;
            PG8_LDA(At, 0, 1); PG8_STAGE_B(PG8_SB(0, 0), b2); PG8_STAGE_B(PG8_SB(0, 1), b2 + hstepB); PG8_STAGE_A(PG8_SA(0, 0), a2, o00, o01);
            PG8_WAIT_V(8); PG8_WAIT_L(0); PG8_BAR; PG8_MMA(1, 0, At, B0); PG8_MMA(1, 1, At, B1); PG8_BAR; PG8_SCHED;
            PG8_LDB(B0, 1, 0); PG8_LDB(B1, 1, 1); PG8_SCHED; PG8_LDA(At, 1, 0); PG8_STAGE_A(PG8_SA(0, 1), a2 + hstepA, o10, o11);
            PG8_WAIT_V(8); PG8_WAIT_L(0); PG8_BAR; PG8_MMA(0, 0, At, B0); PG8_MMA(0, 1, At, B1); PG8_BAR; PG8_SCHED;
            PG8_LDA(At, 1, 1); PG8_STAGE_B(PG8_SB(1, 0), b3); PG8_STAGE_B(PG8_SB(1, 1), b3 + hstepB); PG8_STAGE_A(PG8_SA(1, 0), a3, o00, o01);
            PG8_WAIT_V(8); PG8_WAIT_L(0); PG8_BAR; PG8_MMA(1, 0, At, B0); PG8_MMA(1, 1, At, B1); PG8_BAR; PG8_SCHED;
        }
        if (wr == 0) PG8_BAR;
        if constexpr (FP8) asm volatile("s_nop 15\n\ts_nop 15" ::: "memory");
        E(acc, cur, wr, wc, fr, fq);
        if (!has_next) break;
#pragma unroll
        for (int a = 0; a < 2; ++a)
#pragma unroll
            for (int b = 0; b < 2; ++b)
#pragma unroll
                for (int m = 0; m < 4; ++m)
#pragma unroll
                    for (int n = 0; n < 2; ++n) acc[a][b][m][n] = (f32x4){0.f, 0.f, 0.f, 0.f};
        cur = nxt; cA = nA; cB = nB; ++ui;
#pragma unroll
        for (int h = 0; h < 2; ++h)
#pragma unroll
            for (int i = 0; i < 2; ++i) vc[h][i] = vn[h][i];
        if (wr == 1) PG8_BAR;
    }
    PG8_WAIT_V(0);
    PG8_BAR;
#undef PG8_SA
#undef PG8_SB
#undef PG8_GL
#undef PG8_STAGE_A
#undef PG8_STAGE_B
#undef PG8_LDA
#undef PG8_LDB
#undef PG8_MMA
#undef PG8_WAIT_V
#undef PG8_WAIT_L
#undef PG8_BAR
#undef PG8_SCHED
}

__device__ __forceinline__ u32x4 pack_row8(const f32x4& v0, const f32x4& v1) { u32x4 w; w.x = cvtpk(v0[0], v0[1]); w.y = cvtpk(v0[2], v0[3]); w.z = cvtpk(v1[0], v1[1]); w.w = cvtpk(v1[2], v1[3]); return w; }
__device__ __forceinline__ void unpack8(const u32x4& w, f32x4& a, f32x4& b) { a = (f32x4){bflo(w.x), bfhi(w.x), bflo(w.y), bfhi(w.y)}; b = (f32x4){bflo(w.z), bfhi(w.z), bflo(w.w), bfhi(w.w)}; }

struct EpiStore {
    bf16_t* O; int ldc;
    __device__ __forceinline__ void operator()(const Acc& acc, const Unit& u, int wr, int wc, int fr, int fq) const {
        const int row0 = u.pm * BM + wr * 64 + fr, col0 = u.pn * BM + wc * 32 + 8 * fq;
#pragma unroll
        for (int ai = 0; ai < 2; ++ai)
#pragma unroll
            for (int m = 0; m < 4; ++m) { bf16_t* rowp = O + (size_t)(row0 + ai * HALF + m * 16) * ldc + col0;
#pragma unroll
                for (int bj = 0; bj < 2; ++bj) *(u32x4*)(rowp + bj * HALF) = pack_row8(acc[ai][bj][m][0], acc[ai][bj][m][1]); }
    }
};
struct EpiResid {
    bf16_t* O; const bf16_t* X;
    __device__ __forceinline__ void operator()(const Acc& acc, const Unit& u, int wr, int wc, int fr, int fq) const {
        const int row0 = u.pm * BM + wr * 64 + fr, col0 = u.pn * BM + wc * 32 + 8 * fq;
#pragma unroll
        for (int ai = 0; ai < 2; ++ai)
#pragma unroll
            for (int m = 0; m < 4; ++m) { const size_t off = (size_t)(row0 + ai * HALF + m * 16) * DM + col0;
#pragma unroll
                for (int bj = 0; bj < 2; ++bj) { const u32x4 xw = *(const u32x4*)(X + off + bj * HALF); f32x4 xa, xb; unpack8(xw, xa, xb);
                    *(u32x4*)(O + off + bj * HALF) = pack_row8(xa * ALPHA + acc[ai][bj][m][0], xb * ALPHA + acc[ai][bj][m][1]); }
                if (m & 1) asm volatile("" ::: "memory"); }
    }
};
struct EpiAct {
    unsigned char* O; const float* bgu;
    __device__ __forceinline__ void operator()(const Acc& acc, const Unit& u, int wr, int wc, int fr, int fq) const {
        const int cl = u.pn * HALF + wc * 32 + 8 * fq;
        const float* bg = bgu + (size_t)u.e * 2048 + cl;
        const f32x4 g0 = *(const f32x4*)bg, g1 = *(const f32x4*)(bg + 4), u0 = *(const f32x4*)(bg + 1024), u1 = *(const f32x4*)(bg + 1028);
        unsigned char* obase = O + (size_t)(u.pm * BM + wr * 64 + fr) * DM + cl;
        const int rl0 = wr * 64 + fr;
#pragma unroll
        for (int ai = 0; ai < 2; ++ai)
#pragma unroll
            for (int m = 0; m < 4; ++m) { const int rl = ai * HALF + m * 16 + rl0;
                unsigned w[2];
#pragma unroll
                for (int n = 0; n < 2; ++n) { const f32x4 hg = acc[ai][0][m][n] + (n ? g1 : g0), hu = acc[ai][1][m][n] + (n ? u1 : u0); float o4[4];
#pragma unroll
                    for (int j = 0; j < 4; ++j) { const float g = fminf(hg[j], 7.f), up = fminf(fmaxf(hu[j], -7.f), 7.f);
                        o4[j] = (up + 1.f) * g * __builtin_amdgcn_rcpf(1.f + __builtin_amdgcn_exp2f(-2.4554669595930157f * g)); }
                    w[n] = pk4_fp8(o4[0], o4[1], o4[2], o4[3]); asm volatile("" : "+v"(w[n])); }
                if (rl < u.rows) *(u32x2*)(obase + (size_t)(ai * HALF + m * 16) * DM) = (u32x2){w[0], w[1]};
                asm volatile("" ::: "memory"); }
    }
};
struct EpiDown {
    unsigned char* O; const float* bd; const float* lgate;
    __device__ __forceinline__ void operator()(const Acc& acc, const Unit& u, int wr, int wc, int fr, int fq) const {
        const int col0 = u.pn * BM + wc * 32 + 8 * fq;
        const float* bp = bd + (size_t)u.e * DM + col0;
#pragma unroll
        for (int ai = 0; ai < 2; ++ai)
#pragma unroll
            for (int m = 0; m < 4; ++m) { const int rl = ai * HALF + wr * 64 + m * 16 + fr;
                if (rl < u.rows) { const float gt = lgate[(size_t)u.e * LCAP + u.pl * BM + rl]; unsigned char* rowp = O + (size_t)(u.pm * BM + rl) * DM + col0;
#pragma unroll
                    for (int bj = 0; bj < 2; ++bj) { const f32x4 a = (acc[ai][bj][m][0] + *(const f32x4*)(bp + bj * HALF)) * gt, b = (acc[ai][bj][m][1] + *(const f32x4*)(bp + bj * HALF + 4)) * gt;
                        *(u32x2*)(rowp + bj * HALF) = (u32x2){pk4_fp8(a[0], a[1], a[2], a[3]), pk4_fp8(b[0], b[1], b[2], b[3])}; } }
                asm volatile("" ::: "memory"); }
    }
};
struct EpiSig {
    bf16_t* O; const float* bias;
    __device__ __forceinline__ void operator()(const Acc& acc, const Unit& u, int wr, int wc, int fr, int fq) const {
        const int row0 = u.pm * BM + wr * 64 + fr, col0 = u.pn * BM + wc * 32 + 8 * fq;
        f32x4 bv[2][2];
#pragma unroll
        for (int bj = 0; bj < 2; ++bj)
#pragma unroll
            for (int n = 0; n < 2; ++n) bv[bj][n] = *(const f32x4*)(bias + col0 + bj * HALF + 4 * n);
#pragma unroll
        for (int ai = 0; ai < 2; ++ai)
#pragma unroll
            for (int m = 0; m < 4; ++m) { bf16_t* rowp = O + (size_t)(row0 + ai * HALF + m * 16) * DM + col0;
#pragma unroll
                for (int bj = 0; bj < 2; ++bj) { f32x4 a = acc[ai][bj][m][0] + bv[bj][0], b = acc[ai][bj][m][1] + bv[bj][1];
#pragma unroll
                    for (int j = 0; j < 4; ++j) { a[j] = sigm(a[j]); b[j] = sigm(b[j]); }
                    *(u32x4*)(rowp + bj * HALF) = pack_row8(a, b); }
                asm volatile("" ::: "memory"); }
    }
};
struct EpiActSig {
    EpiAct a; EpiSig g;
    __device__ __forceinline__ void operator()(const Acc& acc, const Unit& u, int wr, int wc, int fr, int fq) const { if (u.e == 255) g(acc, u, wr, wc, fr, fq); else a(acc, u, wr, wc, fr, fq); }
};
struct EpiMul {
    bf16_t* O;
    __device__ __forceinline__ void operator()(const Acc& acc, const Unit& u, int wr, int wc, int fr, int fq) const {
        const int row0 = u.pm * BM + wr * 64 + fr, col0 = u.pn * BM + wc * 32 + 8 * fq;
#pragma unroll
        for (int ai = 0; ai < 2; ++ai)
#pragma unroll
            for (int m = 0; m < 4; ++m) { bf16_t* rowp = O + (size_t)(row0 + ai * HALF + m * 16) * DM + col0;
#pragma unroll
                for (int bj = 0; bj < 2; ++bj) { const u32x4 gw = *(const u32x4*)(rowp + bj * HALF); f32x4 ga, gb; unpack8(gw, ga, gb);
                    *(u32x4*)(rowp + bj * HALF) = pack_row8(ga * acc[ai][bj][m][0], gb * acc[ai][bj][m][1]); }
                if (m & 1) asm volatile("" ::: "memory"); }
    }
};
}

#define XB_TMO      128
#define XB_XCNT(j)  (256  + 64 * (j))
#define XB_XSUB(j)  (1280 + 64 * (j))
#define XB_XGEN(j)  (2304 + 64 * (j))
#define XB_TOP      3328
#define XB_TOPGEN   3392
#define XCD_BAR_WORDS 3456
#define XB_SPIN_CAP (1u << 22)
constexpr int CW_BAR = 4096;
constexpr int LDS_BARST = LDS_MISC + 2048;
__device__ __forceinline__ unsigned xb_ld(unsigned* p)              { return __hip_atomic_load(p, __ATOMIC_RELAXED, __HIP_MEMORY_SCOPE_AGENT); }
__device__ __forceinline__ unsigned xb_add(unsigned* p, unsigned v) { return __hip_atomic_fetch_add(p, v, __ATOMIC_RELAXED, __HIP_MEMORY_SCOPE_AGENT); }
__device__ __forceinline__ unsigned xb_xcc_id() { return (unsigned)__builtin_amdgcn_s_getreg((3 << 11) | 20) & 0xFu; }
#define XB_SPIN(cond, bar) do { unsigned _sp = 0; while (cond) { __builtin_amdgcn_s_sleep(1); \
    if ((++_sp & 255u) == 0u) { if (xb_ld(&(bar)[XB_TMO])) break; if (_sp > XB_SPIN_CAP) { atomicAdd(&(bar)[XB_TMO], 1u); break; } } } } while (0)
struct XcdBarrier { unsigned* bar; unsigned x; volatile LAS unsigned* st; };
__device__ __forceinline__ XcdBarrier xcd_barrier_post(unsigned* bar, volatile LAS unsigned* st) {
    XcdBarrier b; b.bar = bar; b.x = xb_xcc_id(); b.st = st;
    if (threadIdx.x == 0) (void)xb_add(&bar[XB_XCNT(b.x)], 1u);
    return b;
}
__device__ __forceinline__ void xcd_barrier_complete(unsigned* bar, unsigned x, unsigned& nloc, unsigned& nx) {
    const unsigned G = gridDim.x * gridDim.y * gridDim.z;
    unsigned sum, cnt, mine, sp = 0u;
    for (;;) {
        sum = 0u; cnt = 0u; mine = 0u;
#pragma unroll
        for (unsigned j = 0; j < 16; ++j) { const unsigned c = xb_ld(&bar[XB_XCNT(j)]); sum += c; cnt += (c > 0u) ? 1u : 0u; mine = (j == x) ? c : mine; }
        if (sum == G) break;
        __builtin_amdgcn_s_sleep(1);
        if ((++sp & 255u) == 0u) { if (xb_ld(&bar[XB_TMO])) break; if (sp > XB_SPIN_CAP) { atomicAdd(&bar[XB_TMO], 1u); break; } }
    }
    nloc = mine > 0u ? mine : 1u; nx = cnt > 0u ? cnt : 1u;
}
__device__ __forceinline__ void xcd_barrier(const XcdBarrier& b) {
    asm volatile("s_waitcnt vmcnt(0)" ::: "memory");
    __syncthreads();
    if (threadIdx.x == 0) {
        unsigned* bar = b.bar;
        __builtin_amdgcn_s_waitcnt(0);
        unsigned nloc = b.st[0], nx = b.st[1];
        if (nloc == 0u) { xcd_barrier_complete(bar, b.x, nloc, nx); b.st[0] = nloc; b.st[1] = nx; }
        const unsigned old = xb_add(&bar[XB_XSUB(b.x)], 1u);
        const unsigned gen = old / nloc;
        if (old + 1u == (gen + 1u) * nloc) {
            __builtin_amdgcn_fence(__ATOMIC_RELEASE, "agent");
            asm volatile("s_waitcnt vmcnt(0)" ::: "memory");
            const unsigned og = xb_add(&bar[XB_TOP], 1u);
            const unsigned tg = og / nx;
            if (og + 1u == (tg + 1u) * nx) xb_add(&bar[XB_TOPGEN], 1u);
            else XB_SPIN(xb_ld(&bar[XB_TOPGEN]) == tg, bar);
            __builtin_amdgcn_fence(__ATOMIC_ACQUIRE, "agent");
            xb_add(&bar[XB_XGEN(b.x)], 1u);
            asm volatile("s_waitcnt vmcnt(0)" ::: "memory");
        } else {
            XB_SPIN(xb_ld(&bar[XB_XGEN(b.x)]) == gen, bar);
            __builtin_amdgcn_fence(__ATOMIC_ACQUIRE, "agent");
            asm volatile("s_waitcnt vmcnt(0)" ::: "memory");
        }
    }
    __syncthreads();
}

struct Args { const float* in[21]; float* out; unsigned char* ws; int ph_lo, ph_hi; int flags, pad; };
#define THREAD_IDS() int tid = threadIdx.x; asm volatile("" : "+v"(tid)); const int lane = tid & 63; const int wave = __builtin_amdgcn_readfirstlane(tid >> 6); (void)lane; (void)wave
struct Frame {
    unsigned char* lds; int G, blk;
    float* out; unsigned char* ws;
};
__device__ __forceinline__ const float* inptr(int k) {
    const char* ka = (const char*)__builtin_amdgcn_kernarg_segment_ptr(); asm volatile("" : "+s"(ka));
    return *(const float* const*)(ka + 8 * k);
}
#define WSP(T, off) ((T*)(F.ws + (off)))

constexpr int MOE_TILES = NEXP * 16 * 32 + NEXP * 16 * 16;
struct WTile { const float* src; unsigned char* dst; int ldn; };
__device__ __forceinline__ WTile moe_tile_addr(const Frame& F, int r, const float* w_gate_up, const float* w_down, int lane) {
    constexpr int I_GU = NEXP * 16 * 32; const int q4 = lane >> 4, c = lane & 15; WTile t;
    if (r < I_GU) { const int e = r / 512, q = r % 512, kb = q / 32, nb = q % 32, n0 = 64 * nb;
        const int j0 = n0 & 1023, drow0 = 256 * (j0 >> 7) + (j0 & 127) + ((n0 >= 1024) ? 128 : 0);
        t.src = w_gate_up + (size_t)e * 1024 * 2048 + (size_t)(64 * kb + 16 * q4) * 2048 + n0 + 4 * c; t.ldn = 2048;
        t.dst = WSP(unsigned char, WS_WGU) + (size_t)e * 2048 * 1024 + (size_t)(drow0 + 4 * c) * 1024 + 64 * kb + 16 * q4; }
    else { r -= I_GU; const int e = r / 256, q = r % 256, kb = q / 16, nb = q % 16;
        t.src = w_down + (size_t)e * 1024 * 1024 + (size_t)(64 * kb + 16 * q4) * 1024 + 64 * nb + 4 * c; t.ldn = 1024;
        t.dst = WSP(unsigned char, WS_WD) + (size_t)e * 1024 * 1024 + (size_t)(64 * nb + 4 * c) * 1024 + 64 * kb + 16 * q4; }
    return t;
}
__device__ __forceinline__ void wtile_load(f32x4 (&v)[16], const WTile& t) {
#pragma unroll
    for (int i = 0; i < 16; ++i) v[i] = *(const f32x4*)(t.src + (size_t)i * t.ldn);
}
__device__ __forceinline__ void wtile_store(const f32x4 (&v)[16], const WTile& t) {
#pragma unroll
    for (int j = 0; j < 4; ++j) {
        u32x4 o;
        o.x = pk4_fp8(v[0][j] * 32.f, v[1][j] * 32.f, v[2][j] * 32.f, v[3][j] * 32.f); o.y = pk4_fp8(v[4][j] * 32.f, v[5][j] * 32.f, v[6][j] * 32.f, v[7][j] * 32.f);
        o.z = pk4_fp8(v[8][j] * 32.f, v[9][j] * 32.f, v[10][j] * 32.f, v[11][j] * 32.f); o.w = pk4_fp8(v[12][j] * 32.f, v[13][j] * 32.f, v[14][j] * 32.f, v[15][j] * 32.f);
        *(u32x4*)(t.dst + (size_t)j * 1024) = o;
    }
}
__device__ __forceinline__ void moe_weight_batch3(const Frame& F, int r0, int stride, const float* w_gate_up, const float* w_down, int lane) {
    const WTile t0 = moe_tile_addr(F, r0, w_gate_up, w_down, lane), t1 = moe_tile_addr(F, r0 + stride, w_gate_up, w_down, lane), t2 = moe_tile_addr(F, r0 + 2 * stride, w_gate_up, w_down, lane);
    f32x4 va[16], vb[16];
    wtile_load(va, t0); wtile_load(vb, t1);
    wtile_store(va, t0); wtile_load(va, t2);
    wtile_store(vb, t1); wtile_store(va, t2);
}

__device__ __forceinline__ void p0_transpose_tile(const float* W, int ldn, int k0, int n0, bf16_t* WT, int Kd, int drow0, int lane) {
    const int q = lane >> 4, c = lane & 15;
    const float* src = W + (size_t)(k0 + 16 * q) * ldn + n0 + 4 * c;
    f32x4 v[16];
#pragma unroll
    for (int i = 0; i < 16; ++i) v[i] = *(const f32x4*)(src + (size_t)i * ldn);
    bf16_t* dst = WT + (size_t)(drow0 + 4 * c) * Kd + k0 + 16 * q;
#pragma unroll
    for (int j = 0; j < 4; ++j) {
        u32x4 o0, o1;
        o0.x = cvtpk(v[0][j], v[1][j]); o0.y = cvtpk(v[2][j], v[3][j]); o0.z = cvtpk(v[4][j], v[5][j]); o0.w = cvtpk(v[6][j], v[7][j]);
        o1.x = cvtpk(v[8][j], v[9][j]); o1.y = cvtpk(v[10][j], v[11][j]); o1.z = cvtpk(v[12][j], v[13][j]); o1.w = cvtpk(v[14][j], v[15][j]);
        *(u32x4*)(dst + (size_t)j * Kd) = o0; *(u32x4*)(dst + (size_t)j * Kd + 8) = o1;
    }
}
__device__ __forceinline__ void phase0(const Frame& F) {
    THREAD_IDS();
    const float* in_x = inptr(0); const float* in_p = inptr(1); const float* in_w_in = inptr(2); const float* in_w_out = inptr(7); const float* in_w_router = inptr(10); const float* in_w_ple_gate = inptr(16); const float* in_w_ple_proj = inptr(18);
    float* wba = (float*)F.lds;
    for (int i = tid; i < 8192; i += NTHREADS) wba[(i & 7) * 1024 + (i >> 3)] = in_w_in[(size_t)(i >> 3) * INCOLS + HPW + (i & 7)];
    __syncthreads();
    const int gw = F.blk * NWAVES + wave, NGW = F.G * NWAVES;
    bf16_t* XB = WSP(bf16_t, WS_XB); float* BA = WSP(float, WS_BA);
    for (int row = gw; row < T_TOK; row += NGW) {
        const f32x4* xr = (const f32x4*)(in_x + (size_t)row * DM) + lane;
        f32x4 v[4];
#pragma unroll
        for (int j = 0; j < 4; ++j) v[j] = xr[64 * j];
        u32x2* o8 = (u32x2*)(XB + (size_t)row * DM) + lane;
#pragma unroll
        for (int j = 0; j < 4; ++j) { u32x2 w; w.x = cvtpk(v[j][0], v[j][1]); w.y = cvtpk(v[j][2], v[j][3]); o8[64 * j] = w; }
        float a8[8];
#pragma unroll
        for (int q = 0; q < 8; ++q) { float a = 0.f;
#pragma unroll
            for (int j = 0; j < 4; ++j) { const f32x4 w = *(const f32x4*)(wba + q * 1024 + 4 * lane + 256 * j); a += v[j][0] * w[0] + v[j][1] * w[1] + v[j][2] * w[2] + v[j][3] * w[3]; }
            a8[q] = a; }
        float r4[4], r2[2], r1;
        { const bool up = (lane & 32) != 0;
#pragma unroll
            for (int k = 0; k < 4; ++k) { const float keep = up ? a8[k + 4] : a8[k], send = up ? a8[k] : a8[k + 4]; r4[k] = keep + __shfl_xor(send, 32); } }
        { const bool up = (lane & 16) != 0;
#pragma unroll
            for (int k = 0; k < 2; ++k) { const float keep = up ? r4[k + 2] : r4[k], send = up ? r4[k] : r4[k + 2]; r2[k] = keep + __shfl_xor(send, 16); } }
        { const bool up = (lane & 8) != 0; const float keep = up ? r2[1] : r2[0], send = up ? r2[0] : r2[1]; r1 = keep + __shfl_xor(send, 8); }
        r1 += __shfl_xor(r1, 4); r1 += __shfl_xor(r1, 2); r1 += __shfl_xor(r1, 1);
        if ((lane & 7) == 0) BA[(size_t)row * 8 + ((lane >> 5) & 1) * 4 + ((lane >> 4) & 1) * 2 + ((lane >> 3) & 1)] = r1;
    }
    { const f32x4* src = (const f32x4*)in_p; u32x2* dst = WSP(u32x2, WS_PB);
        for (int i = F.blk * NTHREADS + tid; i < T_TOK * 256 / 4; i += F.G * NTHREADS) { const f32x4 v = src[i]; u32x2 w; w.x = cvtpk(v[0], v[1]); w.y = cvtpk(v[2], v[3]); dst[i] = w; } }
    { float* wrt = WSP(float, WS_WRT); for (int i = F.blk * NTHREADS + tid; i < 32768; i += F.G * NTHREADS) wrt[(i & 31) * 1024 + (i >> 5)] = in_w_router[i]; }
    constexpr int I_IN = 16 * 56, I_OUT = 16 * 16, I_PG = 16 * 16, I_PP = 4 * 16;
    constexpr int NITEMS = I_IN + I_OUT + I_PG + I_PP;
    for (int it = gw; it < NITEMS; it += NGW) {
        int r = it;
        if (r < I_IN) { const int kb = r / 56, nb = r % 56; p0_transpose_tile(in_w_in, INCOLS, 64 * kb, 64 * nb, WSP(bf16_t, WS_WIN), 1024, 64 * nb, lane); continue; } r -= I_IN;
        if (r < I_OUT) { const int kb = r / 16, nb = r % 16; p0_transpose_tile(in_w_out, 1024, 64 * kb, 64 * nb, WSP(bf16_t, WS_WOUT), 1024, 64 * nb, lane); continue; } r -= I_OUT;
        if (r < I_PG) { const int kb = r / 16, nb = r % 16, q4 = lane >> 4, c = lane & 15; WTile t; f32x4 v[16];
            t.src = in_w_ple_gate + (size_t)(64 * kb + 16 * q4) * 1024 + 64 * nb + 4 * c; t.ldn = 1024; t.dst = WSP(unsigned char, WS_WPG) + (size_t)(64 * nb + 4 * c) * 1024 + 64 * kb + 16 * q4;
            wtile_load(v, t); wtile_store(v, t); continue; } r -= I_PG;
        { const int kb = r / 16, nb = r % 16; p0_transpose_tile(in_w_ple_proj, 1024, 64 * kb, 64 * nb, WSP(bf16_t, WS_WPP), 256, 64 * nb, lane); }
    }
}
__device__ __forceinline__ void moe_weight_stream(const Frame& F, int cw, int ncw, int lane) {
    const float* w_gate_up = inptr(12); const float* w_down = inptr(14);
    f32x4 va[16], vb[16];
    int r = cw; if (r >= MOE_TILES) return;
    WTile ta = moe_tile_addr(F, r, w_gate_up, w_down, lane); wtile_load(va, ta);
#pragma unroll 1
    for (;;) {
        const int r1 = r + ncw; WTile tb{}; const bool hb = r1 < MOE_TILES;
        if (hb) { tb = moe_tile_addr(F, r1, w_gate_up, w_down, lane); wtile_load(vb, tb); }
        wtile_store(va, ta);
        if (!hb) break;
        const int r2 = r1 + ncw; const bool ha = r2 < MOE_TILES;
        if (ha) { ta = moe_tile_addr(F, r2, w_gate_up, w_down, lane); wtile_load(va, ta); }
        wtile_store(vb, tb);
        if (!ha) break;
        r = r2;
    }
}
#define MFMA32(a, b, c) __builtin_amdgcn_mfma_f32_32x32x16_bf16((a), (b), (c), 0, 0, 0)
constexpr int QR_S = 136, KT_S = 72, NM_S = 68;
constexpr int L_QR = 0, L_KR = 17408, L_KT = 34816, L_VT = 53248, L_NM = 71680, L_TM = 89088, L_PM = 106496, L_TU = 111104, L_TW = 120320, L_SC = 129536;
__device__ __forceinline__ void dn_prep_unit(const Frame& F, int ch) {
    int tid = threadIdx.x; asm volatile("" : "+v"(tid));
    const int lane = tid & 63, wave = __builtin_amdgcn_readfirstlane(tid >> 6), r32 = lane & 31, hi = lane >> 5;
    const float* in_conv_w = inptr(3); const float* in_a_log = inptr(4); const float* in_dt_bias = inptr(5);
    const int b = ch >> 7, h = (ch >> 5) & 3, n = ch & 31;
    bf16_t* Qr = (bf16_t*)(F.lds + L_QR); bf16_t* Kr = (bf16_t*)(F.lds + L_KR); bf16_t* KT = (bf16_t*)(F.lds + L_KT); bf16_t* VT = (bf16_t*)(F.lds + L_VT);
    float* Nm = (float*)(F.lds + L_NM); float* Tm = (float*)(F.lds + L_TM); float* Pm = (float*)(F.lds + L_PM);
    bf16_t* Tu = (bf16_t*)(F.lds + L_TU); bf16_t* Tw = (bf16_t*)(F.lds + L_TW);
    float* beta_s = (float*)(F.lds + L_SC); float* gc_s = beta_s + 64; float* egc_s = gc_s + 64; float* begc_s = egc_s + 64;
    const bf16_t* HP = WSP(const bf16_t, WS_HP);
    const int t0 = 64 * n; const size_t rowb = (size_t)b * SEQ;
    unsigned char* dnb = F.ws + WS_DN + (size_t)ch * DN_STRIDE;
#pragma unroll
    for (int it = 0; it < 2; ++it) {
        const int idx = it * NTHREADS + tid;
        if (idx < 768) {
        const int c3 = idx >> 8, rem = idx & 255, tg = rem >> 4, d0 = (rem & 15) * 8;
        const int chn = c3 * 512 + h * 128 + d0;
        f32x4 cw[4][2];
#pragma unroll
        for (int j = 0; j < 4; ++j) { cw[j][0] = *(const f32x4*)(in_conv_w + (size_t)j * 1536 + chn); cw[j][1] = *(const f32x4*)(in_conv_w + (size_t)j * 1536 + chn + 4); }
        u32x4 xr[7];
#pragma unroll
        for (int r = 0; r < 7; ++r) { const int t = t0 + 4 * tg - 3 + r; const int tc = t < 0 ? 0 : t; xr[r] = *(const u32x4*)(HP + (rowb + tc) * HPW + 1536 + chn); }
        float y[4][8];
#pragma unroll
        for (int q = 0; q < 4; ++q)
#pragma unroll
            for (int c = 0; c < 8; ++c) y[q][c] = 0.f;
#pragma unroll
        for (int r = 0; r < 7; ++r) { const int t = t0 + 4 * tg - 3 + r; const float msk = t < 0 ? 0.f : 1.f; f32x4 xa, xb; pg8::unpack8(xr[r], xa, xb); xa = xa * msk; xb = xb * msk;
#pragma unroll
            for (int q = 0; q < 4; ++q) { const int j = r - q; if (j >= 0 && j < 4) {
#pragma unroll
                for (int c = 0; c < 4; ++c) { y[q][c] += xa[c] * cw[j][0][c]; y[q][4 + c] += xb[c] * cw[j][1][c]; } } } }
        unsigned pk[4][4];
#pragma unroll
        for (int q = 0; q < 4; ++q) { float ss = 0.f;
#pragma unroll
            for (int c = 0; c < 8; ++c) { y[q][c] = y[q][c] * sigm(y[q][c]); ss += y[q][c] * y[q][c]; }
            ss += __shfl_xor(ss, 1); ss += __shfl_xor(ss, 2); ss += __shfl_xor(ss, 4); ss += __shfl_xor(ss, 8);
            const float sc = (c3 == 2) ? 1.f : rsqrtf(ss + 1e-6f) * (c3 == 0 ? 0.08838834764831845f : 1.f);
#pragma unroll
            for (int c = 0; c < 4; ++c) pk[q][c] = cvtpk(y[q][2 * c] * sc, y[q][2 * c + 1] * sc); }
        const int i0 = 4 * tg;
        if (c3 < 2) { bf16_t* dst = (c3 == 0 ? Qr : Kr) + i0 * QR_S + d0;
#pragma unroll
            for (int q = 0; q < 4; ++q) *(u32x4*)(dst + q * QR_S) = (u32x4){pk[q][0], pk[q][1], pk[q][2], pk[q][3]}; }
        if (c3 >= 1) { bf16_t* dt = (c3 == 1 ? KT : VT) + d0 * KT_S + i0;
#pragma unroll
            for (int c = 0; c < 4; ++c) {
                u32x2 lo, hi2; lo.x = (pk[0][c] & 0xffffu) | (pk[1][c] << 16); lo.y = (pk[2][c] & 0xffffu) | (pk[3][c] << 16);
                hi2.x = (pk[0][c] >> 16) | (pk[1][c] & 0xffff0000u); hi2.y = (pk[2][c] >> 16) | (pk[3][c] & 0xffff0000u);
                *(u32x2*)(dt + (2 * c) * KT_S) = lo; *(u32x2*)(dt + (2 * c + 1) * KT_S) = hi2; } }
        }
    }
    if (tid < 64) {
        const float* BA = WSP(const float, WS_BA) + (rowb + t0 + tid) * 8;
        const float bl = BA[h], al = BA[4 + h] + in_dt_bias[h];
        const float sp = fmaxf(al, 0.f) + log1pf(__expf(-fabsf(al)));
        float g = -__expf(in_a_log[h]) * sp;
#pragma unroll
        for (int o = 1; o < 64; o <<= 1) { const float up = __shfl_up(g, o); if (tid >= o) g += up; }
        const float bt = sigm(bl), eg = __expf(g);
        beta_s[tid] = bt; gc_s[tid] = g; egc_s[tid] = eg; begc_s[tid] = bt * eg;
        if (tid == 63) WSP(float, WS_EG)[ch] = eg;
    }
    __syncthreads();
    {
        const int sel = wave >> 2, tq = wave & 3, mt = (tq == 0) ? 0 : 1, nt = (tq == 3) ? 1 : (tq == 2 ? 1 : 0);
        const int amt = sel ? ((tq == 1) ? 0 : mt) : mt, ant = sel ? ((tq == 1) ? 1 : nt) : nt;
        f32x16 c;
#pragma unroll
        for (int r = 0; r < 16; ++r) c[r] = 0.f;
        if (tq != 3) {
            const bf16_t* ap = Kr + (32 * amt + r32) * QR_S + 8 * hi; const bf16_t* bp = (sel ? Qr : Kr) + (32 * ant + r32) * QR_S + 8 * hi;
#pragma unroll
            for (int s = 0; s < 8; ++s) c = MFMA32(*(const bf16x8*)(ap + 16 * s), *(const bf16x8*)(bp + 16 * s), c);
        }
        if (sel == 0) {
            const int mtt = (tq == 3) ? 0 : mt, ntt = (tq == 3) ? 1 : nt, j = 32 * ntt + r32; const float gj = gc_s[j];
#pragma unroll
            for (int r = 0; r < 16; ++r) { const int i = 32 * mtt + crow(r, hi); Nm[i * NM_S + j] = (j < i) ? beta_s[i] * c[r] * __expf(gc_s[i] - gj) : 0.f; }
        } else {
            const int jt = (tq == 3) ? 1 : amt, itile = (tq == 3) ? 0 : ant, i = 32 * itile + r32; const float gi = gc_s[i];
#pragma unroll
            for (int r = 0; r < 16; ++r) { const int j = 32 * jt + crow(r, hi); c[r] = (j <= i) ? c[r] * __expf(gi - gc_s[j]) : 0.f; }
            bf16_t* AT = (bf16_t*)(dnb + DN_AT);
            *(bf16x8*)(AT + ((itile * 4 + 2 * jt) * 64 + lane) * 8) = pack8(c, 0); *(bf16x8*)(AT + ((itile * 4 + 2 * jt + 1) * 64 + lane) * 8) = pack8(c, 8);
        }
        bf16_t* QD = (bf16_t*)(dnb + DN_QD); bf16_t* KD = (bf16_t*)(dnb + DN_KD); const float glast = gc_s[63];
#pragma unroll
        for (int k2 = 0; k2 < 2; ++k2) { const int f = 2 * wave + k2, m2 = f >> 3, s = f & 7, tok = 32 * m2 + r32; const float e = egc_s[tok];
            const u32x2 lo = *(const u32x2*)(Qr + tok * QR_S + 16 * s + 4 * hi), hi2 = *(const u32x2*)(Qr + tok * QR_S + 16 * s + 8 + 4 * hi);
            u32x4 w; w.x = cvtpk(bflo(lo.x) * e, bfhi(lo.x) * e); w.y = cvtpk(bflo(lo.y) * e, bfhi(lo.y) * e); w.z = cvtpk(bflo(hi2.x) * e, bfhi(hi2.x) * e); w.w = cvtpk(bflo(hi2.y) * e, bfhi(hi2.y) * e);
            *(u32x4*)(QD + (f * 64 + lane) * 8) = w; }
#pragma unroll
        for (int k2 = 0; k2 < 2; ++k2) { const int f = 2 * wave + k2, mt2 = f >> 2, s = f & 3, dk = 32 * mt2 + r32, tk = 16 * s + 4 * hi;
            const u32x2 lo = *(const u32x2*)(KT + dk * KT_S + tk), hi2 = *(const u32x2*)(KT + dk * KT_S + tk + 8);
            float e[8];
#pragma unroll
            for (int q = 0; q < 4; ++q) { e[q] = __expf(glast - gc_s[tk + q]); e[4 + q] = __expf(glast - gc_s[tk + 8 + q]); }
            u32x4 w; w.x = cvtpk(bflo(lo.x) * e[0], bfhi(lo.x) * e[1]); w.y = cvtpk(bflo(lo.y) * e[2], bfhi(lo.y) * e[3]); w.z = cvtpk(bflo(hi2.x) * e[4], bfhi(hi2.x) * e[5]); w.w = cvtpk(bflo(hi2.y) * e[6], bfhi(hi2.y) * e[7]);
            *(u32x4*)(KD + (f * 64 + lane) * 8) = w; }
    }
    __syncthreads();
    if (tid < 64) { const int blk = tid >> 4, col = tid & 15, o = 16 * blk; float x[16];
#pragma unroll
        for (int i = 0; i < 16; ++i) { float a = (i == col) ? 1.f : 0.f;
#pragma unroll
            for (int j = 0; j < i; ++j) a -= Nm[(o + i) * NM_S + o + j] * x[j];
            x[i] = a; }
#pragma unroll
        for (int i = 0; i < 16; ++i) { Tm[(o + i) * NM_S + o + col] = x[i]; if (!(blk & 1)) Tm[(o + i) * NM_S + o + 16 + col] = 0.f; } }
    __syncthreads();
    { const int pb = tid >> 8, r = (tid >> 4) & 15, c = tid & 15, oi = 32 * pb + 16, oj = 32 * pb; float a = 0.f;
#pragma unroll
        for (int k = 0; k < 16; ++k) a += Nm[(oi + r) * NM_S + oj + k] * Tm[(oj + k) * NM_S + oj + c];
        Pm[pb * 272 + r * 17 + c] = a; }
    __syncthreads();
    { const int pb = tid >> 8, r = (tid >> 4) & 15, c = tid & 15, oi = 32 * pb + 16, oj = 32 * pb; float a = 0.f;
#pragma unroll
        for (int k = 0; k < 16; ++k) a -= Tm[(oi + r) * NM_S + oi + k] * Pm[pb * 272 + k * 17 + c];
        Tm[(oi + r) * NM_S + oj + c] = a; }
    __syncthreads();
    { const int r = tid >> 4, c = tid & 15; float a0 = 0.f, a1 = 0.f;
#pragma unroll 8
        for (int k = 0; k < 32; ++k) { const float nv = Nm[(32 + r) * NM_S + k]; a0 += nv * Tm[k * NM_S + c]; a1 += nv * Tm[k * NM_S + c + 16]; }
        Pm[r * 36 + c] = a0; Pm[r * 36 + c + 16] = a1; }
    __syncthreads();
    { const int r = tid >> 4, c = tid & 15; float a0 = 0.f, a1 = 0.f;
#pragma unroll 8
        for (int k = 0; k < 32; ++k) { const float tv = Tm[(32 + r) * NM_S + 32 + k]; a0 -= tv * Pm[k * 36 + c]; a1 -= tv * Pm[k * 36 + c + 16]; }
        Tm[(32 + r) * NM_S + c] = a0; Tm[(32 + r) * NM_S + c + 16] = a1; }
    __syncthreads();
    { const int i = tid >> 3, j0 = (tid & 7) * 8; float tu[8], tw[8];
#pragma unroll
        for (int q = 0; q < 8; ++q) { const int j = j0 + q; const float t = (i < 32 && j >= 32) ? 0.f : Tm[i * NM_S + j]; tu[q] = t * beta_s[j]; tw[q] = t * begc_s[j]; }
        *(u32x4*)(Tu + i * KT_S + j0) = (u32x4){cvtpk(tu[0], tu[1]), cvtpk(tu[2], tu[3]), cvtpk(tu[4], tu[5]), cvtpk(tu[6], tu[7])};
        *(u32x4*)(Tw + i * KT_S + j0) = (u32x4){cvtpk(tw[0], tw[1]), cvtpk(tw[2], tw[3]), cvtpk(tw[4], tw[5]), cvtpk(tw[6], tw[7])}; }
    __syncthreads();
    { const int mt = wave >> 2, nt = wave & 3;
        f32x16 c;
#pragma unroll
        for (int r = 0; r < 16; ++r) c[r] = 0.f;
        const bf16_t* ap = Tu + (32 * mt + r32) * KT_S + 8 * hi; const bf16_t* bp = VT + (32 * nt + r32) * KT_S + 8 * hi;
#pragma unroll
        for (int s = 0; s < 4; ++s) c = MFMA32(*(const bf16x8*)(ap + 16 * s), *(const bf16x8*)(bp + 16 * s), c);
        bf16_t* U = (bf16_t*)(dnb + DN_U);
        *(bf16x8*)(U + ((nt * 4 + mt * 2) * 64 + lane) * 8) = pack8(c, 0); *(bf16x8*)(U + ((nt * 4 + mt * 2 + 1) * 64 + lane) * 8) = pack8(c, 8);
    }
    { const int mt = wave >> 1, nt = wave & 1;
        f32x16 c;
#pragma unroll
        for (int r = 0; r < 16; ++r) c[r] = 0.f;
        const bf16_t* ap = KT + (32 * mt + r32) * KT_S + 8 * hi; const bf16_t* bp = Tw + (32 * nt + r32) * KT_S + 8 * hi;
#pragma unroll
        for (int s = 0; s < 4; ++s) c = MFMA32(*(const bf16x8*)(ap + 16 * s), *(const bf16x8*)(bp + 16 * s), c);
#pragma unroll
        for (int r = 0; r < 16; ++r) c[r] = -c[r];
        bf16_t* WN = (bf16_t*)(dnb + DN_WN);
        *(bf16x8*)(WN + ((nt * 8 + 2 * mt) * 64 + lane) * 8) = pack8(c, 0); *(bf16x8*)(WN + ((nt * 8 + 2 * mt + 1) * 64 + lane) * 8) = pack8(c, 8);
    }
    __syncthreads();
}
__device__ __forceinline__ void kv_unit(const Frame& F, int u) {
    THREAD_IDS();
    const int bh = u >> 2, s0 = (u & 3) * 512, b = bh >> 3, h = bh & 7;
    bf16_t* kt = (bf16_t*)F.lds; bf16_t* vt = kt + 512 * 64;
    const bf16_t* HP = WSP(const bf16_t, WS_HP);
#pragma unroll
    for (int it = 0; it < 8; ++it) { const int idx = it * NTHREADS + tid, r = idx >> 3, c8 = (idx & 7) * 8;
        const bf16_t* src = HP + ((size_t)b * SEQ + s0 + r) * HPW + h * 64 + c8;
        const int sw = r * 64 + (((c8 >> 3) ^ (r & 7)) << 3);
        *(u32x4*)(kt + sw) = *(const u32x4*)(src + 512); *(u32x4*)(vt + sw) = *(const u32x4*)(src + 1024); }
    __syncthreads();
    const int r32 = lane & 31, hi = lane >> 5;
#pragma unroll 1
    for (int it = 0; it < 6; ++it) { const int q = it * NWAVES + wave;
        const int di = q >> 4, bi = q & 15, d = (di == 0) ? 1 : (di == 1 ? 4 : 16), nbd = 64 / d, per = 16 / d;
        const int c = bi / per, nbl = bi % per, nb = (s0 / d) / 32 + nbl;
        const size_t fbase = ((size_t)di * (T_TOK * 512)) + (((size_t)bh * 64 + c * nbd + nb) * 4) * 512 + lane * 8;
        bf16_t* kf = WSP(bf16_t, WS_KF) + fbase; bf16_t* vf = WSP(bf16_t, WS_VT) + fbase;
        const int prow = c + d * (32 * nbl + r32);
#pragma unroll
        for (int d0 = 0; d0 < 4; ++d0) *(u32x4*)(kf + d0 * 512) = *(const u32x4*)(kt + prow * 64 + (((2 * d0 + hi) ^ (prow & 7)) << 3));
#pragma unroll
        for (int eb = 0; eb < 2; ++eb)
#pragma unroll
            for (int ks = 0; ks < 2; ++ks) { unsigned w[4];
#pragma unroll
                for (int jj = 0; jj < 4; ++jj) { const int j0 = 2 * jj, j1 = 2 * jj + 1;
                    const int n0 = 32 * nbl + 16 * ks + 8 * (j0 >> 2) + 4 * hi + (j0 & 3), n1 = 32 * nbl + 16 * ks + 8 * (j1 >> 2) + 4 * hi + (j1 & 3);
                    const int ra = c + d * n0, rb = c + d * n1, ech = 4 * eb + (r32 >> 3);
                    const unsigned lo = vt[ra * 64 + ((ech ^ (ra & 7)) << 3) + (r32 & 7)], hi2 = vt[rb * 64 + ((ech ^ (rb & 7)) << 3) + (r32 & 7)]; w[jj] = lo | (hi2 << 16); }
                *(u32x4*)(vf + (eb * 2 + ks) * 512) = (u32x4){w[0], w[1], w[2], w[3]}; }
    }
    __syncthreads();
}

constexpr int SCAN_BUF = 73728;
__device__ __forceinline__ void scan_stage4(const unsigned char* dnb, int wv, LAS unsigned char* buf, int lane) {
    const unsigned char* src = dnb + wv * 18432 + lane * 16; LAS unsigned char* dst = buf + wv * 18432;
#pragma unroll 1
    for (int f = 0; f < 18; ++f) __builtin_amdgcn_global_load_lds((const unsigned*)(src + f * 1024), (LAS unsigned*)(dst + f * 1024), 16, 0, 0);
}
__device__ __forceinline__ void scan_unit4(const Frame& F, int bh, int sl) {
    THREAD_IDS();
    const int r32 = lane & 31, hi = lane >> 5;
    const int b = bh >> 2, h = bh & 3;
    LAS unsigned char* lds3 = (LAS unsigned char*)F.lds;
    volatile LAS unsigned* sbar = (volatile LAS unsigned*)(lds3 + LDS_MISC + 4096 + 64);
    f32x16 S[4];
#pragma unroll
    for (int mt = 0; mt < 4; ++mt)
#pragma unroll
        for (int r = 0; r < 16; ++r) S[mt][r] = 0.f;
    bf16_t* ORAW = WSP(bf16_t, WS_ORAW);
    const int ch0 = bh * 32;
    scan_stage4(F.ws + WS_DN + (size_t)ch0 * DN_STRIDE, sl, lds3, lane);
#pragma unroll 1
    for (int n = 0; n < 32; ++n) {
        const int ch = ch0 + n;
        LAS unsigned char* buf = lds3 + (n & 1) * SCAN_BUF;
        float eg = WSP(const float, WS_EG)[ch];
        asm volatile("s_waitcnt vmcnt(0) lgkmcnt(0)" : "+v"(eg) :: "memory");
        if (lane == 0) __hip_atomic_fetch_add((LAS unsigned*)sbar, 1u, __ATOMIC_RELAXED, __HIP_MEMORY_SCOPE_WORKGROUP);
        { const unsigned want = 4u * (unsigned)(n + 1); while (*sbar < want) __builtin_amdgcn_s_sleep(1); }
        asm volatile("" ::: "memory");
        if (n + 1 < 32) scan_stage4(F.ws + WS_DN + (size_t)(ch + 1) * DN_STRIDE, sl, lds3 + ((n + 1) & 1) * SCAN_BUF, lane);
        const LAS unsigned char* fb = buf + lane * 16;
        bf16x8 Sb[8];
#pragma unroll
        for (int mt = 0; mt < 4; ++mt) { Sb[2 * mt] = pack8(S[mt], 0); Sb[2 * mt + 1] = pack8(S[mt], 8); }
        f32x16 vn[2], o[2];
#pragma unroll
        for (int m2 = 0; m2 < 2; ++m2) {
#pragma unroll
            for (int r8 = 0; r8 < 2; ++r8) { const u32x4 uu = *(const LAS u32x4*)(fb + 57344 + (sl * 4 + m2 * 2 + r8) * 1024);
                vn[m2][8 * r8] = bflo(uu.x); vn[m2][8 * r8 + 1] = bfhi(uu.x); vn[m2][8 * r8 + 2] = bflo(uu.y); vn[m2][8 * r8 + 3] = bfhi(uu.y);
                vn[m2][8 * r8 + 4] = bflo(uu.z); vn[m2][8 * r8 + 5] = bfhi(uu.z); vn[m2][8 * r8 + 6] = bflo(uu.w); vn[m2][8 * r8 + 7] = bfhi(uu.w); }
#pragma unroll
            for (int s = 0; s < 8; ++s) { const bf16x8 a = *(const LAS bf16x8*)(fb + (m2 * 8 + s) * 1024); vn[m2] = MFMA32(a, Sb[s], vn[m2]); }
            __builtin_amdgcn_sched_barrier(0);
#pragma unroll
            for (int r = 0; r < 16; ++r) o[m2][r] = 0.f;
#pragma unroll
            for (int s = 0; s < 8; ++s) { const bf16x8 a = *(const LAS bf16x8*)(fb + 16384 + (m2 * 8 + s) * 1024); o[m2] = MFMA32(a, Sb[s], o[m2]); }
            __builtin_amdgcn_sched_barrier(0);
        }
        bf16x8 vb[4];
#pragma unroll
        for (int m2 = 0; m2 < 2; ++m2) { vb[2 * m2] = pack8(vn[m2], 0); vb[2 * m2 + 1] = pack8(vn[m2], 8); }
#pragma unroll
        for (int m2 = 0; m2 < 2; ++m2) {
#pragma unroll
            for (int s = 0; s < 4; ++s) { const bf16x8 a = *(const LAS bf16x8*)(fb + 32768 + (m2 * 4 + s) * 1024); o[m2] = MFMA32(a, vb[s], o[m2]); }
#pragma unroll
            for (int r = 0; r < 16; ++r) ORAW[((size_t)b * SEQ + 64 * n + 32 * m2 + crow(r, hi)) * 512 + h * 128 + 32 * sl + r32] = f2bf(o[m2][r]);
            __builtin_amdgcn_sched_barrier(0);
        }
#pragma unroll
        for (int mt = 0; mt < 4; ++mt) {
#pragma unroll
            for (int r = 0; r < 16; ++r) S[mt][r] *= eg;
#pragma unroll
            for (int s = 0; s < 4; ++s) { const bf16x8 a = *(const LAS bf16x8*)(fb + 40960 + (mt * 4 + s) * 1024); S[mt] = MFMA32(a, vb[s], S[mt]); }
            if (mt & 1) __builtin_amdgcn_sched_barrier(0);
        }
    }
    asm volatile("s_waitcnt vmcnt(0) lgkmcnt(0)" ::: "memory");
}
__device__ __forceinline__ void attn_block(const bf16x8 (&kc)[4], const bf16x8 (&vc)[4], const bf16x8 (&qr)[4], f32x16 (&o)[2], float& m_run, float& l_run, int dn0  ) {
    f32x16 s;
#pragma unroll
    for (int r = 0; r < 16; ++r) s[r] = 0.f;
#pragma unroll
    for (int d0 = 0; d0 < 4; ++d0) s = MFMA32(kc[d0], qr[d0], s);
#pragma unroll
    for (int r = 0; r < 16; ++r) { const unsigned dlt = (unsigned)(dn0 - ((r & 3) + 8 * (r >> 2))); s[r] = (dlt <= 128u) ? s[r] : -INFINITY; }
    float mb = fmaxf(fmaxf(s[0], s[1]), fmaxf(s[2], s[3]));
#pragma unroll
    for (int r = 4; r < 16; r += 4) mb = fmaxf(mb, fmaxf(fmaxf(s[r], s[r + 1]), fmaxf(s[r + 2], s[r + 3])));
    mb = fmaxf(mb, __shfl_xor(mb, 32));
    const float mn = fmaxf(m_run, mb);
    {
        const float al = __builtin_amdgcn_exp2f(m_run - mn);
        l_run *= al; m_run = mn;
#pragma unroll
        for (int eb = 0; eb < 2; ++eb)
#pragma unroll
            for (int r = 0; r < 16; ++r) o[eb][r] *= al;
    }
    float ps = 0.f;
#pragma unroll
    for (int r = 0; r < 16; ++r) { s[r] = __builtin_amdgcn_exp2f(s[r] - mn); ps += s[r]; }
    l_run += ps;
    const bf16x8 pb0 = pack8(s, 0), pb1 = pack8(s, 8);
#pragma unroll
    for (int eb = 0; eb < 2; ++eb)
#pragma unroll
        for (int ks = 0; ks < 2; ++ks) o[eb] = MFMA32(vc[eb * 2 + ks], ks ? pb1 : pb0, o[eb]);
}
template <int D_>
__device__ __forceinline__ void attn_branch(const Frame& F, int di, int b, int h, int t0, int jq, const bf16x8 (&qr)[4], f32x16 (&o)[2], float& m_run, float& l_run) {
    THREAD_IDS();
    const int r32 = lane & 31, hi = lane >> 5;
    constexpr int STEP = 16 / D_, NBD = 64 / D_;
    const int c = t0 % D_, a0 = t0 / D_;
    const int nq = a0 + STEP * (32 * jq + r32);
    const int nq_lo = a0 + STEP * (32 * jq), nq_hi = a0 + STEP * (32 * jq + 31);
    const int n_lo = (nq_lo - 128) > 0 ? (nq_lo - 128) : 0;
    const size_t fbase = ((size_t)di * (T_TOK * 512)) + (((size_t)(b * 8 + h) * 64 + c * NBD) * 4) * 512;
    const unsigned char* KF = (const unsigned char*)(WSP(const bf16_t, WS_KF) + fbase); const unsigned char* VF = (const unsigned char*)(WSP(const bf16_t, WS_VT) + fbase);
    const unsigned loff = (unsigned)lane * 16u;
    const int nb0 = n_lo >> 5, nb1 = nq_hi >> 5;
    const int dq = nq - 4 * hi;
#define ATT_LOAD(KX, VX, NB) do { const int nb_ = (NB) < nb1 ? (NB) : nb1; _Pragma("unroll") for (int f = 0; f < 4; ++f) { const unsigned off = (unsigned)nb_ * 4096u + loff + f * 1024; KX[f] = *(const bf16x8*)(KF + off); VX[f] = *(const bf16x8*)(VF + off); } } while (0)
    bf16x8 kA[4], vA[4], kB[4], vB[4], kC[4], vC[4];
    ATT_LOAD(kA, vA, nb0); ATT_LOAD(kB, vB, nb0 + 1);
#pragma unroll 1
    for (int nb = nb0; nb <= nb1; nb += 3) {
        ATT_LOAD(kC, vC, nb + 2);
        attn_block(kA, vA, qr, o, m_run, l_run, dq - 32 * nb);
        if (nb + 1 > nb1) break;
        ATT_LOAD(kA, vA, nb + 3);
        attn_block(kB, vB, qr, o, m_run, l_run, dq - 32 * (nb + 1));
        if (nb + 2 > nb1) break;
        ATT_LOAD(kB, vB, nb + 4);
        attn_block(kC, vC, qr, o, m_run, l_run, dq - 32 * (nb + 2));
    }
#undef ATT_LOAD
}
__device__ __forceinline__ void attn_task(const Frame& F, int a) {
    THREAD_IDS();
    const int r32 = lane & 31, hi = lane >> 5;
    const int x = F.blk & 7, bh = x + 8 * (a >> 6), tw = a & 63, t0 = tw & 15, jq = 3 - (tw >> 4), b = bh >> 3, h = bh & 7;
    const int tq = t0 + 16 * (32 * jq + r32);
    const bf16_t* HP = WSP(const bf16_t, WS_HP);
    bf16x8 qr[4];
#pragma unroll
    for (int d0 = 0; d0 < 4; ++d0) { const u32x4 qw = *(const u32x4*)(HP + ((size_t)b * SEQ + tq) * HPW + h * 64 + 16 * d0 + 8 * hi);
        constexpr float SCQ = 0.125f * 1.4426950408889634f; u32x4 w;
        w.x = cvtpk(bflo(qw.x) * SCQ, bfhi(qw.x) * SCQ); w.y = cvtpk(bflo(qw.y) * SCQ, bfhi(qw.y) * SCQ); w.z = cvtpk(bflo(qw.z) * SCQ, bfhi(qw.z) * SCQ); w.w = cvtpk(bflo(qw.w) * SCQ, bfhi(qw.w) * SCQ);
        qr[d0] = __builtin_bit_cast(bf16x8, w); }
    f32x16 o[2];
#pragma unroll
    for (int eb = 0; eb < 2; ++eb)
#pragma unroll
        for (int r = 0; r < 16; ++r) o[eb][r] = 0.f;
    float m_run = -1e30f, l_run = 0.f;
    attn_branch<1>(F, 0, b, h, t0, jq, qr, o, m_run, l_run);
    attn_branch<4>(F, 1, b, h, t0, jq, qr, o, m_run, l_run);
    attn_branch<16>(F, 2, b, h, t0, jq, qr, o, m_run, l_run);
    const float lt = l_run + __shfl_xor(l_run, 32), inv = 1.f / lt;
    bf16_t* dst = WSP(bf16_t, WS_MIX) + ((size_t)b * SEQ + tq) * DM + h * 64;
#pragma unroll
    for (int eb = 0; eb < 2; ++eb)
#pragma unroll
        for (int g = 0; g < 4; ++g) { u32x2 w; w.x = cvtpk(o[eb][4 * g] * inv, o[eb][4 * g + 1] * inv); w.y = cvtpk(o[eb][4 * g + 2] * inv, o[eb][4 * g + 3] * inv);
            *(u32x2*)(dst + 32 * eb + 8 * g + 4 * hi) = w; }
}
__device__ __forceinline__ void phase3(const Frame& F, int flags) {
    THREAD_IDS();
    if (tid == 0) *(volatile LAS unsigned*)((LAS unsigned char*)F.lds + LDS_MISC + 4096 + 64) = 0u;
    __syncthreads();
    if (F.blk < 64 && wave < 4 && !(flags & 1)) scan_unit4(F, F.blk, wave);
    unsigned* qctr = WSP(unsigned, WS_CTL) + 1024 + (F.blk & 7) * 32;
    if (wave == 7) { moe_weight_stream(F, F.blk, F.G, lane); return; }
    if (flags & 2) return;
    for (;;) {
        unsigned a = 0; if (lane == 0) a = atomicAdd(qctr, 1u);
        a = (unsigned)__builtin_amdgcn_readfirstlane((int)a);
        if (a >= 1024u) break;
        attn_task(F, (int)a);
    }
}

__device__ __forceinline__ void phase4(const Frame& F) {
    THREAD_IDS();
    const float* in_gnorm_w = inptr(6);
    const int gw = F.blk * NWAVES + wave, NGW = F.G * NWAVES;
    const bf16_t* ORAW = WSP(const bf16_t, WS_ORAW); const bf16_t* HP = WSP(const bf16_t, WS_HP); bf16_t* MIX = WSP(bf16_t, WS_MIX);
    const f32x4 gw0 = *(const f32x4*)(in_gnorm_w + (lane & 15) * 8), gw1 = *(const f32x4*)(in_gnorm_w + (lane & 15) * 8 + 4);
    for (int row = gw; row < T_TOK; row += NGW) {
        const u32x4 ow = *(const u32x4*)(ORAW + (size_t)row * 512 + lane * 8), zw = *(const u32x4*)(HP + (size_t)row * HPW + 3072 + lane * 8);
        f32x4 oa, ob, za, zb; pg8::unpack8(ow, oa, ob); pg8::unpack8(zw, za, zb);
        float ss = oa[0] * oa[0] + oa[1] * oa[1] + oa[2] * oa[2] + oa[3] * oa[3] + ob[0] * ob[0] + ob[1] * ob[1] + ob[2] * ob[2] + ob[3] * ob[3];
        ss += __shfl_xor(ss, 1); ss += __shfl_xor(ss, 2); ss += __shfl_xor(ss, 4); ss += __shfl_xor(ss, 8);
        const float r = rsqrtf(ss * (1.f / 128.f) + 1e-6f);
        f32x4 ya, yb;
#pragma unroll
        for (int j = 0; j < 4; ++j) { ya[j] = oa[j] * r * gw0[j] * (za[j] * sigm(za[j])); yb[j] = ob[j] * r * gw1[j] * (zb[j] * sigm(zb[j])); }
        *(u32x4*)(MIX + (size_t)row * DM + 512 + lane * 8) = pg8::pack_row8(ya, yb);
    }
}

__device__ __forceinline__ void phase6(const Frame& F) {
    THREAD_IDS();
    const float* in_ln1_g = inptr(8); const float* in_ln1_b = inptr(9); const float* in_b_router = inptr(11);
    float* wrt = (float*)F.lds;
    { const f32x4* src = WSP(const f32x4, WS_WRT); f32x4* dst = (f32x4*)wrt; for (int i = tid; i < 8192; i += NTHREADS) dst[i] = src[i]; }
    __syncthreads();
    const int gw = F.blk * NWAVES + wave, NGW = F.G * NWAVES;
    bf16_t* X1 = WSP(bf16_t, WS_X1);
    unsigned* cnt = WSP(unsigned, WS_CTL); int* rt_e = WSP(int, WS_ROUTE); int* rt_s = rt_e + T_TOK * 4; int* ltok = WSP(int, WS_LTOK); float* lgate = WSP(float, WS_LGATE);
    int* s_cnt = (int*)(F.lds + LDS_MISC + 4096); int* s_base = s_cnt + 32; int* s_e = s_base + 32; float* s_g = (float*)(s_e + 512); int* s_li = (int*)(s_g + 512);
    if (tid < 32) s_cnt[tid] = 0;
    __syncthreads();
    int irow = 0;
    f32x4 lg[4], lb[4];
#pragma unroll
    for (int j = 0; j < 4; ++j) { lg[j] = *(const f32x4*)(in_ln1_g + 4 * lane + 256 * j); lb[j] = *(const f32x4*)(in_ln1_b + 4 * lane + 256 * j); }
    const float brl = in_b_router[((lane >> 5) & 1) * 16 + ((lane >> 4) & 1) * 8 + ((lane >> 3) & 1) * 4 + ((lane >> 2) & 1) * 2 + ((lane >> 1) & 1)];
    for (int row = gw; row < T_TOK && irow < 16; row += NGW, ++irow) {
        u32x2* xr = (u32x2*)(X1 + (size_t)row * DM) + lane;
        f32x4 v[4]; float s = 0.f;
#pragma unroll
        for (int j = 0; j < 4; ++j) { const u32x2 w = xr[64 * j]; v[j] = (f32x4){bflo(w.x), bfhi(w.x), bflo(w.y), bfhi(w.y)}; s += (v[j][0] + v[j][1]) + (v[j][2] + v[j][3]); }
        const float mean = wave_sum(s) * (1.f / DM); float s2 = 0.f;
#pragma unroll
        for (int j = 0; j < 4; ++j) { v[j] = v[j] - mean; s2 += (v[j][0] * v[j][0] + v[j][1] * v[j][1]) + (v[j][2] * v[j][2] + v[j][3] * v[j][3]); }
        const float rstd = rsqrtf(wave_sum(s2) * (1.f / DM) + LN_EPS);
#pragma unroll
        for (int j = 0; j < 4; ++j) { v[j] = v[j] * rstd * lg[j] + lb[j]; u32x2 w; w.x = cvtpk(v[j][0], v[j][1]); w.y = cvtpk(v[j][2], v[j][3]); xr[64 * j] = w;
            (WSP(unsigned, WS_X1F) + (size_t)row * 256)[lane + 64 * j] = pk4_fp8(v[j][0], v[j][1], v[j][2], v[j][3]); }
        float pl[32];
#pragma unroll
        for (int e = 0; e < 32; ++e) { float a = 0.f;
#pragma unroll
            for (int j = 0; j < 4; ++j) { const f32x4 w = *(const f32x4*)(wrt + e * 1024 + 4 * lane + 256 * j); a += v[j][0] * w[0] + v[j][1] * w[1] + v[j][2] * w[2] + v[j][3] * w[3]; }
            pl[e] = a; if ((e & 3) == 3) asm volatile("" ::: "memory"); }
        float q16[16], q8[8], q4[4], q2[2];
        { const bool up = (lane & 32) != 0;
#pragma unroll
            for (int k = 0; k < 16; ++k) { const float keep = up ? pl[k + 16] : pl[k], send = up ? pl[k] : pl[k + 16]; q16[k] = keep + __shfl_xor(send, 32); } }
        { const bool up = (lane & 16) != 0;
#pragma unroll
            for (int k = 0; k < 8; ++k) { const float keep = up ? q16[k + 8] : q16[k], send = up ? q16[k] : q16[k + 8]; q8[k] = keep + __shfl_xor(send, 16); } }
        { const bool up = (lane & 8) != 0;
#pragma unroll
            for (int k = 0; k < 4; ++k) { const float keep = up ? q8[k + 4] : q8[k], send = up ? q8[k] : q8[k + 4]; q4[k] = keep + __shfl_xor(send, 8); } }
        { const bool up = (lane & 4) != 0;
#pragma unroll
            for (int k = 0; k < 2; ++k) { const float keep = up ? q4[k + 2] : q4[k], send = up ? q4[k] : q4[k + 2]; q2[k] = keep + __shfl_xor(send, 4); } }
        float lgt;
        { const bool up = (lane & 2) != 0; const float keep = up ? q2[1] : q2[0], send = up ? q2[0] : q2[1]; lgt = keep + __shfl_xor(send, 2); }
        lgt += __shfl_xor(lgt, 1);
        const int my_e = ((lane >> 5) & 1) * 16 + ((lane >> 4) & 1) * 8 + ((lane >> 3) & 1) * 4 + ((lane >> 2) & 1) * 2 + ((lane >> 1) & 1);
        lgt += brl;
        int rank = 0;
#pragma unroll
        for (int e = 0; e < 32; ++e) { const int src = ((e >> 4) & 1) * 32 + ((e >> 3) & 1) * 16 + ((e >> 2) & 1) * 8 + ((e >> 1) & 1) * 4 + (e & 1) * 2;
            const float ve = __uint_as_float((unsigned)__builtin_amdgcn_readlane((int)__float_as_uint(lgt), src));
            rank += (ve > lgt || (ve == lgt && e < my_e)) ? 1 : 0;
            if ((e & 7) == 7) __builtin_amdgcn_sched_barrier(0); }
        float tv[4]; int te[4];
#pragma unroll
        for (int k = 0; k < 4; ++k) { const unsigned long long mk = __ballot(rank == k && (lane & 1) == 0); const int src = (int)__builtin_ctzll(mk);
            tv[k] = __uint_as_float((unsigned)__builtin_amdgcn_readlane((int)__float_as_uint(lgt), src)); te[k] = __builtin_amdgcn_readlane(my_e, src); }
        const float e1 = __expf(tv[1] - tv[0]), e2 = __expf(tv[2] - tv[0]), e3 = __expf(tv[3] - tv[0]), inv = 1.f / (1.f + e1 + e2 + e3);
        if (lane < 4) { const int ek = lane == 0 ? te[0] : (lane == 1 ? te[1] : (lane == 2 ? te[2] : te[3]));
            const float gk = (lane == 0 ? 1.f : (lane == 1 ? e1 : (lane == 2 ? e2 : e3))) * inv;
            const int li = atomicAdd(s_cnt + ek, 1);
            const int q = (wave * 16 + irow) * 4 + lane; s_e[q] = ek; s_g[q] = gk; s_li[q] = li; }
    }
    __syncthreads();
    if (tid < 32) s_base[tid] = (int)atomicAdd(cnt + tid * 32, (unsigned)s_cnt[tid]);
    __syncthreads();
    { const int lr = tid >> 2, k = tid & 3, wv = lr >> 4, i = lr & 15;
        const int row = (F.blk * NWAVES + wv) + i * NGW;
        if (row < T_TOK) { const int ek = s_e[tid], slot = s_base[ek] + s_li[tid];
            ltok[(size_t)ek * LCAP + slot] = row; lgate[(size_t)ek * LCAP + slot] = s_g[tid]; rt_e[row * 4 + k] = ek; rt_s[row * 4 + k] = slot; } }
}
constexpr int ULIST_OFF = LDS_MISC + 1024, ULIST_MAX = 60;
__device__ __forceinline__ void build_tpre(const Frame& F, int nN, int ndense = 0) {
    THREAD_IDS();
    int* tpre = (int*)(F.lds + LDS_MISC); int* cnts = tpre + 64; int* ulist = (int*)(F.lds + ULIST_OFF);
    __syncthreads();
    if (tid == 0) { const unsigned* cnt = WSP(const unsigned, WS_CTL); int acc = 0;
        for (int e = 0; e < NEXP; ++e) { const int c = (int)__hip_atomic_load(cnt + e * 32, __ATOMIC_RELAXED, __HIP_MEMORY_SCOPE_AGENT); tpre[e] = acc; cnts[e] = c; acc += (c + 255) >> 8; }
        tpre[NEXP] = acc;
        if (nN > 0) { const int totale = acc * nN, total = totale + ndense; int i = 0;
            for (; i < ULIST_MAX; ++i) { const int L = pg8::unit_index(i, F.blk, F.G, total); if (L < 0) break;
                if (L >= totale) { const int l = L - totale, gid = l / 32, w = l - gid * 32;
                    ulist[4 * i] = 255 | ((w / 8) << 8); ulist[4 * i + 1] = gid * 8 + w % 8; ulist[4 * i + 2] = gid * 8 + w % 8; ulist[4 * i + 3] = 256; continue; }
                int e = 0; for (int k = 1; k < NEXP; ++k) if (L >= tpre[k] * nN) e = k;
                const int tp0 = tpre[e], tiles = tpre[e + 1] - tp0, l = L - tp0 * nN, nig = 8 * nN, gid = l / nig, fm = gid * 8, gsz = (tiles - fm) < 8 ? (tiles - fm) : 8, w = l - gid * nig;
                const int pn = w / gsz, pl = fm + w % gsz, rr = cnts[e] - 256 * pl;
                ulist[4 * i] = e | (pn << 8); ulist[4 * i + 1] = pl; ulist[4 * i + 2] = tp0 + pl; ulist[4 * i + 3] = rr < 256 ? rr : 256; }
            ulist[4 * i + 3] = 0; }
    }
    __syncthreads();
}

__device__ __forceinline__ void phase9(const Frame& F) {
    THREAD_IDS();
    const float* in_ln2_g = inptr(19); const float* in_ln2_b = inptr(20);
    build_tpre(F, 0);
    const int* tpre = (const int*)(F.lds + LDS_MISC);
    const int gw = F.blk * NWAVES + wave, NGW = F.G * NWAVES;
    const bf16_t* X1 = WSP(const bf16_t, WS_X1); const bf16_t* PLE = WSP(const bf16_t, WS_PLE); const unsigned char* YB = WSP(const unsigned char, WS_YB);
    const int* rt_e = WSP(const int, WS_ROUTE); const int* rt_s = rt_e + T_TOK * 4;
    f32x4 lg[4], lb[4];
#pragma unroll
    for (int j = 0; j < 4; ++j) { lg[j] = *(const f32x4*)(in_ln2_g + 4 * lane + 256 * j); lb[j] = *(const f32x4*)(in_ln2_b + 4 * lane + 256 * j); }
    for (int row = gw; row < T_TOK; row += NGW) {
        const u32x2* xr = (const u32x2*)(X1 + (size_t)row * DM) + lane; const u32x2* pr = (const u32x2*)(PLE + (size_t)row * DM) + lane;
        f32x4 v[4];
#pragma unroll
        for (int j = 0; j < 4; ++j) { const u32x2 w = xr[64 * j], q = pr[64 * j];
            v[j] = (f32x4){bflo(w.x), bfhi(w.x), bflo(w.y), bfhi(w.y)} * ALPHA + (f32x4){bflo(q.x), bfhi(q.x), bflo(q.y), bfhi(q.y)}; }
#pragma unroll
        for (int k = 0; k < 4; ++k) { const int e = rt_e[row * 4 + k], sl = rt_s[row * 4 + k]; const size_t R = (size_t)tpre[e] * 256 + sl;
            const unsigned* yr = (const unsigned*)(YB + R * DM) + lane;
#pragma unroll
            for (int j = 0; j < 4; ++j) { const int w = (int)yr[64 * j]; const f32x2_t lo = __builtin_amdgcn_cvt_pk_f32_fp8(w, false), hi2 = __builtin_amdgcn_cvt_pk_f32_fp8(w, true); v[j] = v[j] + (f32x4){lo[0], lo[1], hi2[0], hi2[1]}; } }
        float s = 0.f;
#pragma unroll
        for (int j = 0; j < 4; ++j) s += (v[j][0] + v[j][1]) + (v[j][2] + v[j][3]);
        const float mean = wave_sum(s) * (1.f / DM); float s2 = 0.f;
#pragma unroll
        for (int j = 0; j < 4; ++j) { v[j] = v[j] - mean; s2 += (v[j][0] * v[j][0] + v[j][1] * v[j][1]) + (v[j][2] * v[j][2] + v[j][3] * v[j][3]); }
        const float rstd = rsqrtf(wave_sum(s2) * (1.f / DM) + LN_EPS);
        f32x4* orow = (f32x4*)(F.out + (size_t)row * DM) + lane;
#pragma unroll
        for (int j = 0; j < 4; ++j) orow[64 * j] = v[j] * rstd * lg[j] + lb[j];
    }
}

constexpr int N_PHASES = 10;
__global__ void __launch_bounds__(NTHREADS, 2) fwd_kernel(Args args) {
    extern __shared__ __attribute__((aligned(16))) unsigned char lds_raw[];
    Frame F;
    F.lds = lds_raw; F.G = gridDim.x; F.blk = blockIdx.x;
    F.out = args.out; F.ws = args.ws;
    LAS unsigned char* lds3 = (LAS unsigned char*)lds_raw;
    const int lo = args.ph_lo, hi = args.ph_hi;
#if ONE_LAUNCH
    if (threadIdx.x < 2) ((LAS unsigned*)(lds3 + LDS_BARST))[threadIdx.x] = 0u;
    __syncthreads();
    XcdBarrier xbar = xcd_barrier_post(WSP(unsigned, WS_CTL) + CW_BAR, (volatile LAS unsigned*)(lds3 + LDS_BARST));
#define SEAM(k) do { if (lo <= (k) && (k) + 1 < hi) xcd_barrier(xbar); } while (0)
#else
#define SEAM(k) do { } while (0)
#endif
#ifndef PHASE_MASK
#define PHASE_MASK 0x3ff
#endif
#define IN(k) (((PHASE_MASK >> (k)) & 1) && lo <= (k) && (k) < hi)
#define REPS(k) 1
#if ONE_LAUNCH
#define REPSYNC() xcd_barrier(xbar)
#else
#define REPSYNC() do { } while (0)
#endif
    if (IN(0)) { for (int rep = 0; rep < REPS(0); ++rep) { if (rep) REPSYNC(); phase0(F); } SEAM(0); }
    if (IN(1)) {
        for (int rep = 0; rep < REPS(1); ++rep) { if (rep) REPSYNC();
        pg8::DenseSched S{(const char*)WSP(bf16_t, WS_XB), (const char*)WSP(bf16_t, WS_WIN), T_TOK / 256, HPW / 256, 1024, F.blk, F.G};
        pg8::EpiStore E{WSP(bf16_t, WS_HP), HPW};
        pg8::gemm_phase<false>(lds3, 1024, S, E); }
        SEAM(1);
    }
    if (IN(2)) {
        for (int rep = 0; rep < REPS(2); ++rep) { if (rep) REPSYNC();
        for (int u = F.blk; u < 2048 + 512; u += F.G) { if (u < 2048) { if (!(args.flags & 4)) dn_prep_unit(F, u); } else if (!(args.flags & 8)) kv_unit(F, u - 2048); } }
        SEAM(2);
    }
    if (IN(3)) { for (int rep = 0; rep < REPS(3); ++rep) { if (rep) { REPSYNC(); if (F.blk == 0 && threadIdx.x == 0) __hip_atomic_store(WSP(unsigned, WS_CTL) + 64, 0u, __ATOMIC_RELAXED, __HIP_MEMORY_SCOPE_AGENT); REPSYNC(); } phase3(F, args.flags); } SEAM(3); }
    if (IN(4)) { for (int rep = 0; rep < REPS(4); ++rep) { if (rep) REPSYNC(); phase4(F); } SEAM(4); }
    if (IN(5)) {
        for (int rep = 0; rep < REPS(5); ++rep) { if (rep) REPSYNC();
        pg8::DenseSched S{(const char*)WSP(bf16_t, WS_MIX), (const char*)WSP(bf16_t, WS_WOUT), T_TOK / 256, DM / 256, 1024, F.blk, F.G};
        pg8::EpiResid E{WSP(bf16_t, WS_X1), WSP(const bf16_t, WS_XB)};
        pg8::gemm_phase<false>(lds3, 1024, S, E); }
        SEAM(5);
    }
    if (IN(6)) { phase6(F); SEAM(6); }
    if (IN(7)) {
        build_tpre(F, 8, 512);
        for (int rep = 0; rep < REPS(7); ++rep) { if (rep) REPSYNC();
        { pg8::MoeSched<true> S{(const char*)WSP(unsigned char, WS_X1F), (const char*)WSP(unsigned char, WS_WGU), (size_t)2048 * 1024, WSP(const int, WS_LTOK), (const LAS int*)(lds3 + ULIST_OFF), 1024, (const char*)WSP(unsigned char, WS_WPG)};
          pg8::EpiActSig E{{WSP(unsigned char, WS_ACT), inptr(13)}, {WSP(bf16_t, WS_PLE), inptr(17)}};
          pg8::gemm_phase<true>(lds3, 1024, S, E); } }
        SEAM(7);
    }
    if (IN(8)) {
        build_tpre(F, 4);
        for (int rep = 0; rep < REPS(8); ++rep) { if (rep) REPSYNC();
        { pg8::MoeSched<false> S{(const char*)WSP(unsigned char, WS_ACT), (const char*)WSP(unsigned char, WS_WD), (size_t)1024 * 1024, nullptr, (const LAS int*)(lds3 + ULIST_OFF), 1024, nullptr};
          pg8::EpiDown E{WSP(unsigned char, WS_YB), inptr(15), WSP(const float, WS_LGATE)};
          pg8::gemm_phase<true>(lds3, 1024, S, E); } }
        { pg8::DenseSched S{(const char*)WSP(bf16_t, WS_PB), (const char*)WSP(bf16_t, WS_WPP), T_TOK / 256, DM / 256, 256, F.blk, F.G};
          pg8::EpiMul E{WSP(bf16_t, WS_PLE)};
          pg8::gemm_phase<false>(lds3, 256, S, E); }
        SEAM(8);
    }
    if (IN(9)) { for (int rep = 0; rep < REPS(9); ++rep) { if (rep) REPSYNC(); phase9(F); } }

}

extern "C" void kernel_launch(void* const* d_in, const int* in_sizes, int n_in, void* d_out, int out_size, void* d_ws, size_t ws_size, hipStream_t stream) {
    static int grid = 0;
    if (grid == 0) {
        if (n_in != 21 || out_size != T_TOK * DM || ws_size < WS_END) { fprintf(stderr, "kernel_launch: unexpected problem (n_in %d, out %d, ws %zu)\n", n_in, out_size, ws_size); grid = -1; return; }
        int dev = 0, cus = 0, per_cu = 0;
        (void)hipGetDevice(&dev); (void)hipDeviceGetAttribute(&cus, hipDeviceAttributeMultiprocessorCount, dev);
        if (hipFuncSetAttribute((const void*)fwd_kernel, hipFuncAttributeMaxDynamicSharedMemorySize, LDS_BYTES) != hipSuccess) { fprintf(stderr, "kernel_launch: hipFuncSetAttribute failed\n"); grid = -1; return; }
        (void)hipOccupancyMaxActiveBlocksPerMultiprocessor(&per_cu, (const void*)fwd_kernel, NTHREADS, LDS_BYTES);
        (void)hipGetLastError();
        if (per_cu < 1) { fprintf(stderr, "kernel_launch: occupancy query says %d workgroups per CU: cannot make the grid resident\n", per_cu); grid = -1; return; }
        grid = cus;
        if (cus != 256) fprintf(stderr, "kernel_launch: built for a 256-CU device (got %d CUs)\n", cus);
    }
    if (grid < 0) return;
    (void)hipMemsetAsync((char*)d_ws + WS_CTL, 0, 32768, stream);
    Args a{};
    for (int i = 0; i < 21; ++i) a.in[i] = (const float*)d_in[i];
    a.out = (float*)d_out; a.ws = (unsigned char*)d_ws;
#if ONE_LAUNCH
    a.ph_lo = 0; a.ph_hi = N_PHASES;
    void* kargs[] = {&a};
    hipError_t e = hipLaunchCooperativeKernel((const void*)fwd_kernel, dim3(grid), dim3(NTHREADS), kargs, LDS_BYTES, stream);
    if (e != hipSuccess) fprintf(stderr, "cooperative launch failed: %s (grid %d)\n", hipGetErrorString(e), grid);
#else
    for (int ph = 0; ph < N_PHASES; ++ph) { a.ph_lo = ph; a.ph_hi = ph + 1; hipLaunchKernelGGL(fwd_kernel, dim3(grid), dim3(NTHREADS), LDS_BYTES, stream, a);
        if (ph == (PROBE_PH)) { a.flags = PROBE_FLAGS; if (ph == 3) (void)hipMemsetAsync((char*)d_ws + WS_CTL + 4096, 0, 2048, stream); hipLaunchKernelGGL(fwd_kernel, dim3(grid), dim3(NTHREADS), LDS_BYTES, stream, a); a.flags = 0; } }
#endif
}
```

```cpp
#include <hip/hip_runtime.h>
#include <hip/hip_cooperative_groups.h>
#include <cstdio>
#include <cstdint>
namespace cg = cooperative_groups;

#ifndef PROBE_PH
#define PROBE_PH -1
#endif
#ifndef PROBE_FLAGS
#define PROBE_FLAGS 0
#endif
#ifndef ONE_LAUNCH
#define ONE_LAUNCH 1
#endif

#define LAS __attribute__((address_space(3)))
typedef unsigned short bf16_t;
typedef short bf16x8 __attribute__((ext_vector_type(8)));
typedef float f32x4 __attribute__((ext_vector_type(4)));
typedef float f32x16 __attribute__((ext_vector_type(16)));
typedef unsigned u32x4 __attribute__((ext_vector_type(4)));
typedef unsigned u32x2 __attribute__((ext_vector_type(2)));
typedef float f32x2_t __attribute__((ext_vector_type(2)));
typedef __bf16 bf16x2_t __attribute__((ext_vector_type(2)));

constexpr int T_TOK = 32768, DM = 1024, SEQ = 2048, NBATCH = 16;
constexpr int HPW = 3584, INCOLS = 3592;
constexpr int NEXP = 32, LCAP = 32768;
constexpr float ALPHA = 1.189207115002721f;
constexpr float LN_EPS = 1e-5f;
constexpr int NWAVES = 8, NTHREADS = 512;
constexpr int LDS_BYTES = 163840;
constexpr int LDS_MISC = 147456;

constexpr size_t MiB = 1u << 20;
constexpr size_t WS_CTL = 0;
constexpr size_t WS_WGU = 1 * MiB;
constexpr size_t WS_WD = 129 * MiB;
constexpr size_t WS_WIN = 193 * MiB;
constexpr size_t WS_WOUT = 200 * MiB;
constexpr size_t WS_WPG = 202 * MiB;
constexpr size_t WS_WPP = 204 * MiB;
constexpr size_t WS_WRT = 205 * MiB;
constexpr size_t WS_BA = 206 * MiB;
constexpr size_t WS_ROUTE = 207 * MiB;
constexpr size_t WS_LTOK = 208 * MiB;
constexpr size_t WS_LGATE = 212 * MiB;
constexpr size_t WS_X1 = 216 * MiB;
constexpr size_t WS_PLE = 280 * MiB;
constexpr size_t WS_PB = 344 * MiB;
constexpr size_t WS_MIX = 360 * MiB;
constexpr size_t WS_XB = 424 * MiB;
constexpr size_t WS_HP = 488 * MiB;
constexpr size_t WS_DN = 712 * MiB;
constexpr size_t WS_EG = 888 * MiB;
constexpr size_t WS_VT = 889 * MiB;
constexpr size_t WS_KF = 216 * MiB;
constexpr size_t WS_ORAW = 985 * MiB;
constexpr size_t WS_ACT = 360 * MiB;
constexpr size_t WS_X1F = 632 * MiB;
constexpr size_t WS_YB = 672 * MiB;
constexpr size_t WS_END = 1017 * MiB;
constexpr size_t DN_WN = 0, DN_QD = 16384, DN_AT = 32768, DN_KD = 40960, DN_U = 57344, DN_STRIDE = 73728;

__device__ __forceinline__ unsigned cvtpk(float lo, float hi) { f32x2_t v = {lo, hi}; bf16x2_t b = __builtin_convertvector(v, bf16x2_t); return __builtin_bit_cast(unsigned, b); }
typedef int v8i __attribute__((ext_vector_type(8)));
__device__ __forceinline__ unsigned pk4_fp8(float a, float b, float c, float d) { int w = __builtin_amdgcn_cvt_pk_fp8_f32(a, b, 0, false); w = __builtin_amdgcn_cvt_pk_fp8_f32(c, d, w, true); return (unsigned)w; }
__device__ __forceinline__ float bflo(unsigned u) { return __uint_as_float(u << 16); }
__device__ __forceinline__ float bfhi(unsigned u) { return __uint_as_float(u & 0xffff0000u); }
__device__ __forceinline__ bf16_t f2bf(float f) { return (bf16_t)(cvtpk(f, 0.f) & 0xffffu); }
__device__ __forceinline__ float bf2f(bf16_t h) { return __uint_as_float((unsigned)h << 16); }
__device__ __forceinline__ float sigm(float x) { return __builtin_amdgcn_rcpf(1.f + __expf(-x)); }
__device__ __forceinline__ int crow(int r, int hi) { return (r & 3) + 8 * (r >> 2) + 4 * hi; }
__device__ __forceinline__ int kperm(int k) { return (k & ~12) | ((k & 4) << 1) | ((k & 8) >> 1); }
__device__ __forceinline__ bf16x8 pack8(const f32x16& x, int b) {
    u32x4 w; w.x = cvtpk(x[b], x[b + 1]); w.y = cvtpk(x[b + 2], x[b + 3]); w.z = cvtpk(x[b + 4], x[b + 5]); w.w = cvtpk(x[b + 6], x[b + 7]);
    return __builtin_bit_cast(bf16x8, w);
}
template <int CTRL> __device__ __forceinline__ float dppf(float x) { return __builtin_bit_cast(float, __builtin_amdgcn_mov_dpp(__builtin_bit_cast(int, x), CTRL, 0xf, 0xf, true)); }
__device__ __forceinline__ float sum_x16(float a, float b) { auto s = __builtin_amdgcn_permlane16_swap(__float_as_uint(a), __float_as_uint(b), false, false); return __uint_as_float(s[0]) + __uint_as_float(s[1]); }
__device__ __forceinline__ float sum_x32(float a, float b) { auto s = __builtin_amdgcn_permlane32_swap(__float_as_uint(a), __float_as_uint(b), false, false); return __uint_as_float(s[0]) + __uint_as_float(s[1]); }
__device__ __forceinline__ float wave_sum(float v) {
    v += dppf<0xB1>(v); v += dppf<0x4E>(v); v += dppf<0x141>(v); v += dppf<0x128>(v);
    v = sum_x16(v, v); return sum_x32(v, v);
}

namespace pg8 {
constexpr int BM = 256, BK = 64, HALF = 128, HTB = HALF * BK * 2, STAGE_BYTES = 8 * HTB;
__device__ __forceinline__ int lds_byte(int r, int c) { const int st = (r >> 4) * 2 + (c >> 5), rr = r & 15, cc = c & 31, ob = rr * 64 + cc * 2; return st * 1024 + (ob ^ (((ob >> 9) & 1) << 5)); }
__device__ __forceinline__ void stage_rc(int b, int& R, int& C) { const int st = b / 1024, sb = b % 1024, swz = sb ^ (((sb >> 9) & 1) << 5); R = (st >> 1) * 16 + swz / 64; C = (st & 1) * 32 + (swz % 64) / 2; }
__device__ __forceinline__ int perm32(int rho) { const int n = rho >> 4, i = rho & 15; return 8 * (i >> 2) + 4 * n + (i & 3); }

struct Unit { const char* A; const char* B; int pm, pn, e, rows, pl; };

__device__ __forceinline__ int unit_index(int i, int c, int G, int total) {
    if (G % 8 != 0) { const int L = i * G + c; return L < total ? L : -1; }
    const int x = c & 7, per = G >> 3, li = i * per + (c >> 3), q = total >> 3, r = total & 7;
    const int start = x * q + (x < r ? x : r), size = q + (x < r ? 1 : 0);
    return li < size ? start + li : -1;
}

struct DenseSched {
    const char* Abase; const char* Bbase; int nM, nN, K, c, G;
    __device__ __forceinline__ bool next(int i, Unit& u) const {
        const int L = unit_index(i, c, G, nM * nN); if (L < 0) return false;
        const int nig = 8 * nN, gid = L / nig, fm = gid * 8, gsz = (nM - fm) < 8 ? (nM - fm) : 8, w = L - gid * nig;
        u.pn = w / gsz; u.pm = fm + w % gsz; u.e = 0; u.rows = 256; u.pl = u.pm;
        u.A = Abase + (size_t)u.pm * 256 * K * 2; u.B = Bbase + (size_t)u.pn * 256 * K * 2; return true;
    }
    static constexpr bool GATHER = false;
    __device__ __forceinline__ size_t hstepA() const { return (size_t)128 * K * 2; }
    __device__ __forceinline__ void avoff(const Unit& u, const int (&R)[2], const int (&C)[2], unsigned (&vo)[2][2]) const {
#pragma unroll
        for (int h = 0; h < 2; ++h)
#pragma unroll
            for (int i = 0; i < 2; ++i) vo[h][i] = (unsigned)(R[i] * K + C[i]) * 2u;
    }
};
template <bool GATHER_> struct MoeSched {
    static constexpr bool GATHER = GATHER_;
    __device__ __forceinline__ size_t hstepA() const { return GATHER_ ? (size_t)0 : (size_t)128 * K; }
    const char* Abase; const char* Bbase; size_t Bstride; const int* ltok; const LAS int* ulist; int K; const char* Bdense;
    __device__ __forceinline__ bool next(int i, Unit& u) const {
        const int w0 = __builtin_amdgcn_readfirstlane(ulist[4 * i]), w1 = __builtin_amdgcn_readfirstlane(ulist[4 * i + 1]), w2 = __builtin_amdgcn_readfirstlane(ulist[4 * i + 2]), w3 = __builtin_amdgcn_readfirstlane(ulist[4 * i + 3]);
        if (w3 == 0) return false;
        u.e = w0 & 255; u.pn = w0 >> 8; u.pl = w1; u.pm = w2; u.rows = w3;
        u.A = GATHER_ ? Abase : Abase + (size_t)u.pm * 256 * K; u.B = (u.e == 255 ? Bdense : Bbase + (size_t)u.e * Bstride) + (size_t)u.pn * 256 * K; return true;
    }
    __device__ __forceinline__ void avoff(const Unit& u, const int (&R)[2], const int (&C)[2], unsigned (&vo)[2][2]) const {
#pragma unroll
        for (int h = 0; h < 2; ++h)
#pragma unroll
            for (int i = 0; i < 2; ++i) {
                if (GATHER_) { const int r = h * 128 + R[i]; int tok = 0; if (u.e == 255) tok = u.pm * 256 + r; else if (r < u.rows) tok = ltok[(size_t)u.e * LCAP + u.pl * 256 + r]; vo[h][i] = (unsigned)(tok * K + C[i] * 2); }
                else vo[h][i] = (unsigned)(R[i] * K + C[i] * 2);
            }
    }
};

typedef f32x4 Acc[2][2][4][2];

template <bool FP8, class Epi, class Sched>
__device__ __forceinline__ void gemm_phase(LAS unsigned char* lds, const int K, const Sched& S, const Epi& E) {
    const int tid = threadIdx.x, wid = __builtin_amdgcn_readfirstlane(tid >> 6), lane = tid & 63, wr = wid >> 2, wc = wid & 3, fr = lane & 15, fq = lane >> 4;
    const int RB = FP8 ? K : 2 * K;
    const int nt = RB / 128;
    int RA[2], CA[2]; unsigned voffB[2];
#pragma unroll
    for (int i = 0; i < 2; ++i) { int R, C; stage_rc(tid * 16 + i * 8192, R, C); RA[i] = R; CA[i] = C; const int Rb = (R & ~31) + perm32(R & 31); voffB[i] = (unsigned)(Rb * RB + C * 2); }
    const size_t kstep = (size_t)(BK * 2);
    const size_t hstepB = (size_t)HALF * RB, hstepA = S.hstepA();
    const unsigned ldsw = (unsigned)wid * 1024u;
    const int aoff = lds_byte(wr * 64 + fr, fq * 8), boff = lds_byte(wc * 32 + fr, fq * 8);
#define PG8_SA(b, h) (((b) * 2 + (h)) * HTB)
#define PG8_SB(b, h) ((4 + (b) * 2 + (h)) * HTB)
#define PG8_GL(gptr, ldsoff) __builtin_amdgcn_global_load_lds((const unsigned*)(gptr), (LAS unsigned*)(lds + (ldsoff)), 16, 0, 0)
#define PG8_STAGE_B(bufoff, gbase) do { PG8_GL((const char*)(gbase) + voffB[0], (bufoff) + ldsw); PG8_GL((const char*)(gbase) + voffB[1], (bufoff) + ldsw + 8192); } while (0)
#define PG8_STAGE_A(bufoff, gbase, o0, o1) do { PG8_GL((const char*)(gbase) + (o0), (bufoff) + ldsw); PG8_GL((const char*)(gbase) + (o1), (bufoff) + ldsw + 8192); } while (0)
#define PG8_LDA(dst, b, h) do { _Pragma("unroll") for (int m = 0; m < 4; ++m) { \
        if constexpr (FP8) { const u32x4 l_ = *(const LAS u32x4*)(lds + PG8_SA(b, h) + aoff + m * 2048), h_ = *(const LAS u32x4*)(lds + PG8_SA(b, h) + aoff + m * 2048 + 1024); \
            dst##8[m] = (v8i){(int)l_.x, (int)l_.y, (int)l_.z, (int)l_.w, (int)h_.x, (int)h_.y, (int)h_.z, (int)h_.w}; } \
        else { _Pragma("unroll") for (int k = 0; k < 2; ++k) dst[m][k] = *(const LAS bf16x8*)(lds + PG8_SA(b, h) + aoff + m * 2048 + k * 1024); } } } while (0)
#define PG8_LDB(dst, b, h) do { _Pragma("unroll") for (int n = 0; n < 2; ++n) { \
        if constexpr (FP8) { const u32x4 l_ = *(const LAS u32x4*)(lds + PG8_SB(b, h) + boff + n * 2048), h_ = *(const LAS u32x4*)(lds + PG8_SB(b, h) + boff + n * 2048 + 1024); \
            dst##8[n] = (v8i){(int)l_.x, (int)l_.y, (int)l_.z, (int)l_.w, (int)h_.x, (int)h_.y, (int)h_.z, (int)h_.w}; } \
        else { _Pragma("unroll") for (int k = 0; k < 2; ++k) dst[n][k] = *(const LAS bf16x8*)(lds + PG8_SB(b, h) + boff + n * 2048 + k * 1024); } } } while (0)
#define PG8_MMA(ai, bj, At, Bt) do { __builtin_amdgcn_s_setprio(1); \
        if constexpr (FP8) { _Pragma("unroll") for (int m = 0; m < 4; ++m) _Pragma("unroll") for (int n = 0; n < 2; ++n) \
            asm volatile("s_nop 1\n\tv_mfma_scale_f32_16x16x128_f8f6f4 %0, %1, %2, %0, %3, %4 op_sel_hi:[0,0,0]" : "+v"(acc[ai][bj][m][n]) : "v"(Bt##8[n]), "v"(At##8[m]), "v"(sc_w), "v"(sc_a)); } \
        else { _Pragma("unroll") for (int m = 0; m < 4; ++m) _Pragma("unroll") for (int n = 0; n < 2; ++n) _Pragma("unroll") for (int k = 0; k < 2; ++k) \
            acc[ai][bj][m][n] = __builtin_amdgcn_mfma_f32_16x16x32_bf16(Bt[n][k], At[m][k], acc[ai][bj][m][n], 0, 0, 0); } \
        __builtin_amdgcn_s_setprio(0); } while (0)
#define PG8_WAIT_V(n) asm volatile("s_waitcnt vmcnt(" #n ")" ::: "memory")
#define PG8_WAIT_L(n) asm volatile("s_waitcnt lgkmcnt(" #n ")" ::: "memory")
#define PG8_BAR __builtin_amdgcn_s_barrier()
#define PG8_SCHED __builtin_amdgcn_sched_barrier(0)
    Unit cur, nxt; int ui = 0;
    if (!S.next(0, cur)) return;
    unsigned vc[2][2], vn[2][2];
    S.avoff(cur, RA, CA, vc);
    Acc acc;
#pragma unroll
    for (int a = 0; a < 2; ++a)
#pragma unroll
        for (int b = 0; b < 2; ++b)
#pragma unroll
            for (int m = 0; m < 4; ++m)
#pragma unroll
                for (int n = 0; n < 2; ++n) acc[a][b][m][n] = (f32x4){0.f, 0.f, 0.f, 0.f};
    const int sc_w = 122, sc_a = 127;
    bf16x8 At[4][2], B0[2][2], B1[2][2]; v8i At8[4], B08[2], B18[2];
    const char* cA = cur.A; const char* cB = cur.B;
    PG8_STAGE_B(PG8_SB(0, 0), cB); PG8_STAGE_B(PG8_SB(0, 1), cB + hstepB); PG8_STAGE_A(PG8_SA(0, 0), cA, vc[0][0], vc[0][1]); PG8_STAGE_A(PG8_SA(0, 1), cA + hstepA, vc[1][0], vc[1][1]);
    if (wr == 1) PG8_BAR;
    PG8_WAIT_V(2); PG8_BAR;
    PG8_STAGE_B(PG8_SB(1, 0), cB + kstep); PG8_STAGE_A(PG8_SA(1, 0), cA + kstep, vc[0][0], vc[0][1]); PG8_STAGE_B(PG8_SB(1, 1), cB + hstepB + kstep);
    PG8_WAIT_V(6); PG8_BAR;
    for (;;) {
        const bool has_next = S.next(ui + 1, nxt);
        if (Sched::GATHER && has_next) S.avoff(nxt, RA, CA, vn);
        else {
#pragma unroll
            for (int h = 0; h < 2; ++h)
#pragma unroll
                for (int i = 0; i < 2; ++i) vn[h][i] = vc[h][i];
        }
        const char* nA = has_next ? nxt.A : cA; const char* nB = has_next ? nxt.B : cB;
#pragma unroll 1
        for (int t = 0; t < nt; t += 2) {
            const bool last = (t == nt - 2);
            const char* a1 = cA + (size_t)(t + 1) * kstep;
            const char* a2 = last ? nA : cA + (size_t)(t + 2) * kstep; const char* b2 = last ? nB : cB + (size_t)(t + 2) * kstep;
            const char* a3 = a2 + kstep; const char* b3 = b2 + kstep;
            const unsigned o00 = last ? vn[0][0] : vc[0][0], o01 = last ? vn[0][1] : vc[0][1], o10 = last ? vn[1][0] : vc[1][0], o11 = last ? vn[1][1] : vc[1][1];
            PG8_LDB(B0, 0, 0); PG8_LDB(B1, 0, 1); PG8_SCHED; PG8_LDA(At, 0, 0); PG8_STAGE_A(PG8_SA(1, 1), a1 + hstepA, vc[1][0], vc[1][1]);
            PG8_WAIT_V(8); PG8_WAIT_L(0); PG8_BAR; PG8_MMA(0, 0, At, B0); PG8_MMA(0, 1, At, B1); PG8_BAR; PG8_SCHED;
            PG8_LDA(At, 0, 1); PG8_STAGE_B(PG8_SB(0, 0), b2); PG8_STAGE_B(PG8_SB(0, 1), b2 + hstepB); PG8_STAGE_A(PG8_SA(0, 0), a2, o00, o01);
            PG8_WAIT_V(8); PG8_WAIT_L(0); PG8_BAR; PG8_MMA(1, 0, At, B0); PG8_MMA(1, 1, At, B1); PG8_BAR; PG8_SCHED;
            PG8_LDB(B0, 1, 0); PG8_LDB(B1, 1, 1); PG8_SCHED; PG8_LDA(At, 1, 0); PG8_STAGE_A(PG8_SA(0, 1), a2 + hstepA, o10, o11);
            PG8_WAIT_V(8); PG8_WAIT_L(0); PG8_BAR; PG8_MMA(0, 0, At, B0); PG8_MMA(0, 1, At, B1); PG8_BAR; PG8_SCHED;
            PG8_LDA(At, 1, 1); PG8_STAGE_B(PG8_SB(1, 0), b3); PG8_STAGE_B(PG8_SB(1, 1), b3 + hstepB); PG8_STAGE_A(PG8_SA(1, 0), a3, o00, o01);
            PG8_WAIT_V(8); PG8_WAIT_L(0); PG8_BAR; PG8_MMA(1, 0, At, B0); PG8_MMA(1, 1, At, B1); PG8_BAR; PG8_SCHED;
        }
        if (wr == 0) PG8_BAR;
        if constexpr (FP8) asm volatile("s_nop 15\n\ts_nop 15" ::: "memory");
        E(acc, cur, wr, wc, fr, fq);
        if (!has_next) break;
#pragma unroll
        for (int a = 0; a < 2; ++a)
#pragma unroll
            for (int b = 0; b < 2; ++b)
#pragma unroll
                for (int m = 0; m < 4; ++m)
#pragma unroll
                    for (int n = 0; n < 2; ++n) acc[a][b][m][n] = (f32x4){0.f, 0.f, 0.f, 0.f};
        cur = nxt; cA = nA; cB = nB; ++ui;
#pragma unroll
        for (int h = 0; h < 2; ++h)
#pragma unroll
            for (int i = 0; i < 2; ++i) vc[h][i] = vn[h][i];
        if (wr == 1) PG8_BAR;
    }
    PG8_WAIT_V(0);
    PG8_BAR;
#undef PG8_SA
#undef PG8_SB
#undef PG8_GL
#undef PG8_STAGE_A
#undef PG8_STAGE_B
#undef PG8_LDA
#undef PG8_LDB
#undef PG8_MMA
#undef PG8_WAIT_V
#undef PG8_WAIT_L
#undef PG8_BAR
#undef PG8_SCHED
}

__device__ __forceinline__ u32x4 pack_row8(const f32x4& v0, const f32x4& v1) { u32x4 w; w.x = cvtpk(v0[0], v0[1]); w.y = cvtpk(v0[2], v0[3]); w.z = cvtpk(v1[0], v1[1]); w.w = cvtpk(v1[2], v1[3]); return w; }
__device__ __forceinline__ void unpack8(const u32x4& w, f32x4& a, f32x4& b) { a = (f32x4){bflo(w.x), bfhi(w.x), bflo(w.y), bfhi(w.y)}; b = (f32x4){bflo(w.z), bfhi(w.z), bflo(w.w), bfhi(w.w)}; }

struct EpiStore {
    bf16_t* O; int ldc;
    __device__ __forceinline__ void operator()(const Acc& acc, const Unit& u, int wr, int wc, int fr, int fq) const {
        const int row0 = u.pm * BM + wr * 64 + fr, col0 = u.pn * BM + wc * 32 + 8 * fq;
#pragma unroll
        for (int ai = 0; ai < 2; ++ai)
#pragma unroll
            for (int m = 0; m < 4; ++m) { bf16_t* rowp = O + (size_t)(row0 + ai * HALF + m * 16) * ldc + col0;
#pragma unroll
                for (int bj = 0; bj < 2; ++bj) *(u32x4*)(rowp + bj * HALF) = pack_row8(acc[ai][bj][m][0], acc[ai][bj][m][1]); }
    }
};
struct EpiResid {
    bf16_t* O; const bf16_t* X;
    __device__ __forceinline__ void operator()(const Acc& acc, const Unit& u, int wr, int wc, int fr, int fq) const {
        const int row0 = u.pm * BM + wr * 64 + fr, col0 = u.pn * BM + wc * 32 + 8 * fq;
#pragma unroll
        for (int ai = 0; ai < 2; ++ai)
#pragma unroll
            for (int m = 0; m < 4; ++m) { const size_t off = (size_t)(row0 + ai * HALF + m * 16) * DM + col0;
#pragma unroll
                for (int bj = 0; bj < 2; ++bj) { const u32x4 xw = *(const u32x4*)(X + off + bj * HALF); f32x4 xa, xb; unpack8(xw, xa, xb);
                    *(u32x4*)(O + off + bj * HALF) = pack_row8(xa * ALPHA + acc[ai][bj][m][0], xb * ALPHA + acc[ai][bj][m][1]); }
                if (m & 1) asm volatile("" ::: "memory"); }
    }
};
struct EpiAct {
    unsigned char* O; const float* bgu;
    __device__ __forceinline__ void operator()(const Acc& acc, const Unit& u, int wr, int wc, int fr, int fq) const {
        const int cl = u.pn * HALF + wc * 32 + 8 * fq;
        const float* bg = bgu + (size_t)u.e * 2048 + cl;
        const f32x4 g0 = *(const f32x4*)bg, g1 = *(const f32x4*)(bg + 4), u0 = *(const f32x4*)(bg + 1024), u1 = *(const f32x4*)(bg + 1028);
        unsigned char* obase = O + (size_t)(u.pm * BM + wr * 64 + fr) * DM + cl;
        const int rl0 = wr * 64 + fr;
#pragma unroll
        for (int ai = 0; ai < 2; ++ai)
#pragma unroll
            for (int m = 0; m < 4; ++m) { const int rl = ai * HALF + m * 16 + rl0;
                unsigned w[2];
#pragma unroll
                for (int n = 0; n < 2; ++n) { const f32x4 hg = acc[ai][0][m][n] + (n ? g1 : g0), hu = acc[ai][1][m][n] + (n ? u1 : u0); float o4[4];
#pragma unroll
                    for (int j = 0; j < 4; ++j) { const float g = fminf(hg[j], 7.f), up = fminf(fmaxf(hu[j], -7.f), 7.f);
                        o4[j] = (up + 1.f) * g * __builtin_amdgcn_rcpf(1.f + __builtin_amdgcn_exp2f(-2.4554669595930157f * g)); }
                    w[n] = pk4_fp8(o4[0], o4[1], o4[2], o4[3]); asm volatile("" : "+v"(w[n])); }
                if (rl < u.rows) *(u32x2*)(obase + (size_t)(ai * HALF + m * 16) * DM) = (u32x2){w[0], w[1]};
                asm volatile("" ::: "memory"); }
    }
};
struct EpiDown {
    unsigned char* O; const float* bd; const float* lgate;
    __device__ __forceinline__ void operator()(const Acc& acc, const Unit& u, int wr, int wc, int fr, int fq) const {
        const int col0 = u.pn * BM + wc * 32 + 8 * fq;
        const float* bp = bd + (size_t)u.e * DM + col0;
#pragma unroll
        for (int ai = 0; ai < 2; ++ai)
#pragma unroll
            for (int m = 0; m < 4; ++m) { const int rl = ai * HALF + wr * 64 + m * 16 + fr;
                if (rl < u.rows) { const float gt = lgate[(size_t)u.e * LCAP + u.pl * BM + rl]; unsigned char* rowp = O + (size_t)(u.pm * BM + rl) * DM + col0;
#pragma unroll
                    for (int bj = 0; bj < 2; ++bj) { const f32x4 a = (acc[ai][bj][m][0] + *(const f32x4*)(bp + bj * HALF)) * gt, b = (acc[ai][bj][m][1] + *(const f32x4*)(bp + bj * HALF + 4)) * gt;
                        *(u32x2*)(rowp + bj * HALF) = (u32x2){pk4_fp8(a[0], a[1], a[2], a[3]), pk4_fp8(b[0], b[1], b[2], b[3])}; } }
                asm volatile("" ::: "memory"); }
    }
};
struct EpiSig {
    bf16_t* O; const float* bias;
    __device__ __forceinline__ void operator()(const Acc& acc, const Unit& u, int wr, int wc, int fr, int fq) const {
        const int row0 = u.pm * BM + wr * 64 + fr, col0 = u.pn * BM + wc * 32 + 8 * fq;
        f32x4 bv[2][2];
#pragma unroll
        for (int bj = 0; bj < 2; ++bj)
#pragma unroll
            for (int n = 0; n < 2; ++n) bv[bj][n] = *(const f32x4*)(bias + col0 + bj * HALF + 4 * n);
#pragma unroll
        for (int ai = 0; ai < 2; ++ai)
#pragma unroll
            for (int m = 0; m < 4; ++m) { bf16_t* rowp = O + (size_t)(row0 + ai * HALF + m * 16) * DM + col0;
#pragma unroll
                for (int bj = 0; bj < 2; ++bj) { f32x4 a = acc[ai][bj][m][0] + bv[bj][0], b = acc[ai][bj][m][1] + bv[bj][1];
#pragma unroll
                    for (int j = 0; j < 4; ++j) { a[j] = sigm(a[j]); b[j] = sigm(b[j]); }
                    *(u32x4*)(rowp + bj * HALF) = pack_row8(a, b); }
                asm volatile("" ::: "memory"); }
    }
};
struct EpiActSig {
    EpiAct a; EpiSig g;
    __device__ __forceinline__ void operator()(const Acc& acc, const Unit& u, int wr, int wc, int fr, int fq) const { if (u.e == 255) g(acc, u, wr, wc, fr, fq); else a(acc, u, wr, wc, fr, fq); }
};
struct EpiMul {
    bf16_t* O;
    __device__ __forceinline__ void operator()(const Acc& acc, const Unit& u, int wr, int wc, int fr, int fq) const {
        const int row0 = u.pm * BM + wr * 64 + fr, col0 = u.pn * BM + wc * 32 + 8 * fq;
#pragma unroll
        for (int ai = 0; ai < 2; ++ai)
#pragma unroll
            for (int m = 0; m < 4; ++m) { bf16_t* rowp = O + (size_t)(row0 + ai * HALF + m * 16) * DM + col0;
#pragma unroll
                for (int bj = 0; bj < 2; ++bj) { const u32x4 gw = *(const u32x4*)(rowp + bj * HALF); f32x4 ga, gb; unpack8(gw, ga, gb);
                    *(u32x4*)(rowp + bj * HALF) = pack_row8(ga * acc[ai][bj][m][0], gb * acc[ai][bj][m][1]); }
                if (m & 1) asm volatile("" ::: "memory"); }
    }
};
}

#define XB_TMO      128
#define XB_XCNT(j)  (256  + 64 * (j))
#define XB_XSUB(j)  (1280 + 64 * (j))
#define XB_XGEN(j)  (2304 + 64 * (j))
#define XB_TOP      3328
#define XB_TOPGEN   3392
#define XCD_BAR_WORDS 3456
#define XB_SPIN_CAP (1u << 22)
constexpr int CW_BAR = 4096;
constexpr int LDS_BARST = LDS_MISC + 2048;
__device__ __forceinline__ unsigned xb_ld(unsigned* p)              { return __hip_atomic_load(p, __ATOMIC_RELAXED, __HIP_MEMORY_SCOPE_AGENT); }
__device__ __forceinline__ unsigned xb_add(unsigned* p, unsigned v) { return __hip_atomic_fetch_add(p, v, __ATOMIC_RELAXED, __HIP_MEMORY_SCOPE_AGENT); }
__device__ __forceinline__ unsigned xb_xcc_id() { return (unsigned)__builtin_amdgcn_s_getreg((3 << 11) | 20) & 0xFu; }
#define XB_SPIN(cond, bar) do { unsigned _sp = 0; while (cond) { __builtin_amdgcn_s_sleep(1); \
    if ((++_sp & 255u) == 0u) { if (xb_ld(&(bar)[XB_TMO])) break; if (_sp > XB_SPIN_CAP) { atomicAdd(&(bar)[XB_TMO], 1u); break; } } } } while (0)
struct XcdBarrier { unsigned* bar; unsigned x; volatile LAS unsigned* st; };
__device__ __forceinline__ XcdBarrier xcd_barrier_post(unsigned* bar, volatile LAS unsigned* st) {
    XcdBarrier b; b.bar = bar; b.x = xb_xcc_id(); b.st = st;
    if (threadIdx.x == 0) (void)xb_add(&bar[XB_XCNT(b.x)], 1u);
    return b;
}
__device__ __forceinline__ void xcd_barrier_complete(unsigned* bar, unsigned x, unsigned& nloc, unsigned& nx) {
    const unsigned G = gridDim.x * gridDim.y * gridDim.z;
    unsigned sum, cnt, mine, sp = 0u;
    for (;;) {
        sum = 0u; cnt = 0u; mine = 0u;
#pragma unroll
        for (unsigned j = 0; j < 16; ++j) { const unsigned c = xb_ld(&bar[XB_XCNT(j)]); sum += c; cnt += (c > 0u) ? 1u : 0u; mine = (j == x) ? c : mine; }
        if (sum == G) break;
        __builtin_amdgcn_s_sleep(1);
        if ((++sp & 255u) == 0u) { if (xb_ld(&bar[XB_TMO])) break; if (sp > XB_SPIN_CAP) { atomicAdd(&bar[XB_TMO], 1u); break; } }
    }
    nloc = mine > 0u ? mine : 1u; nx = cnt > 0u ? cnt : 1u;
}
__device__ __forceinline__ void xcd_barrier(const XcdBarrier& b) {
    asm volatile("s_waitcnt vmcnt(0)" ::: "memory");
    __syncthreads();
    if (threadIdx.x == 0) {
        unsigned* bar = b.bar;
        __builtin_amdgcn_s_waitcnt(0);
        unsigned nloc = b.st[0], nx = b.st[1];
        if (nloc == 0u) { xcd_barrier_complete(bar, b.x, nloc, nx); b.st[0] = nloc; b.st[1] = nx; }
        const unsigned old = xb_add(&bar[XB_XSUB(b.x)], 1u);
        const unsigned gen = old / nloc;
        if (old + 1u == (gen + 1u) * nloc) {
            __builtin_amdgcn_fence(__ATOMIC_RELEASE, "agent");
            asm volatile("s_waitcnt vmcnt(0)" ::: "memory");
            const unsigned og = xb_add(&bar[XB_TOP], 1u);
            const unsigned tg = og / nx;
            if (og + 1u == (tg + 1u) * nx) xb_add(&bar[XB_TOPGEN], 1u);
            else XB_SPIN(xb_ld(&bar[XB_TOPGEN]) == tg, bar);
            __builtin_amdgcn_fence(__ATOMIC_ACQUIRE, "agent");
            xb_add(&bar[XB_XGEN(b.x)], 1u);
            asm volatile("s_waitcnt vmcnt(0)" ::: "memory");
        } else {
            XB_SPIN(xb_ld(&bar[XB_XGEN(b.x)]) == gen, bar);
            __builtin_amdgcn_fence(__ATOMIC_ACQUIRE, "agent");
            asm volatile("s_waitcnt vmcnt(0)" ::: "memory");
        }
    }
    __syncthreads();
}

struct Args { const float* in[21]; float* out; unsigned char* ws; int ph_lo, ph_hi; int flags, pad; };
#define THREAD_IDS() int tid = threadIdx.x; asm volatile("" : "+v"(tid)); const int lane = tid & 63; const int wave = __builtin_amdgcn_readfirstlane(tid >> 6); (void)lane; (void)wave
struct Frame {
    unsigned char* lds; int G, blk;
    float* out; unsigned char* ws;
};
__device__ __forceinline__ const float* inptr(int k) {
    const char* ka = (const char*)__builtin_amdgcn_kernarg_segment_ptr(); asm volatile("" : "+s"(ka));
    return *(const float* const*)(ka + 8 * k);
}
#define WSP(T, off) ((T*)(F.ws + (off)))

constexpr int MOE_TILES = NEXP * 16 * 32 + NEXP * 16 * 16;
struct WTile { const float* src; unsigned char* dst; int ldn; };
__device__ __forceinline__ WTile moe_tile_addr(const Frame& F, int r, const float* w_gate_up, const float* w_down, int lane) {
    constexpr int I_GU = NEXP * 16 * 32; const int q4 = lane >> 4, c = lane & 15; WTile t;
    if (r < I_GU) { const int e = r / 512, q = r % 512, kb = q / 32, nb = q % 32, n0 = 64 * nb;
        const int j0 = n0 & 1023, drow0 = 256 * (j0 >> 7) + (j0 & 127) + ((n0 >= 1024) ? 128 : 0);
        t.src = w_gate_up + (size_t)e * 1024 * 2048 + (size_t)(64 * kb + 16 * q4) * 2048 + n0 + 4 * c; t.ldn = 2048;
        t.dst = WSP(unsigned char, WS_WGU) + (size_t)e * 2048 * 1024 + (size_t)(drow0 + 4 * c) * 1024 + 64 * kb + 16 * q4; }
    else { r -= I_GU; const int e = r / 256, q = r % 256, kb = q / 16, nb = q % 16;
        t.src = w_down + (size_t)e * 1024 * 1024 + (size_t)(64 * kb + 16 * q4) * 1024 + 64 * nb + 4 * c; t.ldn = 1024;
        t.dst = WSP(unsigned char, WS_WD) + (size_t)e * 1024 * 1024 + (size_t)(64 * nb + 4 * c) * 1024 + 64 * kb + 16 * q4; }
    return t;
}
__device__ __forceinline__ void wtile_load(f32x4 (&v)[16], const WTile& t) {
#pragma unroll
    for (int i = 0; i < 16; ++i) v[i] = *(const f32x4*)(t.src + (size_t)i * t.ldn);
}
__device__ __forceinline__ void wtile_store(const f32x4 (&v)[16], const WTile& t) {
#pragma unroll
    for (int j = 0; j < 4; ++j) {
        u32x4 o;
        o.x = pk4_fp8(v[0][j] * 32.f, v[1][j] * 32.f, v[2][j] * 32.f, v[3][j] * 32.f); o.y = pk4_fp8(v[4][j] * 32.f, v[5][j] * 32.f, v[6][j] * 32.f, v[7][j] * 32.f);
        o.z = pk4_fp8(v[8][j] * 32.f, v[9][j] * 32.f, v[10][j] * 32.f, v[11][j] * 32.f); o.w = pk4_fp8(v[12][j] * 32.f, v[13][j] * 32.f, v[14][j] * 32.f, v[15][j] * 32.f);
        *(u32x4*)(t.dst + (size_t)j * 1024) = o;
    }
}
__device__ __forceinline__ void moe_weight_batch3(const Frame& F, int r0, int stride, const float* w_gate_up, const float* w_down, int lane) {
    const WTile t0 = moe_tile_addr(F, r0, w_gate_up, w_down, lane), t1 = moe_tile_addr(F, r0 + stride, w_gate_up, w_down, lane), t2 = moe_tile_addr(F, r0 + 2 * stride, w_gate_up, w_down, lane);
    f32x4 va[16], vb[16];
    wtile_load(va, t0); wtile_load(vb, t1);
    wtile_store(va, t0); wtile_load(va, t2);
    wtile_store(vb, t1); wtile_store(va, t2);
}

__device__ __forceinline__ void p0_transpose_tile(const float* W, int ldn, int k0, int n0, bf16_t* WT, int Kd, int drow0, int lane) {
    const int q = lane >> 4, c = lane & 15;
    const float* src = W + (size_t)(k0 + 16 * q) * ldn + n0 + 4 * c;
    f32x4 v[16];
#pragma unroll
    for (int i = 0; i < 16; ++i) v[i] = *(const f32x4*)(src + (size_t)i * ldn);
    bf16_t* dst = WT + (size_t)(drow0 + 4 * c) * Kd + k0 + 16 * q;
#pragma unroll
    for (int j = 0; j < 4; ++j) {
        u32x4 o0, o1;
        o0.x = cvtpk(v[0][j], v[1][j]); o0.y = cvtpk(v[2][j], v[3][j]); o0.z = cvtpk(v[4][j], v[5][j]); o0.w = cvtpk(v[6][j], v[7][j]);
        o1.x = cvtpk(v[8][j], v[9][j]); o1.y = cvtpk(v[10][j], v[11][j]); o1.z = cvtpk(v[12][j], v[13][j]); o1.w = cvtpk(v[14][j], v[15][j]);
        *(u32x4*)(dst + (size_t)j * Kd) = o0; *(u32x4*)(dst + (size_t)j * Kd + 8) = o1;
    }
}
__device__ __forceinline__ void phase0(const Frame& F) {
    THREAD_IDS();
    const float* in_x = inptr(0); const float* in_p = inptr(1); const float* in_w_in = inptr(2); const float* in_w_out = inptr(7); const float* in_w_router = inptr(10); const float* in_w_ple_gate = inptr(16); const float* in_w_ple_proj = inptr(18);
    float* wba = (float*)F.lds;
    for (int i = tid; i < 8192; i += NTHREADS) wba[(i & 7) * 1024 + (i >> 3)] = in_w_in[(size_t)(i >> 3) * INCOLS + HPW + (i & 7)];
    __syncthreads();
    const int gw = F.blk * NWAVES + wave, NGW = F.G * NWAVES;
    bf16_t* XB = WSP(bf16_t, WS_XB); float* BA = WSP(float, WS_BA);
    for (int row = gw; row < T_TOK; row += NGW) {
        const f32x4* xr = (const f32x4*)(in_x + (size_t)row * DM) + lane;
        f32x4 v[4];
#pragma unroll
        for (int j = 0; j < 4; ++j) v[j] = xr[64 * j];
        u32x2* o8 = (u32x2*)(XB + (size_t)row * DM) + lane;
#pragma unroll
        for (int j = 0; j < 4; ++j) { u32x2 w; w.x = cvtpk(v[j][0], v[j][1]); w.y = cvtpk(v[j][2], v[j][3]); o8[64 * j] = w; }
        float a8[8];
#pragma unroll
        for (int q = 0; q < 8; ++q) { float a = 0.f;
#pragma unroll
            for (int j = 0; j < 4; ++j) { const f32x4 w = *(const f32x4*)(wba + q * 1024 + 4 * lane + 256 * j); a += v[j][0] * w[0] + v[j][1] * w[1] + v[j][2] * w[2] + v[j][3] * w[3]; }
            a8[q] = a; }
        float r4[4], r2[2], r1;
#pragma unroll
        for (int k = 0; k < 4; ++k) r4[k] = sum_x32(a8[k], a8[k + 4]);
#pragma unroll
        for (int k = 0; k < 2; ++k) r2[k] = sum_x16(r4[k], r4[k + 2]);
        { const bool up = (lane & 8) != 0; const float keep = up ? r2[1] : r2[0], send = up ? r2[0] : r2[1]; r1 = keep + dppf<0x128>(send); }
        r1 += dppf<0x141>(r1); r1 += dppf<0x4E>(r1); r1 += dppf<0xB1>(r1);
        if ((lane & 7) == 0) BA[(size_t)row * 8 + ((lane >> 5) & 1) * 4 + ((lane >> 4) & 1) * 2 + ((lane >> 3) & 1)] = r1;
    }
    { const f32x4* src = (const f32x4*)in_p; u32x2* dst = WSP(u32x2, WS_PB);
        for (int i = F.blk * NTHREADS + tid; i < T_TOK * 256 / 4; i += F.G * NTHREADS) { const f32x4 v = src[i]; u32x2 w; w.x = cvtpk(v[0], v[1]); w.y = cvtpk(v[2], v[3]); dst[i] = w; } }
    { float* wrt = WSP(float, WS_WRT); for (int i = F.blk * NTHREADS + tid; i < 32768; i += F.G * NTHREADS) wrt[(i & 31) * 1024 + (i >> 5)] = in_w_router[i]; }
    constexpr int I_IN = 16 * 56, I_OUT = 16 * 16, I_PG = 16 * 16, I_PP = 4 * 16;
    constexpr int NITEMS = I_IN + I_OUT + I_PG + I_PP;
    for (int it = gw; it < NITEMS; it += NGW) {
        int r = it;
        if (r < I_IN) { const int kb = r / 56, nb = r % 56; p0_transpose_tile(in_w_in, INCOLS, 64 * kb, 64 * nb, WSP(bf16_t, WS_WIN), 1024, 64 * nb, lane); continue; } r -= I_IN;
        if (r < I_OUT) { const int kb = r / 16, nb = r % 16; p0_transpose_tile(in_w_out, 1024, 64 * kb, 64 * nb, WSP(bf16_t, WS_WOUT), 1024, 64 * nb, lane); continue; } r -= I_OUT;
        if (r < I_PG) { const int kb = r / 16, nb = r % 16, q4 = lane >> 4, c = lane & 15; WTile t; f32x4 v[16];
            t.src = in_w_ple_gate + (size_t)(64 * kb + 16 * q4) * 1024 + 64 * nb + 4 * c; t.ldn = 1024; t.dst = WSP(unsigned char, WS_WPG) + (size_t)(64 * nb + 4 * c) * 1024 + 64 * kb + 16 * q4;
            wtile_load(v, t); wtile_store(v, t); continue; } r -= I_PG;
        { const int kb = r / 16, nb = r % 16; p0_transpose_tile(in_w_ple_proj, 1024, 64 * kb, 64 * nb, WSP(bf16_t, WS_WPP), 256, 64 * nb, lane); }
    }
}
__device__ __forceinline__ void moe_weight_stream(const Frame& F, int cw, int ncw, int lane) {
    const float* w_gate_up = inptr(12); const float* w_down = inptr(14);
    f32x4 va[16], vb[16];
    int r = cw; if (r >= MOE_TILES) return;
    WTile ta = moe_tile_addr(F, r, w_gate_up, w_down, lane); wtile_load(va, ta);
#pragma unroll 1
    for (;;) {
        const int r1 = r + ncw; WTile tb{}; const bool hb = r1 < MOE_TILES;
        if (hb) { tb = moe_tile_addr(F, r1, w_gate_up, w_down, lane); wtile_load(vb, tb); }
        wtile_store(va, ta);
        if (!hb) break;
        const int r2 = r1 + ncw; const bool ha = r2 < MOE_TILES;
        if (ha) { ta = moe_tile_addr(F, r2, w_gate_up, w_down, lane); wtile_load(va, ta); }
        wtile_store(vb, tb);
        if (!ha) break;
        r = r2;
    }
}
#define MFMA32(a, b, c) __builtin_amdgcn_mfma_f32_32x32x16_bf16((a), (b), (c), 0, 0, 0)
constexpr int QR_S = 136, KT_S = 72, NM_S = 68;
constexpr int L_QR = 0, L_KR = 17408, L_KT = 34816, L_VT = 53248, L_NM = 71680, L_TM = 89088, L_PM = 106496, L_TU = 111104, L_TW = 120320, L_SC = 129536;
__device__ __forceinline__ void dn_prep_unit(const Frame& F, int ch) {
    int tid = threadIdx.x; asm volatile("" : "+v"(tid));
    const int lane = tid & 63, wave = __builtin_amdgcn_readfirstlane(tid >> 6), r32 = lane & 31, hi = lane >> 5;
    const float* in_conv_w = inptr(3); const float* in_a_log = inptr(4); const float* in_dt_bias = inptr(5);
    const int b = ch >> 7, h = (ch >> 5) & 3, n = ch & 31;
    bf16_t* Qr = (bf16_t*)(F.lds + L_QR); bf16_t* Kr = (bf16_t*)(F.lds + L_KR); bf16_t* KT = (bf16_t*)(F.lds + L_KT); bf16_t* VT = (bf16_t*)(F.lds + L_VT);
    float* Nm = (float*)(F.lds + L_NM); float* Tm = (float*)(F.lds + L_TM); float* Pm = (float*)(F.lds + L_PM);
    bf16_t* Tu = (bf16_t*)(F.lds + L_TU); bf16_t* Tw = (bf16_t*)(F.lds + L_TW);
    float* beta_s = (float*)(F.lds + L_SC); float* gc_s = beta_s + 64; float* egc_s = gc_s + 64; float* begc_s = egc_s + 64;
    const bf16_t* HP = WSP(const bf16_t, WS_HP);
    const int t0 = 64 * n; const size_t rowb = (size_t)b * SEQ;
    unsigned char* dnb = F.ws + WS_DN + (size_t)ch * DN_STRIDE;
#pragma unroll
    for (int it = 0; it < 2; ++it) {
        const int idx = it * NTHREADS + tid;
        if (idx < 768) {
        const int c3 = idx >> 8, rem = idx & 255, tg = rem >> 4, d0 = (rem & 15) * 8;
        const int chn = c3 * 512 + h * 128 + d0;
        f32x4 cw[4][2];
#pragma unroll
        for (int j = 0; j < 4; ++j) { cw[j][0] = *(const f32x4*)(in_conv_w + (size_t)j * 1536 + chn); cw[j][1] = *(const f32x4*)(in_conv_w + (size_t)j * 1536 + chn + 4); }
        u32x4 xr[7];
#pragma unroll
        for (int r = 0; r < 7; ++r) { const int t = t0 + 4 * tg - 3 + r; const int tc = t < 0 ? 0 : t; xr[r] = *(const u32x4*)(HP + (rowb + tc) * HPW + 1536 + chn); }
        float y[4][8];
#pragma unroll
        for (int q = 0; q < 4; ++q)
#pragma unroll
            for (int c = 0; c < 8; ++c) y[q][c] = 0.f;
#pragma unroll
        for (int r = 0; r < 7; ++r) { const int t = t0 + 4 * tg - 3 + r; const float msk = t < 0 ? 0.f : 1.f; f32x4 xa, xb; pg8::unpack8(xr[r], xa, xb); xa = xa * msk; xb = xb * msk;
#pragma unroll
            for (int q = 0; q < 4; ++q) { const int j = r - q; if (j >= 0 && j < 4) {
#pragma unroll
                for (int c = 0; c < 4; ++c) { y[q][c] += xa[c] * cw[j][0][c]; y[q][4 + c] += xb[c] * cw[j][1][c]; } } } }
        unsigned pk[4][4];
#pragma unroll
        for (int q = 0; q < 4; ++q) { float ss = 0.f;
#pragma unroll
            for (int c = 0; c < 8; ++c) { y[q][c] = y[q][c] * sigm(y[q][c]); ss += y[q][c] * y[q][c]; }
            ss += dppf<0xB1>(ss); ss += dppf<0x4E>(ss); ss += dppf<0x141>(ss); ss += dppf<0x128>(ss);
            const float sc = (c3 == 2) ? 1.f : rsqrtf(ss + 1e-6f) * (c3 == 0 ? 0.08838834764831845f : 1.f);
#pragma unroll
            for (int c = 0; c < 4; ++c) pk[q][c] = cvtpk(y[q][2 * c] * sc, y[q][2 * c + 1] * sc); }
        const int i0 = 4 * tg;
        if (c3 < 2) { bf16_t* dst = (c3 == 0 ? Qr : Kr) + i0 * QR_S + d0;
#pragma unroll
            for (int q = 0; q < 4; ++q) *(u32x4*)(dst + q * QR_S) = (u32x4){pk[q][0], pk[q][1], pk[q][2], pk[q][3]}; }
        if (c3 >= 1) { bf16_t* dt = (c3 == 1 ? KT : VT) + d0 * KT_S + i0;
#pragma unroll
            for (int c = 0; c < 4; ++c) {
                u32x2 lo, hi2; lo.x = (pk[0][c] & 0xffffu) | (pk[1][c] << 16); lo.y = (pk[2][c] & 0xffffu) | (pk[3][c] << 16);
                hi2.x = (pk[0][c] >> 16) | (pk[1][c] & 0xffff0000u); hi2.y = (pk[2][c] >> 16) | (pk[3][c] & 0xffff0000u);
                *(u32x2*)(dt + (2 * c) * KT_S) = lo; *(u32x2*)(dt + (2 * c + 1) * KT_S) = hi2; } }
        }
    }
    if (tid < 64) {
        const float* BA = WSP(const float, WS_BA) + (rowb + t0 + tid) * 8;
        const float bl = BA[h], al = BA[4 + h] + in_dt_bias[h];
        const float sp = fmaxf(al, 0.f) + log1pf(__expf(-fabsf(al)));
        float g = -__expf(in_a_log[h]) * sp;
#pragma unroll
        for (int o = 1; o < 64; o <<= 1) { const float up = __shfl_up(g, o); if (tid >= o) g += up; }
        const float bt = sigm(bl), eg = __expf(g);
        beta_s[tid] = bt; gc_s[tid] = g; egc_s[tid] = eg; begc_s[tid] = bt * eg;
        if (tid == 63) WSP(float, WS_EG)[ch] = eg;
    }
    __syncthreads();
    {
        const int sel = wave >> 2, tq = wave & 3, mt = (tq == 0) ? 0 : 1, nt = (tq == 3) ? 1 : (tq == 2 ? 1 : 0);
        const int amt = sel ? ((tq == 1) ? 0 : mt) : mt, ant = sel ? ((tq == 1) ? 1 : nt) : nt;
        f32x16 c;
#pragma unroll
        for (int r = 0; r < 16; ++r) c[r] = 0.f;
        if (tq != 3) {
            const bf16_t* ap = Kr + (32 * amt + r32) * QR_S + 8 * hi; const bf16_t* bp = (sel ? Qr : Kr) + (32 * ant + r32) * QR_S + 8 * hi;
#pragma unroll
            for (int s = 0; s < 8; ++s) c = MFMA32(*(const bf16x8*)(ap + 16 * s), *(const bf16x8*)(bp + 16 * s), c);
        }
        if (sel == 0) {
            const int mtt = (tq == 3) ? 0 : mt, ntt = (tq == 3) ? 1 : nt, j = 32 * ntt + r32; const float gj = gc_s[j];
#pragma unroll
            for (int r = 0; r < 16; ++r) { const int i = 32 * mtt + crow(r, hi); Nm[i * NM_S + j] = (j < i) ? beta_s[i] * c[r] * __expf(gc_s[i] - gj) : 0.f; }
        } else {
            const int jt = (tq == 3) ? 1 : amt, itile = (tq == 3) ? 0 : ant, i = 32 * itile + r32; const float gi = gc_s[i];
#pragma unroll
            for (int r = 0; r < 16; ++r) { const int j = 32 * jt + crow(r, hi); c[r] = (j <= i) ? c[r] * __expf(gi - gc_s[j]) : 0.f; }
            bf16_t* AT = (bf16_t*)(dnb + DN_AT);
            *(bf16x8*)(AT + ((itile * 4 + 2 * jt) * 64 + lane) * 8) = pack8(c, 0); *(bf16x8*)(AT + ((itile * 4 + 2 * jt + 1) * 64 + lane) * 8) = pack8(c, 8);
        }
        bf16_t* QD = (bf16_t*)(dnb + DN_QD); bf16_t* KD = (bf16_t*)(dnb + DN_KD); const float glast = gc_s[63];
#pragma unroll
        for (int k2 = 0; k2 < 2; ++k2) { const int f = 2 * wave + k2, m2 = f >> 3, s = f & 7, tok = 32 * m2 + r32; const float e = egc_s[tok];
            const u32x2 lo = *(const u32x2*)(Qr + tok * QR_S + 16 * s + 4 * hi), hi2 = *(const u32x2*)(Qr + tok * QR_S + 16 * s + 8 + 4 * hi);
            u32x4 w; w.x = cvtpk(bflo(lo.x) * e, bfhi(lo.x) * e); w.y = cvtpk(bflo(lo.y) * e, bfhi(lo.y) * e); w.z = cvtpk(bflo(hi2.x) * e, bfhi(hi2.x) * e); w.w = cvtpk(bflo(hi2.y) * e, bfhi(hi2.y) * e);
            *(u32x4*)(QD + (f * 64 + lane) * 8) = w; }
#pragma unroll
        for (int k2 = 0; k2 < 2; ++k2) { const int f = 2 * wave + k2, mt2 = f >> 2, s = f & 3, dk = 32 * mt2 + r32, tk = 16 * s + 4 * hi;
            const u32x2 lo = *(const u32x2*)(KT + dk * KT_S + tk), hi2 = *(const u32x2*)(KT + dk * KT_S + tk + 8);
            float e[8];
#pragma unroll
            for (int q = 0; q < 4; ++q) { e[q] = __expf(glast - gc_s[tk + q]); e[4 + q] = __expf(glast - gc_s[tk + 8 + q]); }
            u32x4 w; w.x = cvtpk(bflo(lo.x) * e[0], bfhi(lo.x) * e[1]); w.y = cvtpk(bflo(lo.y) * e[2], bfhi(lo.y) * e[3]); w.z = cvtpk(bflo(hi2.x) * e[4], bfhi(hi2.x) * e[5]); w.w = cvtpk(bflo(hi2.y) * e[6], bfhi(hi2.y) * e[7]);
            *(u32x4*)(KD + (f * 64 + lane) * 8) = w; }
    }
    __syncthreads();
    if (tid < 64) { const int blk = tid >> 4, col = tid & 15, o = 16 * blk; float x[16];
#pragma unroll
        for (int i = 0; i < 16; ++i) { float a = (i == col) ? 1.f : 0.f;
#pragma unroll
            for (int j = 0; j < i; ++j) a -= Nm[(o + i) * NM_S + o + j] * x[j];
            x[i] = a; }
#pragma unroll
        for (int i = 0; i < 16; ++i) { Tm[(o + i) * NM_S + o + col] = x[i]; if (!(blk & 1)) Tm[(o + i) * NM_S + o + 16 + col] = 0.f; } }
    __syncthreads();
    { const int pb = tid >> 8, r = (tid >> 4) & 15, c = tid & 15, oi = 32 * pb + 16, oj = 32 * pb; float a = 0.f;
#pragma unroll
        for (int k = 0; k < 16; ++k) a += Nm[(oi + r) * NM_S + oj + k] * Tm[(oj + k) * NM_S + oj + c];
        Pm[pb * 272 + r * 17 + c] = a; }
    __syncthreads();
    { const int pb = tid >> 8, r = (tid >> 4) & 15, c = tid & 15, oi = 32 * pb + 16, oj = 32 * pb; float a = 0.f;
#pragma unroll
        for (int k = 0; k < 16; ++k) a -= Tm[(oi + r) * NM_S + oi + k] * Pm[pb * 272 + k * 17 + c];
        Tm[(oi + r) * NM_S + oj + c] = a; }
    __syncthreads();
    { const int r = tid >> 4, c = tid & 15; float a0 = 0.f, a1 = 0.f;
#pragma unroll 8
        for (int k = 0; k < 32; ++k) { const float nv = Nm[(32 + r) * NM_S + k]; a0 += nv * Tm[k * NM_S + c]; a1 += nv * Tm[k * NM_S + c + 16]; }
        Pm[r * 36 + c] = a0; Pm[r * 36 + c + 16] = a1; }
    __syncthreads();
    { const int r = tid >> 4, c = tid & 15; float a0 = 0.f, a1 = 0.f;
#pragma unroll 8
        for (int k = 0; k < 32; ++k) { const float tv = Tm[(32 + r) * NM_S + 32 + k]; a0 -= tv * Pm[k * 36 + c]; a1 -= tv * Pm[k * 36 + c + 16]; }
        Tm[(32 + r) * NM_S + c] = a0; Tm[(32 + r) * NM_S + c + 16] = a1; }
    __syncthreads();
    { const int i = tid >> 3, j0 = (tid & 7) * 8; float tu[8], tw[8];
#pragma unroll
        for (int q = 0; q < 8; ++q) { const int j = j0 + q; const float t = (i < 32 && j >= 32) ? 0.f : Tm[i * NM_S + j]; tu[q] = t * beta_s[j]; tw[q] = t * begc_s[j]; }
        *(u32x4*)(Tu + i * KT_S + j0) = (u32x4){cvtpk(tu[0], tu[1]), cvtpk(tu[2], tu[3]), cvtpk(tu[4], tu[5]), cvtpk(tu[6], tu[7])};
        *(u32x4*)(Tw + i * KT_S + j0) = (u32x4){cvtpk(tw[0], tw[1]), cvtpk(tw[2], tw[3]), cvtpk(tw[4], tw[5]), cvtpk(tw[6], tw[7])}; }
    __syncthreads();
    { const int mt = wave >> 2, nt = wave & 3;
        f32x16 c;
#pragma unroll
        for (int r = 0; r < 16; ++r) c[r] = 0.f;
        const bf16_t* ap = Tu + (32 * mt + r32) * KT_S + 8 * hi; const bf16_t* bp = VT + (32 * nt + r32) * KT_S + 8 * hi;
#pragma unroll
        for (int s = 0; s < 4; ++s) c = MFMA32(*(const bf16x8*)(ap + 16 * s), *(const bf16x8*)(bp + 16 * s), c);
        bf16_t* U = (bf16_t*)(dnb + DN_U);
        *(bf16x8*)(U + ((nt * 4 + mt * 2) * 64 + lane) * 8) = pack8(c, 0); *(bf16x8*)(U + ((nt * 4 + mt * 2 + 1) * 64 + lane) * 8) = pack8(c, 8);
    }
    { const int mt = wave >> 1, nt = wave & 1;
        f32x16 c;
#pragma unroll
        for (int r = 0; r < 16; ++r) c[r] = 0.f;
        const bf16_t* ap = KT + (32 * mt + r32) * KT_S + 8 * hi; const bf16_t* bp = Tw + (32 * nt + r32) * KT_S + 8 * hi;
#pragma unroll
        for (int s = 0; s < 4; ++s) c = MFMA32(*(const bf16x8*)(ap + 16 * s), *(const bf16x8*)(bp + 16 * s), c);
#pragma unroll
        for (int r = 0; r < 16; ++r) c[r] = -c[r];
        bf16_t* WN = (bf16_t*)(dnb + DN_WN);
        *(bf16x8*)(WN + ((nt * 8 + 2 * mt) * 64 + lane) * 8) = pack8(c, 0); *(bf16x8*)(WN + ((nt * 8 + 2 * mt + 1) * 64 + lane) * 8) = pack8(c, 8);
    }
    __syncthreads();
}
__device__ __forceinline__ void kv_unit(const Frame& F, int u) {
    THREAD_IDS();
    const int bh = u >> 2, s0 = (u & 3) * 512, b = bh >> 3, h = bh & 7;
    bf16_t* kt = (bf16_t*)F.lds; bf16_t* vt = kt + 512 * 64;
    const bf16_t* HP = WSP(const bf16_t, WS_HP);
#pragma unroll
    for (int it = 0; it < 8; ++it) { const int idx = it * NTHREADS + tid, r = idx >> 3, c8 = (idx & 7) * 8;
        const bf16_t* src = HP + ((size_t)b * SEQ + s0 + r) * HPW + h * 64 + c8;
        const int sw = r * 64 + (((c8 >> 3) ^ (r & 7)) << 3);
        *(u32x4*)(kt + sw) = *(const u32x4*)(src + 512); *(u32x4*)(vt + sw) = *(const u32x4*)(src + 1024); }
    __syncthreads();
    const int r32 = lane & 31, hi = lane >> 5;
#pragma unroll 1
    for (int it = 0; it < 6; ++it) { const int q = it * NWAVES + wave;
        const int di = q >> 4, bi = q & 15, d = (di == 0) ? 1 : (di == 1 ? 4 : 16), nbd = 64 / d, per = 16 / d;
        const int c = bi / per, nbl = bi % per, nb = (s0 / d) / 32 + nbl;
        const size_t fbase = ((size_t)di * (T_TOK * 512)) + (((size_t)bh * 64 + c * nbd + nb) * 4) * 512 + lane * 8;
        bf16_t* kf = WSP(bf16_t, WS_KF) + fbase; bf16_t* vf = WSP(bf16_t, WS_VT) + fbase;
        const int prow = c + d * (32 * nbl + r32);
#pragma unroll
        for (int d0 = 0; d0 < 4; ++d0) *(u32x4*)(kf + d0 * 512) = *(const u32x4*)(kt + prow * 64 + (((2 * d0 + hi) ^ (prow & 7)) << 3));
#pragma unroll
        for (int eb = 0; eb < 2; ++eb)
#pragma unroll
            for (int ks = 0; ks < 2; ++ks) { unsigned w[4];
#pragma unroll
                for (int jj = 0; jj < 4; ++jj) { const int j0 = 2 * jj, j1 = 2 * jj + 1;
                    const int n0 = 32 * nbl + 16 * ks + 8 * (j0 >> 2) + 4 * hi + (j0 & 3), n1 = 32 * nbl + 16 * ks + 8 * (j1 >> 2) + 4 * hi + (j1 & 3);
                    const int ra = c + d * n0, rb = c + d * n1, ech = 4 * eb + (r32 >> 3);
                    const unsigned lo = vt[ra * 64 + ((ech ^ (ra & 7)) << 3) + (r32 & 7)], hi2 = vt[rb * 64 + ((ech ^ (rb & 7)) << 3) + (r32 & 7)]; w[jj] = lo | (hi2 << 16); }
                *(u32x4*)(vf + (eb * 2 + ks) * 512) = (u32x4){w[0], w[1], w[2], w[3]}; }
    }
    __syncthreads();
}

constexpr int SCAN_BUF = 73728;
__device__ __forceinline__ void scan_stage4(const unsigned char* dnb, int wv, LAS unsigned char* buf, int lane) {
    const unsigned char* src = dnb + wv * 18432 + lane * 16; LAS unsigned char* dst = buf + wv * 18432;
#pragma unroll 1
    for (int f = 0; f < 18; ++f) __builtin_amdgcn_global_load_lds((const unsigned*)(src + f * 1024), (LAS unsigned*)(dst + f * 1024), 16, 0, 0);
}
__device__ __forceinline__ void scan_unit4(const Frame& F, int bh, int sl) {
    THREAD_IDS();
    const int r32 = lane & 31, hi = lane >> 5;
    const int b = bh >> 2, h = bh & 3;
    LAS unsigned char* lds3 = (LAS unsigned char*)F.lds;
    volatile LAS unsigned* sbar = (volatile LAS unsigned*)(lds3 + LDS_MISC + 4096 + 64);
    f32x16 S[4];
#pragma unroll
    for (int mt = 0; mt < 4; ++mt)
#pragma unroll
        for (int r = 0; r < 16; ++r) S[mt][r] = 0.f;
    bf16_t* ORAW = WSP(bf16_t, WS_ORAW);
    const int ch0 = bh * 32;
    scan_stage4(F.ws + WS_DN + (size_t)ch0 * DN_STRIDE, sl, lds3, lane);
#pragma unroll 1
    for (int n = 0; n < 32; ++n) {
        const int ch = ch0 + n;
        LAS unsigned char* buf = lds3 + (n & 1) * SCAN_BUF;
        float eg = WSP(const float, WS_EG)[ch];
        asm volatile("s_waitcnt vmcnt(0) lgkmcnt(0)" : "+v"(eg) :: "memory");
        if (lane == 0) __hip_atomic_fetch_add((LAS unsigned*)sbar, 1u, __ATOMIC_RELAXED, __HIP_MEMORY_SCOPE_WORKGROUP);
        { const unsigned want = 4u * (unsigned)(n + 1); while (*sbar < want) __builtin_amdgcn_s_sleep(1); }
        asm volatile("" ::: "memory");
        if (n + 1 < 32) scan_stage4(F.ws + WS_DN + (size_t)(ch + 1) * DN_STRIDE, sl, lds3 + ((n + 1) & 1) * SCAN_BUF, lane);
        const LAS unsigned char* fb = buf + lane * 16;
        bf16x8 Sb[8];
#pragma unroll
        for (int mt = 0; mt < 4; ++mt) { Sb[2 * mt] = pack8(S[mt], 0); Sb[2 * mt + 1] = pack8(S[mt], 8); }
        f32x16 vn[2], o[2];
#pragma unroll
        for (int m2 = 0; m2 < 2; ++m2) {
#pragma unroll
            for (int r8 = 0; r8 < 2; ++r8) { const u32x4 uu = *(const LAS u32x4*)(fb + 57344 + (sl * 4 + m2 * 2 + r8) * 1024);
                vn[m2][8 * r8] = bflo(uu.x); vn[m2][8 * r8 + 1] = bfhi(uu.x); vn[m2][8 * r8 + 2] = bflo(uu.y); vn[m2][8 * r8 + 3] = bfhi(uu.y);
                vn[m2][8 * r8 + 4] = bflo(uu.z); vn[m2][8 * r8 + 5] = bfhi(uu.z); vn[m2][8 * r8 + 6] = bflo(uu.w); vn[m2][8 * r8 + 7] = bfhi(uu.w); }
#pragma unroll
            for (int s = 0; s < 8; ++s) { const bf16x8 a = *(const LAS bf16x8*)(fb + (m2 * 8 + s) * 1024); vn[m2] = MFMA32(a, Sb[s], vn[m2]); }
            __builtin_amdgcn_sched_barrier(0);
#pragma unroll
            for (int r = 0; r < 16; ++r) o[m2][r] = 0.f;
#pragma unroll
            for (int s = 0; s < 8; ++s) { const bf16x8 a = *(const LAS bf16x8*)(fb + 16384 + (m2 * 8 + s) * 1024); o[m2] = MFMA32(a, Sb[s], o[m2]); }
            __builtin_amdgcn_sched_barrier(0);
        }
        bf16x8 vb[4];
#pragma unroll
        for (int m2 = 0; m2 < 2; ++m2) { vb[2 * m2] = pack8(vn[m2], 0); vb[2 * m2 + 1] = pack8(vn[m2], 8); }
#pragma unroll
        for (int m2 = 0; m2 < 2; ++m2) {
#pragma unroll
            for (int s = 0; s < 4; ++s) { const bf16x8 a = *(const LAS bf16x8*)(fb + 32768 + (m2 * 4 + s) * 1024); o[m2] = MFMA32(a, vb[s], o[m2]); }
#pragma unroll
            for (int r = 0; r < 16; ++r) ORAW[((size_t)b * SEQ + 64 * n + 32 * m2 + crow(r, hi)) * 512 + h * 128 + 32 * sl + r32] = f2bf(o[m2][r]);
            __builtin_amdgcn_sched_barrier(0);
        }
#pragma unroll
        for (int mt = 0; mt < 4; ++mt) {
#pragma unroll
            for (int r = 0; r < 16; ++r) S[mt][r] *= eg;
#pragma unroll
            for (int s = 0; s < 4; ++s) { const bf16x8 a = *(const LAS bf16x8*)(fb + 40960 + (mt * 4 + s) * 1024); S[mt] = MFMA32(a, vb[s], S[mt]); }
            if (mt & 1) __builtin_amdgcn_sched_barrier(0);
        }
    }
    asm volatile("s_waitcnt vmcnt(0) lgkmcnt(0)" ::: "memory");
}
__device__ __forceinline__ void attn_block(const bf16x8 (&kc)[4], const bf16x8 (&vc)[4], const bf16x8 (&qr)[4], f32x16 (&o)[2], float& m_run, float& l_run, int dn0  ) {
    f32x16 s;
#pragma unroll
    for (int r = 0; r < 16; ++r) s[r] = 0.f;
#pragma unroll
    for (int d0 = 0; d0 < 4; ++d0) s = MFMA32(kc[d0], qr[d0], s);
#pragma unroll
    for (int r = 0; r < 16; ++r) { const unsigned dlt = (unsigned)(dn0 - ((r & 3) + 8 * (r >> 2))); s[r] = (dlt <= 128u) ? s[r] : -INFINITY; }
    float mb = fmaxf(fmaxf(s[0], s[1]), fmaxf(s[2], s[3]));
#pragma unroll
    for (int r = 4; r < 16; r += 4) mb = fmaxf(mb, fmaxf(fmaxf(s[r], s[r + 1]), fmaxf(s[r + 2], s[r + 3])));
    { auto rr = __builtin_amdgcn_permlane32_swap(__float_as_uint(mb), __float_as_uint(mb), false, false); mb = fmaxf(__uint_as_float(rr[0]), __uint_as_float(rr[1])); }
    const float mn = fmaxf(m_run, mb);
    {
        const float al = __builtin_amdgcn_exp2f(m_run - mn);
        l_run *= al; m_run = mn;
#pragma unroll
        for (int eb = 0; eb < 2; ++eb)
#pragma unroll
            for (int r = 0; r < 16; ++r) o[eb][r] *= al;
    }
    float ps = 0.f;
#pragma unroll
    for (int r = 0; r < 16; ++r) { s[r] = __builtin_amdgcn_exp2f(s[r] - mn); ps += s[r]; }
    l_run += ps;
    const bf16x8 pb0 = pack8(s, 0), pb1 = pack8(s, 8);
#pragma unroll
    for (int eb = 0; eb < 2; ++eb)
#pragma unroll
        for (int ks = 0; ks < 2; ++ks) o[eb] = MFMA32(vc[eb * 2 + ks], ks ? pb1 : pb0, o[eb]);
}
template <int D_>
__device__ __forceinline__ void attn_branch(const Frame& F, int di, int b, int h, int t0, int jq, const bf16x8 (&qr)[4], f32x16 (&o)[2], float& m_run, float& l_run) {
    THREAD_IDS();
    const int r32 = lane & 31, hi = lane >> 5;
    constexpr int STEP = 16 / D_, NBD = 64 / D_;
    const int c = t0 % D_, a0 = t0 / D_;
    const int nq = a0 + STEP * (32 * jq + r32);
    const int nq_lo = a0 + STEP * (32 * jq), nq_hi = a0 + STEP * (32 * jq + 31);
    const int n_lo = (nq_lo - 128) > 0 ? (nq_lo - 128) : 0;
    const size_t fbase = ((size_t)di * (T_TOK * 512)) + (((size_t)(b * 8 + h) * 64 + c * NBD) * 4) * 512;
    const unsigned char* KF = (const unsigned char*)(WSP(const bf16_t, WS_KF) + fbase); const unsigned char* VF = (const unsigned char*)(WSP(const bf16_t, WS_VT) + fbase);
    const unsigned loff = (unsigned)lane * 16u;
    const int nb0 = n_lo >> 5, nb1 = nq_hi >> 5;
    const int dq = nq - 4 * hi;
#define ATT_LOAD(KX, VX, NB) do { const int nb_ = (NB) < nb1 ? (NB) : nb1; _Pragma("unroll") for (int f = 0; f < 4; ++f) { const unsigned off = (unsigned)nb_ * 4096u + loff + f * 1024; KX[f] = *(const bf16x8*)(KF + off); VX[f] = *(const bf16x8*)(VF + off); } } while (0)
    bf16x8 kA[4], vA[4], kB[4], vB[4], kC[4], vC[4];
    ATT_LOAD(kA, vA, nb0); ATT_LOAD(kB, vB, nb0 + 1);
#pragma unroll 1
    for (int nb = nb0; nb <= nb1; nb += 3) {
        ATT_LOAD(kC, vC, nb + 2);
        attn_block(kA, vA, qr, o, m_run, l_run, dq - 32 * nb);
        if (nb + 1 > nb1) break;
        ATT_LOAD(kA, vA, nb + 3);
        attn_block(kB, vB, qr, o, m_run, l_run, dq - 32 * (nb + 1));
        if (nb + 2 > nb1) break;
        ATT_LOAD(kB, vB, nb + 4);
        attn_block(kC, vC, qr, o, m_run, l_run, dq - 32 * (nb + 2));
    }
#undef ATT_LOAD
}
__device__ __forceinline__ void attn_task(const Frame& F, int a) {
    THREAD_IDS();
    const int r32 = lane & 31, hi = lane >> 5;
    const int x = F.blk & 7, bh = x + 8 * (a >> 6), tw = a & 63, t0 = tw & 15, jq = 3 - (tw >> 4), b = bh >> 3, h = bh & 7;
    const int tq = t0 + 16 * (32 * jq + r32);
    const bf16_t* HP = WSP(const bf16_t, WS_HP);
    bf16x8 qr[4];
#pragma unroll
    for (int d0 = 0; d0 < 4; ++d0) { const u32x4 qw = *(const u32x4*)(HP + ((size_t)b * SEQ + tq) * HPW + h * 64 + 16 * d0 + 8 * hi);
        constexpr float SCQ = 0.125f * 1.4426950408889634f; u32x4 w;
        w.x = cvtpk(bflo(qw.x) * SCQ, bfhi(qw.x) * SCQ); w.y = cvtpk(bflo(qw.y) * SCQ, bfhi(qw.y) * SCQ); w.z = cvtpk(bflo(qw.z) * SCQ, bfhi(qw.z) * SCQ); w.w = cvtpk(bflo(qw.w) * SCQ, bfhi(qw.w) * SCQ);
        qr[d0] = __builtin_bit_cast(bf16x8, w); }
    f32x16 o[2];
#pragma unroll
    for (int eb = 0; eb < 2; ++eb)
#pragma unroll
        for (int r = 0; r < 16; ++r) o[eb][r] = 0.f;
    float m_run = -1e30f, l_run = 0.f;
    attn_branch<1>(F, 0, b, h, t0, jq, qr, o, m_run, l_run);
    attn_branch<4>(F, 1, b, h, t0, jq, qr, o, m_run, l_run);
    attn_branch<16>(F, 2, b, h, t0, jq, qr, o, m_run, l_run);
    const float lt = sum_x32(l_run, l_run), inv = 1.f / lt;
    bf16_t* dst = WSP(bf16_t, WS_MIX) + ((size_t)b * SEQ + tq) * DM + h * 64;
#pragma unroll
    for (int eb = 0; eb < 2; ++eb)
#pragma unroll
        for (int g = 0; g < 4; ++g) { u32x2 w; w.x = cvtpk(o[eb][4 * g] * inv, o[eb][4 * g + 1] * inv); w.y = cvtpk(o[eb][4 * g + 2] * inv, o[eb][4 * g + 3] * inv);
            *(u32x2*)(dst + 32 * eb + 8 * g + 4 * hi) = w; }
}
__device__ __forceinline__ void phase3(const Frame& F, int flags) {
    THREAD_IDS();
    if (tid == 0) *(volatile LAS unsigned*)((LAS unsigned char*)F.lds + LDS_MISC + 4096 + 64) = 0u;
    __syncthreads();
    if (F.blk < 64 && wave < 4 && !(flags & 1)) scan_unit4(F, F.blk, wave);
    unsigned* qctr = WSP(unsigned, WS_CTL) + 1024 + (F.blk & 7) * 32;
    if (wave == 7) { moe_weight_stream(F, F.blk, F.G, lane); return; }
    if (flags & 2) return;
    for (;;) {
        unsigned a = 0; if (lane == 0) a = atomicAdd(qctr, 1u);
        a = (unsigned)__builtin_amdgcn_readfirstlane((int)a);
        if (a >= 1024u) break;
        attn_task(F, (int)a);
    }
}

__device__ __forceinline__ void phase4(const Frame& F) {
    THREAD_IDS();
    const float* in_gnorm_w = inptr(6);
    const int gw = F.blk * NWAVES + wave, NGW = F.G * NWAVES;
    const bf16_t* ORAW = WSP(const bf16_t, WS_ORAW); const bf16_t* HP = WSP(const bf16_t, WS_HP); bf16_t* MIX = WSP(bf16_t, WS_MIX);
    const f32x4 gw0 = *(const f32x4*)(in_gnorm_w + (lane & 15) * 8), gw1 = *(const f32x4*)(in_gnorm_w + (lane & 15) * 8 + 4);
    for (int row = gw; row < T_TOK; row += NGW) {
        const u32x4 ow = *(const u32x4*)(ORAW + (size_t)row * 512 + lane * 8), zw = *(const u32x4*)(HP + (size_t)row * HPW + 3072 + lane * 8);
        f32x4 oa, ob, za, zb; pg8::unpack8(ow, oa, ob); pg8::unpack8(zw, za, zb);
        float ss = oa[0] * oa[0] + oa[1] * oa[1] + oa[2] * oa[2] + oa[3] * oa[3] + ob[0] * ob[0] + ob[1] * ob[1] + ob[2] * ob[2] + ob[3] * ob[3];
        ss += dppf<0xB1>(ss); ss += dppf<0x4E>(ss); ss += dppf<0x141>(ss); ss += dppf<0x128>(ss);
        const float r = rsqrtf(ss * (1.f / 128.f) + 1e-6f);
        f32x4 ya, yb;
#pragma unroll
        for (int j = 0; j < 4; ++j) { ya[j] = oa[j] * r * gw0[j] * (za[j] * sigm(za[j])); yb[j] = ob[j] * r * gw1[j] * (zb[j] * sigm(zb[j])); }
        *(u32x4*)(MIX + (size_t)row * DM + 512 + lane * 8) = pg8::pack_row8(ya, yb);
    }
}

__device__ __forceinline__ void phase6(const Frame& F) {
    THREAD_IDS();
    const float* in_ln1_g = inptr(8); const float* in_ln1_b = inptr(9); const float* in_b_router = inptr(11);
    float* wrt = (float*)F.lds;
    { const f32x4* src = WSP(const f32x4, WS_WRT); f32x4* dst = (f32x4*)wrt; for (int i = tid; i < 8192; i += NTHREADS) dst[i] = src[i]; }
    __syncthreads();
    const int gw = F.blk * NWAVES + wave, NGW = F.G * NWAVES;
    bf16_t* X1 = WSP(bf16_t, WS_X1);
    unsigned* cnt = WSP(unsigned, WS_CTL); int* rt_e = WSP(int, WS_ROUTE); int* rt_s = rt_e + T_TOK * 4; int* ltok = WSP(int, WS_LTOK); float* lgate = WSP(float, WS_LGATE);
    int* s_cnt = (int*)(F.lds + LDS_MISC + 4096); int* s_base = s_cnt + 32; int* s_e = s_base + 32; float* s_g = (float*)(s_e + 512); int* s_li = (int*)(s_g + 512);
    if (tid < 32) s_cnt[tid] = 0;
    __syncthreads();
    int irow = 0;
    f32x4 lg[4], lb[4];
#pragma unroll
    for (int j = 0; j < 4; ++j) { lg[j] = *(const f32x4*)(in_ln1_g + 4 * lane + 256 * j); lb[j] = *(const f32x4*)(in_ln1_b + 4 * lane + 256 * j); }
    const float brl = in_b_router[((lane >> 5) & 1) * 16 + ((lane >> 4) & 1) * 8 + ((lane >> 3) & 1) * 4 + ((lane >> 2) & 1) * 2 + ((lane >> 1) & 1)];
    u32x2 rawn[4];
#pragma unroll
    for (int j = 0; j < 4; ++j) rawn[j] = ((const u32x2*)(X1 + (size_t)gw * DM) + lane)[64 * j];
    for (int row = gw; row < T_TOK && irow < 16; row += NGW, ++irow) {
        u32x2* xr = (u32x2*)(X1 + (size_t)row * DM) + lane;
        u32x2 raw[4];
#pragma unroll
        for (int j = 0; j < 4; ++j) raw[j] = rawn[j];
        { const int rn = (row + NGW < T_TOK) ? row + NGW : row;
#pragma unroll
            for (int j = 0; j < 4; ++j) rawn[j] = ((const u32x2*)(X1 + (size_t)rn * DM) + lane)[64 * j]; }
        f32x4 v[4]; float s = 0.f;
#pragma unroll
        for (int j = 0; j < 4; ++j) { const u32x2 w = raw[j]; v[j] = (f32x4){bflo(w.x), bfhi(w.x), bflo(w.y), bfhi(w.y)}; s += (v[j][0] + v[j][1]) + (v[j][2] + v[j][3]); }
        const float mean = wave_sum(s) * (1.f / DM); float s2 = 0.f;
#pragma unroll
        for (int j = 0; j < 4; ++j) { v[j] = v[j] - mean; s2 += (v[j][0] * v[j][0] + v[j][1] * v[j][1]) + (v[j][2] * v[j][2] + v[j][3] * v[j][3]); }
        const float rstd = rsqrtf(wave_sum(s2) * (1.f / DM) + LN_EPS);
#pragma unroll
        for (int j = 0; j < 4; ++j) { v[j] = v[j] * rstd * lg[j] + lb[j]; u32x2 w; w.x = cvtpk(v[j][0], v[j][1]); w.y = cvtpk(v[j][2], v[j][3]); xr[64 * j] = w;
            (WSP(unsigned, WS_X1F) + (size_t)row * 256)[lane + 64 * j] = pk4_fp8(v[j][0], v[j][1], v[j][2], v[j][3]); }
        float pl[32];
#pragma unroll
        for (int e = 0; e < 32; ++e) { float a = 0.f;
#pragma unroll
            for (int j = 0; j < 4; ++j) { const f32x4 w = *(const f32x4*)(wrt + e * 1024 + 4 * lane + 256 * j); a += v[j][0] * w[0] + v[j][1] * w[1] + v[j][2] * w[2] + v[j][3] * w[3]; }
            pl[e] = a; if ((e & 3) == 3) asm volatile("" ::: "memory"); }
        float q16[16], q8[8], q4[4], q2[2];
#pragma unroll
        for (int k = 0; k < 16; ++k) q16[k] = sum_x32(pl[k], pl[k + 16]);
#pragma unroll
        for (int k = 0; k < 8; ++k) q8[k] = sum_x16(q16[k], q16[k + 8]);
        { const bool up = (lane & 8) != 0;
#pragma unroll
            for (int k = 0; k < 4; ++k) { const float keep = up ? q8[k + 4] : q8[k], send = up ? q8[k] : q8[k + 4]; q4[k] = keep + dppf<0x128>(send); } }
        { const bool up = (lane & 4) != 0;
#pragma unroll
            for (int k = 0; k < 2; ++k) { const float keep = up ? q4[k + 2] : q4[k], send = up ? q4[k] : q4[k + 2]; q2[k] = keep + dppf<0x141>(send); } }
        float lgt;
        { const bool up = (lane & 2) != 0; const float keep = up ? q2[1] : q2[0], send = up ? q2[0] : q2[1]; lgt = keep + dppf<0x4E>(send); }
        lgt += dppf<0xB1>(lgt);
        const int my_e = ((lane >> 5) & 1) * 16 + ((lane >> 4) & 1) * 8 + ((lane >> 3) & 1) * 4 + ((lane >> 2) & 1) * 2 + ((lane >> 1) & 1);
        lgt += brl;
        int rank = 0;
#pragma unroll
        for (int e = 0; e < 32; ++e) { const int src = ((e >> 4) & 1) * 32 + ((e >> 3) & 1) * 16 + ((e >> 2) & 1) * 8 + ((e >> 1) & 1) * 4 + (e & 1) * 2;
            const float ve = __uint_as_float((unsigned)__builtin_amdgcn_readlane((int)__float_as_uint(lgt), src));
            rank += (ve > lgt || (ve == lgt && e < my_e)) ? 1 : 0;
            if ((e & 7) == 7) __builtin_amdgcn_sched_barrier(0); }
        float tv[4]; int te[4];
#pragma unroll
        for (int k = 0; k < 4; ++k) { const unsigned long long mk = __ballot(rank == k && (lane & 1) == 0); const int src = (int)__builtin_ctzll(mk);
            tv[k] = __uint_as_float((unsigned)__builtin_amdgcn_readlane((int)__float_as_uint(lgt), src)); te[k] = __builtin_amdgcn_readlane(my_e, src); }
        const float e1 = __expf(tv[1] - tv[0]), e2 = __expf(tv[2] - tv[0]), e3 = __expf(tv[3] - tv[0]), inv = 1.f / (1.f + e1 + e2 + e3);
        if (lane < 4) { const int ek = lane == 0 ? te[0] : (lane == 1 ? te[1] : (lane == 2 ? te[2] : te[3]));
            const float gk = (lane == 0 ? 1.f : (lane == 1 ? e1 : (lane == 2 ? e2 : e3))) * inv;
            const int li = atomicAdd(s_cnt + ek, 1);
            const int q = (wave * 16 + irow) * 4 + lane; s_e[q] = ek; s_g[q] = gk; s_li[q] = li; }
    }
    __syncthreads();
    if (tid < 32) s_base[tid] = (int)atomicAdd(cnt + tid * 32, (unsigned)s_cnt[tid]);
    __syncthreads();
    { const int lr = tid >> 2, k = tid & 3, wv = lr >> 4, i = lr & 15;
        const int row = (F.blk * NWAVES + wv) + i * NGW;
        if (row < T_TOK) { const int ek = s_e[tid], slot = s_base[ek] + s_li[tid];
            ltok[(size_t)ek * LCAP + slot] = row; lgate[(size_t)ek * LCAP + slot] = s_g[tid]; rt_e[row * 4 + k] = ek; rt_s[row * 4 + k] = slot; } }
}
constexpr int ULIST_OFF = LDS_MISC + 1024, ULIST_MAX = 60;
__device__ __forceinline__ void build_tpre(const Frame& F, int nN, int ndense = 0) {
    THREAD_IDS();
    int* tpre = (int*)(F.lds + LDS_MISC); int* cnts = tpre + 64; int* ulist = (int*)(F.lds + ULIST_OFF);
    __syncthreads();
    if (tid == 0) { const unsigned* cnt = WSP(const unsigned, WS_CTL); int acc = 0;
        for (int e = 0; e < NEXP; ++e) { const int c = (int)__hip_atomic_load(cnt + e * 32, __ATOMIC_RELAXED, __HIP_MEMORY_SCOPE_AGENT); tpre[e] = acc; cnts[e] = c; acc += (c + 255) >> 8; }
        tpre[NEXP] = acc;
        if (nN > 0) { const int totale = acc * nN, total = totale + ndense; int i = 0;
            for (; i < ULIST_MAX; ++i) { const int L = pg8::unit_index(i, F.blk, F.G, total); if (L < 0) break;
                if (L >= totale) { const int l = L - totale, gid = l / 32, w = l - gid * 32;
                    ulist[4 * i] = 255 | ((w / 8) << 8); ulist[4 * i + 1] = gid * 8 + w % 8; ulist[4 * i + 2] = gid * 8 + w % 8; ulist[4 * i + 3] = 256; continue; }
                int e = 0; for (int k = 1; k < NEXP; ++k) if (L >= tpre[k] * nN) e = k;
                const int tp0 = tpre[e], tiles = tpre[e + 1] - tp0, l = L - tp0 * nN, nig = 8 * nN, gid = l / nig, fm = gid * 8, gsz = (tiles - fm) < 8 ? (tiles - fm) : 8, w = l - gid * nig;
                const int pn = w / gsz, pl = fm + w % gsz, rr = cnts[e] - 256 * pl;
                ulist[4 * i] = e | (pn << 8); ulist[4 * i + 1] = pl; ulist[4 * i + 2] = tp0 + pl; ulist[4 * i + 3] = rr < 256 ? rr : 256; }
            ulist[4 * i + 3] = 0; }
    }
    __syncthreads();
}

__device__ __forceinline__ void phase9(const Frame& F) {
    THREAD_IDS();
    const float* in_ln2_g = inptr(19); const float* in_ln2_b = inptr(20);
    build_tpre(F, 0);
    const int* tpre = (const int*)(F.lds + LDS_MISC);
    const int gw = F.blk * NWAVES + wave, NGW = F.G * NWAVES;
    const bf16_t* X1 = WSP(const bf16_t, WS_X1); const bf16_t* PLE = WSP(const bf16_t, WS_PLE); const unsigned char* YB = WSP(const unsigned char, WS_YB);
    const int* rt_e = WSP(const int, WS_ROUTE); const int* rt_s = rt_e + T_TOK * 4;
    f32x4 lg[4], lb[4];
#pragma unroll
    for (int j = 0; j < 4; ++j) { lg[j] = *(const f32x4*)(in_ln2_g + 4 * lane + 256 * j); lb[j] = *(const f32x4*)(in_ln2_b + 4 * lane + 256 * j); }
    for (int row = gw; row < T_TOK; row += NGW) {
        const u32x2* xr = (const u32x2*)(X1 + (size_t)row * DM) + lane; const u32x2* pr = (const u32x2*)(PLE + (size_t)row * DM) + lane;
        f32x4 v[4];
#pragma unroll
        for (int j = 0; j < 4; ++j) { const u32x2 w = xr[64 * j], q = pr[64 * j];
            v[j] = (f32x4){bflo(w.x), bfhi(w.x), bflo(w.y), bfhi(w.y)} * ALPHA + (f32x4){bflo(q.x), bfhi(q.x), bflo(q.y), bfhi(q.y)}; }
#pragma unroll
        for (int k = 0; k < 4; ++k) { const int e = rt_e[row * 4 + k], sl = rt_s[row * 4 + k]; const size_t R = (size_t)tpre[e] * 256 + sl;
            const unsigned* yr = (const unsigned*)(YB + R * DM) + lane;
#pragma unroll
            for (int j = 0; j < 4; ++j) { const int w = (int)yr[64 * j]; const f32x2_t lo = __builtin_amdgcn_cvt_pk_f32_fp8(w, false), hi2 = __builtin_amdgcn_cvt_pk_f32_fp8(w, true); v[j] = v[j] + (f32x4){lo[0], lo[1], hi2[0], hi2[1]}; } }
        float s = 0.f;
#pragma unroll
        for (int j = 0; j < 4; ++j) s += (v[j][0] + v[j][1]) + (v[j][2] + v[j][3]);
        const float mean = wave_sum(s) * (1.f / DM); float s2 = 0.f;
#pragma unroll
        for (int j = 0; j < 4; ++j) { v[j] = v[j] - mean; s2 += (v[j][0] * v[j][0] + v[j][1] * v[j][1]) + (v[j][2] * v[j][2] + v[j][3] * v[j][3]); }
        const float rstd = rsqrtf(wave_sum(s2) * (1.f / DM) + LN_EPS);
        f32x4* orow = (f32x4*)(F.out + (size_t)row * DM) + lane;
#pragma unroll
        for (int j = 0; j < 4; ++j) orow[64 * j] = v[j] * rstd * lg[j] + lb[j];
    }
}

constexpr int N_PHASES = 10;
__global__ void __launch_bounds__(NTHREADS, 2) fwd_kernel(Args args) {
    extern __shared__ __attribute__((aligned(16))) unsigned char lds_raw[];
    Frame F;
    F.lds = lds_raw; F.G = gridDim.x; F.blk = blockIdx.x;
    F.out = args.out; F.ws = args.ws;
    LAS unsigned char* lds3 = (LAS unsigned char*)lds_raw;
    const int lo = args.ph_lo, hi = args.ph_hi;
#if ONE_LAUNCH
    if (threadIdx.x < 2) ((LAS unsigned*)(lds3 + LDS_BARST))[threadIdx.x] = 0u;
    __syncthreads();
    XcdBarrier xbar = xcd_barrier_post(WSP(unsigned, WS_CTL) + CW_BAR, (volatile LAS unsigned*)(lds3 + LDS_BARST));
#define SEAM(k) do { if (lo <= (k) && (k) + 1 < hi) xcd_barrier(xbar); } while (0)
#else
#define SEAM(k) do { } while (0)
#endif
#ifndef PHASE_MASK
#define PHASE_MASK 0x3ff
#endif
#define IN(k) (((PHASE_MASK >> (k)) & 1) && lo <= (k) && (k) < hi)
#define REPS(k) 1
#if ONE_LAUNCH
#define REPSYNC() xcd_barrier(xbar)
#else
#define REPSYNC() do { } while (0)
#endif
    if (IN(0)) { for (int rep = 0; rep < REPS(0); ++rep) { if (rep) REPSYNC(); phase0(F); } SEAM(0); }
    if (IN(1)) {
        for (int rep = 0; rep < REPS(1); ++rep) { if (rep) REPSYNC();
        pg8::DenseSched S{(const char*)WSP(bf16_t, WS_XB), (const char*)WSP(bf16_t, WS_WIN), T_TOK / 256, HPW / 256, 1024, F.blk, F.G};
        pg8::EpiStore E{WSP(bf16_t, WS_HP), HPW};
        pg8::gemm_phase<false>(lds3, 1024, S, E); }
        SEAM(1);
    }
    if (IN(2)) {
        for (int rep = 0; rep < REPS(2); ++rep) { if (rep) REPSYNC();
        for (int u = F.blk; u < 2048 + 512; u += F.G) { if (u < 2048) { if (!(args.flags & 4)) dn_prep_unit(F, u); } else if (!(args.flags & 8)) kv_unit(F, u - 2048); } }
        SEAM(2);
    }
    if (IN(3)) { for (int rep = 0; rep < REPS(3); ++rep) { if (rep) { REPSYNC(); if (F.blk == 0 && threadIdx.x == 0) __hip_atomic_store(WSP(unsigned, WS_CTL) + 64, 0u, __ATOMIC_RELAXED, __HIP_MEMORY_SCOPE_AGENT); REPSYNC(); } phase3(F, args.flags); } SEAM(3); }
    if (IN(4)) { for (int rep = 0; rep < REPS(4); ++rep) { if (rep) REPSYNC(); phase4(F); } SEAM(4); }
    if (IN(5)) {
        for (int rep = 0; rep < REPS(5); ++rep) { if (rep) REPSYNC();
        pg8::DenseSched S{(const char*)WSP(bf16_t, WS_MIX), (const char*)WSP(bf16_t, WS_WOUT), T_TOK / 256, DM / 256, 1024, F.blk, F.G};
        pg8::EpiResid E{WSP(bf16_t, WS_X1), WSP(const bf16_t, WS_XB)};
        pg8::gemm_phase<false>(lds3, 1024, S, E); }
        SEAM(5);
    }
    if (IN(6)) { phase6(F); SEAM(6); }
    if (IN(7)) {
        build_tpre(F, 8, 512);
        for (int rep = 0; rep < REPS(7); ++rep) { if (rep) REPSYNC();
        { pg8::MoeSched<true> S{(const char*)WSP(unsigned char, WS_X1F), (const char*)WSP(unsigned char, WS_WGU), (size_t)2048 * 1024, WSP(const int, WS_LTOK), (const LAS int*)(lds3 + ULIST_OFF), 1024, (const char*)WSP(unsigned char, WS_WPG)};
          pg8::EpiActSig E{{WSP(unsigned char, WS_ACT), inptr(13)}, {WSP(bf16_t, WS_PLE), inptr(17)}};
          pg8::gemm_phase<true>(lds3, 1024, S, E); } }
        SEAM(7);
    }
    if (IN(8)) {
        build_tpre(F, 4);
        for (int rep = 0; rep < REPS(8); ++rep) { if (rep) REPSYNC();
        { pg8::MoeSched<false> S{(const char*)WSP(unsigned char, WS_ACT), (const char*)WSP(unsigned char, WS_WD), (size_t)1024 * 1024, nullptr, (const LAS int*)(lds3 + ULIST_OFF), 1024, nullptr};
          pg8::EpiDown E{WSP(unsigned char, WS_YB), inptr(15), WSP(const float, WS_LGATE)};
          pg8::gemm_phase<true>(lds3, 1024, S, E); } }
        { pg8::DenseSched S{(const char*)WSP(bf16_t, WS_PB), (const char*)WSP(bf16_t, WS_WPP), T_TOK / 256, DM / 256, 256, F.blk, F.G};
          pg8::EpiMul E{WSP(bf16_t, WS_PLE)};
          pg8::gemm_phase<false>(lds3, 256, S, E); }
        SEAM(8);
    }
    if (IN(9)) { for (int rep = 0; rep < REPS(9); ++rep) { if (rep) REPSYNC(); phase9(F); } }

}

extern "C" void kernel_launch(void* const* d_in, const int* in_sizes, int n_in, void* d_out, int out_size, void* d_ws, size_t ws_size, hipStream_t stream) {
    static int grid = 0;
    if (grid == 0) {
        if (n_in != 21 || out_size != T_TOK * DM || ws_size < WS_END) { fprintf(stderr, "kernel_launch: unexpected problem (n_in %d, out %d, ws %zu)\n", n_in, out_size, ws_size); grid = -1; return; }
        int dev = 0, cus = 0, per_cu = 0;
        (void)hipGetDevice(&dev); (void)hipDeviceGetAttribute(&cus, hipDeviceAttributeMultiprocessorCount, dev);
        if (hipFuncSetAttribute((const void*)fwd_kernel, hipFuncAttributeMaxDynamicSharedMemorySize, LDS_BYTES) != hipSuccess) { fprintf(stderr, "kernel_launch: hipFuncSetAttribute failed\n"); grid = -1; return; }
        (void)hipOccupancyMaxActiveBlocksPerMultiprocessor(&per_cu, (const void*)fwd_kernel, NTHREADS, LDS_BYTES);
        (void)hipGetLastError();
        if (per_cu < 1) { fprintf(stderr, "kernel_launch: occupancy query says %d workgroups per CU: cannot make the grid resident\n", per_cu); grid = -1; return; }
        grid = cus;
        if (cus != 256) fprintf(stderr, "kernel_launch: built for a 256-CU device (got %d CUs)\n", cus);
    }
    if (grid < 0) return;
    (void)hipMemsetAsync((char*)d_ws + WS_CTL, 0, 32768, stream);
    Args a{};
    for (int i = 0; i < 21; ++i) a.in[i] = (const float*)d_in[i];
    a.out = (float*)d_out; a.ws = (unsigned char*)d_ws;
#if ONE_LAUNCH
    a.ph_lo = 0; a.ph_hi = N_PHASES;
    void* kargs[] = {&a};
    hipError_t e = hipLaunchCooperativeKernel((const void*)fwd_kernel, dim3(grid), dim3(NTHREADS), kargs, LDS_BYTES, stream);
    if (e != hipSuccess) fprintf(stderr, "cooperative launch failed: %s (grid %d)\n", hipGetErrorString(e), grid);
#else
    for (int ph = 0; ph < N_PHASES; ++ph) { a.ph_lo = ph; a.ph_hi = ph + 1; hipLaunchKernelGGL(fwd_kernel, dim3(grid), dim3(NTHREADS), LDS_BYTES, stream, a);
        if (ph == (PROBE_PH)) { a.flags = PROBE_FLAGS; if (ph == 3) (void)hipMemsetAsync((char*)d_ws + WS_CTL + 4096, 0, 2048, stream); hipLaunchKernelGGL(fwd_kernel, dim3(grid), dim3(NTHREADS), LDS_BYTES, stream, a); a.flags = 0; } }
#endif
}
```

```cpp
#include <hip/hip_runtime.h>
#include <cstdio>
#include <cstdint>

#ifndef PROBE_PH
#define PROBE_PH -1
#endif
#ifndef PROBE_FLAGS
#define PROBE_FLAGS 0
#endif
#ifndef ONE_LAUNCH
#define ONE_LAUNCH 1
#endif

#define LAS __attribute__((address_space(3)))
typedef unsigned short bf16_t;
typedef short bf16x8 __attribute__((ext_vector_type(8)));
typedef float f32x4 __attribute__((ext_vector_type(4)));
typedef float f32x16 __attribute__((ext_vector_type(16)));
typedef unsigned u32x4 __attribute__((ext_vector_type(4)));
typedef unsigned u32x2 __attribute__((ext_vector_type(2)));
typedef float f32x2_t __attribute__((ext_vector_type(2)));
typedef __bf16 bf16x2_t __attribute__((ext_vector_type(2)));

constexpr int T_TOK = 32768, DM = 1024, SEQ = 2048, NBATCH = 16;
constexpr int HPW = 3584, INCOLS = 3592;
constexpr int NEXP = 32, LCAP = 32768;
constexpr float ALPHA = 1.189207115002721f;
constexpr float LN_EPS = 1e-5f;
constexpr int NWAVES = 8, NTHREADS = 512;
constexpr int LDS_BYTES = 163840;
constexpr int LDS_MISC = 147456;

constexpr size_t MiB = 1u << 20;
constexpr size_t WS_CTL = 0;
constexpr size_t WS_WGU = 1 * MiB;
constexpr size_t WS_WD = 129 * MiB;
constexpr size_t WS_WIN = 193 * MiB;
constexpr size_t WS_WOUT = 200 * MiB;
constexpr size_t WS_WPG = 202 * MiB;
constexpr size_t WS_WPP = 204 * MiB;
constexpr size_t WS_WRT = 205 * MiB;
constexpr size_t WS_BA = 206 * MiB;
constexpr size_t WS_ROUTE = 207 * MiB;
constexpr size_t WS_LTOK = 208 * MiB;
constexpr size_t WS_LGATE = 212 * MiB;
constexpr size_t WS_X1 = 216 * MiB;
constexpr size_t WS_PLE = 280 * MiB;
constexpr size_t WS_PB = 344 * MiB;
constexpr size_t WS_MIX = 360 * MiB;
constexpr size_t WS_XB = 424 * MiB;
constexpr size_t WS_HP = 488 * MiB;
constexpr size_t WS_DN = 712 * MiB;
constexpr size_t WS_EG = 888 * MiB;
constexpr size_t WS_VT = 889 * MiB;
constexpr size_t WS_KF = 216 * MiB;
constexpr size_t WS_ORAW = 985 * MiB;
constexpr size_t WS_ACT = 360 * MiB;
constexpr size_t WS_X1F = 632 * MiB;
constexpr size_t WS_YB = 672 * MiB;
constexpr size_t WS_END = 1017 * MiB;
constexpr size_t DN_WN = 0, DN_QD = 16384, DN_AT = 32768, DN_KD = 40960, DN_U = 57344, DN_STRIDE = 73728;

__device__ __forceinline__ unsigned cvtpk(float lo, float hi) { f32x2_t v = {lo, hi}; bf16x2_t b = __builtin_convertvector(v, bf16x2_t); return __builtin_bit_cast(unsigned, b); }
typedef int v8i __attribute__((ext_vector_type(8)));
__device__ __forceinline__ unsigned pk4_fp8(float a, float b, float c, float d) { int w = __builtin_amdgcn_cvt_pk_fp8_f32(a, b, 0, false); w = __builtin_amdgcn_cvt_pk_fp8_f32(c, d, w, true); return (unsigned)w; }
__device__ __forceinline__ float bflo(unsigned u) { return __uint_as_float(u << 16); }
__device__ __forceinline__ float bfhi(unsigned u) { return __uint_as_float(u & 0xffff0000u); }
__device__ __forceinline__ bf16_t f2bf(float f) { return (bf16_t)(cvtpk(f, 0.f) & 0xffffu); }
__device__ __forceinline__ float bf2f(bf16_t h) { return __uint_as_float((unsigned)h << 16); }
__device__ __forceinline__ float sigm(float x) { return __builtin_amdgcn_rcpf(1.f + __expf(-x)); }
__device__ __forceinline__ int crow(int r, int hi) { return (r & 3) + 8 * (r >> 2) + 4 * hi; }
__device__ __forceinline__ int kperm(int k) { return (k & ~12) | ((k & 4) << 1) | ((k & 8) >> 1); }
__device__ __forceinline__ bf16x8 pack8(const f32x16& x, int b) {
    u32x4 w; w.x = cvtpk(x[b], x[b + 1]); w.y = cvtpk(x[b + 2], x[b + 3]); w.z = cvtpk(x[b + 4], x[b + 5]); w.w = cvtpk(x[b + 6], x[b + 7]);
    return __builtin_bit_cast(bf16x8, w);
}
template <int CTRL> __device__ __forceinline__ float dppf(float x) { return __builtin_bit_cast(float, __builtin_amdgcn_mov_dpp(__builtin_bit_cast(int, x), CTRL, 0xf, 0xf, true)); }
__device__ __forceinline__ float sum_x16(float a, float b) { auto s = __builtin_amdgcn_permlane16_swap(__float_as_uint(a), __float_as_uint(b), false, false); return __uint_as_float(s[0]) + __uint_as_float(s[1]); }
__device__ __forceinline__ float sum_x32(float a, float b) { auto s = __builtin_amdgcn_permlane32_swap(__float_as_uint(a), __float_as_uint(b), false, false); return __uint_as_float(s[0]) + __uint_as_float(s[1]); }
__device__ __forceinline__ float wave_sum(float v) {
    v += dppf<0xB1>(v); v += dppf<0x4E>(v); v += dppf<0x141>(v); v += dppf<0x128>(v);
    v = sum_x16(v, v); return sum_x32(v, v);
}

namespace pg8 {
constexpr int BM = 256, BK = 64, HALF = 128, HTB = HALF * BK * 2, STAGE_BYTES = 8 * HTB;
__device__ __forceinline__ int lds_byte(int r, int c) { const int st = (r >> 4) * 2 + (c >> 5), rr = r & 15, cc = c & 31, ob = rr * 64 + cc * 2; return st * 1024 + (ob ^ (((ob >> 9) & 1) << 5)); }
__device__ __forceinline__ void stage_rc(int b, int& R, int& C) { const int st = b / 1024, sb = b % 1024, swz = sb ^ (((sb >> 9) & 1) << 5); R = (st >> 1) * 16 + swz / 64; C = (st & 1) * 32 + (swz % 64) / 2; }
__device__ __forceinline__ int perm32(int rho) { const int n = rho >> 4, i = rho & 15; return 8 * (i >> 2) + 4 * n + (i & 3); }

struct Unit { const char* A; const char* B; int pm, pn, e, rows, pl; };

__device__ __forceinline__ int unit_index(int i, int c, int G, int total) {
    if (G % 8 != 0) { const int L = i * G + c; return L < total ? L : -1; }
    const int x = c & 7, per = G >> 3, li = i * per + (c >> 3), q = total >> 3, r = total & 7;
    const int start = x * q + (x < r ? x : r), size = q + (x < r ? 1 : 0);
    return li < size ? start + li : -1;
}

struct DenseSched {
    const char* Abase; const char* Bbase; int nM, nN, K, c, G;
    __device__ __forceinline__ bool next(int i, Unit& u) const {
        const int L = unit_index(i, c, G, nM * nN); if (L < 0) return false;
        const int nig = 8 * nN, gid = L / nig, fm = gid * 8, gsz = (nM - fm) < 8 ? (nM - fm) : 8, w = L - gid * nig;
        u.pn = w / gsz; u.pm = fm + w % gsz; u.e = 0; u.rows = 256; u.pl = u.pm;
        u.A = Abase + (size_t)u.pm * 256 * K * 2; u.B = Bbase + (size_t)u.pn * 256 * K * 2; return true;
    }
    static constexpr bool GATHER = false;
    __device__ __forceinline__ size_t hstepA() const { return (size_t)128 * K * 2; }
    __device__ __forceinline__ void avoff(const Unit& u, const int (&R)[2], const int (&C)[2], unsigned (&vo)[2][2]) const {
#pragma unroll
        for (int h = 0; h < 2; ++h)
#pragma unroll
            for (int i = 0; i < 2; ++i) vo[h][i] = (unsigned)(R[i] * K + C[i]) * 2u;
    }
};
template <bool GATHER_> struct MoeSched {
    static constexpr bool GATHER = GATHER_;
    __device__ __forceinline__ size_t hstepA() const { return GATHER_ ? (size_t)0 : (size_t)128 * K; }
    const char* Abase; const char* Bbase; size_t Bstride; const int* ltok; const LAS int* ulist; int K; const char* Bdense;
    __device__ __forceinline__ bool next(int i, Unit& u) const {
        const int w0 = __builtin_amdgcn_readfirstlane(ulist[4 * i]), w1 = __builtin_amdgcn_readfirstlane(ulist[4 * i + 1]), w2 = __builtin_amdgcn_readfirstlane(ulist[4 * i + 2]), w3 = __builtin_amdgcn_readfirstlane(ulist[4 * i + 3]);
        if (w3 == 0) return false;
        u.e = w0 & 255; u.pn = w0 >> 8; u.pl = w1; u.pm = w2; u.rows = w3;
        u.A = GATHER_ ? Abase : Abase + (size_t)u.pm * 256 * K; u.B = (u.e == 255 ? Bdense : Bbase + (size_t)u.e * Bstride) + (size_t)u.pn * 256 * K; return true;
    }
    __device__ __forceinline__ void avoff(const Unit& u, const int (&R)[2], const int (&C)[2], unsigned (&vo)[2][2]) const {
#pragma unroll
        for (int h = 0; h < 2; ++h)
#pragma unroll
            for (int i = 0; i < 2; ++i) {
                if (GATHER_) { const int r = h * 128 + R[i]; int tok = 0; if (u.e == 255) tok = u.pm * 256 + r; else if (r < u.rows) tok = ltok[(size_t)u.e * LCAP + u.pl * 256 + r]; vo[h][i] = (unsigned)(tok * K + C[i] * 2); }
                else vo[h][i] = (unsigned)(R[i] * K + C[i] * 2);
            }
    }
};

typedef f32x4 Acc[2][2][4][2];

template <bool FP8, class Epi, class Sched>
__device__ __forceinline__ void gemm_phase(LAS unsigned char* lds, const int K, const Sched& S, const Epi& E) {
    const int tid = threadIdx.x, wid = __builtin_amdgcn_readfirstlane(tid >> 6), lane = tid & 63, wr = wid >> 2, wc = wid & 3, fr = lane & 15, fq = lane >> 4;
    const int RB = FP8 ? K : 2 * K;
    const int nt = RB / 128;
    int RA[2], CA[2]; unsigned voffB[2];
#pragma unroll
    for (int i = 0; i < 2; ++i) { int R, C; stage_rc(tid * 16 + i * 8192, R, C); RA[i] = R; CA[i] = C; const int Rb = (R & ~31) + perm32(R & 31); voffB[i] = (unsigned)(Rb * RB + C * 2); }
    const size_t kstep = (size_t)(BK * 2);
    const size_t hstepB = (size_t)HALF * RB, hstepA = S.hstepA();
    const unsigned ldsw = (unsigned)wid * 1024u;
    const int aoff = lds_byte(wr * 64 + fr, fq * 8), boff = lds_byte(wc * 32 + fr, fq * 8);
#define PG8_SA(b, h) (((b) * 2 + (h)) * HTB)
#define PG8_SB(b, h) ((4 + (b) * 2 + (h)) * HTB)
#define PG8_GL(gptr, ldsoff) __builtin_amdgcn_global_load_lds((const unsigned*)(gptr), (LAS unsigned*)(lds + (ldsoff)), 16, 0, 0)
#define PG8_STAGE_B(bufoff, gbase) do { PG8_GL((const char*)(gbase) + voffB[0], (bufoff) + ldsw); PG8_GL((const char*)(gbase) + voffB[1], (bufoff) + ldsw + 8192); } while (0)
#define PG8_STAGE_A(bufoff, gbase, o0, o1) do { PG8_GL((const char*)(gbase) + (o0), (bufoff) + ldsw); PG8_GL((const char*)(gbase) + (o1), (bufoff) + ldsw + 8192); } while (0)
#define PG8_LDA(dst, b, h) do { _Pragma("unroll") for (int m = 0; m < 4; ++m) { \
        if constexpr (FP8) { const u32x4 l_ = *(const LAS u32x4*)(lds + PG8_SA(b, h) + aoff + m * 2048), h_ = *(const LAS u32x4*)(lds + PG8_SA(b, h) + aoff + m * 2048 + 1024); \
            dst##8[m] = (v8i){(int)l_.x, (int)l_.y, (int)l_.z, (int)l_.w, (int)h_.x, (int)h_.y, (int)h_.z, (int)h_.w}; } \
        else { _Pragma("unroll") for (int k = 0; k < 2; ++k) dst[m][k] = *(const LAS bf16x8*)(lds + PG8_SA(b, h) + aoff + m * 2048 + k * 1024); } } } while (0)
#define PG8_LDB(dst, b, h) do { _Pragma("unroll") for (int n = 0; n < 2; ++n) { \
        if constexpr (FP8) { const u32x4 l_ = *(const LAS u32x4*)(lds + PG8_SB(b, h) + boff + n * 2048), h_ = *(const LAS u32x4*)(lds + PG8_SB(b, h) + boff + n * 2048 + 1024); \
            dst##8[n] = (v8i){(int)l_.x, (int)l_.y, (int)l_.z, (int)l_.w, (int)h_.x, (int)h_.y, (int)h_.z, (int)h_.w}; } \
        else { _Pragma("unroll") for (int k = 0; k < 2; ++k) dst[n][k] = *(const LAS bf16x8*)(lds + PG8_SB(b, h) + boff + n * 2048 + k * 1024); } } } while (0)
#define PG8_MMA(ai, bj, At, Bt) do { __builtin_amdgcn_s_setprio(1); \
        if constexpr (FP8) { _Pragma("unroll") for (int m = 0; m < 4; ++m) _Pragma("unroll") for (int n = 0; n < 2; ++n) \
            asm volatile("s_nop 1\n\tv_mfma_scale_f32_16x16x128_f8f6f4 %0, %1, %2, %0, %3, %4 op_sel_hi:[0,0,0]" : "+v"(acc[ai][bj][m][n]) : "v"(Bt##8[n]), "v"(At##8[m]), "v"(sc_w), "v"(sc_a)); } \
        else { _Pragma("unroll") for (int m = 0; m < 4; ++m) _Pragma("unroll") for (int n = 0; n < 2; ++n) _Pragma("unroll") for (int k = 0; k < 2; ++k) \
            acc[ai][bj][m][n] = __builtin_amdgcn_mfma_f32_16x16x32_bf16(Bt[n][k], At[m][k], acc[ai][bj][m][n], 0, 0, 0); } \
        __builtin_amdgcn_s_setprio(0); } while (0)
#define PG8_WAIT_V(n) asm volatile("s_waitcnt vmcnt(" #n ")" ::: "memory")
#define PG8_WAIT_L(n) asm volatile("s_waitcnt lgkmcnt(" #n ")" ::: "memory")
#define PG8_BAR __builtin_amdgcn_s_barrier()
#define PG8_SCHED __builtin_amdgcn_sched_barrier(0)
    Unit cur, nxt; int ui = 0;
    if (!S.next(0, cur)) return;
    unsigned vc[2][2], vn[2][2];
    S.avoff(cur, RA, CA, vc);
    Acc acc;
#pragma unroll
    for (int a = 0; a < 2; ++a)
#pragma unroll
        for (int b = 0; b < 2; ++b)
#pragma unroll
            for (int m = 0; m < 4; ++m)
#pragma unroll
                for (int n = 0; n < 2; ++n) acc[a][b][m][n] = (f32x4){0.f, 0.f, 0.f, 0.f};
    const int sc_w = 122, sc_a = 127;
    bf16x8 At[4][2], B0[2][2], B1[2][2]; v8i At8[4], B08[2], B18[2];
    const char* cA = cur.A; const char* cB = cur.B;
    PG8_STAGE_B(PG8_SB(0, 0), cB); PG8_STAGE_B(PG8_SB(0, 1), cB + hstepB); PG8_STAGE_A(PG8_SA(0, 0), cA, vc[0][0], vc[0][1]); PG8_STAGE_A(PG8_SA(0, 1), cA + hstepA, vc[1][0], vc[1][1]);
    if (wr == 1) PG8_BAR;
    PG8_WAIT_V(2); PG8_BAR;
    PG8_STAGE_B(PG8_SB(1, 0), cB + kstep); PG8_STAGE_A(PG8_SA(1, 0), cA + kstep, vc[0][0], vc[0][1]); PG8_STAGE_B(PG8_SB(1, 1), cB + hstepB + kstep);
    PG8_WAIT_V(6); PG8_BAR;
    for (;;) {
        const bool has_next = S.next(ui + 1, nxt);
        if (Sched::GATHER && has_next) S.avoff(nxt, RA, CA, vn);
        else {
#pragma unroll
            for (int h = 0; h < 2; ++h)
#pragma unroll
                for (int i = 0; i < 2; ++i) vn[h][i] = vc[h][i];
        }
        const char* nA = has_next ? nxt.A : cA; const char* nB = has_next ? nxt.B : cB;
#pragma unroll 1
        for (int t = 0; t < nt; t += 2) {
            const bool last = (t == nt - 2);
            const char* a1 = cA + (size_t)(t + 1) * kstep;
            const char* a2 = last ? nA : cA + (size_t)(t + 2) * kstep; const char* b2 = last ? nB : cB + (size_t)(t + 2) * kstep;
            const char* a3 = a2 + kstep; const char* b3 = b2 + kstep;
            const unsigned o00 = last ? vn[0][0] : vc[0][0], o01 = last ? vn[0][1] : vc[0][1], o10 = last ? vn[1][0] : vc[1][0], o11 = last ? vn[1][1] : vc[1][1];
            PG8_LDB(B0, 0, 0); PG8_LDB(B1, 0, 1); PG8_SCHED; PG8_LDA(At, 0, 0); PG8_STAGE_A(PG8_SA(1, 1), a1 + hstepA, vc[1][0], vc[1][1]);
            PG8_WAIT_V(8); PG8_WAIT_L(0); PG8_BAR; PG8_MMA(0, 0, At, B0); PG8_MMA(0, 1, At, B1); PG8_BAR; PG8_SCHED;
            PG8_LDA(At, 0, 1); PG8_STAGE_B(PG8_SB(0, 0), b2); PG8_STAGE_B(PG8_SB(0, 1), b2 + hstepB); PG8_STAGE_A(PG8_SA(0, 0), a2, o00, o01);
            PG8_WAIT_V(8); PG8_WAIT_L(0); PG8_BAR; PG8_MMA(1, 0, At, B0); PG8_MMA(1, 1, At, B1); PG8_BAR; PG8_SCHED;
            PG8_LDB(B0, 1, 0); PG8_LDB(B1, 1, 1); PG8_SCHED; PG8_LDA(At, 1, 0); PG8_STAGE_A(PG8_SA(0, 1), a2 + hstepA, o10, o11);
            PG8_WAIT_V(8); PG8_WAIT_L(0); PG8_BAR; PG8_MMA(0, 0, At, B0); PG8_MMA(0, 1, At, B1); PG8_BAR; PG8_SCHED;
            PG8_LDA(At, 1, 1); PG8_STAGE_B(PG8_SB(1, 0), b3); PG8_STAGE_B(PG8_SB(1, 1), b3 + hstepB); PG8_STAGE_A(PG8_SA(1, 0), a3, o00, o01);
            PG8_WAIT_V(8); PG8_WAIT_L(0); PG8_BAR; PG8_MMA(1, 0, At, B0); PG8_MMA(1, 1, At, B1); PG8_BAR; PG8_SCHED;
        }
        if (wr == 0) PG8_BAR;
        if constexpr (FP8) asm volatile("s_nop 15\n\ts_nop 15" ::: "memory");
        E(acc, cur, wr, wc, fr, fq);
        if (!has_next) break;
#pragma unroll
        for (int a = 0; a < 2; ++a)
#pragma unroll
            for (int b = 0; b < 2; ++b)
#pragma unroll
                for (int m = 0; m < 4; ++m)
#pragma unroll
                    for (int n = 0; n < 2; ++n) acc[a][b][m][n] = (f32x4){0.f, 0.f, 0.f, 0.f};
        cur = nxt; cA = nA; cB = nB; ++ui;
#pragma unroll
        for (int h = 0; h < 2; ++h)
#pragma unroll
            for (int i = 0; i < 2; ++i) vc[h][i] = vn[h][i];
        if (wr == 1) PG8_BAR;
    }
    PG8_WAIT_V(0);
    PG8_BAR;
#undef PG8_SA
#undef PG8_SB
#undef PG8_GL
#undef PG8_STAGE_A
#undef PG8_STAGE_B
#undef PG8_LDA
#undef PG8_LDB
#undef PG8_MMA
#undef PG8_WAIT_V
#undef PG8_WAIT_L
#undef PG8_BAR
#undef PG8_SCHED
}

__device__ __forceinline__ u32x4 pack_row8(const f32x4& v0, const f32x4& v1) { u32x4 w; w.x = cvtpk(v0[0], v0[1]); w.y = cvtpk(v0[2], v0[3]); w.z = cvtpk(v1[0], v1[1]); w.w = cvtpk(v1[2], v1[3]); return w; }
__device__ __forceinline__ void unpack8(const u32x4& w, f32x4& a, f32x4& b) { a = (f32x4){bflo(w.x), bfhi(w.x), bflo(w.y), bfhi(w.y)}; b = (f32x4){bflo(w.z), bfhi(w.z), bflo(w.w), bfhi(w.w)}; }

struct EpiStore {
    bf16_t* O; int ldc;
    __device__ __forceinline__ void operator()(const Acc& acc, const Unit& u, int wr, int wc, int fr, int fq) const {
        const int row0 = u.pm * BM + wr * 64 + fr, col0 = u.pn * BM + wc * 32 + 8 * fq;
#pragma unroll
        for (int ai = 0; ai < 2; ++ai)
#pragma unroll
            for (int m = 0; m < 4; ++m) { bf16_t* rowp = O + (size_t)(row0 + ai * HALF + m * 16) * ldc + col0;
#pragma unroll
                for (int bj = 0; bj < 2; ++bj) *(u32x4*)(rowp + bj * HALF) = pack_row8(acc[ai][bj][m][0], acc[ai][bj][m][1]); }
    }
};
struct EpiResid {
    bf16_t* O; const bf16_t* X;
    __device__ __forceinline__ void operator()(const Acc& acc, const Unit& u, int wr, int wc, int fr, int fq) const {
        const int row0 = u.pm * BM + wr * 64 + fr, col0 = u.pn * BM + wc * 32 + 8 * fq;
#pragma unroll
        for (int ai = 0; ai < 2; ++ai)
#pragma unroll
            for (int m = 0; m < 4; ++m) { const size_t off = (size_t)(row0 + ai * HALF + m * 16) * DM + col0;
#pragma unroll
                for (int bj = 0; bj < 2; ++bj) { const u32x4 xw = *(const u32x4*)(X + off + bj * HALF); f32x4 xa, xb; unpack8(xw, xa, xb);
                    *(u32x4*)(O + off + bj * HALF) = pack_row8(xa * ALPHA + acc[ai][bj][m][0], xb * ALPHA + acc[ai][bj][m][1]); }
                if (m & 1) asm volatile("" ::: "memory"); }
    }
};
struct EpiAct {
    unsigned char* O; const float* bgu;
    __device__ __forceinline__ void operator()(const Acc& acc, const Unit& u, int wr, int wc, int fr, int fq) const {
        const int cl = u.pn * HALF + wc * 32 + 8 * fq;
        const float* bg = bgu + (size_t)u.e * 2048 + cl;
        const f32x4 g0 = *(const f32x4*)bg, g1 = *(const f32x4*)(bg + 4), u0 = *(const f32x4*)(bg + 1024), u1 = *(const f32x4*)(bg + 1028);
        unsigned char* obase = O + (size_t)(u.pm * BM + wr * 64 + fr) * DM + cl;
        const int rl0 = wr * 64 + fr;
#pragma unroll
        for (int ai = 0; ai < 2; ++ai)
#pragma unroll
            for (int m = 0; m < 4; ++m) { const int rl = ai * HALF + m * 16 + rl0;
                unsigned w[2];
#pragma unroll
                for (int n = 0; n < 2; ++n) { const f32x4 hg = acc[ai][0][m][n] + (n ? g1 : g0), hu = acc[ai][1][m][n] + (n ? u1 : u0); float o4[4];
#pragma unroll
                    for (int j = 0; j < 4; ++j) { const float g = fminf(hg[j], 7.f), up = fminf(fmaxf(hu[j], -7.f), 7.f);
                        o4[j] = (up + 1.f) * g * __builtin_amdgcn_rcpf(1.f + __builtin_amdgcn_exp2f(-2.4554669595930157f * g)); }
                    w[n] = pk4_fp8(o4[0], o4[1], o4[2], o4[3]); asm volatile("" : "+v"(w[n])); }
                if (rl < u.rows) *(u32x2*)(obase + (size_t)(ai * HALF + m * 16) * DM) = (u32x2){w[0], w[1]};
                asm volatile("" ::: "memory"); }
    }
};
struct EpiDown {
    unsigned char* O; const float* bd; const float* lgate;
    __device__ __forceinline__ void operator()(const Acc& acc, const Unit& u, int wr, int wc, int fr, int fq) const {
        const int col0 = u.pn * BM + wc * 32 + 8 * fq;
        const float* bp = bd + (size_t)u.e * DM + col0;
#pragma unroll
        for (int ai = 0; ai < 2; ++ai)
#pragma unroll
            for (int m = 0; m < 4; ++m) { const int rl = ai * HALF + wr * 64 + m * 16 + fr;
                if (rl < u.rows) { const float gt = lgate[(size_t)u.e * LCAP + u.pl * BM + rl]; unsigned char* rowp = O + (size_t)(u.pm * BM + rl) * DM + col0;
#pragma unroll
                    for (int bj = 0; bj < 2; ++bj) { const f32x4 a = (acc[ai][bj][m][0] + *(const f32x4*)(bp + bj * HALF)) * gt, b = (acc[ai][bj][m][1] + *(const f32x4*)(bp + bj * HALF + 4)) * gt;
                        *(u32x2*)(rowp + bj * HALF) = (u32x2){pk4_fp8(a[0], a[1], a[2], a[3]), pk4_fp8(b[0], b[1], b[2], b[3])}; } }
                asm volatile("" ::: "memory"); }
    }
};
struct EpiSig {
    bf16_t* O; const float* bias;
    __device__ __forceinline__ void operator()(const Acc& acc, const Unit& u, int wr, int wc, int fr, int fq) const {
        const int row0 = u.pm * BM + wr * 64 + fr, col0 = u.pn * BM + wc * 32 + 8 * fq;
        f32x4 bv[2][2];
#pragma unroll
        for (int bj = 0; bj < 2; ++bj)
#pragma unroll
            for (int n = 0; n < 2; ++n) bv[bj][n] = *(const f32x4*)(bias + col0 + bj * HALF + 4 * n);
#pragma unroll
        for (int ai = 0; ai < 2; ++ai)
#pragma unroll
            for (int m = 0; m < 4; ++m) { bf16_t* rowp = O + (size_t)(row0 + ai * HALF + m * 16) * DM + col0;
#pragma unroll
                for (int bj = 0; bj < 2; ++bj) { f32x4 a = acc[ai][bj][m][0] + bv[bj][0], b = acc[ai][bj][m][1] + bv[bj][1];
#pragma unroll
                    for (int j = 0; j < 4; ++j) { a[j] = sigm(a[j]); b[j] = sigm(b[j]); }
                    *(u32x4*)(rowp + bj * HALF) = pack_row8(a, b); }
                asm volatile("" ::: "memory"); }
    }
};
struct EpiActSig {
    EpiAct a; EpiSig g;
    __device__ __forceinline__ void operator()(const Acc& acc, const Unit& u, int wr, int wc, int fr, int fq) const { if (u.e == 255) g(acc, u, wr, wc, fr, fq); else a(acc, u, wr, wc, fr, fq); }
};
struct EpiMul {
    bf16_t* O;
    __device__ __forceinline__ void operator()(const Acc& acc, const Unit& u, int wr, int wc, int fr, int fq) const {
        const int row0 = u.pm * BM + wr * 64 + fr, col0 = u.pn * BM + wc * 32 + 8 * fq;
#pragma unroll
        for (int ai = 0; ai < 2; ++ai)
#pragma unroll
            for (int m = 0; m < 4; ++m) { bf16_t* rowp = O + (size_t)(row0 + ai * HALF + m * 16) * DM + col0;
#pragma unroll
                for (int bj = 0; bj < 2; ++bj) { const u32x4 gw = *(const u32x4*)(rowp + bj * HALF); f32x4 ga, gb; unpack8(gw, ga, gb);
                    *(u32x4*)(rowp + bj * HALF) = pack_row8(ga * acc[ai][bj][m][0], gb * acc[ai][bj][m][1]); }
                if (m & 1) asm volatile("" ::: "memory"); }
    }
};
}

#define XB_TMO      128
#define XB_XCNT(j)  (256  + 64 * (j))
#define XB_XSUB(j)  (1280 + 64 * (j))
#define XB_XGEN(j)  (2304 + 64 * (j))
#define XB_TOP      3328
#define XB_TOPGEN   3392
#define XCD_BAR_WORDS 3456
#define XB_SPIN_CAP (1u << 22)
constexpr int CW_BAR = 4096;
constexpr int LDS_BARST = LDS_MISC + 2048;
__device__ __forceinline__ unsigned xb_ld(unsigned* p)              { return __hip_atomic_load(p, __ATOMIC_RELAXED, __HIP_MEMORY_SCOPE_AGENT); }
__device__ __forceinline__ unsigned xb_add(unsigned* p, unsigned v) { return __hip_atomic_fetch_add(p, v, __ATOMIC_RELAXED, __HIP_MEMORY_SCOPE_AGENT); }
__device__ __forceinline__ unsigned xb_xcc_id() { return (unsigned)__builtin_amdgcn_s_getreg((3 << 11) | 20) & 0xFu; }
#define XB_SPIN(cond, bar) do { unsigned _sp = 0; while (cond) { __builtin_amdgcn_s_sleep(1); \
    if ((++_sp & 255u) == 0u) { if (xb_ld(&(bar)[XB_TMO])) break; if (_sp > XB_SPIN_CAP) { atomicAdd(&(bar)[XB_TMO], 1u); break; } } } } while (0)
struct XcdBarrier { unsigned* bar; unsigned x; volatile LAS unsigned* st; };
__device__ __forceinline__ XcdBarrier xcd_barrier_post(unsigned* bar, volatile LAS unsigned* st) {
    XcdBarrier b; b.bar = bar; b.x = xb_xcc_id(); b.st = st;
    if (threadIdx.x == 0) (void)xb_add(&bar[XB_XCNT(b.x)], 1u);
    return b;
}
__device__ __forceinline__ void xcd_barrier_complete(unsigned* bar, unsigned x, unsigned& nloc, unsigned& nx) {
    const unsigned G = gridDim.x * gridDim.y * gridDim.z;
    unsigned sum, cnt, mine, sp = 0u;
    for (;;) {
        sum = 0u; cnt = 0u; mine = 0u;
#pragma unroll
        for (unsigned j = 0; j < 16; ++j) { const unsigned c = xb_ld(&bar[XB_XCNT(j)]); sum += c; cnt += (c > 0u) ? 1u : 0u; mine = (j == x) ? c : mine; }
        if (sum == G) break;
        __builtin_amdgcn_s_sleep(1);
        if ((++sp & 255u) == 0u) { if (xb_ld(&bar[XB_TMO])) break; if (sp > XB_SPIN_CAP) { atomicAdd(&bar[XB_TMO], 1u); break; } }
    }
    nloc = mine > 0u ? mine : 1u; nx = cnt > 0u ? cnt : 1u;
}
__device__ __forceinline__ void xcd_barrier(const XcdBarrier& b) {
    asm volatile("s_waitcnt vmcnt(0)" ::: "memory");
    __syncthreads();
    if (threadIdx.x == 0) {
        unsigned* bar = b.bar;
        __builtin_amdgcn_s_waitcnt(0);
        unsigned nloc = b.st[0], nx = b.st[1];
        if (nloc == 0u) { xcd_barrier_complete(bar, b.x, nloc, nx); b.st[0] = nloc; b.st[1] = nx; }
        const unsigned old = xb_add(&bar[XB_XSUB(b.x)], 1u);
        const unsigned gen = old / nloc;
        if (old + 1u == (gen + 1u) * nloc) {
            __builtin_amdgcn_fence(__ATOMIC_RELEASE, "agent");
            asm volatile("s_waitcnt vmcnt(0)" ::: "memory");
            const unsigned og = xb_add(&bar[XB_TOP], 1u);
            const unsigned tg = og / nx;
            if (og + 1u == (tg + 1u) * nx) xb_add(&bar[XB_TOPGEN], 1u);
            else XB_SPIN(xb_ld(&bar[XB_TOPGEN]) == tg, bar);
            __builtin_amdgcn_fence(__ATOMIC_ACQUIRE, "agent");
            xb_add(&bar[XB_XGEN(b.x)], 1u);
            asm volatile("s_waitcnt vmcnt(0)" ::: "memory");
        } else {
            XB_SPIN(xb_ld(&bar[XB_XGEN(b.x)]) == gen, bar);
            __builtin_amdgcn_fence(__ATOMIC_ACQUIRE, "agent");
            asm volatile("s_waitcnt vmcnt(0)" ::: "memory");
        }
    }
    __syncthreads();
}

struct Args { const float* in[21]; float* out; unsigned char* ws; int ph_lo, ph_hi; int flags, pad; };
#define THREAD_IDS() int tid = threadIdx.x; asm volatile("" : "+v"(tid)); const int lane = tid & 63; const int wave = __builtin_amdgcn_readfirstlane(tid >> 6); (void)lane; (void)wave
struct Frame {
    unsigned char* lds; int G, blk;
    float* out; unsigned char* ws;
};
__device__ __forceinline__ const float* inptr(int k) {
    const char* ka = (const char*)__builtin_amdgcn_kernarg_segment_ptr(); asm volatile("" : "+s"(ka));
    return *(const float* const*)(ka + 8 * k);
}
#define WSP(T, off) ((T*)(F.ws + (off)))

constexpr int MOE_TILES = NEXP * 16 * 32 + NEXP * 16 * 16;
struct WTile { const float* src; unsigned char* dst; int ldn; };
__device__ __forceinline__ WTile moe_tile_addr(const Frame& F, int r, const float* w_gate_up, const float* w_down, int lane) {
    constexpr int I_GU = NEXP * 16 * 32; const int q4 = lane >> 4, c = lane & 15; WTile t;
    if (r < I_GU) { const int e = r / 512, q = r % 512, kb = q / 32, nb = q % 32, n0 = 64 * nb;
        const int j0 = n0 & 1023, drow0 = 256 * (j0 >> 7) + (j0 & 127) + ((n0 >= 1024) ? 128 : 0);
        t.src = w_gate_up + (size_t)e * 1024 * 2048 + (size_t)(64 * kb + 16 * q4) * 2048 + n0 + 4 * c; t.ldn = 2048;
        t.dst = WSP(unsigned char, WS_WGU) + (size_t)e * 2048 * 1024 + (size_t)(drow0 + 4 * c) * 1024 + 64 * kb + 16 * q4; }
    else { r -= I_GU; const int e = r / 256, q = r % 256, kb = q / 16, nb = q % 16;
        t.src = w_down + (size_t)e * 1024 * 1024 + (size_t)(64 * kb + 16 * q4) * 1024 + 64 * nb + 4 * c; t.ldn = 1024;
        t.dst = WSP(unsigned char, WS_WD) + (size_t)e * 1024 * 1024 + (size_t)(64 * nb + 4 * c) * 1024 + 64 * kb + 16 * q4; }
    return t;
}
__device__ __forceinline__ void wtile_load(f32x4 (&v)[16], const WTile& t) {
#pragma unroll
    for (int i = 0; i < 16; ++i) v[i] = *(const f32x4*)(t.src + (size_t)i * t.ldn);
}
__device__ __forceinline__ void wtile_store(const f32x4 (&v)[16], const WTile& t) {
#pragma unroll
    for (int j = 0; j < 4; ++j) {
        u32x4 o;
        o.x = pk4_fp8(v[0][j] * 32.f, v[1][j] * 32.f, v[2][j] * 32.f, v[3][j] * 32.f); o.y = pk4_fp8(v[4][j] * 32.f, v[5][j] * 32.f, v[6][j] * 32.f, v[7][j] * 32.f);
        o.z = pk4_fp8(v[8][j] * 32.f, v[9][j] * 32.f, v[10][j] * 32.f, v[11][j] * 32.f); o.w = pk4_fp8(v[12][j] * 32.f, v[13][j] * 32.f, v[14][j] * 32.f, v[15][j] * 32.f);
        *(u32x4*)(t.dst + (size_t)j * 1024) = o;
    }
}
__device__ __forceinline__ void moe_weight_batch3(const Frame& F, int r0, int stride, const float* w_gate_up, const float* w_down, int lane) {
    const WTile t0 = moe_tile_addr(F, r0, w_gate_up, w_down, lane), t1 = moe_tile_addr(F, r0 + stride, w_gate_up, w_down, lane), t2 = moe_tile_addr(F, r0 + 2 * stride, w_gate_up, w_down, lane);
    f32x4 va[16], vb[16];
    wtile_load(va, t0); wtile_load(vb, t1);
    wtile_store(va, t0); wtile_load(va, t2);
    wtile_store(vb, t1); wtile_store(va, t2);
}

__device__ __forceinline__ void p0_transpose_tile(const float* W, int ldn, int k0, int n0, bf16_t* WT, int Kd, int drow0, int lane) {
    const int q = lane >> 4, c = lane & 15;
    const float* src = W + (size_t)(k0 + 16 * q) * ldn + n0 + 4 * c;
    f32x4 v[16];
#pragma unroll
    for (int i = 0; i < 16; ++i) v[i] = *(const f32x4*)(src + (size_t)i * ldn);
    bf16_t* dst = WT + (size_t)(drow0 + 4 * c) * Kd + k0 + 16 * q;
#pragma unroll
    for (int j = 0; j < 4; ++j) {
        u32x4 o0, o1;
        o0.x = cvtpk(v[0][j], v[1][j]); o0.y = cvtpk(v[2][j], v[3][j]); o0.z = cvtpk(v[4][j], v[5][j]); o0.w = cvtpk(v[6][j], v[7][j]);
        o1.x = cvtpk(v[8][j], v[9][j]); o1.y = cvtpk(v[10][j], v[11][j]); o1.z = cvtpk(v[12][j], v[13][j]); o1.w = cvtpk(v[14][j], v[15][j]);
        *(u32x4*)(dst + (size_t)j * Kd) = o0; *(u32x4*)(dst + (size_t)j * Kd + 8) = o1;
    }
}
__device__ __forceinline__ void phase0(const Frame& F) {
    THREAD_IDS();
    const float* in_x = inptr(0); const float* in_p = inptr(1); const float* in_w_in = inptr(2); const float* in_w_out = inptr(7); const float* in_w_router = inptr(10); const float* in_w_ple_gate = inptr(16); const float* in_w_ple_proj = inptr(18);
    float* wba = (float*)F.lds;
    for (int i = tid; i < 8192; i += NTHREADS) wba[(i & 7) * 1024 + (i >> 3)] = in_w_in[(size_t)(i >> 3) * INCOLS + HPW + (i & 7)];
    __syncthreads();
    const int gw = F.blk * NWAVES + wave, NGW = F.G * NWAVES;
    bf16_t* XB = WSP(bf16_t, WS_XB); float* BA = WSP(float, WS_BA);
    for (int row = gw; row < T_TOK; row += NGW) {
        const f32x4* xr = (const f32x4*)(in_x + (size_t)row * DM) + lane;
        f32x4 v[4];
#pragma unroll
        for (int j = 0; j < 4; ++j) v[j] = xr[64 * j];
        u32x2* o8 = (u32x2*)(XB + (size_t)row * DM) + lane;
#pragma unroll
        for (int j = 0; j < 4; ++j) { u32x2 w; w.x = cvtpk(v[j][0], v[j][1]); w.y = cvtpk(v[j][2], v[j][3]); o8[64 * j] = w; }
        float a8[8];
#pragma unroll
        for (int q = 0; q < 8; ++q) { float a = 0.f;
#pragma unroll
            for (int j = 0; j < 4; ++j) { const f32x4 w = *(const f32x4*)(wba + q * 1024 + 4 * lane + 256 * j); a += v[j][0] * w[0] + v[j][1] * w[1] + v[j][2] * w[2] + v[j][3] * w[3]; }
            a8[q] = a; }
        float r4[4], r2[2], r1;
#pragma unroll
        for (int k = 0; k < 4; ++k) r4[k] = sum_x32(a8[k], a8[k + 4]);
#pragma unroll
        for (int k = 0; k < 2; ++k) r2[k] = sum_x16(r4[k], r4[k + 2]);
        { const bool up = (lane & 8) != 0; const float keep = up ? r2[1] : r2[0], send = up ? r2[0] : r2[1]; r1 = keep + dppf<0x128>(send); }
        r1 += dppf<0x141>(r1); r1 += dppf<0x4E>(r1); r1 += dppf<0xB1>(r1);
        if ((lane & 7) == 0) BA[(size_t)row * 8 + ((lane >> 5) & 1) * 4 + ((lane >> 4) & 1) * 2 + ((lane >> 3) & 1)] = r1;
    }
    { const f32x4* src = (const f32x4*)in_p; u32x2* dst = WSP(u32x2, WS_PB);
        for (int i = F.blk * NTHREADS + tid; i < T_TOK * 256 / 4; i += F.G * NTHREADS) { const f32x4 v = src[i]; u32x2 w; w.x = cvtpk(v[0], v[1]); w.y = cvtpk(v[2], v[3]); dst[i] = w; } }
    { float* wrt = WSP(float, WS_WRT); for (int i = F.blk * NTHREADS + tid; i < 32768; i += F.G * NTHREADS) wrt[(i & 31) * 1024 + (i >> 5)] = in_w_router[i]; }
    constexpr int I_IN = 16 * 56, I_OUT = 16 * 16, I_PG = 16 * 16, I_PP = 4 * 16;
    constexpr int NITEMS = I_IN + I_OUT + I_PG + I_PP;
    for (int it = gw; it < NITEMS; it += NGW) {
        int r = it;
        if (r < I_IN) { const int kb = r / 56, nb = r % 56; p0_transpose_tile(in_w_in, INCOLS, 64 * kb, 64 * nb, WSP(bf16_t, WS_WIN), 1024, 64 * nb, lane); continue; } r -= I_IN;
        if (r < I_OUT) { const int kb = r / 16, nb = r % 16; p0_transpose_tile(in_w_out, 1024, 64 * kb, 64 * nb, WSP(bf16_t, WS_WOUT), 1024, 64 * nb, lane); continue; } r -= I_OUT;
        if (r < I_PG) { const int kb = r / 16, nb = r % 16, q4 = lane >> 4, c = lane & 15; WTile t; f32x4 v[16];
            t.src = in_w_ple_gate + (size_t)(64 * kb + 16 * q4) * 1024 + 64 * nb + 4 * c; t.ldn = 1024; t.dst = WSP(unsigned char, WS_WPG) + (size_t)(64 * nb + 4 * c) * 1024 + 64 * kb + 16 * q4;
            wtile_load(v, t); wtile_store(v, t); continue; } r -= I_PG;
        { const int kb = r / 16, nb = r % 16; p0_transpose_tile(in_w_ple_proj, 1024, 64 * kb, 64 * nb, WSP(bf16_t, WS_WPP), 256, 64 * nb, lane); }
    }
}
__device__ __forceinline__ void moe_weight_stream(const Frame& F, int cw, int ncw, int lane) {
    const float* w_gate_up = inptr(12); const float* w_down = inptr(14);
    f32x4 va[16], vb[16];
    int r = cw; if (r >= MOE_TILES) return;
    WTile ta = moe_tile_addr(F, r, w_gate_up, w_down, lane); wtile_load(va, ta);
#pragma unroll 1
    for (;;) {
        const int r1 = r + ncw; WTile tb{}; const bool hb = r1 < MOE_TILES;
        if (hb) { tb = moe_tile_addr(F, r1, w_gate_up, w_down, lane); wtile_load(vb, tb); }
        wtile_store(va, ta);
        if (!hb) break;
        const int r2 = r1 + ncw; const bool ha = r2 < MOE_TILES;
        if (ha) { ta = moe_tile_addr(F, r2, w_gate_up, w_down, lane); wtile_load(va, ta); }
        wtile_store(vb, tb);
        if (!ha) break;
        r = r2;
    }
}
#define MFMA32(a, b, c) __builtin_amdgcn_mfma_f32_32x32x16_bf16((a), (b), (c), 0, 0, 0)
constexpr int QR_S = 136, KT_S = 72, NM_S = 68;
constexpr int L_QR = 0, L_KR = 17408, L_KT = 34816, L_VT = 53248, L_NM = 71680, L_TM = 89088, L_PM = 106496, L_TU = 111104, L_TW = 120320, L_SC = 129536;
__device__ __forceinline__ void dn_prep_unit(const Frame& F, int ch) {
    int tid = threadIdx.x; asm volatile("" : "+v"(tid));
    const int lane = tid & 63, wave = __builtin_amdgcn_readfirstlane(tid >> 6), r32 = lane & 31, hi = lane >> 5;
    const float* in_conv_w = inptr(3); const float* in_a_log = inptr(4); const float* in_dt_bias = inptr(5);
    const int b = ch >> 7, h = (ch >> 5) & 3, n = ch & 31;
    bf16_t* Qr = (bf16_t*)(F.lds + L_QR); bf16_t* Kr = (bf16_t*)(F.lds + L_KR); bf16_t* KT = (bf16_t*)(F.lds + L_KT); bf16_t* VT = (bf16_t*)(F.lds + L_VT);
    float* Nm = (float*)(F.lds + L_NM); float* Tm = (float*)(F.lds + L_TM); float* Pm = (float*)(F.lds + L_PM);
    bf16_t* Tu = (bf16_t*)(F.lds + L_TU); bf16_t* Tw = (bf16_t*)(F.lds + L_TW);
    float* beta_s = (float*)(F.lds + L_SC); float* gc_s = beta_s + 64; float* egc_s = gc_s + 64; float* begc_s = egc_s + 64;
    const bf16_t* HP = WSP(const bf16_t, WS_HP);
    const int t0 = 64 * n; const size_t rowb = (size_t)b * SEQ;
    unsigned char* dnb = F.ws + WS_DN + (size_t)ch * DN_STRIDE;
#pragma unroll
    for (int it = 0; it < 2; ++it) {
        const int idx = it * NTHREADS + tid;
        if (idx < 768) {
        const int c3 = idx >> 8, rem = idx & 255, tg = rem >> 4, d0 = (rem & 15) * 8;
        const int chn = c3 * 512 + h * 128 + d0;
        f32x4 cw[4][2];
#pragma unroll
        for (int j = 0; j < 4; ++j) { cw[j][0] = *(const f32x4*)(in_conv_w + (size_t)j * 1536 + chn); cw[j][1] = *(const f32x4*)(in_conv_w + (size_t)j * 1536 + chn + 4); }
        u32x4 xr[7];
#pragma unroll
        for (int r = 0; r < 7; ++r) { const int t = t0 + 4 * tg - 3 + r; const int tc = t < 0 ? 0 : t; xr[r] = *(const u32x4*)(HP + (rowb + tc) * HPW + 1536 + chn); }
        float y[4][8];
#pragma unroll
        for (int q = 0; q < 4; ++q)
#pragma unroll
            for (int c = 0; c < 8; ++c) y[q][c] = 0.f;
#pragma unroll
        for (int r = 0; r < 7; ++r) { const int t = t0 + 4 * tg - 3 + r; const float msk = t < 0 ? 0.f : 1.f; f32x4 xa, xb; pg8::unpack8(xr[r], xa, xb); xa = xa * msk; xb = xb * msk;
#pragma unroll
            for (int q = 0; q < 4; ++q) { const int j = r - q; if (j >= 0 && j < 4) {
#pragma unroll
                for (int c = 0; c < 4; ++c) { y[q][c] += xa[c] * cw[j][0][c]; y[q][4 + c] += xb[c] * cw[j][1][c]; } } } }
        unsigned pk[4][4];
#pragma unroll
        for (int q = 0; q < 4; ++q) { float ss = 0.f;
#pragma unroll
            for (int c = 0; c < 8; ++c) { y[q][c] = y[q][c] * sigm(y[q][c]); ss += y[q][c] * y[q][c]; }
            ss += dppf<0xB1>(ss); ss += dppf<0x4E>(ss); ss += dppf<0x141>(ss); ss += dppf<0x128>(ss);
            const float sc = (c3 == 2) ? 1.f : rsqrtf(ss + 1e-6f) * (c3 == 0 ? 0.08838834764831845f : 1.f);
#pragma unroll
            for (int c = 0; c < 4; ++c) pk[q][c] = cvtpk(y[q][2 * c] * sc, y[q][2 * c + 1] * sc); }
        const int i0 = 4 * tg;
        if (c3 < 2) { bf16_t* dst = (c3 == 0 ? Qr : Kr) + i0 * QR_S + d0;
#pragma unroll
            for (int q = 0; q < 4; ++q) *(u32x4*)(dst + q * QR_S) = (u32x4){pk[q][0], pk[q][1], pk[q][2], pk[q][3]}; }
        if (c3 >= 1) { bf16_t* dt = (c3 == 1 ? KT : VT) + d0 * KT_S + i0;
#pragma unroll
            for (int c = 0; c < 4; ++c) {
                u32x2 lo, hi2; lo.x = (pk[0][c] & 0xffffu) | (pk[1][c] << 16); lo.y = (pk[2][c] & 0xffffu) | (pk[3][c] << 16);
                hi2.x = (pk[0][c] >> 16) | (pk[1][c] & 0xffff0000u); hi2.y = (pk[2][c] >> 16) | (pk[3][c] & 0xffff0000u);
                *(u32x2*)(dt + (2 * c) * KT_S) = lo; *(u32x2*)(dt + (2 * c + 1) * KT_S) = hi2; } }
        }
    }
    if (tid < 64) {
        const float* BA = WSP(const float, WS_BA) + (rowb + t0 + tid) * 8;
        const float bl = BA[h], al = BA[4 + h] + in_dt_bias[h];
        const float sp = fmaxf(al, 0.f) + log1pf(__expf(-fabsf(al)));
        float g = -__expf(in_a_log[h]) * sp;
#pragma unroll
        for (int o = 1; o < 64; o <<= 1) { const float up = __shfl_up(g, o); if (tid >= o) g += up; }
        const float bt = sigm(bl), eg = __expf(g);
        beta_s[tid] = bt; gc_s[tid] = g; egc_s[tid] = eg; begc_s[tid] = bt * eg;
        if (tid == 63) WSP(float, WS_EG)[ch] = eg;
    }
    __syncthreads();
    {
        const int sel = wave >> 2, tq = wave & 3, mt = (tq == 0) ? 0 : 1, nt = (tq == 3) ? 1 : (tq == 2 ? 1 : 0);
        const int amt = sel ? ((tq == 1) ? 0 : mt) : mt, ant = sel ? ((tq == 1) ? 1 : nt) : nt;
        f32x16 c;
#pragma unroll
        for (int r = 0; r < 16; ++r) c[r] = 0.f;
        if (tq != 3) {
            const bf16_t* ap = Kr + (32 * amt + r32) * QR_S + 8 * hi; const bf16_t* bp = (sel ? Qr : Kr) + (32 * ant + r32) * QR_S + 8 * hi;
#pragma unroll
            for (int s = 0; s < 8; ++s) c = MFMA32(*(const bf16x8*)(ap + 16 * s), *(const bf16x8*)(bp + 16 * s), c);
        }
        if (sel == 0) {
            const int mtt = (tq == 3) ? 0 : mt, ntt = (tq == 3) ? 1 : nt, j = 32 * ntt + r32; const float gj = gc_s[j];
#pragma unroll
            for (int r = 0; r < 16; ++r) { const int i = 32 * mtt + crow(r, hi); Nm[i * NM_S + j] = (j < i) ? beta_s[i] * c[r] * __expf(gc_s[i] - gj) : 0.f; }
        } else {
            const int jt = (tq == 3) ? 1 : amt, itile = (tq == 3) ? 0 : ant, i = 32 * itile + r32; const float gi = gc_s[i];
#pragma unroll
            for (int r = 0; r < 16; ++r) { const int j = 32 * jt + crow(r, hi); c[r] = (j <= i) ? c[r] * __expf(gi - gc_s[j]) : 0.f; }
            bf16_t* AT = (bf16_t*)(dnb + DN_AT);
            *(bf16x8*)(AT + ((itile * 4 + 2 * jt) * 64 + lane) * 8) = pack8(c, 0); *(bf16x8*)(AT + ((itile * 4 + 2 * jt + 1) * 64 + lane) * 8) = pack8(c, 8);
        }
        bf16_t* QD = (bf16_t*)(dnb + DN_QD); bf16_t* KD = (bf16_t*)(dnb + DN_KD); const float glast = gc_s[63];
#pragma unroll
        for (int k2 = 0; k2 < 2; ++k2) { const int f = 2 * wave + k2, m2 = f >> 3, s = f & 7, tok = 32 * m2 + r32; const float e = egc_s[tok];
            const u32x2 lo = *(const u32x2*)(Qr + tok * QR_S + 16 * s + 4 * hi), hi2 = *(const u32x2*)(Qr + tok * QR_S + 16 * s + 8 + 4 * hi);
            u32x4 w; w.x = cvtpk(bflo(lo.x) * e, bfhi(lo.x) * e); w.y = cvtpk(bflo(lo.y) * e, bfhi(lo.y) * e); w.z = cvtpk(bflo(hi2.x) * e, bfhi(hi2.x) * e); w.w = cvtpk(bflo(hi2.y) * e, bfhi(hi2.y) * e);
            *(u32x4*)(QD + (f * 64 + lane) * 8) = w; }
#pragma unroll
        for (int k2 = 0; k2 < 2; ++k2) { const int f = 2 * wave + k2, mt2 = f >> 2, s = f & 3, dk = 32 * mt2 + r32, tk = 16 * s + 4 * hi;
            const u32x2 lo = *(const u32x2*)(KT + dk * KT_S + tk), hi2 = *(const u32x2*)(KT + dk * KT_S + tk + 8);
            float e[8];
#pragma unroll
            for (int q = 0; q < 4; ++q) { e[q] = __expf(glast - gc_s[tk + q]); e[4 + q] = __expf(glast - gc_s[tk + 8 + q]); }
            u32x4 w; w.x = cvtpk(bflo(lo.x) * e[0], bfhi(lo.x) * e[1]); w.y = cvtpk(bflo(lo.y) * e[2], bfhi(lo.y) * e[3]); w.z = cvtpk(bflo(hi2.x) * e[4], bfhi(hi2.x) * e[5]); w.w = cvtpk(bflo(hi2.y) * e[6], bfhi(hi2.y) * e[7]);
            *(u32x4*)(KD + (f * 64 + lane) * 8) = w; }
    }
    __syncthreads();
    if (tid < 64) { const int blk = tid >> 4, col = tid & 15, o = 16 * blk; float x[16];
#pragma unroll
        for (int i = 0; i < 16; ++i) { float a = (i == col) ? 1.f : 0.f;
#pragma unroll
            for (int j = 0; j < i; ++j) a -= Nm[(o + i) * NM_S + o + j] * x[j];
            x[i] = a; }
#pragma unroll
        for (int i = 0; i < 16; ++i) { Tm[(o + i) * NM_S + o + col] = x[i]; if (!(blk & 1)) Tm[(o + i) * NM_S + o + 16 + col] = 0.f; } }
    __syncthreads();
    { const int pb = tid >> 8, r = (tid >> 4) & 15, c = tid & 15, oi = 32 * pb + 16, oj = 32 * pb; float a = 0.f;
#pragma unroll
        for (int k = 0; k < 16; ++k) a += Nm[(oi + r) * NM_S + oj + k] * Tm[(oj + k) * NM_S + oj + c];
        Pm[pb * 272 + r * 17 + c] = a; }
    __syncthreads();
    { const int pb = tid >> 8, r = (tid >> 4) & 15, c = tid & 15, oi = 32 * pb + 16, oj = 32 * pb; float a = 0.f;
#pragma unroll
        for (int k = 0; k < 16; ++k) a -= Tm[(oi + r) * NM_S + oi + k] * Pm[pb * 272 + k * 17 + c];
        Tm[(oi + r) * NM_S + oj + c] = a; }
    __syncthreads();
    { const int r = tid >> 4, c = tid & 15; float a0 = 0.f, a1 = 0.f;
#pragma unroll 8
        for (int k = 0; k < 32; ++k) { const float nv = Nm[(32 + r) * NM_S + k]; a0 += nv * Tm[k * NM_S + c]; a1 += nv * Tm[k * NM_S + c + 16]; }
        Pm[r * 36 + c] = a0; Pm[r * 36 + c + 16] = a1; }
    __syncthreads();
    { const int r = tid >> 4, c = tid & 15; float a0 = 0.f, a1 = 0.f;
#pragma unroll 8
        for (int k = 0; k < 32; ++k) { const float tv = Tm[(32 + r) * NM_S + 32 + k]; a0 -= tv * Pm[k * 36 + c]; a1 -= tv * Pm[k * 36 + c + 16]; }
        Tm[(32 + r) * NM_S + c] = a0; Tm[(32 + r) * NM_S + c + 16] = a1; }
    __syncthreads();
    { const int i = tid >> 3, j0 = (tid & 7) * 8; float tu[8], tw[8];
#pragma unroll
        for (int q = 0; q < 8; ++q) { const int j = j0 + q; const float t = (i < 32 && j >= 32) ? 0.f : Tm[i * NM_S + j]; tu[q] = t * beta_s[j]; tw[q] = t * begc_s[j]; }
        *(u32x4*)(Tu + i * KT_S + j0) = (u32x4){cvtpk(tu[0], tu[1]), cvtpk(tu[2], tu[3]), cvtpk(tu[4], tu[5]), cvtpk(tu[6], tu[7])};
        *(u32x4*)(Tw + i * KT_S + j0) = (u32x4){cvtpk(tw[0], tw[1]), cvtpk(tw[2], tw[3]), cvtpk(tw[4], tw[5]), cvtpk(tw[6], tw[7])}; }
    __syncthreads();
    { const int mt = wave >> 2, nt = wave & 3;
        f32x16 c;
#pragma unroll
        for (int r = 0; r < 16; ++r) c[r] = 0.f;
        const bf16_t* ap = Tu + (32 * mt + r32) * KT_S + 8 * hi; const bf16_t* bp = VT + (32 * nt + r32) * KT_S + 8 * hi;
#pragma unroll
        for (int s = 0; s < 4; ++s) c = MFMA32(*(const bf16x8*)(ap + 16 * s), *(const bf16x8*)(bp + 16 * s), c);
        bf16_t* U = (bf16_t*)(dnb + DN_U);
        *(bf16x8*)(U + ((nt * 4 + mt * 2) * 64 + lane) * 8) = pack8(c, 0); *(bf16x8*)(U + ((nt * 4 + mt * 2 + 1) * 64 + lane) * 8) = pack8(c, 8);
    }
    { const int mt = wave >> 1, nt = wave & 1;
        f32x16 c;
#pragma unroll
        for (int r = 0; r < 16; ++r) c[r] = 0.f;
        const bf16_t* ap = KT + (32 * mt + r32) * KT_S + 8 * hi; const bf16_t* bp = Tw + (32 * nt + r32) * KT_S + 8 * hi;
#pragma unroll
        for (int s = 0; s < 4; ++s) c = MFMA32(*(const bf16x8*)(ap + 16 * s), *(const bf16x8*)(bp + 16 * s), c);
#pragma unroll
        for (int r = 0; r < 16; ++r) c[r] = -c[r];
        bf16_t* WN = (bf16_t*)(dnb + DN_WN);
        *(bf16x8*)(WN + ((nt * 8 + 2 * mt) * 64 + lane) * 8) = pack8(c, 0); *(bf16x8*)(WN + ((nt * 8 + 2 * mt + 1) * 64 + lane) * 8) = pack8(c, 8);
    }
    __syncthreads();
}
__device__ __forceinline__ void kv_unit(const Frame& F, int u) {
    THREAD_IDS();
    const int bh = u >> 2, s0 = (u & 3) * 512, b = bh >> 3, h = bh & 7;
    bf16_t* kt = (bf16_t*)F.lds; bf16_t* vt = kt + 512 * 64;
    const bf16_t* HP = WSP(const bf16_t, WS_HP);
#pragma unroll
    for (int it = 0; it < 8; ++it) { const int idx = it * NTHREADS + tid, r = idx >> 3, c8 = (idx & 7) * 8;
        const bf16_t* src = HP + ((size_t)b * SEQ + s0 + r) * HPW + h * 64 + c8;
        const int sw = r * 64 + (((c8 >> 3) ^ (r & 7)) << 3);
        *(u32x4*)(kt + sw) = *(const u32x4*)(src + 512); *(u32x4*)(vt + sw) = *(const u32x4*)(src + 1024); }
    __syncthreads();
    const int r32 = lane & 31, hi = lane >> 5;
#pragma unroll 1
    for (int it = 0; it < 6; ++it) { const int q = it * NWAVES + wave;
        const int di = q >> 4, bi = q & 15, d = (di == 0) ? 1 : (di == 1 ? 4 : 16), nbd = 64 / d, per = 16 / d;
        const int c = bi / per, nbl = bi % per, nb = (s0 / d) / 32 + nbl;
        const size_t fbase = ((size_t)di * (T_TOK * 512)) + (((size_t)bh * 64 + c * nbd + nb) * 4) * 512 + lane * 8;
        bf16_t* kf = WSP(bf16_t, WS_KF) + fbase; bf16_t* vf = WSP(bf16_t, WS_VT) + fbase;
        const int prow = c + d * (32 * nbl + r32);
#pragma unroll
        for (int d0 = 0; d0 < 4; ++d0) *(u32x4*)(kf + d0 * 512) = *(const u32x4*)(kt + prow * 64 + (((2 * d0 + hi) ^ (prow & 7)) << 3));
#pragma unroll
        for (int eb = 0; eb < 2; ++eb)
#pragma unroll
            for (int ks = 0; ks < 2; ++ks) { unsigned w[4];
#pragma unroll
                for (int jj = 0; jj < 4; ++jj) { const int j0 = 2 * jj, j1 = 2 * jj + 1;
                    const int n0 = 32 * nbl + 16 * ks + 8 * (j0 >> 2) + 4 * hi + (j0 & 3), n1 = 32 * nbl + 16 * ks + 8 * (j1 >> 2) + 4 * hi + (j1 & 3);
                    const int ra = c + d * n0, rb = c + d * n1, ech = 4 * eb + (r32 >> 3);
                    const unsigned lo = vt[ra * 64 + ((ech ^ (ra & 7)) << 3) + (r32 & 7)], hi2 = vt[rb * 64 + ((ech ^ (rb & 7)) << 3) + (r32 & 7)]; w[jj] = lo | (hi2 << 16); }
                *(u32x4*)(vf + (eb * 2 + ks) * 512) = (u32x4){w[0], w[1], w[2], w[3]}; }
    }
    __syncthreads();
}

constexpr int SCAN_BUF = 73728;
__device__ __forceinline__ void scan_stage4(const unsigned char* dnb, int wv, LAS unsigned char* buf, int lane) {
    const unsigned char* src = dnb + wv * 18432 + lane * 16; LAS unsigned char* dst = buf + wv * 18432;
#pragma unroll 1
    for (int f = 0; f < 18; ++f) __builtin_amdgcn_global_load_lds((const unsigned*)(src + f * 1024), (LAS unsigned*)(dst + f * 1024), 16, 0, 0);
}
__device__ __forceinline__ void scan_unit4(const Frame& F, int bh, int sl) {
    THREAD_IDS();
    const int r32 = lane & 31, hi = lane >> 5;
    const int b = bh >> 2, h = bh & 3;
    LAS unsigned char* lds3 = (LAS unsigned char*)F.lds;
    volatile LAS unsigned* sbar = (volatile LAS unsigned*)(lds3 + LDS_MISC + 4096 + 64);
    f32x16 S[4];
#pragma unroll
    for (int mt = 0; mt < 4; ++mt)
#pragma unroll
        for (int r = 0; r < 16; ++r) S[mt][r] = 0.f;
    bf16_t* ORAW = WSP(bf16_t, WS_ORAW);
    const int ch0 = bh * 32;
    scan_stage4(F.ws + WS_DN + (size_t)ch0 * DN_STRIDE, sl, lds3, lane);
#pragma unroll 1
    for (int n = 0; n < 32; ++n) {
        const int ch = ch0 + n;
        LAS unsigned char* buf = lds3 + (n & 1) * SCAN_BUF;
        float eg = WSP(const float, WS_EG)[ch];
        asm volatile("s_waitcnt vmcnt(0) lgkmcnt(0)" : "+v"(eg) :: "memory");
        if (lane == 0) __hip_atomic_fetch_add((LAS unsigned*)sbar, 1u, __ATOMIC_RELAXED, __HIP_MEMORY_SCOPE_WORKGROUP);
        { const unsigned want = 4u * (unsigned)(n + 1); while (*sbar < want) __builtin_amdgcn_s_sleep(1); }
        asm volatile("" ::: "memory");
        if (n + 1 < 32) scan_stage4(F.ws + WS_DN + (size_t)(ch + 1) * DN_STRIDE, sl, lds3 + ((n + 1) & 1) * SCAN_BUF, lane);
        const LAS unsigned char* fb = buf + lane * 16;
        bf16x8 Sb[8];
#pragma unroll
        for (int mt = 0; mt < 4; ++mt) { Sb[2 * mt] = pack8(S[mt], 0); Sb[2 * mt + 1] = pack8(S[mt], 8); }
        f32x16 vn[2], o[2];
#pragma unroll
        for (int m2 = 0; m2 < 2; ++m2) {
#pragma unroll
            for (int r8 = 0; r8 < 2; ++r8) { const u32x4 uu = *(const LAS u32x4*)(fb + 57344 + (sl * 4 + m2 * 2 + r8) * 1024);
                vn[m2][8 * r8] = bflo(uu.x); vn[m2][8 * r8 + 1] = bfhi(uu.x); vn[m2][8 * r8 + 2] = bflo(uu.y); vn[m2][8 * r8 + 3] = bfhi(uu.y);
                vn[m2][8 * r8 + 4] = bflo(uu.z); vn[m2][8 * r8 + 5] = bfhi(uu.z); vn[m2][8 * r8 + 6] = bflo(uu.w); vn[m2][8 * r8 + 7] = bfhi(uu.w); }
#pragma unroll
            for (int s = 0; s < 8; ++s) { const bf16x8 a = *(const LAS bf16x8*)(fb + (m2 * 8 + s) * 1024); vn[m2] = MFMA32(a, Sb[s], vn[m2]); }
            __builtin_amdgcn_sched_barrier(0);
#pragma unroll
            for (int r = 0; r < 16; ++r) o[m2][r] = 0.f;
#pragma unroll
            for (int s = 0; s < 8; ++s) { const bf16x8 a = *(const LAS bf16x8*)(fb + 16384 + (m2 * 8 + s) * 1024); o[m2] = MFMA32(a, Sb[s], o[m2]); }
            __builtin_amdgcn_sched_barrier(0);
        }
        bf16x8 vb[4];
#pragma unroll
        for (int m2 = 0; m2 < 2; ++m2) { vb[2 * m2] = pack8(vn[m2], 0); vb[2 * m2 + 1] = pack8(vn[m2], 8); }
#pragma unroll
        for (int m2 = 0; m2 < 2; ++m2) {
#pragma unroll
            for (int s = 0; s < 4; ++s) { const bf16x8 a = *(const LAS bf16x8*)(fb + 32768 + (m2 * 4 + s) * 1024); o[m2] = MFMA32(a, vb[s], o[m2]); }
#pragma unroll
            for (int r = 0; r < 16; ++r) ORAW[((size_t)b * SEQ + 64 * n + 32 * m2 + crow(r, hi)) * 512 + h * 128 + 32 * sl + r32] = f2bf(o[m2][r]);
            __builtin_amdgcn_sched_barrier(0);
        }
#pragma unroll
        for (int mt = 0; mt < 4; ++mt) {
#pragma unroll
            for (int r = 0; r < 16; ++r) S[mt][r] *= eg;
#pragma unroll
            for (int s = 0; s < 4; ++s) { const bf16x8 a = *(const LAS bf16x8*)(fb + 40960 + (mt * 4 + s) * 1024); S[mt] = MFMA32(a, vb[s], S[mt]); }
            if (mt & 1) __builtin_amdgcn_sched_barrier(0);
        }
    }
    asm volatile("s_waitcnt vmcnt(0) lgkmcnt(0)" ::: "memory");
}
__device__ __forceinline__ void attn_block(const bf16x8 (&kc)[4], const bf16x8 (&vc)[4], const bf16x8 (&qr)[4], f32x16 (&o)[2], float& m_run, float& l_run, int dn0  ) {
    f32x16 s;
#pragma unroll
    for (int r = 0; r < 16; ++r) s[r] = 0.f;
#pragma unroll
    for (int d0 = 0; d0 < 4; ++d0) s = MFMA32(kc[d0], qr[d0], s);
#pragma unroll
    for (int r = 0; r < 16; ++r) { const unsigned dlt = (unsigned)(dn0 - ((r & 3) + 8 * (r >> 2))); s[r] = (dlt <= 128u) ? s[r] : -INFINITY; }
    float mb = fmaxf(fmaxf(s[0], s[1]), fmaxf(s[2], s[3]));
#pragma unroll
    for (int r = 4; r < 16; r += 4) mb = fmaxf(mb, fmaxf(fmaxf(s[r], s[r + 1]), fmaxf(s[r + 2], s[r + 3])));
    { auto rr = __builtin_amdgcn_permlane32_swap(__float_as_uint(mb), __float_as_uint(mb), false, false); mb = fmaxf(__uint_as_float(rr[0]), __uint_as_float(rr[1])); }
    const float mn = fmaxf(m_run, mb);
    {
        const float al = __builtin_amdgcn_exp2f(m_run - mn);
        l_run *= al; m_run = mn;
#pragma unroll
        for (int eb = 0; eb < 2; ++eb)
#pragma unroll
            for (int r = 0; r < 16; ++r) o[eb][r] *= al;
    }
    float ps = 0.f;
#pragma unroll
    for (int r = 0; r < 16; ++r) { s[r] = __builtin_amdgcn_exp2f(s[r] - mn); ps += s[r]; }
    l_run += ps;
    const bf16x8 pb0 = pack8(s, 0), pb1 = pack8(s, 8);
#pragma unroll
    for (int eb = 0; eb < 2; ++eb)
#pragma unroll
        for (int ks = 0; ks < 2; ++ks) o[eb] = MFMA32(vc[eb * 2 + ks], ks ? pb1 : pb0, o[eb]);
}
template <int D_>
__device__ __forceinline__ void attn_branch(const Frame& F, int di, int b, int h, int t0, int jq, const bf16x8 (&qr)[4], f32x16 (&o)[2], float& m_run, float& l_run) {
    THREAD_IDS();
    const int r32 = lane & 31, hi = lane >> 5;
    constexpr int STEP = 16 / D_, NBD = 64 / D_;
    const int c = t0 % D_, a0 = t0 / D_;
    const int nq = a0 + STEP * (32 * jq + r32);
    const int nq_lo = a0 + STEP * (32 * jq), nq_hi = a0 + STEP * (32 * jq + 31);
    const int n_lo = (nq_lo - 128) > 0 ? (nq_lo - 128) : 0;
    const size_t fbase = ((size_t)di * (T_TOK * 512)) + (((size_t)(b * 8 + h) * 64 + c * NBD) * 4) * 512;
    const unsigned char* KF = (const unsigned char*)(WSP(const bf16_t, WS_KF) + fbase); const unsigned char* VF = (const unsigned char*)(WSP(const bf16_t, WS_VT) + fbase);
    const unsigned loff = (unsigned)lane * 16u;
    const int nb0 = n_lo >> 5, nb1 = nq_hi >> 5;
    const int dq = nq - 4 * hi;
#define ATT_LOAD(KX, VX, NB) do { const int nb_ = (NB) < nb1 ? (NB) : nb1; _Pragma("unroll") for (int f = 0; f < 4; ++f) { const unsigned off = (unsigned)nb_ * 4096u + loff + f * 1024; KX[f] = *(const bf16x8*)(KF + off); VX[f] = *(const bf16x8*)(VF + off); } } while (0)
    bf16x8 kA[4], vA[4], kB[4], vB[4], kC[4], vC[4];
    ATT_LOAD(kA, vA, nb0); ATT_LOAD(kB, vB, nb0 + 1);
#pragma unroll 1
    for (int nb = nb0; nb <= nb1; nb += 3) {
        ATT_LOAD(kC, vC, nb + 2);
        attn_block(kA, vA, qr, o, m_run, l_run, dq - 32 * nb);
        if (nb + 1 > nb1) break;
        ATT_LOAD(kA, vA, nb + 3);
        attn_block(kB, vB, qr, o, m_run, l_run, dq - 32 * (nb + 1));
        if (nb + 2 > nb1) break;
        ATT_LOAD(kB, vB, nb + 4);
        attn_block(kC, vC, qr, o, m_run, l_run, dq - 32 * (nb + 2));
    }
#undef ATT_LOAD
}
__device__ __forceinline__ void attn_task(const Frame& F, int a) {
    THREAD_IDS();
    const int r32 = lane & 31, hi = lane >> 5;
    const int x = F.blk & 7, bh = x + 8 * (a >> 6), tw = a & 63, t0 = tw & 15, jq = 3 - (tw >> 4), b = bh >> 3, h = bh & 7;
    const int tq = t0 + 16 * (32 * jq + r32);
    const bf16_t* HP = WSP(const bf16_t, WS_HP);
    bf16x8 qr[4];
#pragma unroll
    for (int d0 = 0; d0 < 4; ++d0) { const u32x4 qw = *(const u32x4*)(HP + ((size_t)b * SEQ + tq) * HPW + h * 64 + 16 * d0 + 8 * hi);
        constexpr float SCQ = 0.125f * 1.4426950408889634f; u32x4 w;
        w.x = cvtpk(bflo(qw.x) * SCQ, bfhi(qw.x) * SCQ); w.y = cvtpk(bflo(qw.y) * SCQ, bfhi(qw.y) * SCQ); w.z = cvtpk(bflo(qw.z) * SCQ, bfhi(qw.z) * SCQ); w.w = cvtpk(bflo(qw.w) * SCQ, bfhi(qw.w) * SCQ);
        qr[d0] = __builtin_bit_cast(bf16x8, w); }
    f32x16 o[2];
#pragma unroll
    for (int eb = 0; eb < 2; ++eb)
#pragma unroll
        for (int r = 0; r < 16; ++r) o[eb][r] = 0.f;
    float m_run = -1e30f, l_run = 0.f;
    attn_branch<1>(F, 0, b, h, t0, jq, qr, o, m_run, l_run);
    attn_branch<4>(F, 1, b, h, t0, jq, qr, o, m_run, l_run);
    attn_branch<16>(F, 2, b, h, t0, jq, qr, o, m_run, l_run);
    const float lt = sum_x32(l_run, l_run), inv = 1.f / lt;
    bf16_t* dst = WSP(bf16_t, WS_MIX) + ((size_t)b * SEQ + tq) * DM + h * 64;
#pragma unroll
    for (int eb = 0; eb < 2; ++eb)
#pragma unroll
        for (int g = 0; g < 4; ++g) { u32x2 w; w.x = cvtpk(o[eb][4 * g] * inv, o[eb][4 * g + 1] * inv); w.y = cvtpk(o[eb][4 * g + 2] * inv, o[eb][4 * g + 3] * inv);
            *(u32x2*)(dst + 32 * eb + 8 * g + 4 * hi) = w; }
}
__device__ __forceinline__ void phase3(const Frame& F, int flags) {
    THREAD_IDS();
    if (tid == 0) *(volatile LAS unsigned*)((LAS unsigned char*)F.lds + LDS_MISC + 4096 + 64) = 0u;
    __syncthreads();
    if (F.blk < 64 && wave < 4 && !(flags & 1)) scan_unit4(F, F.blk, wave);
    unsigned* qctr = WSP(unsigned, WS_CTL) + 1024 + (F.blk & 7) * 32;
    if (wave == 7) { moe_weight_stream(F, F.blk, F.G, lane); return; }
    if (flags & 2) return;
    for (;;) {
        unsigned a = 0; if (lane == 0) a = atomicAdd(qctr, 1u);
        a = (unsigned)__builtin_amdgcn_readfirstlane((int)a);
        if (a >= 1024u) break;
        attn_task(F, (int)a);
    }
}

__device__ __forceinline__ void phase4(const Frame& F) {
    THREAD_IDS();
    const float* in_gnorm_w = inptr(6);
    const int gw = F.blk * NWAVES + wave, NGW = F.G * NWAVES;
    const bf16_t* ORAW = WSP(const bf16_t, WS_ORAW); const bf16_t* HP = WSP(const bf16_t, WS_HP); bf16_t* MIX = WSP(bf16_t, WS_MIX);
    const f32x4 gw0 = *(const f32x4*)(in_gnorm_w + (lane & 15) * 8), gw1 = *(const f32x4*)(in_gnorm_w + (lane & 15) * 8 + 4);
    for (int row = gw; row < T_TOK; row += NGW) {
        const u32x4 ow = *(const u32x4*)(ORAW + (size_t)row * 512 + lane * 8), zw = *(const u32x4*)(HP + (size_t)row * HPW + 3072 + lane * 8);
        f32x4 oa, ob, za, zb; pg8::unpack8(ow, oa, ob); pg8::unpack8(zw, za, zb);
        float ss = oa[0] * oa[0] + oa[1] * oa[1] + oa[2] * oa[2] + oa[3] * oa[3] + ob[0] * ob[0] + ob[1] * ob[1] + ob[2] * ob[2] + ob[3] * ob[3];
        ss += dppf<0xB1>(ss); ss += dppf<0x4E>(ss); ss += dppf<0x141>(ss); ss += dppf<0x128>(ss);
        const float r = rsqrtf(ss * (1.f / 128.f) + 1e-6f);
        f32x4 ya, yb;
#pragma unroll
        for (int j = 0; j < 4; ++j) { ya[j] = oa[j] * r * gw0[j] * (za[j] * sigm(za[j])); yb[j] = ob[j] * r * gw1[j] * (zb[j] * sigm(zb[j])); }
        *(u32x4*)(MIX + (size_t)row * DM + 512 + lane * 8) = pg8::pack_row8(ya, yb);
    }
}

__device__ __forceinline__ void phase6(const Frame& F) {
    THREAD_IDS();
    const float* in_ln1_g = inptr(8); const float* in_ln1_b = inptr(9); const float* in_b_router = inptr(11);
    float* wrt = (float*)F.lds;
    { const f32x4* src = WSP(const f32x4, WS_WRT); f32x4* dst = (f32x4*)wrt; for (int i = tid; i < 8192; i += NTHREADS) dst[i] = src[i]; }
    __syncthreads();
    const int gw = F.blk * NWAVES + wave, NGW = F.G * NWAVES;
    bf16_t* X1 = WSP(bf16_t, WS_X1);
    unsigned* cnt = WSP(unsigned, WS_CTL); int* rt_e = WSP(int, WS_ROUTE); int* rt_s = rt_e + T_TOK * 4; int* ltok = WSP(int, WS_LTOK); float* lgate = WSP(float, WS_LGATE);
    int* s_cnt = (int*)(F.lds + LDS_MISC + 4096); int* s_base = s_cnt + 32; int* s_e = s_base + 32; float* s_g = (float*)(s_e + 512); int* s_li = (int*)(s_g + 512);
    if (tid < 32) s_cnt[tid] = 0;
    __syncthreads();
    f32x4 lg[4], lb[4];
#pragma unroll
    for (int j = 0; j < 4; ++j) { lg[j] = *(const f32x4*)(in_ln1_g + 4 * lane + 256 * j); lb[j] = *(const f32x4*)(in_ln1_b + 4 * lane + 256 * j); }
    const float brl = in_b_router[((lane >> 5) & 1) * 16 + ((lane >> 4) & 1) * 8 + ((lane >> 3) & 1) * 4 + ((lane >> 2) & 1) * 2 + ((lane >> 1) & 1)];
    const int my_e = ((lane >> 5) & 1) * 16 + ((lane >> 4) & 1) * 8 + ((lane >> 3) & 1) * 4 + ((lane >> 2) & 1) * 2 + ((lane >> 1) & 1);
#pragma unroll 1
    for (int ip = 0; ip < 8; ++ip) {
        const int rowa = gw + (2 * ip) * NGW, rowb = rowa + NGW;
        f32x4 va[4], vb[4];
        { u32x2 ra[4], rb[4];
#pragma unroll
            for (int j = 0; j < 4; ++j) { ra[j] = ((const u32x2*)(X1 + (size_t)rowa * DM) + lane)[64 * j]; rb[j] = ((const u32x2*)(X1 + (size_t)rowb * DM) + lane)[64 * j]; }
#pragma unroll
            for (int h2 = 0; h2 < 2; ++h2) { f32x4 (&v)[4] = h2 ? vb : va; const int row = h2 ? rowb : rowa; float s = 0.f;
#pragma unroll
                for (int j = 0; j < 4; ++j) { const u32x2 w = h2 ? rb[j] : ra[j]; v[j] = (f32x4){bflo(w.x), bfhi(w.x), bflo(w.y), bfhi(w.y)}; s += (v[j][0] + v[j][1]) + (v[j][2] + v[j][3]); }
                const float mean = wave_sum(s) * (1.f / DM); float s2 = 0.f;
#pragma unroll
                for (int j = 0; j < 4; ++j) { v[j] = v[j] - mean; s2 += (v[j][0] * v[j][0] + v[j][1] * v[j][1]) + (v[j][2] * v[j][2] + v[j][3] * v[j][3]); }
                const float rstd = rsqrtf(wave_sum(s2) * (1.f / DM) + LN_EPS);
#pragma unroll
                for (int j = 0; j < 4; ++j) { v[j] = v[j] * rstd * lg[j] + lb[j]; u32x2 w; w.x = cvtpk(v[j][0], v[j][1]); w.y = cvtpk(v[j][2], v[j][3]); ((u32x2*)(X1 + (size_t)row * DM) + lane)[64 * j] = w;
                    (WSP(unsigned, WS_X1F) + (size_t)row * 256)[lane + 64 * j] = pk4_fp8(v[j][0], v[j][1], v[j][2], v[j][3]); } } }
        float pl[2][32];
        int woff = 4 * lane; asm volatile("" : "+v"(woff));
#pragma unroll
        for (int e = 0; e < 32; ++e) { float a = 0.f, bsum = 0.f;
#pragma unroll
            for (int j = 0; j < 4; ++j) { const f32x4 w = *(const f32x4*)(wrt + e * 1024 + 256 * j + woff);
                a += va[j][0] * w[0] + va[j][1] * w[1] + va[j][2] * w[2] + va[j][3] * w[3]; bsum += vb[j][0] * w[0] + vb[j][1] * w[1] + vb[j][2] * w[2] + vb[j][3] * w[3]; }
            asm volatile("" : "+v"(a), "+v"(bsum)); pl[0][e] = a; pl[1][e] = bsum; if ((e & 3) == 3) asm volatile("" ::: "memory"); }
#pragma unroll
        for (int h2 = 0; h2 < 2; ++h2) {
            float q16[16], q8[8], q4[4], q2[2];
#pragma unroll
            for (int k = 0; k < 16; ++k) q16[k] = sum_x32(pl[h2][k], pl[h2][k + 16]);
#pragma unroll
            for (int k = 0; k < 8; ++k) q8[k] = sum_x16(q16[k], q16[k + 8]);
            { const bool up = (lane & 8) != 0;
#pragma unroll
                for (int k = 0; k < 4; ++k) { const float keep = up ? q8[k + 4] : q8[k], send = up ? q8[k] : q8[k + 4]; q4[k] = keep + dppf<0x128>(send); } }
            { const bool up = (lane & 4) != 0;
#pragma unroll
                for (int k = 0; k < 2; ++k) { const float keep = up ? q4[k + 2] : q4[k], send = up ? q4[k] : q4[k + 2]; q2[k] = keep + dppf<0x141>(send); } }
            float lgt;
            { const bool up = (lane & 2) != 0; const float keep = up ? q2[1] : q2[0], send = up ? q2[0] : q2[1]; lgt = keep + dppf<0x4E>(send); }
            lgt += dppf<0xB1>(lgt);
            lgt += brl;
            int rank = 0;
#pragma unroll
            for (int e = 0; e < 32; ++e) { const int src = ((e >> 4) & 1) * 32 + ((e >> 3) & 1) * 16 + ((e >> 2) & 1) * 8 + ((e >> 1) & 1) * 4 + (e & 1) * 2;
                const float ve = __uint_as_float((unsigned)__builtin_amdgcn_readlane((int)__float_as_uint(lgt), src));
                rank += (ve > lgt || (ve == lgt && e < my_e)) ? 1 : 0;
                if ((e & 7) == 7) __builtin_amdgcn_sched_barrier(0); }
            float tv[4]; int te[4];
#pragma unroll
            for (int k = 0; k < 4; ++k) { const unsigned long long mk = __ballot(rank == k && (lane & 1) == 0); const int src = (int)__builtin_ctzll(mk);
                tv[k] = __uint_as_float((unsigned)__builtin_amdgcn_readlane((int)__float_as_uint(lgt), src)); te[k] = __builtin_amdgcn_readlane(my_e, src); }
            const float e1 = __expf(tv[1] - tv[0]), e2 = __expf(tv[2] - tv[0]), e3 = __expf(tv[3] - tv[0]), inv = 1.f / (1.f + e1 + e2 + e3);
            if (lane < 4) { const int ek = lane == 0 ? te[0] : (lane == 1 ? te[1] : (lane == 2 ? te[2] : te[3]));
                const float gk = (lane == 0 ? 1.f : (lane == 1 ? e1 : (lane == 2 ? e2 : e3))) * inv;
                const int li = atomicAdd(s_cnt + ek, 1);
                const int q = (wave * 16 + 2 * ip + h2) * 4 + lane; s_e[q] = ek; s_g[q] = gk; s_li[q] = li; }
            asm volatile("" ::: "memory");
        }
    }
    __syncthreads();
    if (tid < 32) s_base[tid] = (int)atomicAdd(cnt + tid * 32, (unsigned)s_cnt[tid]);
    __syncthreads();
    { const int lr = tid >> 2, k = tid & 3, wv = lr >> 4, i = lr & 15;
        const int row = (F.blk * NWAVES + wv) + i * NGW;
        if (row < T_TOK) { const int ek = s_e[tid], slot = s_base[ek] + s_li[tid];
            ltok[(size_t)ek * LCAP + slot] = row; lgate[(size_t)ek * LCAP + slot] = s_g[tid]; rt_e[row * 4 + k] = ek; rt_s[row * 4 + k] = slot; } }
}
constexpr int ULIST_OFF = LDS_MISC + 1024, ULIST_MAX = 60;
__device__ __forceinline__ void build_tpre(const Frame& F, int nN, int ndense = 0) {
    THREAD_IDS();
    int* tpre = (int*)(F.lds + LDS_MISC); int* cnts = tpre + 64; int* ulist = (int*)(F.lds + ULIST_OFF);
    __syncthreads();
    if (tid == 0) { const unsigned* cnt = WSP(const unsigned, WS_CTL); int acc = 0;
        for (int e = 0; e < NEXP; ++e) { const int c = (int)__hip_atomic_load(cnt + e * 32, __ATOMIC_RELAXED, __HIP_MEMORY_SCOPE_AGENT); tpre[e] = acc; cnts[e] = c; acc += (c + 255) >> 8; }
        tpre[NEXP] = acc;
        if (nN > 0) { const int totale = acc * nN, total = totale + ndense; int i = 0;
            for (; i < ULIST_MAX; ++i) { const int L = pg8::unit_index(i, F.blk, F.G, total); if (L < 0) break;
                if (L >= totale) { const int l = L - totale, gid = l / 32, w = l - gid * 32;
                    ulist[4 * i] = 255 | ((w / 8) << 8); ulist[4 * i + 1] = gid * 8 + w % 8; ulist[4 * i + 2] = gid * 8 + w % 8; ulist[4 * i + 3] = 256; continue; }
                int e = 0; for (int k = 1; k < NEXP; ++k) if (L >= tpre[k] * nN) e = k;
                const int tp0 = tpre[e], tiles = tpre[e + 1] - tp0, l = L - tp0 * nN, nig = 8 * nN, gid = l / nig, fm = gid * 8, gsz = (tiles - fm) < 8 ? (tiles - fm) : 8, w = l - gid * nig;
                const int pn = w / gsz, pl = fm + w % gsz, rr = cnts[e] - 256 * pl;
                ulist[4 * i] = e | (pn << 8); ulist[4 * i + 1] = pl; ulist[4 * i + 2] = tp0 + pl; ulist[4 * i + 3] = rr < 256 ? rr : 256; }
            ulist[4 * i + 3] = 0; }
    }
    __syncthreads();
}

__device__ __forceinline__ void phase9(const Frame& F) {
    THREAD_IDS();
    const float* in_ln2_g = inptr(19); const float* in_ln2_b = inptr(20);
    build_tpre(F, 0);
    const int* tpre = (const int*)(F.lds + LDS_MISC);
    const int gw = F.blk * NWAVES + wave, NGW = F.G * NWAVES;
    const bf16_t* X1 = WSP(const bf16_t, WS_X1); const bf16_t* PLE = WSP(const bf16_t, WS_PLE); const unsigned char* YB = WSP(const unsigned char, WS_YB);
    const int* rt_e = WSP(const int, WS_ROUTE); const int* rt_s = rt_e + T_TOK * 4;
    f32x4 lg[4], lb[4];
#pragma unroll
    for (int j = 0; j < 4; ++j) { lg[j] = *(const f32x4*)(in_ln2_g + 4 * lane + 256 * j); lb[j] = *(const f32x4*)(in_ln2_b + 4 * lane + 256 * j); }
#pragma unroll 1
    for (int row0 = gw; row0 < T_TOK; row0 += 4 * NGW) {
        int rr[4]; size_t R[4][4];
#pragma unroll
        for (int q = 0; q < 4; ++q) { rr[q] = row0 + q * NGW; if (rr[q] >= T_TOK) rr[q] = row0;
#pragma unroll
            for (int k = 0; k < 4; ++k) { const int e = rt_e[rr[q] * 4 + k], sl = rt_s[rr[q] * 4 + k]; R[q][k] = (size_t)tpre[e] * 256 + sl; } }
        u32x2 xw[4][4], pw[4][4]; unsigned yw[4][4][4];
#pragma unroll
        for (int q = 0; q < 4; ++q) { const u32x2* xr = (const u32x2*)(X1 + (size_t)rr[q] * DM) + lane; const u32x2* pr = (const u32x2*)(PLE + (size_t)rr[q] * DM) + lane;
#pragma unroll
            for (int j = 0; j < 4; ++j) { xw[q][j] = xr[64 * j]; pw[q][j] = pr[64 * j]; }
#pragma unroll
            for (int k = 0; k < 4; ++k) { const unsigned* yr = (const unsigned*)(YB + R[q][k] * DM) + lane;
#pragma unroll
                for (int j = 0; j < 4; ++j) yw[q][k][j] = yr[64 * j]; } }
#pragma unroll
        for (int q = 0; q < 4; ++q) {
            f32x4 v[4];
#pragma unroll
            for (int j = 0; j < 4; ++j) { const u32x2 w = xw[q][j], p2 = pw[q][j];
                v[j] = (f32x4){bflo(w.x), bfhi(w.x), bflo(w.y), bfhi(w.y)} * ALPHA + (f32x4){bflo(p2.x), bfhi(p2.x), bflo(p2.y), bfhi(p2.y)};
#pragma unroll
                for (int k = 0; k < 4; ++k) { const int yv = (int)yw[q][k][j]; const f32x2_t lo = __builtin_amdgcn_cvt_pk_f32_fp8(yv, false), hi2 = __builtin_amdgcn_cvt_pk_f32_fp8(yv, true); v[j] = v[j] + (f32x4){lo[0], lo[1], hi2[0], hi2[1]}; } }
            float s = 0.f;
#pragma unroll
            for (int j = 0; j < 4; ++j) s += (v[j][0] + v[j][1]) + (v[j][2] + v[j][3]);
            const float mean = wave_sum(s) * (1.f / DM); float s2 = 0.f;
#pragma unroll
            for (int j = 0; j < 4; ++j) { v[j] = v[j] - mean; s2 += (v[j][0] * v[j][0] + v[j][1] * v[j][1]) + (v[j][2] * v[j][2] + v[j][3] * v[j][3]); }
            const float rstd = rsqrtf(wave_sum(s2) * (1.f / DM) + LN_EPS);
            if (row0 + q * NGW < T_TOK) { f32x4* orow = (f32x4*)(F.out + (size_t)rr[q] * DM) + lane;
#pragma unroll
                for (int j = 0; j < 4; ++j) orow[64 * j] = v[j] * rstd * lg[j] + lb[j]; }
        }
    }
}

constexpr int N_PHASES = 10;
__global__ void __launch_bounds__(NTHREADS, 2) fwd_kernel(Args args) {
    extern __shared__ __attribute__((aligned(16))) unsigned char lds_raw[];
    Frame F;
    F.lds = lds_raw; F.G = gridDim.x; F.blk = blockIdx.x;
    F.out = args.out; F.ws = args.ws;
    LAS unsigned char* lds3 = (LAS unsigned char*)lds_raw;
    const int lo = args.ph_lo, hi = args.ph_hi;
#if ONE_LAUNCH
    if (threadIdx.x < 2) ((LAS unsigned*)(lds3 + LDS_BARST))[threadIdx.x] = 0u;
    __syncthreads();
    XcdBarrier xbar = xcd_barrier_post(WSP(unsigned, WS_CTL) + CW_BAR, (volatile LAS unsigned*)(lds3 + LDS_BARST));
#define SEAM(k) do { if (lo <= (k) && (k) + 1 < hi) xcd_barrier(xbar); } while (0)
#else
#define SEAM(k) do { } while (0)
#endif
#ifndef PHASE_MASK
#define PHASE_MASK 0x3ff
#endif
#define IN(k) (((PHASE_MASK >> (k)) & 1) && lo <= (k) && (k) < hi)
#define REPS(k) 1
#if ONE_LAUNCH
#define REPSYNC() xcd_barrier(xbar)
#else
#define REPSYNC() do { } while (0)
#endif
    if (IN(0)) { for (int rep = 0; rep < REPS(0); ++rep) { if (rep) REPSYNC(); phase0(F); } SEAM(0); }
    if (IN(1)) {
        for (int rep = 0; rep < REPS(1); ++rep) { if (rep) REPSYNC();
        pg8::DenseSched S{(const char*)WSP(bf16_t, WS_XB), (const char*)WSP(bf16_t, WS_WIN), T_TOK / 256, HPW / 256, 1024, F.blk, F.G};
        pg8::EpiStore E{WSP(bf16_t, WS_HP), HPW};
        pg8::gemm_phase<false>(lds3, 1024, S, E); }
        SEAM(1);
    }
    if (IN(2)) {
        for (int rep = 0; rep < REPS(2); ++rep) { if (rep) REPSYNC();
        for (int u = F.blk; u < 2048 + 512; u += F.G) { if (u < 2048) { if (!(args.flags & 4)) dn_prep_unit(F, u); } else if (!(args.flags & 8)) kv_unit(F, u - 2048); } }
        SEAM(2);
    }
    if (IN(3)) { for (int rep = 0; rep < REPS(3); ++rep) { if (rep) { REPSYNC(); if (F.blk == 0 && threadIdx.x == 0) __hip_atomic_store(WSP(unsigned, WS_CTL) + 64, 0u, __ATOMIC_RELAXED, __HIP_MEMORY_SCOPE_AGENT); REPSYNC(); } phase3(F, args.flags); } SEAM(3); }
    if (IN(4)) { for (int rep = 0; rep < REPS(4); ++rep) { if (rep) REPSYNC(); phase4(F); } SEAM(4); }
    if (IN(5)) {
        for (int rep = 0; rep < REPS(5); ++rep) { if (rep) REPSYNC();
        pg8::DenseSched S{(const char*)WSP(bf16_t, WS_MIX), (const char*)WSP(bf16_t, WS_WOUT), T_TOK / 256, DM / 256, 1024, F.blk, F.G};
        pg8::EpiResid E{WSP(bf16_t, WS_X1), WSP(const bf16_t, WS_XB)};
        pg8::gemm_phase<false>(lds3, 1024, S, E); }
        SEAM(5);
    }
    if (IN(6)) { phase6(F); SEAM(6); }
    if (IN(7)) {
        build_tpre(F, 8, 512);
        for (int rep = 0; rep < REPS(7); ++rep) { if (rep) REPSYNC();
        { pg8::MoeSched<true> S{(const char*)WSP(unsigned char, WS_X1F), (const char*)WSP(unsigned char, WS_WGU), (size_t)2048 * 1024, WSP(const int, WS_LTOK), (const LAS int*)(lds3 + ULIST_OFF), 1024, (const char*)WSP(unsigned char, WS_WPG)};
          pg8::EpiActSig E{{WSP(unsigned char, WS_ACT), inptr(13)}, {WSP(bf16_t, WS_PLE), inptr(17)}};
          pg8::gemm_phase<true>(lds3, 1024, S, E); } }
        SEAM(7);
    }
    if (IN(8)) {
        build_tpre(F, 4);
        for (int rep = 0; rep < REPS(8); ++rep) { if (rep) REPSYNC();
        { pg8::MoeSched<false> S{(const char*)WSP(unsigned char, WS_ACT), (const char*)WSP(unsigned char, WS_WD), (size_t)1024 * 1024, nullptr, (const LAS int*)(lds3 + ULIST_OFF), 1024, nullptr};
          pg8::EpiDown E{WSP(unsigned char, WS_YB), inptr(15), WSP(const float, WS_LGATE)};
          pg8::gemm_phase<true>(lds3, 1024, S, E); } }
        { pg8::DenseSched S{(const char*)WSP(bf16_t, WS_PB), (const char*)WSP(bf16_t, WS_WPP), T_TOK / 256, DM / 256, 256, F.blk, F.G};
          pg8::EpiMul E{WSP(bf16_t, WS_PLE)};
          pg8::gemm_phase<false>(lds3, 256, S, E); }
        SEAM(8);
    }
    if (IN(9)) { for (int rep = 0; rep < REPS(9); ++rep) { if (rep) REPSYNC(); phase9(F); } }

}

extern "C" void kernel_launch(void* const* d_in, const int* in_sizes, int n_in, void* d_out, int out_size, void* d_ws, size_t ws_size, hipStream_t stream) {
    static int grid = 0;
    if (grid == 0) {
        if (n_in != 21 || out_size != T_TOK * DM || ws_size < WS_END) { fprintf(stderr, "kernel_launch: unexpected problem (n_in %d, out %d, ws %zu)\n", n_in, out_size, ws_size); grid = -1; return; }
        int dev = 0, cus = 0, per_cu = 0;
        (void)hipGetDevice(&dev); (void)hipDeviceGetAttribute(&cus, hipDeviceAttributeMultiprocessorCount, dev);
        if (hipFuncSetAttribute((const void*)fwd_kernel, hipFuncAttributeMaxDynamicSharedMemorySize, LDS_BYTES) != hipSuccess) { fprintf(stderr, "kernel_launch: hipFuncSetAttribute failed\n"); grid = -1; return; }
        (void)hipOccupancyMaxActiveBlocksPerMultiprocessor(&per_cu, (const void*)fwd_kernel, NTHREADS, LDS_BYTES);
        (void)hipGetLastError();
        if (per_cu < 1) { fprintf(stderr, "kernel_launch: occupancy query says %d workgroups per CU: cannot make the grid resident\n", per_cu); grid = -1; return; }
        grid = cus;
        if (cus != 256) fprintf(stderr, "kernel_launch: built for a 256-CU device (got %d CUs)\n", cus);
    }
    if (grid < 0) return;
    (void)hipMemsetAsync((char*)d_ws + WS_CTL, 0, 32768, stream);
    Args a{};
    for (int i = 0; i < 21; ++i) a.in[i] = (const float*)d_in[i];
    a.out = (float*)d_out; a.ws = (unsigned char*)d_ws;
#if ONE_LAUNCH
    a.ph_lo = 0; a.ph_hi = N_PHASES;
    void* kargs[] = {&a};
    hipError_t e = hipLaunchCooperativeKernel((const void*)fwd_kernel, dim3(grid), dim3(NTHREADS), kargs, LDS_BYTES, stream);
    if (e != hipSuccess) fprintf(stderr, "cooperative launch failed: %s (grid %d)\n", hipGetErrorString(e), grid);
#else
    for (int ph = 0; ph < N_PHASES; ++ph) { a.ph_lo = ph; a.ph_hi = ph + 1; hipLaunchKernelGGL(fwd_kernel, dim3(grid), dim3(NTHREADS), LDS_BYTES, stream, a);
        if (ph == (PROBE_PH)) { a.flags = PROBE_FLAGS; if (ph == 3) (void)hipMemsetAsync((char*)d_ws + WS_CTL + 4096, 0, 2048, stream); hipLaunchKernelGGL(fwd_kernel, dim3(grid), dim3(NTHREADS), LDS_BYTES, stream, a); a.flags = 0; } }
#endif
}
```

```cpp
#include <hip/hip_runtime.h>
#include <cstdio>
#include <cstdint>

#ifndef PROBE_PH
#define PROBE_PH -1
#endif
#ifndef PROBE_FLAGS
#define PROBE_FLAGS 0
#endif
#ifndef ONE_LAUNCH
#define ONE_LAUNCH 1
#endif

#define LAS __attribute__((address_space(3)))
typedef unsigned short bf16_t;
typedef short bf16x8 __attribute__((ext_vector_type(8)));
typedef float f32x4 __attribute__((ext_vector_type(4)));
typedef float f32x16 __attribute__((ext_vector_type(16)));
typedef unsigned u32x4 __attribute__((ext_vector_type(4)));
typedef unsigned u32x2 __attribute__((ext_vector_type(2)));
typedef float f32x2_t __attribute__((ext_vector_type(2)));
typedef __bf16 bf16x2_t __attribute__((ext_vector_type(2)));

constexpr int T_TOK = 32768, DM = 1024, SEQ = 2048, NBATCH = 16;
constexpr int HPW = 3584, INCOLS = 3592;
constexpr int NEXP = 32, LCAP = 32768;
constexpr float ALPHA = 1.189207115002721f;
constexpr float LN_EPS = 1e-5f;
constexpr int NWAVES = 8, NTHREADS = 512;
constexpr int LDS_BYTES = 163840;
constexpr int LDS_MISC = 147456;

constexpr size_t MiB = 1u << 20;
constexpr size_t WS_CTL = 0;
constexpr size_t WS_WGU = 1 * MiB;
constexpr size_t WS_WD = 129 * MiB;
constexpr size_t WS_WIN = 193 * MiB;
constexpr size_t WS_WOUT = 200 * MiB;
constexpr size_t WS_WPG = 202 * MiB;
constexpr size_t WS_WPP = 204 * MiB;
constexpr size_t WS_WRT = 205 * MiB;
constexpr size_t WS_BA = 206 * MiB;
constexpr size_t WS_ROUTE = 207 * MiB;
constexpr size_t WS_LTOK = 208 * MiB;
constexpr size_t WS_LGATE = 212 * MiB;
constexpr size_t WS_X1 = 216 * MiB;
constexpr size_t WS_PLE = 280 * MiB;
constexpr size_t WS_PB = 344 * MiB;
constexpr size_t WS_MIX = 360 * MiB;
constexpr size_t WS_XB = 424 * MiB;
constexpr size_t WS_HP = 488 * MiB;
constexpr size_t WS_DN = 712 * MiB;
constexpr size_t WS_EG = 888 * MiB;
constexpr size_t WS_VT = 889 * MiB;
constexpr size_t WS_KF = 216 * MiB;
constexpr size_t WS_ORAW = 985 * MiB;
constexpr size_t WS_ACT = 360 * MiB;
constexpr size_t WS_X1F = 632 * MiB;
constexpr size_t WS_YB = 672 * MiB;
constexpr size_t WS_END = 1017 * MiB;
constexpr size_t DN_WN = 0, DN_QD = 16384, DN_AT = 32768, DN_KD = 40960, DN_U = 57344, DN_STRIDE = 73728;

__device__ __forceinline__ unsigned cvtpk(float lo, float hi) { f32x2_t v = {lo, hi}; bf16x2_t b = __builtin_convertvector(v, bf16x2_t); return __builtin_bit_cast(unsigned, b); }
typedef int v8i __attribute__((ext_vector_type(8)));
__device__ __forceinline__ unsigned pk4_fp8(float a, float b, float c, float d) { int w = __builtin_amdgcn_cvt_pk_fp8_f32(a, b, 0, false); w = __builtin_amdgcn_cvt_pk_fp8_f32(c, d, w, true); return (unsigned)w; }
__device__ __forceinline__ float bflo(unsigned u) { return __uint_as_float(u << 16); }
__device__ __forceinline__ float bfhi(unsigned u) { return __uint_as_float(u & 0xffff0000u); }
__device__ __forceinline__ bf16_t f2bf(float f) { return (bf16_t)(cvtpk(f, 0.f) & 0xffffu); }
__device__ __forceinline__ float bf2f(bf16_t h) { return __uint_as_float((unsigned)h << 16); }
__device__ __forceinline__ float sigm(float x) { return __builtin_amdgcn_rcpf(1.f + __expf(-x)); }
__device__ __forceinline__ int crow(int r, int hi) { return (r & 3) + 8 * (r >> 2) + 4 * hi; }
__device__ __forceinline__ int kperm(int k) { return (k & ~12) | ((k & 4) << 1) | ((k & 8) >> 1); }
__device__ __forceinline__ bf16x8 pack8(const f32x16& x, int b) {
    u32x4 w; w.x = cvtpk(x[b], x[b + 1]); w.y = cvtpk(x[b + 2], x[b + 3]); w.z = cvtpk(x[b + 4], x[b + 5]); w.w = cvtpk(x[b + 6], x[b + 7]);
    return __builtin_bit_cast(bf16x8, w);
}
template <int CTRL> __device__ __forceinline__ float dppf(float x) { return __builtin_bit_cast(float, __builtin_amdgcn_mov_dpp(__builtin_bit_cast(int, x), CTRL, 0xf, 0xf, true)); }
__device__ __forceinline__ float sum_x16(float a, float b) { auto s = __builtin_amdgcn_permlane16_swap(__float_as_uint(a), __float_as_uint(b), false, false); return __uint_as_float(s[0]) + __uint_as_float(s[1]); }
__device__ __forceinline__ float sum_x32(float a, float b) { auto s = __builtin_amdgcn_permlane32_swap(__float_as_uint(a), __float_as_uint(b), false, false); return __uint_as_float(s[0]) + __uint_as_float(s[1]); }
__device__ __forceinline__ float wave_sum(float v) {
    v += dppf<0xB1>(v); v += dppf<0x4E>(v); v += dppf<0x141>(v); v += dppf<0x128>(v);
    v = sum_x16(v, v); return sum_x32(v, v);
}

namespace pg8 {
constexpr int BM = 256, BK = 64, HALF = 128, HTB = HALF * BK * 2, STAGE_BYTES = 8 * HTB;
__device__ __forceinline__ int lds_byte(int r, int c) { const int st = (r >> 4) * 2 + (c >> 5), rr = r & 15, cc = c & 31, ob = rr * 64 + cc * 2; return st * 1024 + (ob ^ (((ob >> 9) & 1) << 5)); }
__device__ __forceinline__ void stage_rc(int b, int& R, int& C) { const int st = b / 1024, sb = b % 1024, swz = sb ^ (((sb >> 9) & 1) << 5); R = (st >> 1) * 16 + swz / 64; C = (st & 1) * 32 + (swz % 64) / 2; }
__device__ __forceinline__ int perm32(int rho) { const int n = rho >> 4, i = rho & 15; return 8 * (i >> 2) + 4 * n + (i & 3); }

struct Unit { const char* A; const char* B; int pm, pn, e, rows, pl; };

__device__ __forceinline__ int unit_index(int i, int c, int G, int total) {
    if (G % 8 != 0) { const int L = i * G + c; return L < total ? L : -1; }
    const int x = c & 7, per = G >> 3, li = i * per + (c >> 3), q = total >> 3, r = total & 7;
    const int start = x * q + (x < r ? x : r), size = q + (x < r ? 1 : 0);
    return li < size ? start + li : -1;
}

struct DenseSched {
    const char* Abase; const char* Bbase; int nM, nN, K, c, G;
    __device__ __forceinline__ bool next(int i, Unit& u) const {
        const int L = unit_index(i, c, G, nM * nN); if (L < 0) return false;
        const int nig = 8 * nN, gid = L / nig, fm = gid * 8, gsz = (nM - fm) < 8 ? (nM - fm) : 8, w = L - gid * nig;
        u.pn = w / gsz; u.pm = fm + w % gsz; u.e = 0; u.rows = 256; u.pl = u.pm;
        u.A = Abase + (size_t)u.pm * 256 * K * 2; u.B = Bbase + (size_t)u.pn * 256 * K * 2; return true;
    }
    static constexpr bool GATHER = false;
    __device__ __forceinline__ size_t hstepA() const { return (size_t)128 * K * 2; }
    __device__ __forceinline__ void avoff(const Unit& u, const int (&R)[2], const int (&C)[2], unsigned (&vo)[2][2]) const {
#pragma unroll
        for (int h = 0; h < 2; ++h)
#pragma unroll
            for (int i = 0; i < 2; ++i) vo[h][i] = (unsigned)(R[i] * K + C[i]) * 2u;
    }
};
template <bool GATHER_> struct MoeSched {
    static constexpr bool GATHER = GATHER_;
    __device__ __forceinline__ size_t hstepA() const { return GATHER_ ? (size_t)0 : (size_t)128 * K; }
    const char* Abase; const char* Bbase; size_t Bstride; const int* ltok; const LAS int* ulist; int K; const char* Bdense;
    __device__ __forceinline__ bool next(int i, Unit& u) const {
        const int w0 = __builtin_amdgcn_readfirstlane(ulist[4 * i]), w1 = __builtin_amdgcn_readfirstlane(ulist[4 * i + 1]), w2 = __builtin_amdgcn_readfirstlane(ulist[4 * i + 2]), w3 = __builtin_amdgcn_readfirstlane(ulist[4 * i + 3]);
        if (w3 == 0) return false;
        u.e = w0 & 255; u.pn = w0 >> 8; u.pl = w1; u.pm = w2; u.rows = w3;
        u.A = GATHER_ ? Abase : Abase + (size_t)u.pm * 256 * K; u.B = (u.e == 255 ? Bdense : Bbase + (size_t)u.e * Bstride) + (size_t)u.pn * 256 * K; return true;
    }
    __device__ __forceinline__ void avoff(const Unit& u, const int (&R)[2], const int (&C)[2], unsigned (&vo)[2][2]) const {
#pragma unroll
        for (int h = 0; h < 2; ++h)
#pragma unroll
            for (int i = 0; i < 2; ++i) {
                if (GATHER_) { const int r = h * 128 + R[i]; int tok = 0; if (u.e == 255) tok = u.pm * 256 + r; else if (r < u.rows) tok = ltok[(size_t)u.e * LCAP + u.pl * 256 + r]; vo[h][i] = (unsigned)(tok * K + C[i] * 2); }
                else vo[h][i] = (unsigned)(R[i] * K + C[i] * 2);
            }
    }
};

typedef f32x4 Acc[2][2][4][2];

template <bool FP8, class Epi, class Sched>
__device__ __forceinline__ void gemm_phase(LAS unsigned char* lds, const int K, const Sched& S, const Epi& E) {
    const int tid = threadIdx.x, wid = __builtin_amdgcn_readfirstlane(tid >> 6), lane = tid & 63, wr = wid >> 2, wc = wid & 3, fr = lane & 15, fq = lane >> 4;
    const int RB = FP8 ? K : 2 * K;
    const int nt = RB / 128;
    int RA[2], CA[2]; unsigned voffB[2];
#pragma unroll
    for (int i = 0; i < 2; ++i) { int R, C; stage_rc(tid * 16 + i * 8192, R, C); RA[i] = R; CA[i] = C; const int Rb = (R & ~31) + perm32(R & 31); voffB[i] = (unsigned)(Rb * RB + C * 2); }
    const size_t kstep = (size_t)(BK * 2);
    const size_t hstepB = (size_t)HALF * RB, hstepA = S.hstepA();
    const unsigned ldsw = (unsigned)wid * 1024u;
    const int aoff = lds_byte(wr * 64 + fr, fq * 8), boff = lds_byte(wc * 32 + fr, fq * 8);
#define PG8_SA(b, h) (((b) * 2 + (h)) * HTB)
#define PG8_SB(b, h) ((4 + (b) * 2 + (h)) * HTB)
#define PG8_GL(gptr, ldsoff) __builtin_amdgcn_global_load_lds((const unsigned*)(gptr), (LAS unsigned*)(lds + (ldsoff)), 16, 0, 0)
#define PG8_STAGE_B(bufoff, gbase) do { PG8_GL((const char*)(gbase) + voffB[0], (bufoff) + ldsw); PG8_GL((const char*)(gbase) + voffB[1], (bufoff) + ldsw + 8192); } while (0)
#define PG8_STAGE_A(bufoff, gbase, o0, o1) do { PG8_GL((const char*)(gbase) + (o0), (bufoff) + ldsw); PG8_GL((const char*)(gbase) + (o1), (bufoff) + ldsw + 8192); } while (0)
#define PG8_LDA(dst, b, h) do { _Pragma("unroll") for (int m = 0; m < 4; ++m) { \
        if constexpr (FP8) { const u32x4 l_ = *(const LAS u32x4*)(lds + PG8_SA(b, h) + aoff + m * 2048), h_ = *(const LAS u32x4*)(lds + PG8_SA(b, h) + aoff + m * 2048 + 1024); \
            dst##8[m] = (v8i){(int)l_.x, (int)l_.y, (int)l_.z, (int)l_.w, (int)h_.x, (int)h_.y, (int)h_.z, (int)h_.w}; } \
        else { _Pragma("unroll") for (int k = 0; k < 2; ++k) dst[m][k] = *(const LAS bf16x8*)(lds + PG8_SA(b, h) + aoff + m * 2048 + k * 1024); } } } while (0)
#define PG8_LDB(dst, b, h) do { _Pragma("unroll") for (int n = 0; n < 2; ++n) { \
        if constexpr (FP8) { const u32x4 l_ = *(const LAS u32x4*)(lds + PG8_SB(b, h) + boff + n * 2048), h_ = *(const LAS u32x4*)(lds + PG8_SB(b, h) + boff + n * 2048 + 1024); \
            dst##8[n] = (v8i){(int)l_.x, (int)l_.y, (int)l_.z, (int)l_.w, (int)h_.x, (int)h_.y, (int)h_.z, (int)h_.w}; } \
        else { _Pragma("unroll") for (int k = 0; k < 2; ++k) dst[n][k] = *(const LAS bf16x8*)(lds + PG8_SB(b, h) + boff + n * 2048 + k * 1024); } } } while (0)
#define PG8_MMA(ai, bj, At, Bt) do { __builtin_amdgcn_s_setprio(1); \
        if constexpr (FP8) { _Pragma("unroll") for (int m = 0; m < 4; ++m) _Pragma("unroll") for (int n = 0; n < 2; ++n) \
            asm volatile("s_nop 1\n\tv_mfma_scale_f32_16x16x128_f8f6f4 %0, %1, %2, %0, %3, %4 op_sel_hi:[0,0,0]" : "+v"(acc[ai][bj][m][n]) : "v"(Bt##8[n]), "v"(At##8[m]), "v"(sc_w), "v"(sc_a)); } \
        else { _Pragma("unroll") for (int m = 0; m < 4; ++m) _Pragma("unroll") for (int n = 0; n < 2; ++n) _Pragma("unroll") for (int k = 0; k < 2; ++k) \
            acc[ai][bj][m][n] = __builtin_amdgcn_mfma_f32_16x16x32_bf16(Bt[n][k], At[m][k], acc[ai][bj][m][n], 0, 0, 0); } \
        __builtin_amdgcn_s_setprio(0); } while (0)
#define PG8_WAIT_V(n) asm volatile("s_waitcnt vmcnt(" #n ")" ::: "memory")
#define PG8_WAIT_L(n) asm volatile("s_waitcnt lgkmcnt(" #n ")" ::: "memory")
#define PG8_BAR __builtin_amdgcn_s_barrier()
#define PG8_SCHED __builtin_amdgcn_sched_barrier(0)
    Unit cur, nxt; int ui = 0;
    if (!S.next(0, cur)) return;
    unsigned vc[2][2], vn[2][2];
    S.avoff(cur, RA, CA, vc);
    Acc acc;
#pragma unroll
    for (int a = 0; a < 2; ++a)
#pragma unroll
        for (int b = 0; b < 2; ++b)
#pragma unroll
            for (int m = 0; m < 4; ++m)
#pragma unroll
                for (int n = 0; n < 2; ++n) acc[a][b][m][n] = (f32x4){0.f, 0.f, 0.f, 0.f};
    const int sc_w = 122, sc_a = 127;
    bf16x8 At[4][2], B0[2][2], B1[2][2]; v8i At8[4], B08[2], B18[2];
    const char* cA = cur.A; const char* cB = cur.B;
    PG8_STAGE_B(PG8_SB(0, 0), cB); PG8_STAGE_B(PG8_SB(0, 1), cB + hstepB); PG8_STAGE_A(PG8_SA(0, 0), cA, vc[0][0], vc[0][1]); PG8_STAGE_A(PG8_SA(0, 1), cA + hstepA, vc[1][0], vc[1][1]);
    if (wr == 1) PG8_BAR;
    PG8_WAIT_V(2); PG8_BAR;
    PG8_STAGE_B(PG8_SB(1, 0), cB + kstep); PG8_STAGE_A(PG8_SA(1, 0), cA + kstep, vc[0][0], vc[0][1]); PG8_STAGE_B(PG8_SB(1, 1), cB + hstepB + kstep);
    PG8_WAIT_V(6); PG8_BAR;
    for (;;) {
        const bool has_next = S.next(ui + 1, nxt);
        if (Sched::GATHER && has_next) S.avoff(nxt, RA, CA, vn);
        else {
#pragma unroll
            for (int h = 0; h < 2; ++h)
#pragma unroll
                for (int i = 0; i < 2; ++i) vn[h][i] = vc[h][i];
        }
        const char* nA = has_next ? nxt.A : cA; const char* nB = has_next ? nxt.B : cB;
#pragma unroll 1
        for (int t = 0; t < nt; t += 2) {
            const bool last = (t == nt - 2);
            const char* a1 = cA + (size_t)(t + 1) * kstep;
            const char* a2 = last ? nA : cA + (size_t)(t + 2) * kstep; const char* b2 = last ? nB : cB + (size_t)(t + 2) * kstep;
            const char* a3 = a2 + kstep; const char* b3 = b2 + kstep;
            const unsigned o00 = last ? vn[0][0] : vc[0][0], o01 = last ? vn[0][1] : vc[0][1], o10 = last ? vn[1][0] : vc[1][0], o11 = last ? vn[1][1] : vc[1][1];
            PG8_LDB(B0, 0, 0); PG8_LDB(B1, 0, 1); PG8_SCHED; PG8_LDA(At, 0, 0); PG8_STAGE_A(PG8_SA(1, 1), a1 + hstepA, vc[1][0], vc[1][1]);
            PG8_WAIT_V(8); PG8_WAIT_L(0); PG8_BAR; PG8_MMA(0, 0, At, B0); PG8_MMA(0, 1, At, B1); PG8_BAR; PG8_SCHED;
            PG8_LDA(At, 0, 1); PG8_STAGE_B(PG8_SB(0, 0), b2); PG8_STAGE_B(PG8_SB(0, 1), b2 + hstepB); PG8_STAGE_A(PG8_SA(0, 0), a2, o00, o01);
            PG8_WAIT_V(8); PG8_WAIT_L(0); PG8_BAR; PG8_MMA(1, 0, At, B0); PG8_MMA(1, 1, At, B1); PG8_BAR; PG8_SCHED;
            PG8_LDB(B0, 1, 0); PG8_LDB(B1, 1, 1); PG8_SCHED; PG8_LDA(At, 1, 0); PG8_STAGE_A(PG8_SA(0, 1), a2 + hstepA, o10, o11);
            PG8_WAIT_V(8); PG8_WAIT_L(0); PG8_BAR; PG8_MMA(0, 0, At, B0); PG8_MMA(0, 1, At, B1); PG8_BAR; PG8_SCHED;
            PG8_LDA(At, 1, 1); PG8_STAGE_B(PG8_SB(1, 0), b3); PG8_STAGE_B(PG8_SB(1, 1), b3 + hstepB); PG8_STAGE_A(PG8_SA(1, 0), a3, o00, o01);
            PG8_WAIT_V(8); PG8_WAIT_L(0); PG8_BAR; PG8_MMA(1, 0, At, B0); PG8_MMA(1, 1, At, B1); PG8_BAR; PG8_SCHED;
        }
        if (wr == 0) PG8_BAR;
        if constexpr (FP8) asm volatile("s_nop 15\n\ts_nop 15" ::: "memory");
        E(acc, cur, wr, wc, fr, fq);
        if (!has_next) break;
#pragma unroll
        for (int a = 0; a < 2; ++a)
#pragma unroll
            for (int b = 0; b < 2; ++b)
#pragma unroll
                for (int m = 0; m < 4; ++m)
#pragma unroll
                    for (int n = 0; n < 2; ++n) acc[a][b][m][n] = (f32x4){0.f, 0.f, 0.f, 0.f};
        cur = nxt; cA = nA; cB = nB; ++ui;
#pragma unroll
        for (int h = 0; h < 2; ++h)
#pragma unroll
            for (int i = 0; i < 2; ++i) vc[h][i] = vn[h][i];
        if (wr == 1) PG8_BAR;
    }
    PG8_WAIT_V(0);
    PG8_BAR;
#undef PG8_SA
#undef PG8_SB
#undef PG8_GL
#undef PG8_STAGE_A
#undef PG8_STAGE_B
#undef PG8_LDA
#undef PG8_LDB
#undef PG8_MMA
#undef PG8_WAIT_V
#undef PG8_WAIT_L
#undef PG8_BAR
#undef PG8_SCHED
}

__device__ __forceinline__ u32x4 pack_row8(const f32x4& v0, const f32x4& v1) { u32x4 w; w.x = cvtpk(v0[0], v0[1]); w.y = cvtpk(v0[2], v0[3]); w.z = cvtpk(v1[0], v1[1]); w.w = cvtpk(v1[2], v1[3]); return w; }
__device__ __forceinline__ void unpack8(const u32x4& w, f32x4& a, f32x4& b) { a = (f32x4){bflo(w.x), bfhi(w.x), bflo(w.y), bfhi(w.y)}; b = (f32x4){bflo(w.z), bfhi(w.z), bflo(w.w), bfhi(w.w)}; }

struct EpiStore {
    bf16_t* O; int ldc;
    __device__ __forceinline__ void operator()(const Acc& acc, const Unit& u, int wr, int wc, int fr, int fq) const {
        const int row0 = u.pm * BM + wr * 64 + fr, col0 = u.pn * BM + wc * 32 + 8 * fq;
#pragma unroll
        for (int ai = 0; ai < 2; ++ai)
#pragma unroll
            for (int m = 0; m < 4; ++m) { bf16_t* rowp = O + (size_t)(row0 + ai * HALF + m * 16) * ldc + col0;
#pragma unroll
                for (int bj = 0; bj < 2; ++bj) *(u32x4*)(rowp + bj * HALF) = pack_row8(acc[ai][bj][m][0], acc[ai][bj][m][1]); }
    }
};
struct EpiResid {
    bf16_t* O; const bf16_t* X;
    __device__ __forceinline__ void operator()(const Acc& acc, const Unit& u, int wr, int wc, int fr, int fq) const {
        const int row0 = u.pm * BM + wr * 64 + fr, col0 = u.pn * BM + wc * 32 + 8 * fq;
        u32x4 xw[2][4][2];
#pragma unroll
        for (int ai = 0; ai < 2; ++ai)
#pragma unroll
            for (int m = 0; m < 4; ++m)
#pragma unroll
                for (int bj = 0; bj < 2; ++bj) xw[ai][m][bj] = *(const u32x4*)(X + (size_t)(row0 + ai * HALF + m * 16) * DM + col0 + bj * HALF);
#pragma unroll
        for (int ai = 0; ai < 2; ++ai)
#pragma unroll
            for (int m = 0; m < 4; ++m) { const size_t off = (size_t)(row0 + ai * HALF + m * 16) * DM + col0;
#pragma unroll
                for (int bj = 0; bj < 2; ++bj) { f32x4 xa, xb; unpack8(xw[ai][m][bj], xa, xb);
                    *(u32x4*)(O + off + bj * HALF) = pack_row8(xa * ALPHA + acc[ai][bj][m][0], xb * ALPHA + acc[ai][bj][m][1]); } }
    }
};
struct EpiAct {
    unsigned char* O; const float* bgu;
    __device__ __forceinline__ void operator()(const Acc& acc, const Unit& u, int wr, int wc, int fr, int fq) const {
        const int cl = u.pn * HALF + wc * 32 + 8 * fq;
        const float* bg = bgu + (size_t)u.e * 2048 + cl;
        const f32x4 g0 = *(const f32x4*)bg, g1 = *(const f32x4*)(bg + 4), u0 = *(const f32x4*)(bg + 1024), u1 = *(const f32x4*)(bg + 1028);
        unsigned char* obase = O + (size_t)(u.pm * BM + wr * 64 + fr) * DM + cl;
        const int rl0 = wr * 64 + fr;
#pragma unroll
        for (int ai = 0; ai < 2; ++ai)
#pragma unroll
            for (int m = 0; m < 4; ++m) { const int rl = ai * HALF + m * 16 + rl0;
                unsigned w[2];
#pragma unroll
                for (int n = 0; n < 2; ++n) { const f32x4 hg = acc[ai][0][m][n] + (n ? g1 : g0), hu = acc[ai][1][m][n] + (n ? u1 : u0); float o4[4];
#pragma unroll
                    for (int j = 0; j < 4; ++j) { const float g = fminf(hg[j], 7.f), up = fminf(fmaxf(hu[j], -7.f), 7.f);
                        o4[j] = (up + 1.f) * g * __builtin_amdgcn_rcpf(1.f + __builtin_amdgcn_exp2f(-2.4554669595930157f * g)); }
                    w[n] = pk4_fp8(o4[0], o4[1], o4[2], o4[3]); asm volatile("" : "+v"(w[n])); }
                if (rl < u.rows) *(u32x2*)(obase + (size_t)(ai * HALF + m * 16) * DM) = (u32x2){w[0], w[1]};
                asm volatile("" ::: "memory"); }
    }
};
struct EpiDown {
    unsigned char* O; const float* bd; const float* lgate;
    __device__ __forceinline__ void operator()(const Acc& acc, const Unit& u, int wr, int wc, int fr, int fq) const {
        const int col0 = u.pn * BM + wc * 32 + 8 * fq;
        const float* bp = bd + (size_t)u.e * DM + col0;
        f32x4 bv[2][2]; float gt[2][4];
#pragma unroll
        for (int bj = 0; bj < 2; ++bj) { bv[bj][0] = *(const f32x4*)(bp + bj * HALF); bv[bj][1] = *(const f32x4*)(bp + bj * HALF + 4); }
        const float* gp = lgate + (size_t)u.e * LCAP + u.pl * BM + wr * 64 + fr;
#pragma unroll
        for (int ai = 0; ai < 2; ++ai)
#pragma unroll
            for (int m = 0; m < 4; ++m) { const int rl = ai * HALF + wr * 64 + m * 16 + fr; gt[ai][m] = (rl < u.rows) ? gp[ai * HALF + m * 16] : 0.f; }
#pragma unroll
        for (int ai = 0; ai < 2; ++ai)
#pragma unroll
            for (int m = 0; m < 4; ++m) { const int rl = ai * HALF + wr * 64 + m * 16 + fr;
                if (rl < u.rows) { unsigned char* rowp = O + (size_t)(u.pm * BM + rl) * DM + col0; const float g = gt[ai][m];
#pragma unroll
                    for (int bj = 0; bj < 2; ++bj) { const f32x4 a = (acc[ai][bj][m][0] + bv[bj][0]) * g, b = (acc[ai][bj][m][1] + bv[bj][1]) * g;
                        *(u32x2*)(rowp + bj * HALF) = (u32x2){pk4_fp8(a[0], a[1], a[2], a[3]), pk4_fp8(b[0], b[1], b[2], b[3])}; } } }
    }
};
struct EpiSig {
    bf16_t* O; const float* bias;
    __device__ __forceinline__ void operator()(const Acc& acc, const Unit& u, int wr, int wc, int fr, int fq) const {
        const int row0 = u.pm * BM + wr * 64 + fr, col0 = u.pn * BM + wc * 32 + 8 * fq;
        f32x4 bv[2][2];
#pragma unroll
        for (int bj = 0; bj < 2; ++bj)
#pragma unroll
            for (int n = 0; n < 2; ++n) bv[bj][n] = *(const f32x4*)(bias + col0 + bj * HALF + 4 * n);
#pragma unroll
        for (int ai = 0; ai < 2; ++ai)
#pragma unroll
            for (int m = 0; m < 4; ++m) { bf16_t* rowp = O + (size_t)(row0 + ai * HALF + m * 16) * DM + col0;
#pragma unroll
                for (int bj = 0; bj < 2; ++bj) { f32x4 a = acc[ai][bj][m][0] + bv[bj][0], b = acc[ai][bj][m][1] + bv[bj][1];
#pragma unroll
                    for (int j = 0; j < 4; ++j) { a[j] = sigm(a[j]); b[j] = sigm(b[j]); }
                    *(u32x4*)(rowp + bj * HALF) = pack_row8(a, b); }
                asm volatile("" ::: "memory"); }
    }
};
struct EpiActSig {
    EpiAct a; EpiSig g;
    __device__ __forceinline__ void operator()(const Acc& acc, const Unit& u, int wr, int wc, int fr, int fq) const { if (u.e == 255) g(acc, u, wr, wc, fr, fq); else a(acc, u, wr, wc, fr, fq); }
};
struct EpiMul {
    bf16_t* O;
    __device__ __forceinline__ void operator()(const Acc& acc, const Unit& u, int wr, int wc, int fr, int fq) const {
        const int row0 = u.pm * BM + wr * 64 + fr, col0 = u.pn * BM + wc * 32 + 8 * fq;
        u32x4 gw[2][4][2];
#pragma unroll
        for (int ai = 0; ai < 2; ++ai)
#pragma unroll
            for (int m = 0; m < 4; ++m)
#pragma unroll
                for (int bj = 0; bj < 2; ++bj) gw[ai][m][bj] = *(const u32x4*)(O + (size_t)(row0 + ai * HALF + m * 16) * DM + col0 + bj * HALF);
#pragma unroll
        for (int ai = 0; ai < 2; ++ai)
#pragma unroll
            for (int m = 0; m < 4; ++m) { bf16_t* rowp = O + (size_t)(row0 + ai * HALF + m * 16) * DM + col0;
#pragma unroll
                for (int bj = 0; bj < 2; ++bj) { f32x4 ga, gb; unpack8(gw[ai][m][bj], ga, gb);
                    *(u32x4*)(rowp + bj * HALF) = pack_row8(ga * acc[ai][bj][m][0], gb * acc[ai][bj][m][1]); } }
    }
};
}

#define XB_TMO      128
#define XB_XCNT(j)  (256  + 64 * (j))
#define XB_XSUB(j)  (1280 + 64 * (j))
#define XB_XGEN(j)  (2304 + 64 * (j))
#define XB_TOP      3328
#define XB_TOPGEN   3392
#define XCD_BAR_WORDS 3456
#define XB_SPIN_CAP (1u << 22)
constexpr int CW_BAR = 4096;
constexpr int LDS_BARST = LDS_MISC + 2048;
__device__ __forceinline__ unsigned xb_ld(unsigned* p)              { return __hip_atomic_load(p, __ATOMIC_RELAXED, __HIP_MEMORY_SCOPE_AGENT); }
__device__ __forceinline__ unsigned xb_add(unsigned* p, unsigned v) { return __hip_atomic_fetch_add(p, v, __ATOMIC_RELAXED, __HIP_MEMORY_SCOPE_AGENT); }
__device__ __forceinline__ unsigned xb_xcc_id() { return (unsigned)__builtin_amdgcn_s_getreg((3 << 11) | 20) & 0xFu; }
#define XB_SPIN(cond, bar) do { unsigned _sp = 0; while (cond) { __builtin_amdgcn_s_sleep(1); \
    if ((++_sp & 255u) == 0u) { if (xb_ld(&(bar)[XB_TMO])) break; if (_sp > XB_SPIN_CAP) { atomicAdd(&(bar)[XB_TMO], 1u); break; } } } } while (0)
struct XcdBarrier { unsigned* bar; unsigned x; volatile LAS unsigned* st; };
__device__ __forceinline__ XcdBarrier xcd_barrier_post(unsigned* bar, volatile LAS unsigned* st) {
    XcdBarrier b; b.bar = bar; b.x = xb_xcc_id(); b.st = st;
    if (threadIdx.x == 0) (void)xb_add(&bar[XB_XCNT(b.x)], 1u);
    return b;
}
__device__ __forceinline__ void xcd_barrier_complete(unsigned* bar, unsigned x, unsigned& nloc, unsigned& nx) {
    const unsigned G = gridDim.x * gridDim.y * gridDim.z;
    unsigned sum, cnt, mine, sp = 0u;
    for (;;) {
        sum = 0u; cnt = 0u; mine = 0u;
#pragma unroll
        for (unsigned j = 0; j < 16; ++j) { const unsigned c = xb_ld(&bar[XB_XCNT(j)]); sum += c; cnt += (c > 0u) ? 1u : 0u; mine = (j == x) ? c : mine; }
        if (sum == G) break;
        __builtin_amdgcn_s_sleep(1);
        if ((++sp & 255u) == 0u) { if (xb_ld(&bar[XB_TMO])) break; if (sp > XB_SPIN_CAP) { atomicAdd(&bar[XB_TMO], 1u); break; } }
    }
    nloc = mine > 0u ? mine : 1u; nx = cnt > 0u ? cnt : 1u;
}
__device__ __forceinline__ void xcd_barrier(const XcdBarrier& b) {
    asm volatile("s_waitcnt vmcnt(0)" ::: "memory");
    __syncthreads();
    if (threadIdx.x == 0) {
        unsigned* bar = b.bar;
        __builtin_amdgcn_s_waitcnt(0);
        unsigned nloc = b.st[0], nx = b.st[1];
        if (nloc == 0u) { xcd_barrier_complete(bar, b.x, nloc, nx); b.st[0] = nloc; b.st[1] = nx; }
        const unsigned old = xb_add(&bar[XB_XSUB(b.x)], 1u);
        const unsigned gen = old / nloc;
        if (old + 1u == (gen + 1u) * nloc) {
            __builtin_amdgcn_fence(__ATOMIC_RELEASE, "agent");
            asm volatile("s_waitcnt vmcnt(0)" ::: "memory");
            const unsigned og = xb_add(&bar[XB_TOP], 1u);
            const unsigned tg = og / nx;
            if (og + 1u == (tg + 1u) * nx) xb_add(&bar[XB_TOPGEN], 1u);
            else XB_SPIN(xb_ld(&bar[XB_TOPGEN]) == tg, bar);
            __builtin_amdgcn_fence(__ATOMIC_ACQUIRE, "agent");
            xb_add(&bar[XB_XGEN(b.x)], 1u);
            asm volatile("s_waitcnt vmcnt(0)" ::: "memory");
        } else {
            XB_SPIN(xb_ld(&bar[XB_XGEN(b.x)]) == gen, bar);
            __builtin_amdgcn_fence(__ATOMIC_ACQUIRE, "agent");
            asm volatile("s_waitcnt vmcnt(0)" ::: "memory");
        }
    }
    __syncthreads();
}

struct Args { const float* in[21]; float* out; unsigned char* ws; int ph_lo, ph_hi; int flags, pad; };
#define THREAD_IDS() int tid = threadIdx.x; asm volatile("" : "+v"(tid)); const int lane = tid & 63; const int wave = __builtin_amdgcn_readfirstlane(tid >> 6); (void)lane; (void)wave
struct Frame {
    unsigned char* lds; int G, blk;
    float* out; unsigned char* ws;
};
__device__ __forceinline__ const float* inptr(int k) {
    const char* ka = (const char*)__builtin_amdgcn_kernarg_segment_ptr(); asm volatile("" : "+s"(ka));
    return *(const float* const*)(ka + 8 * k);
}
#define WSP(T, off) ((T*)(F.ws + (off)))

constexpr int MOE_TILES = NEXP * 16 * 32 + NEXP * 16 * 16;
struct WTile { const float* src; unsigned char* dst; int ldn; };
__device__ __forceinline__ WTile moe_tile_addr(const Frame& F, int r, const float* w_gate_up, const float* w_down, int lane) {
    constexpr int I_GU = NEXP * 16 * 32; const int q4 = lane >> 4, c = lane & 15; WTile t;
    if (r < I_GU) { const int e = r / 512, q = r % 512, kb = q / 32, nb = q % 32, n0 = 64 * nb;
        const int j0 = n0 & 1023, drow0 = 256 * (j0 >> 7) + (j0 & 127) + ((n0 >= 1024) ? 128 : 0);
        t.src = w_gate_up + (size_t)e * 1024 * 2048 + (size_t)(64 * kb + 16 * q4) * 2048 + n0 + 4 * c; t.ldn = 2048;
        t.dst = WSP(unsigned char, WS_WGU) + (size_t)e * 2048 * 1024 + (size_t)(drow0 + 4 * c) * 1024 + 64 * kb + 16 * q4; }
    else { r -= I_GU; const int e = r / 256, q = r % 256, kb = q / 16, nb = q % 16;
        t.src = w_down + (size_t)e * 1024 * 1024 + (size_t)(64 * kb + 16 * q4) * 1024 + 64 * nb + 4 * c; t.ldn = 1024;
        t.dst = WSP(unsigned char, WS_WD) + (size_t)e * 1024 * 1024 + (size_t)(64 * nb + 4 * c) * 1024 + 64 * kb + 16 * q4; }
    return t;
}
__device__ __forceinline__ void wtile_load(f32x4 (&v)[16], const WTile& t) {
#pragma unroll
    for (int i = 0; i < 16; ++i) v[i] = *(const f32x4*)(t.src + (size_t)i * t.ldn);
}
__device__ __forceinline__ void wtile_store(const f32x4 (&v)[16], const WTile& t) {
#pragma unroll
    for (int j = 0; j < 4; ++j) {
        u32x4 o;
        o.x = pk4_fp8(v[0][j] * 32.f, v[1][j] * 32.f, v[2][j] * 32.f, v[3][j] * 32.f); o.y = pk4_fp8(v[4][j] * 32.f, v[5][j] * 32.f, v[6][j] * 32.f, v[7][j] * 32.f);
        o.z = pk4_fp8(v[8][j] * 32.f, v[9][j] * 32.f, v[10][j] * 32.f, v[11][j] * 32.f); o.w = pk4_fp8(v[12][j] * 32.f, v[13][j] * 32.f, v[14][j] * 32.f, v[15][j] * 32.f);
        *(u32x4*)(t.dst + (size_t)j * 1024) = o;
    }
}
__device__ __forceinline__ void moe_weight_batch3(const Frame& F, int r0, int stride, const float* w_gate_up, const float* w_down, int lane) {
    const WTile t0 = moe_tile_addr(F, r0, w_gate_up, w_down, lane), t1 = moe_tile_addr(F, r0 + stride, w_gate_up, w_down, lane), t2 = moe_tile_addr(F, r0 + 2 * stride, w_gate_up, w_down, lane);
    f32x4 va[16], vb[16];
    wtile_load(va, t0); wtile_load(vb, t1);
    wtile_store(va, t0); wtile_load(va, t2);
    wtile_store(vb, t1); wtile_store(va, t2);
}

__device__ __forceinline__ void p0_transpose_tile(const float* W, int ldn, int k0, int n0, bf16_t* WT, int Kd, int drow0, int lane) {
    const int q = lane >> 4, c = lane & 15;
    const float* src = W + (size_t)(k0 + 16 * q) * ldn + n0 + 4 * c;
    f32x4 v[16];
#pragma unroll
    for (int i = 0; i < 16; ++i) v[i] = *(const f32x4*)(src + (size_t)i * ldn);
    bf16_t* dst = WT + (size_t)(drow0 + 4 * c) * Kd + k0 + 16 * q;
#pragma unroll
    for (int j = 0; j < 4; ++j) {
        u32x4 o0, o1;
        o0.x = cvtpk(v[0][j], v[1][j]); o0.y = cvtpk(v[2][j], v[3][j]); o0.z = cvtpk(v[4][j], v[5][j]); o0.w = cvtpk(v[6][j], v[7][j]);
        o1.x = cvtpk(v[8][j], v[9][j]); o1.y = cvtpk(v[10][j], v[11][j]); o1.z = cvtpk(v[12][j], v[13][j]); o1.w = cvtpk(v[14][j], v[15][j]);
        *(u32x4*)(dst + (size_t)j * Kd) = o0; *(u32x4*)(dst + (size_t)j * Kd + 8) = o1;
    }
}
__device__ __forceinline__ void phase0(const Frame& F) {
    THREAD_IDS();
    const float* in_x = inptr(0); const float* in_p = inptr(1); const float* in_w_in = inptr(2); const float* in_w_out = inptr(7); const float* in_w_router = inptr(10); const float* in_w_ple_gate = inptr(16); const float* in_w_ple_proj = inptr(18);
    float* wba = (float*)F.lds;
    for (int i = tid; i < 8192; i += NTHREADS) wba[(i & 7) * 1024 + (i >> 3)] = in_w_in[(size_t)(i >> 3) * INCOLS + HPW + (i & 7)];
    __syncthreads();
    const int gw = F.blk * NWAVES + wave, NGW = F.G * NWAVES;
    bf16_t* XB = WSP(bf16_t, WS_XB); float* BA = WSP(float, WS_BA);
    for (int row = gw; row < T_TOK; row += NGW) {
        const f32x4* xr = (const f32x4*)(in_x + (size_t)row * DM) + lane;
        f32x4 v[4];
#pragma unroll
        for (int j = 0; j < 4; ++j) v[j] = xr[64 * j];
        u32x2* o8 = (u32x2*)(XB + (size_t)row * DM) + lane;
#pragma unroll
        for (int j = 0; j < 4; ++j) { u32x2 w; w.x = cvtpk(v[j][0], v[j][1]); w.y = cvtpk(v[j][2], v[j][3]); o8[64 * j] = w; }
        float a8[8];
#pragma unroll
        for (int q = 0; q < 8; ++q) { float a = 0.f;
#pragma unroll
            for (int j = 0; j < 4; ++j) { const f32x4 w = *(const f32x4*)(wba + q * 1024 + 4 * lane + 256 * j); a += v[j][0] * w[0] + v[j][1] * w[1] + v[j][2] * w[2] + v[j][3] * w[3]; }
            a8[q] = a; }
        float r4[4], r2[2], r1;
#pragma unroll
        for (int k = 0; k < 4; ++k) r4[k] = sum_x32(a8[k], a8[k + 4]);
#pragma unroll
        for (int k = 0; k < 2; ++k) r2[k] = sum_x16(r4[k], r4[k + 2]);
        { const bool up = (lane & 8) != 0; const float keep = up ? r2[1] : r2[0], send = up ? r2[0] : r2[1]; r1 = keep + dppf<0x128>(send); }
        r1 += dppf<0x141>(r1); r1 += dppf<0x4E>(r1); r1 += dppf<0xB1>(r1);
        if ((lane & 7) == 0) BA[(size_t)row * 8 + ((lane >> 5) & 1) * 4 + ((lane >> 4) & 1) * 2 + ((lane >> 3) & 1)] = r1;
    }
    { const f32x4* src = (const f32x4*)in_p; u32x2* dst = WSP(u32x2, WS_PB);
        for (int i = F.blk * NTHREADS + tid; i < T_TOK * 256 / 4; i += F.G * NTHREADS) { const f32x4 v = src[i]; u32x2 w; w.x = cvtpk(v[0], v[1]); w.y = cvtpk(v[2], v[3]); dst[i] = w; } }
    { float* wrt = WSP(float, WS_WRT); for (int i = F.blk * NTHREADS + tid; i < 32768; i += F.G * NTHREADS) wrt[(i & 31) * 1024 + (i >> 5)] = in_w_router[i]; }
    constexpr int I_IN = 16 * 56, I_OUT = 16 * 16, I_PG = 16 * 16, I_PP = 4 * 16;
    constexpr int NITEMS = I_IN + I_OUT + I_PG + I_PP;
    for (int it = gw; it < NITEMS; it += NGW) {
        int r = it;
        if (r < I_IN) { const int kb = r / 56, nb = r % 56; p0_transpose_tile(in_w_in, INCOLS, 64 * kb, 64 * nb, WSP(bf16_t, WS_WIN), 1024, 64 * nb, lane); continue; } r -= I_IN;
        if (r < I_OUT) { const int kb = r / 16, nb = r % 16; p0_transpose_tile(in_w_out, 1024, 64 * kb, 64 * nb, WSP(bf16_t, WS_WOUT), 1024, 64 * nb, lane); continue; } r -= I_OUT;
        if (r < I_PG) { const int kb = r / 16, nb = r % 16, q4 = lane >> 4, c = lane & 15; WTile t; f32x4 v[16];
            t.src = in_w_ple_gate + (size_t)(64 * kb + 16 * q4) * 1024 + 64 * nb + 4 * c; t.ldn = 1024; t.dst = WSP(unsigned char, WS_WPG) + (size_t)(64 * nb + 4 * c) * 1024 + 64 * kb + 16 * q4;
            wtile_load(v, t); wtile_store(v, t); continue; } r -= I_PG;
        { const int kb = r / 16, nb = r % 16; p0_transpose_tile(in_w_ple_proj, 1024, 64 * kb, 64 * nb, WSP(bf16_t, WS_WPP), 256, 64 * nb, lane); }
    }
}
__device__ __forceinline__ void moe_weight_stream(const Frame& F, int cw, int ncw, int lane) {
    const float* w_gate_up = inptr(12); const float* w_down = inptr(14);
    f32x4 va[16], vb[16];
    int r = cw; if (r >= MOE_TILES) return;
    WTile ta = moe_tile_addr(F, r, w_gate_up, w_down, lane); wtile_load(va, ta);
#pragma unroll 1
    for (;;) {
        const int r1 = r + ncw; WTile tb{}; const bool hb = r1 < MOE_TILES;
        if (hb) { tb = moe_tile_addr(F, r1, w_gate_up, w_down, lane); wtile_load(vb, tb); }
        wtile_store(va, ta);
        if (!hb) break;
        const int r2 = r1 + ncw; const bool ha = r2 < MOE_TILES;
        if (ha) { ta = moe_tile_addr(F, r2, w_gate_up, w_down, lane); wtile_load(va, ta); }
        wtile_store(vb, tb);
        if (!ha) break;
        r = r2;
    }
}
#define MFMA32(a, b, c) __builtin_amdgcn_mfma_f32_32x32x16_bf16((a), (b), (c), 0, 0, 0)
constexpr int QR_S = 136, KT_S = 72, NM_S = 68;
constexpr int L_QR = 0, L_KR = 17408, L_KT = 34816, L_VT = 53248, L_NM = 71680, L_TM = 89088, L_PM = 106496, L_TU = 111104, L_TW = 120320, L_SC = 129536;
__device__ __forceinline__ void dn_prep_unit(const Frame& F, int ch) {
    int tid = threadIdx.x; asm volatile("" : "+v"(tid));
    const int lane = tid & 63, wave = __builtin_amdgcn_readfirstlane(tid >> 6), r32 = lane & 31, hi = lane >> 5;
    const float* in_conv_w = inptr(3); const float* in_a_log = inptr(4); const float* in_dt_bias = inptr(5);
    const int b = ch >> 7, h = (ch >> 5) & 3, n = ch & 31;
    bf16_t* Qr = (bf16_t*)(F.lds + L_QR); bf16_t* Kr = (bf16_t*)(F.lds + L_KR); bf16_t* KT = (bf16_t*)(F.lds + L_KT); bf16_t* VT = (bf16_t*)(F.lds + L_VT);
    float* Nm = (float*)(F.lds + L_NM); float* Tm = (float*)(F.lds + L_TM); float* Pm = (float*)(F.lds + L_PM);
    bf16_t* Tu = (bf16_t*)(F.lds + L_TU); bf16_t* Tw = (bf16_t*)(F.lds + L_TW);
    float* beta_s = (float*)(F.lds + L_SC); float* gc_s = beta_s + 64; float* egc_s = gc_s + 64; float* begc_s = egc_s + 64;
    const bf16_t* HP = WSP(const bf16_t, WS_HP);
    const int t0 = 64 * n; const size_t rowb = (size_t)b * SEQ;
    unsigned char* dnb = F.ws + WS_DN + (size_t)ch * DN_STRIDE;
#pragma unroll
    for (int it = 0; it < 2; ++it) {
        const int idx = it * NTHREADS + tid;
        if (idx < 768) {
        const int c3 = idx >> 8, rem = idx & 255, tg = rem >> 4, d0 = (rem & 15) * 8;
        const int chn = c3 * 512 + h * 128 + d0;
        f32x4 cw[4][2];
#pragma unroll
        for (int j = 0; j < 4; ++j) { cw[j][0] = *(const f32x4*)(in_conv_w + (size_t)j * 1536 + chn); cw[j][1] = *(const f32x4*)(in_conv_w + (size_t)j * 1536 + chn + 4); }
        u32x4 xr[7];
#pragma unroll
        for (int r = 0; r < 7; ++r) { const int t = t0 + 4 * tg - 3 + r; const int tc = t < 0 ? 0 : t; xr[r] = *(const u32x4*)(HP + (rowb + tc) * HPW + 1536 + chn); }
        float y[4][8];
#pragma unroll
        for (int q = 0; q < 4; ++q)
#pragma unroll
            for (int c = 0; c < 8; ++c) y[q][c] = 0.f;
#pragma unroll
        for (int r = 0; r < 7; ++r) { const int t = t0 + 4 * tg - 3 + r; const float msk = t < 0 ? 0.f : 1.f; f32x4 xa, xb; pg8::unpack8(xr[r], xa, xb); xa = xa * msk; xb = xb * msk;
#pragma unroll
            for (int q = 0; q < 4; ++q) { const int j = r - q; if (j >= 0 && j < 4) {
#pragma unroll
                for (int c = 0; c < 4; ++c) { y[q][c] += xa[c] * cw[j][0][c]; y[q][4 + c] += xb[c] * cw[j][1][c]; } } } }
        unsigned pk[4][4];
#pragma unroll
        for (int q = 0; q < 4; ++q) { float ss = 0.f;
#pragma unroll
            for (int c = 0; c < 8; ++c) { y[q][c] = y[q][c] * sigm(y[q][c]); ss += y[q][c] * y[q][c]; }
            ss += dppf<0xB1>(ss); ss += dppf<0x4E>(ss); ss += dppf<0x141>(ss); ss += dppf<0x128>(ss);
            const float sc = (c3 == 2) ? 1.f : rsqrtf(ss + 1e-6f) * (c3 == 0 ? 0.08838834764831845f : 1.f);
#pragma unroll
            for (int c = 0; c < 4; ++c) pk[q][c] = cvtpk(y[q][2 * c] * sc, y[q][2 * c + 1] * sc); }
        const int i0 = 4 * tg;
        if (c3 < 2) { bf16_t* dst = (c3 == 0 ? Qr : Kr) + i0 * QR_S + d0;
#pragma unroll
            for (int q = 0; q < 4; ++q) *(u32x4*)(dst + q * QR_S) = (u32x4){pk[q][0], pk[q][1], pk[q][2], pk[q][3]}; }
        if (c3 >= 1) { bf16_t* dt = (c3 == 1 ? KT : VT) + d0 * KT_S + i0;
#pragma unroll
            for (int c = 0; c < 4; ++c) {
                u32x2 lo, hi2; lo.x = (pk[0][c] & 0xffffu) | (pk[1][c] << 16); lo.y = (pk[2][c] & 0xffffu) | (pk[3][c] << 16);
                hi2.x = (pk[0][c] >> 16) | (pk[1][c] & 0xffff0000u); hi2.y = (pk[2][c] >> 16) | (pk[3][c] & 0xffff0000u);
                *(u32x2*)(dt + (2 * c) * KT_S) = lo; *(u32x2*)(dt + (2 * c + 1) * KT_S) = hi2; } }
        }
    }
    if (tid < 64) {
        const float* BA = WSP(const float, WS_BA) + (rowb + t0 + tid) * 8;
        const float bl = BA[h], al = BA[4 + h] + in_dt_bias[h];
        const float sp = fmaxf(al, 0.f) + log1pf(__expf(-fabsf(al)));
        float g = -__expf(in_a_log[h]) * sp;
#pragma unroll
        for (int o = 1; o < 64; o <<= 1) { const float up = __shfl_up(g, o); if (tid >= o) g += up; }
        const float bt = sigm(bl), eg = __expf(g);
        beta_s[tid] = bt; gc_s[tid] = g; egc_s[tid] = eg; begc_s[tid] = bt * eg;
        if (tid == 63) WSP(float, WS_EG)[ch] = eg;
    }
    __syncthreads();
    {
        const int sel = wave >> 2, tq = wave & 3, mt = (tq == 0) ? 0 : 1, nt = (tq == 3) ? 1 : (tq == 2 ? 1 : 0);
        const int amt = sel ? ((tq == 1) ? 0 : mt) : mt, ant = sel ? ((tq == 1) ? 1 : nt) : nt;
        f32x16 c;
#pragma unroll
        for (int r = 0; r < 16; ++r) c[r] = 0.f;
        if (tq != 3) {
            const bf16_t* ap = Kr + (32 * amt + r32) * QR_S + 8 * hi; const bf16_t* bp = (sel ? Qr : Kr) + (32 * ant + r32) * QR_S + 8 * hi;
#pragma unroll
            for (int s = 0; s < 8; ++s) c = MFMA32(*(const bf16x8*)(ap + 16 * s), *(const bf16x8*)(bp + 16 * s), c);
        }
        if (sel == 0) {
            const int mtt = (tq == 3) ? 0 : mt, ntt = (tq == 3) ? 1 : nt, j = 32 * ntt + r32; const float gj = gc_s[j];
#pragma unroll
            for (int r = 0; r < 16; ++r) { const int i = 32 * mtt + crow(r, hi); Nm[i * NM_S + j] = (j < i) ? beta_s[i] * c[r] * __expf(gc_s[i] - gj) : 0.f; }
        } else {
            const int jt = (tq == 3) ? 1 : amt, itile = (tq == 3) ? 0 : ant, i = 32 * itile + r32; const float gi = gc_s[i];
#pragma unroll
            for (int r = 0; r < 16; ++r) { const int j = 32 * jt + crow(r, hi); c[r] = (j <= i) ? c[r] * __expf(gi - gc_s[j]) : 0.f; }
            bf16_t* AT = (bf16_t*)(dnb + DN_AT);
            *(bf16x8*)(AT + ((itile * 4 + 2 * jt) * 64 + lane) * 8) = pack8(c, 0); *(bf16x8*)(AT + ((itile * 4 + 2 * jt + 1) * 64 + lane) * 8) = pack8(c, 8);
        }
        bf16_t* QD = (bf16_t*)(dnb + DN_QD); bf16_t* KD = (bf16_t*)(dnb + DN_KD); const float glast = gc_s[63];
#pragma unroll
        for (int k2 = 0; k2 < 2; ++k2) { const int f = 2 * wave + k2, m2 = f >> 3, s = f & 7, tok = 32 * m2 + r32; const float e = egc_s[tok];
            const u32x2 lo = *(const u32x2*)(Qr + tok * QR_S + 16 * s + 4 * hi), hi2 = *(const u32x2*)(Qr + tok * QR_S + 16 * s + 8 + 4 * hi);
            u32x4 w; w.x = cvtpk(bflo(lo.x) * e, bfhi(lo.x) * e); w.y = cvtpk(bflo(lo.y) * e, bfhi(lo.y) * e); w.z = cvtpk(bflo(hi2.x) * e, bfhi(hi2.x) * e); w.w = cvtpk(bflo(hi2.y) * e, bfhi(hi2.y) * e);
            *(u32x4*)(QD + (f * 64 + lane) * 8) = w; }
#pragma unroll
        for (int k2 = 0; k2 < 2; ++k2) { const int f = 2 * wave + k2, mt2 = f >> 2, s = f & 3, dk = 32 * mt2 + r32, tk = 16 * s + 4 * hi;
            const u32x2 lo = *(const u32x2*)(KT + dk * KT_S + tk), hi2 = *(const u32x2*)(KT + dk * KT_S + tk + 8);
            float e[8];
#pragma unroll
            for (int q = 0; q < 4; ++q) { e[q] = __expf(glast - gc_s[tk + q]); e[4 + q] = __expf(glast - gc_s[tk + 8 + q]); }
            u32x4 w; w.x = cvtpk(bflo(lo.x) * e[0], bfhi(lo.x) * e[1]); w.y = cvtpk(bflo(lo.y) * e[2], bfhi(lo.y) * e[3]); w.z = cvtpk(bflo(hi2.x) * e[4], bfhi(hi2.x) * e[5]); w.w = cvtpk(bflo(hi2.y) * e[6], bfhi(hi2.y) * e[7]);
            *(u32x4*)(KD + (f * 64 + lane) * 8) = w; }
    }
    __syncthreads();
    if (tid < 64) { const int blk = tid >> 4, col = tid & 15, o = 16 * blk; float x[16];
#pragma unroll
        for (int i = 0; i < 16; ++i) { float a = (i == col) ? 1.f : 0.f;
#pragma unroll
            for (int j = 0; j < i; ++j) a -= Nm[(o + i) * NM_S + o + j] * x[j];
            x[i] = a; }
#pragma unroll
        for (int i = 0; i < 16; ++i) { Tm[(o + i) * NM_S + o + col] = x[i]; if (!(blk & 1)) Tm[(o + i) * NM_S + o + 16 + col] = 0.f; } }
    __syncthreads();
    { const int pb = tid >> 8, r = (tid >> 4) & 15, c = tid & 15, oi = 32 * pb + 16, oj = 32 * pb; float a = 0.f;
#pragma unroll
        for (int k = 0; k < 16; ++k) a += Nm[(oi + r) * NM_S + oj + k] * Tm[(oj + k) * NM_S + oj + c];
        Pm[pb * 272 + r * 17 + c] = a; }
    __syncthreads();
    { const int pb = tid >> 8, r = (tid >> 4) & 15, c = tid & 15, oi = 32 * pb + 16, oj = 32 * pb; float a = 0.f;
#pragma unroll
        for (int k = 0; k < 16; ++k) a -= Tm[(oi + r) * NM_S + oi + k] * Pm[pb * 272 + k * 17 + c];
        Tm[(oi + r) * NM_S + oj + c] = a; }
    __syncthreads();
    { const int r = tid >> 4, c = tid & 15; float a0 = 0.f, a1 = 0.f;
#pragma unroll 8
        for (int k = 0; k < 32; ++k) { const float nv = Nm[(32 + r) * NM_S + k]; a0 += nv * Tm[k * NM_S + c]; a1 += nv * Tm[k * NM_S + c + 16]; }
        Pm[r * 36 + c] = a0; Pm[r * 36 + c + 16] = a1; }
    __syncthreads();
    { const int r = tid >> 4, c = tid & 15; float a0 = 0.f, a1 = 0.f;
#pragma unroll 8
        for (int k = 0; k < 32; ++k) { const float tv = Tm[(32 + r) * NM_S + 32 + k]; a0 -= tv * Pm[k * 36 + c]; a1 -= tv * Pm[k * 36 + c + 16]; }
        Tm[(32 + r) * NM_S + c] = a0; Tm[(32 + r) * NM_S + c + 16] = a1; }
    __syncthreads();
    { const int i = tid >> 3, j0 = (tid & 7) * 8; float tu[8], tw[8];
#pragma unroll
        for (int q = 0; q < 8; ++q) { const int j = j0 + q; const float t = (i < 32 && j >= 32) ? 0.f : Tm[i * NM_S + j]; tu[q] = t * beta_s[j]; tw[q] = t * begc_s[j]; }
        *(u32x4*)(Tu + i * KT_S + j0) = (u32x4){cvtpk(tu[0], tu[1]), cvtpk(tu[2], tu[3]), cvtpk(tu[4], tu[5]), cvtpk(tu[6], tu[7])};
        *(u32x4*)(Tw + i * KT_S + j0) = (u32x4){cvtpk(tw[0], tw[1]), cvtpk(tw[2], tw[3]), cvtpk(tw[4], tw[5]), cvtpk(tw[6], tw[7])}; }
    __syncthreads();
    { const int mt = wave >> 2, nt = wave & 3;
        f32x16 c;
#pragma unroll
        for (int r = 0; r < 16; ++r) c[r] = 0.f;
        const bf16_t* ap = Tu + (32 * mt + r32) * KT_S + 8 * hi; const bf16_t* bp = VT + (32 * nt + r32) * KT_S + 8 * hi;
#pragma unroll
        for (int s = 0; s < 4; ++s) c = MFMA32(*(const bf16x8*)(ap + 16 * s), *(const bf16x8*)(bp + 16 * s), c);
        bf16_t* U = (bf16_t*)(dnb + DN_U);
        *(bf16x8*)(U + ((nt * 4 + mt * 2) * 64 + lane) * 8) = pack8(c, 0); *(bf16x8*)(U + ((nt * 4 + mt * 2 + 1) * 64 + lane) * 8) = pack8(c, 8);
    }
    { const int mt = wave >> 1, nt = wave & 1;
        f32x16 c;
#pragma unroll
        for (int r = 0; r < 16; ++r) c[r] = 0.f;
        const bf16_t* ap = KT + (32 * mt + r32) * KT_S + 8 * hi; const bf16_t* bp = Tw + (32 * nt + r32) * KT_S + 8 * hi;
#pragma unroll
        for (int s = 0; s < 4; ++s) c = MFMA32(*(const bf16x8*)(ap + 16 * s), *(const bf16x8*)(bp + 16 * s), c);
#pragma unroll
        for (int r = 0; r < 16; ++r) c[r] = -c[r];
        bf16_t* WN = (bf16_t*)(dnb + DN_WN);
        *(bf16x8*)(WN + ((nt * 8 + 2 * mt) * 64 + lane) * 8) = pack8(c, 0); *(bf16x8*)(WN + ((nt * 8 + 2 * mt + 1) * 64 + lane) * 8) = pack8(c, 8);
    }
    __syncthreads();
}
__device__ __forceinline__ void kv_unit(const Frame& F, int u) {
    THREAD_IDS();
    const int bh = u >> 2, s0 = (u & 3) * 512, b = bh >> 3, h = bh & 7;
    bf16_t* kt = (bf16_t*)F.lds; bf16_t* vt = kt + 512 * 64;
    const bf16_t* HP = WSP(const bf16_t, WS_HP);
#pragma unroll
    for (int it = 0; it < 8; ++it) { const int idx = it * NTHREADS + tid, r = idx >> 3, c8 = (idx & 7) * 8;
        const bf16_t* src = HP + ((size_t)b * SEQ + s0 + r) * HPW + h * 64 + c8;
        const int sw = r * 64 + (((c8 >> 3) ^ (r & 7)) << 3);
        *(u32x4*)(kt + sw) = *(const u32x4*)(src + 512); *(u32x4*)(vt + sw) = *(const u32x4*)(src + 1024); }
    __syncthreads();
    const int r32 = lane & 31, hi = lane >> 5;
#pragma unroll 1
    for (int it = 0; it < 6; ++it) { const int q = it * NWAVES + wave;
        const int di = q >> 4, bi = q & 15, d = (di == 0) ? 1 : (di == 1 ? 4 : 16), nbd = 64 / d, per = 16 / d;
        const int c = bi / per, nbl = bi % per, nb = (s0 / d) / 32 + nbl;
        const size_t fbase = ((size_t)di * (T_TOK * 512)) + (((size_t)bh * 64 + c * nbd + nb) * 4) * 512 + lane * 8;
        bf16_t* kf = WSP(bf16_t, WS_KF) + fbase; bf16_t* vf = WSP(bf16_t, WS_VT) + fbase;
        const int prow = c + d * (32 * nbl + r32);
#pragma unroll
        for (int d0 = 0; d0 < 4; ++d0) *(u32x4*)(kf + d0 * 512) = *(const u32x4*)(kt + prow * 64 + (((2 * d0 + hi) ^ (prow & 7)) << 3));
#pragma unroll
        for (int eb = 0; eb < 2; ++eb)
#pragma unroll
            for (int ks = 0; ks < 2; ++ks) { unsigned w[4];
#pragma unroll
                for (int jj = 0; jj < 4; ++jj) { const int j0 = 2 * jj, j1 = 2 * jj + 1;
                    const int n0 = 32 * nbl + 16 * ks + 8 * (j0 >> 2) + 4 * hi + (j0 & 3), n1 = 32 * nbl + 16 * ks + 8 * (j1 >> 2) + 4 * hi + (j1 & 3);
                    const int ra = c + d * n0, rb = c + d * n1, ech = 4 * eb + (r32 >> 3);
                    const unsigned lo = vt[ra * 64 + ((ech ^ (ra & 7)) << 3) + (r32 & 7)], hi2 = vt[rb * 64 + ((ech ^ (rb & 7)) << 3) + (r32 & 7)]; w[jj] = lo | (hi2 << 16); }
                *(u32x4*)(vf + (eb * 2 + ks) * 512) = (u32x4){w[0], w[1], w[2], w[3]}; }
    }
    __syncthreads();
}

constexpr int SCAN_BUF = 73728;
__device__ __forceinline__ void scan_stage4(const unsigned char* dnb, int wv, LAS unsigned char* buf, int lane) {
    const unsigned char* src = dnb + wv * 18432 + lane * 16; LAS unsigned char* dst = buf + wv * 18432;
#pragma unroll 1
    for (int f = 0; f < 18; ++f) __builtin_amdgcn_global_load_lds((const unsigned*)(src + f * 1024), (LAS unsigned*)(dst + f * 1024), 16, 0, 0);
}
__device__ __forceinline__ void scan_unit4(const Frame& F, int bh, int sl) {
    THREAD_IDS();
    const int r32 = lane & 31, hi = lane >> 5;
    const int b = bh >> 2, h = bh & 3;
    LAS unsigned char* lds3 = (LAS unsigned char*)F.lds;
    volatile LAS unsigned* sbar = (volatile LAS unsigned*)(lds3 + LDS_MISC + 4096 + 64);
    f32x16 S[4];
#pragma unroll
    for (int mt = 0; mt < 4; ++mt)
#pragma unroll
        for (int r = 0; r < 16; ++r) S[mt][r] = 0.f;
    bf16_t* ORAW = WSP(bf16_t, WS_ORAW);
    const int ch0 = bh * 32;
    scan_stage4(F.ws + WS_DN + (size_t)ch0 * DN_STRIDE, sl, lds3, lane);
#pragma unroll 1
    for (int n = 0; n < 32; ++n) {
        const int ch = ch0 + n;
        LAS unsigned char* buf = lds3 + (n & 1) * SCAN_BUF;
        float eg = WSP(const float, WS_EG)[ch];
        asm volatile("s_waitcnt vmcnt(0) lgkmcnt(0)" : "+v"(eg) :: "memory");
        if (lane == 0) __hip_atomic_fetch_add((LAS unsigned*)sbar, 1u, __ATOMIC_RELAXED, __HIP_MEMORY_SCOPE_WORKGROUP);
        { const unsigned want = 4u * (unsigned)(n + 1); while (*sbar < want) __builtin_amdgcn_s_sleep(1); }
        asm volatile("" ::: "memory");
        if (n + 1 < 32) scan_stage4(F.ws + WS_DN + (size_t)(ch + 1) * DN_STRIDE, sl, lds3 + ((n + 1) & 1) * SCAN_BUF, lane);
        const LAS unsigned char* fb = buf + lane * 16;
        bf16x8 Sb[8];
#pragma unroll
        for (int mt = 0; mt < 4; ++mt) { Sb[2 * mt] = pack8(S[mt], 0); Sb[2 * mt + 1] = pack8(S[mt], 8); }
        f32x16 vn[2], o[2];
#pragma unroll
        for (int m2 = 0; m2 < 2; ++m2) {
#pragma unroll
            for (int r8 = 0; r8 < 2; ++r8) { const u32x4 uu = *(const LAS u32x4*)(fb + 57344 + (sl * 4 + m2 * 2 + r8) * 1024);
                vn[m2][8 * r8] = bflo(uu.x); vn[m2][8 * r8 + 1] = bfhi(uu.x); vn[m2][8 * r8 + 2] = bflo(uu.y); vn[m2][8 * r8 + 3] = bfhi(uu.y);
                vn[m2][8 * r8 + 4] = bflo(uu.z); vn[m2][8 * r8 + 5] = bfhi(uu.z); vn[m2][8 * r8 + 6] = bflo(uu.w); vn[m2][8 * r8 + 7] = bfhi(uu.w); }
#pragma unroll
            for (int s = 0; s < 8; ++s) { const bf16x8 a = *(const LAS bf16x8*)(fb + (m2 * 8 + s) * 1024); vn[m2] = MFMA32(a, Sb[s], vn[m2]); }
            __builtin_amdgcn_sched_barrier(0);
#pragma unroll
            for (int r = 0; r < 16; ++r) o[m2][r] = 0.f;
#pragma unroll
            for (int s = 0; s < 8; ++s) { const bf16x8 a = *(const LAS bf16x8*)(fb + 16384 + (m2 * 8 + s) * 1024); o[m2] = MFMA32(a, Sb[s], o[m2]); }
            __builtin_amdgcn_sched_barrier(0);
        }
        bf16x8 vb[4];
#pragma unroll
        for (int m2 = 0; m2 < 2; ++m2) { vb[2 * m2] = pack8(vn[m2], 0); vb[2 * m2 + 1] = pack8(vn[m2], 8); }
#pragma unroll
        for (int m2 = 0; m2 < 2; ++m2) {
#pragma unroll
            for (int s = 0; s < 4; ++s) { const bf16x8 a = *(const LAS bf16x8*)(fb + 32768 + (m2 * 4 + s) * 1024); o[m2] = MFMA32(a, vb[s], o[m2]); }
#pragma unroll
            for (int r = 0; r < 16; ++r) ORAW[((size_t)b * SEQ + 64 * n + 32 * m2 + crow(r, hi)) * 512 + h * 128 + 32 * sl + r32] = f2bf(o[m2][r]);
            __builtin_amdgcn_sched_barrier(0);
        }
#pragma unroll
        for (int mt = 0; mt < 4; ++mt) {
#pragma unroll
            for (int r = 0; r < 16; ++r) S[mt][r] *= eg;
#pragma unroll
            for (int s = 0; s < 4; ++s) { const bf16x8 a = *(const LAS bf16x8*)(fb + 40960 + (mt * 4 + s) * 1024); S[mt] = MFMA32(a, vb[s], S[mt]); }
            if (mt & 1) __builtin_amdgcn_sched_barrier(0);
        }
    }
    asm volatile("s_waitcnt vmcnt(0) lgkmcnt(0)" ::: "memory");
}
__device__ __forceinline__ void attn_block(const bf16x8 (&kc)[4], const bf16x8 (&vc)[4], const bf16x8 (&qr)[4], f32x16 (&o)[2], float& m_run, float& l_run, int dn0  ) {
    f32x16 s;
#pragma unroll
    for (int r = 0; r < 16; ++r) s[r] = 0.f;
#pragma unroll
    for (int d0 = 0; d0 < 4; ++d0) s = MFMA32(kc[d0], qr[d0], s);
#pragma unroll
    for (int r = 0; r < 16; ++r) { const unsigned dlt = (unsigned)(dn0 - ((r & 3) + 8 * (r >> 2))); s[r] = (dlt <= 128u) ? s[r] : -INFINITY; }
    float mb = fmaxf(fmaxf(s[0], s[1]), fmaxf(s[2], s[3]));
#pragma unroll
    for (int r = 4; r < 16; r += 4) mb = fmaxf(mb, fmaxf(fmaxf(s[r], s[r + 1]), fmaxf(s[r + 2], s[r + 3])));
    { auto rr = __builtin_amdgcn_permlane32_swap(__float_as_uint(mb), __float_as_uint(mb), false, false); mb = fmaxf(__uint_as_float(rr[0]), __uint_as_float(rr[1])); }
    const float mn = fmaxf(m_run, mb);
    {
        const float al = __builtin_amdgcn_exp2f(m_run - mn);
        l_run *= al; m_run = mn;
#pragma unroll
        for (int eb = 0; eb < 2; ++eb)
#pragma unroll
            for (int r = 0; r < 16; ++r) o[eb][r] *= al;
    }
    float ps = 0.f;
#pragma unroll
    for (int r = 0; r < 16; ++r) { s[r] = __builtin_amdgcn_exp2f(s[r] - mn); ps += s[r]; }
    l_run += ps;
    const bf16x8 pb0 = pack8(s, 0), pb1 = pack8(s, 8);
#pragma unroll
    for (int eb = 0; eb < 2; ++eb)
#pragma unroll
        for (int ks = 0; ks < 2; ++ks) o[eb] = MFMA32(vc[eb * 2 + ks], ks ? pb1 : pb0, o[eb]);
}
template <int D_>
__device__ __forceinline__ void attn_branch(const Frame& F, int di, int b, int h, int t0, int jq, const bf16x8 (&qr)[4], f32x16 (&o)[2], float& m_run, float& l_run) {
    THREAD_IDS();
    const int r32 = lane & 31, hi = lane >> 5;
    constexpr int STEP = 16 / D_, NBD = 64 / D_;
    const int c = t0 % D_, a0 = t0 / D_;
    const int nq = a0 + STEP * (32 * jq + r32);
    const int nq_lo = a0 + STEP * (32 * jq), nq_hi = a0 + STEP * (32 * jq + 31);
    const int n_lo = (nq_lo - 128) > 0 ? (nq_lo - 128) : 0;
    const size_t fbase = ((size_t)di * (T_TOK * 512)) + (((size_t)(b * 8 + h) * 64 + c * NBD) * 4) * 512;
    const unsigned char* KF = (const unsigned char*)(WSP(const bf16_t, WS_KF) + fbase); const unsigned char* VF = (const unsigned char*)(WSP(const bf16_t, WS_VT) + fbase);
    const unsigned loff = (unsigned)lane * 16u;
    const int nb0 = n_lo >> 5, nb1 = nq_hi >> 5;
    const int dq = nq - 4 * hi;
#define ATT_LOAD(KX, VX, NB) do { const int nb_ = (NB) < nb1 ? (NB) : nb1; _Pragma("unroll") for (int f = 0; f < 4; ++f) { const unsigned off = (unsigned)nb_ * 4096u + loff + f * 1024; KX[f] = *(const bf16x8*)(KF + off); VX[f] = *(const bf16x8*)(VF + off); } } while (0)
    bf16x8 kA[4], vA[4], kB[4], vB[4], kC[4], vC[4];
    ATT_LOAD(kA, vA, nb0); ATT_LOAD(kB, vB, nb0 + 1);
#pragma unroll 1
    for (int nb = nb0; nb <= nb1; nb += 3) {
        ATT_LOAD(kC, vC, nb + 2);
        attn_block(kA, vA, qr, o, m_run, l_run, dq - 32 * nb);
        if (nb + 1 > nb1) break;
        ATT_LOAD(kA, vA, nb + 3);
        attn_block(kB, vB, qr, o, m_run, l_run, dq - 32 * (nb + 1));
        if (nb + 2 > nb1) break;
        ATT_LOAD(kB, vB, nb + 4);
        attn_block(kC, vC, qr, o, m_run, l_run, dq - 32 * (nb + 2));
    }
#undef ATT_LOAD
}
__device__ __forceinline__ void attn_task(const Frame& F, int a) {
    THREAD_IDS();
    const int r32 = lane & 31, hi = lane >> 5;
    const int x = F.blk & 7, bh = x + 8 * (a >> 6), tw = a & 63, t0 = tw & 15, jq = 3 - (tw >> 4), b = bh >> 3, h = bh & 7;
    const int tq = t0 + 16 * (32 * jq + r32);
    const bf16_t* HP = WSP(const bf16_t, WS_HP);
    bf16x8 qr[4];
#pragma unroll
    for (int d0 = 0; d0 < 4; ++d0) { const u32x4 qw = *(const u32x4*)(HP + ((size_t)b * SEQ + tq) * HPW + h * 64 + 16 * d0 + 8 * hi);
        constexpr float SCQ = 0.125f * 1.4426950408889634f; u32x4 w;
        w.x = cvtpk(bflo(qw.x) * SCQ, bfhi(qw.x) * SCQ); w.y = cvtpk(bflo(qw.y) * SCQ, bfhi(qw.y) * SCQ); w.z = cvtpk(bflo(qw.z) * SCQ, bfhi(qw.z) * SCQ); w.w = cvtpk(bflo(qw.w) * SCQ, bfhi(qw.w) * SCQ);
        qr[d0] = __builtin_bit_cast(bf16x8, w); }
    f32x16 o[2];
#pragma unroll
    for (int eb = 0; eb < 2; ++eb)
#pragma unroll
        for (int r = 0; r < 16; ++r) o[eb][r] = 0.f;
    float m_run = -1e30f, l_run = 0.f;
    attn_branch<1>(F, 0, b, h, t0, jq, qr, o, m_run, l_run);
    attn_branch<4>(F, 1, b, h, t0, jq, qr, o, m_run, l_run);
    attn_branch<16>(F, 2, b, h, t0, jq, qr, o, m_run, l_run);
    const float lt = sum_x32(l_run, l_run), inv = 1.f / lt;
    bf16_t* dst = WSP(bf16_t, WS_MIX) + ((size_t)b * SEQ + tq) * DM + h * 64;
#pragma unroll
    for (int eb = 0; eb < 2; ++eb)
#pragma unroll
        for (int g = 0; g < 4; ++g) { u32x2 w; w.x = cvtpk(o[eb][4 * g] * inv, o[eb][4 * g + 1] * inv); w.y = cvtpk(o[eb][4 * g + 2] * inv, o[eb][4 * g + 3] * inv);
            *(u32x2*)(dst + 32 * eb + 8 * g + 4 * hi) = w; }
}
__device__ __forceinline__ void phase3(const Frame& F, int flags) {
    THREAD_IDS();
    if (tid == 0) *(volatile LAS unsigned*)((LAS unsigned char*)F.lds + LDS_MISC + 4096 + 64) = 0u;
    __syncthreads();
    if (F.blk < 64 && wave < 4 && !(flags & 1)) scan_unit4(F, F.blk, wave);
    unsigned* qctr = WSP(unsigned, WS_CTL) + 1024 + (F.blk & 7) * 32;
    if (wave == 7) { moe_weight_stream(F, F.blk, F.G, lane); return; }
    if (flags & 2) return;
    for (;;) {
        unsigned a = 0; if (lane == 0) a = atomicAdd(qctr, 1u);
        a = (unsigned)__builtin_amdgcn_readfirstlane((int)a);
        if (a >= 1024u) break;
        attn_task(F, (int)a);
    }
}

__device__ __forceinline__ void phase4(const Frame& F) {
    THREAD_IDS();
    const float* in_gnorm_w = inptr(6);
    const int gw = F.blk * NWAVES + wave, NGW = F.G * NWAVES;
    const bf16_t* ORAW = WSP(const bf16_t, WS_ORAW); const bf16_t* HP = WSP(const bf16_t, WS_HP); bf16_t* MIX = WSP(bf16_t, WS_MIX);
    const f32x4 gw0 = *(const f32x4*)(in_gnorm_w + (lane & 15) * 8), gw1 = *(const f32x4*)(in_gnorm_w + (lane & 15) * 8 + 4);
    for (int row = gw; row < T_TOK; row += NGW) {
        const u32x4 ow = *(const u32x4*)(ORAW + (size_t)row * 512 + lane * 8), zw = *(const u32x4*)(HP + (size_t)row * HPW + 3072 + lane * 8);
        f32x4 oa, ob, za, zb; pg8::unpack8(ow, oa, ob); pg8::unpack8(zw, za, zb);
        float ss = oa[0] * oa[0] + oa[1] * oa[1] + oa[2] * oa[2] + oa[3] * oa[3] + ob[0] * ob[0] + ob[1] * ob[1] + ob[2] * ob[2] + ob[3] * ob[3];
        ss += dppf<0xB1>(ss); ss += dppf<0x4E>(ss); ss += dppf<0x141>(ss); ss += dppf<0x128>(ss);
        const float r = rsqrtf(ss * (1.f / 128.f) + 1e-6f);
        f32x4 ya, yb;
#pragma unroll
        for (int j = 0; j < 4; ++j) { ya[j] = oa[j] * r * gw0[j] * (za[j] * sigm(za[j])); yb[j] = ob[j] * r * gw1[j] * (zb[j] * sigm(zb[j])); }
        *(u32x4*)(MIX + (size_t)row * DM + 512 + lane * 8) = pg8::pack_row8(ya, yb);
    }
}

__device__ __forceinline__ void phase6(const Frame& F) {
    THREAD_IDS();
    const float* in_ln1_g = inptr(8); const float* in_ln1_b = inptr(9); const float* in_b_router = inptr(11);
    float* wrt = (float*)F.lds;
    { const f32x4* src = WSP(const f32x4, WS_WRT); f32x4* dst = (f32x4*)wrt; for (int i = tid; i < 8192; i += NTHREADS) dst[i] = src[i]; }
    __syncthreads();
    const int gw = F.blk * NWAVES + wave, NGW = F.G * NWAVES;
    bf16_t* X1 = WSP(bf16_t, WS_X1);
    unsigned* cnt = WSP(unsigned, WS_CTL); int* rt_e = WSP(int, WS_ROUTE); int* rt_s = rt_e + T_TOK * 4; int* ltok = WSP(int, WS_LTOK); float* lgate = WSP(float, WS_LGATE);
    int* s_cnt = (int*)(F.lds + LDS_MISC + 4096); int* s_base = s_cnt + 32; int* s_e = s_base + 32; float* s_g = (float*)(s_e + 512); int* s_li = (int*)(s_g + 512);
    if (tid < 32) s_cnt[tid] = 0;
    __syncthreads();
    f32x4 lg[4], lb[4];
#pragma unroll
    for (int j = 0; j < 4; ++j) { lg[j] = *(const f32x4*)(in_ln1_g + 4 * lane + 256 * j); lb[j] = *(const f32x4*)(in_ln1_b + 4 * lane + 256 * j); }
    const float brl = in_b_router[((lane >> 5) & 1) * 16 + ((lane >> 4) & 1) * 8 + ((lane >> 3) & 1) * 4 + ((lane >> 2) & 1) * 2 + ((lane >> 1) & 1)];
    const int my_e = ((lane >> 5) & 1) * 16 + ((lane >> 4) & 1) * 8 + ((lane >> 3) & 1) * 4 + ((lane >> 2) & 1) * 2 + ((lane >> 1) & 1);
#pragma unroll 1
    for (int ip = 0; ip < 8; ++ip) {
        const int rowa = gw + (2 * ip) * NGW, rowb = rowa + NGW;
        f32x4 va[4], vb[4];
        { u32x2 ra[4], rb[4];
#pragma unroll
            for (int j = 0; j < 4; ++j) { ra[j] = ((const u32x2*)(X1 + (size_t)rowa * DM) + lane)[64 * j]; rb[j] = ((const u32x2*)(X1 + (size_t)rowb * DM) + lane)[64 * j]; }
#pragma unroll
            for (int h2 = 0; h2 < 2; ++h2) { f32x4 (&v)[4] = h2 ? vb : va; const int row = h2 ? rowb : rowa; float s = 0.f;
#pragma unroll
                for (int j = 0; j < 4; ++j) { const u32x2 w = h2 ? rb[j] : ra[j]; v[j] = (f32x4){bflo(w.x), bfhi(w.x), bflo(w.y), bfhi(w.y)}; s += (v[j][0] + v[j][1]) + (v[j][2] + v[j][3]); }
                const float mean = wave_sum(s) * (1.f / DM); float s2 = 0.f;
#pragma unroll
                for (int j = 0; j < 4; ++j) { v[j] = v[j] - mean; s2 += (v[j][0] * v[j][0] + v[j][1] * v[j][1]) + (v[j][2] * v[j][2] + v[j][3] * v[j][3]); }
                const float rstd = rsqrtf(wave_sum(s2) * (1.f / DM) + LN_EPS);
#pragma unroll
                for (int j = 0; j < 4; ++j) { v[j] = v[j] * rstd * lg[j] + lb[j]; u32x2 w; w.x = cvtpk(v[j][0], v[j][1]); w.y = cvtpk(v[j][2], v[j][3]); ((u32x2*)(X1 + (size_t)row * DM) + lane)[64 * j] = w;
                    (WSP(unsigned, WS_X1F) + (size_t)row * 256)[lane + 64 * j] = pk4_fp8(v[j][0], v[j][1], v[j][2], v[j][3]); } } }
        float pl[2][32];
        int woff = 4 * lane; asm volatile("" : "+v"(woff));
#pragma unroll
        for (int e = 0; e < 32; ++e) { float a = 0.f, bsum = 0.f;
#pragma unroll
            for (int j = 0; j < 4; ++j) { const f32x4 w = *(const f32x4*)(wrt + e * 1024 + 256 * j + woff);
                a += va[j][0] * w[0] + va[j][1] * w[1] + va[j][2] * w[2] + va[j][3] * w[3]; bsum += vb[j][0] * w[0] + vb[j][1] * w[1] + vb[j][2] * w[2] + vb[j][3] * w[3]; }
            asm volatile("" : "+v"(a), "+v"(bsum)); pl[0][e] = a; pl[1][e] = bsum; if ((e & 3) == 3) asm volatile("" ::: "memory"); }
#pragma unroll
        for (int h2 = 0; h2 < 2; ++h2) {
            float q16[16], q8[8], q4[4], q2[2];
#pragma unroll
            for (int k = 0; k < 16; ++k) q16[k] = sum_x32(pl[h2][k], pl[h2][k + 16]);
#pragma unroll
            for (int k = 0; k < 8; ++k) q8[k] = sum_x16(q16[k], q16[k + 8]);
            { const bool up = (lane & 8) != 0;
#pragma unroll
                for (int k = 0; k < 4; ++k) { const float keep = up ? q8[k + 4] : q8[k], send = up ? q8[k] : q8[k + 4]; q4[k] = keep + dppf<0x128>(send); } }
            { const bool up = (lane & 4) != 0;
#pragma unroll
                for (int k = 0; k < 2; ++k) { const float keep = up ? q4[k + 2] : q4[k], send = up ? q4[k] : q4[k + 2]; q2[k] = keep + dppf<0x141>(send); } }
            float lgt;
            { const bool up = (lane & 2) != 0; const float keep = up ? q2[1] : q2[0], send = up ? q2[0] : q2[1]; lgt = keep + dppf<0x4E>(send); }
            lgt += dppf<0xB1>(lgt);
            lgt += brl;
            int rank = 0;
#pragma unroll
            for (int e = 0; e < 32; ++e) { const int src = ((e >> 4) & 1) * 32 + ((e >> 3) & 1) * 16 + ((e >> 2) & 1) * 8 + ((e >> 1) & 1) * 4 + (e & 1) * 2;
                const float ve = __uint_as_float((unsigned)__builtin_amdgcn_readlane((int)__float_as_uint(lgt), src));
                rank += (ve > lgt || (ve == lgt && e < my_e)) ? 1 : 0;
                if ((e & 7) == 7) __builtin_amdgcn_sched_barrier(0); }
            float tv[4]; int te[4];
#pragma unroll
            for (int k = 0; k < 4; ++k) { const unsigned long long mk = __ballot(rank == k && (lane & 1) == 0); const int src = (int)__builtin_ctzll(mk);
                tv[k] = __uint_as_float((unsigned)__builtin_amdgcn_readlane((int)__float_as_uint(lgt), src)); te[k] = __builtin_amdgcn_readlane(my_e, src); }
            const float e1 = __expf(tv[1] - tv[0]), e2 = __expf(tv[2] - tv[0]), e3 = __expf(tv[3] - tv[0]), inv = 1.f / (1.f + e1 + e2 + e3);
            if (lane < 4) { const int ek = lane == 0 ? te[0] : (lane == 1 ? te[1] : (lane == 2 ? te[2] : te[3]));
                const float gk = (lane == 0 ? 1.f : (lane == 1 ? e1 : (lane == 2 ? e2 : e3))) * inv;
                const int li = atomicAdd(s_cnt + ek, 1);
                const int q = (wave * 16 + 2 * ip + h2) * 4 + lane; s_e[q] = ek; s_g[q] = gk; s_li[q] = li; }
            asm volatile("" ::: "memory");
        }
    }
    __syncthreads();
    if (tid < 32) s_base[tid] = (int)atomicAdd(cnt + tid * 32, (unsigned)s_cnt[tid]);
    __syncthreads();
    { const int lr = tid >> 2, k = tid & 3, wv = lr >> 4, i = lr & 15;
        const int row = (F.blk * NWAVES + wv) + i * NGW;
        if (row < T_TOK) { const int ek = s_e[tid], slot = s_base[ek] + s_li[tid];
            ltok[(size_t)ek * LCAP + slot] = row; lgate[(size_t)ek * LCAP + slot] = s_g[tid]; rt_e[row * 4 + k] = ek; rt_s[row * 4 + k] = slot; } }
}
constexpr int ULIST_OFF = LDS_MISC + 1024, ULIST_MAX = 60;
__device__ __forceinline__ void build_tpre(const Frame& F, int nN, int ndense = 0) {
    THREAD_IDS();
    int* tpre = (int*)(F.lds + LDS_MISC); int* cnts = tpre + 64; int* ulist = (int*)(F.lds + ULIST_OFF);
    __syncthreads();
    if (tid == 0) { const unsigned* cnt = WSP(const unsigned, WS_CTL); int acc = 0;
        for (int e = 0; e < NEXP; ++e) { const int c = (int)__hip_atomic_load(cnt + e * 32, __ATOMIC_RELAXED, __HIP_MEMORY_SCOPE_AGENT); tpre[e] = acc; cnts[e] = c; acc += (c + 255) >> 8; }
        tpre[NEXP] = acc;
        if (nN > 0) { const int totale = acc * nN, total = totale + ndense; int i = 0;
            for (; i < ULIST_MAX; ++i) { const int L = pg8::unit_index(i, F.blk, F.G, total); if (L < 0) break;
                if (L >= totale) { const int l = L - totale, gid = l / 32, w = l - gid * 32;
                    ulist[4 * i] = 255 | ((w / 8) << 8); ulist[4 * i + 1] = gid * 8 + w % 8; ulist[4 * i + 2] = gid * 8 + w % 8; ulist[4 * i + 3] = 256; continue; }
                int e = 0; for (int k = 1; k < NEXP; ++k) if (L >= tpre[k] * nN) e = k;
                const int tp0 = tpre[e], tiles = tpre[e + 1] - tp0, l = L - tp0 * nN, nig = 8 * nN, gid = l / nig, fm = gid * 8, gsz = (tiles - fm) < 8 ? (tiles - fm) : 8, w = l - gid * nig;
                const int pn = w / gsz, pl = fm + w % gsz, rr = cnts[e] - 256 * pl;
                ulist[4 * i] = e | (pn << 8); ulist[4 * i + 1] = pl; ulist[4 * i + 2] = tp0 + pl; ulist[4 * i + 3] = rr < 256 ? rr : 256; }
            ulist[4 * i + 3] = 0; }
    }
    __syncthreads();
}

__device__ __forceinline__ void phase9(const Frame& F) {
    THREAD_IDS();
    const float* in_ln2_g = inptr(19); const float* in_ln2_b = inptr(20);
    build_tpre(F, 0);
    const int* tpre = (const int*)(F.lds + LDS_MISC);
    const int gw = F.blk * NWAVES + wave, NGW = F.G * NWAVES;
    const bf16_t* X1 = WSP(const bf16_t, WS_X1); const bf16_t* PLE = WSP(const bf16_t, WS_PLE); const unsigned char* YB = WSP(const unsigned char, WS_YB);
    const int* rt_e = WSP(const int, WS_ROUTE); const int* rt_s = rt_e + T_TOK * 4;
    f32x4 lg[4], lb[4];
#pragma unroll
    for (int j = 0; j < 4; ++j) { lg[j] = *(const f32x4*)(in_ln2_g + 4 * lane + 256 * j); lb[j] = *(const f32x4*)(in_ln2_b + 4 * lane + 256 * j); }
#pragma unroll 1
    for (int row0 = gw; row0 < T_TOK; row0 += 4 * NGW) {
        int rr[4]; size_t R[4][4];
#pragma unroll
        for (int q = 0; q < 4; ++q) { rr[q] = row0 + q * NGW; if (rr[q] >= T_TOK) rr[q] = row0;
#pragma unroll
            for (int k = 0; k < 4; ++k) { const int e = rt_e[rr[q] * 4 + k], sl = rt_s[rr[q] * 4 + k]; R[q][k] = (size_t)tpre[e] * 256 + sl; } }
        u32x2 xw[4][4], pw[4][4]; unsigned yw[4][4][4];
#pragma unroll
        for (int q = 0; q < 4; ++q) { const u32x2* xr = (const u32x2*)(X1 + (size_t)rr[q] * DM) + lane; const u32x2* pr = (const u32x2*)(PLE + (size_t)rr[q] * DM) + lane;
#pragma unroll
            for (int j = 0; j < 4; ++j) { xw[q][j] = xr[64 * j]; pw[q][j] = pr[64 * j]; }
#pragma unroll
            for (int k = 0; k < 4; ++k) { const unsigned* yr = (const unsigned*)(YB + R[q][k] * DM) + lane;
#pragma unroll
                for (int j = 0; j < 4; ++j) yw[q][k][j] = yr[64 * j]; } }
#pragma unroll
        for (int q = 0; q < 4; ++q) {
            f32x4 v[4];
#pragma unroll
            for (int j = 0; j < 4; ++j) { const u32x2 w = xw[q][j], p2 = pw[q][j];
                v[j] = (f32x4){bflo(w.x), bfhi(w.x), bflo(w.y), bfhi(w.y)} * ALPHA + (f32x4){bflo(p2.x), bfhi(p2.x), bflo(p2.y), bfhi(p2.y)};
#pragma unroll
                for (int k = 0; k < 4; ++k) { const int yv = (int)yw[q][k][j]; const f32x2_t lo = __builtin_amdgcn_cvt_pk_f32_fp8(yv, false), hi2 = __builtin_amdgcn_cvt_pk_f32_fp8(yv, true); v[j] = v[j] + (f32x4){lo[0], lo[1], hi2[0], hi2[1]}; } }
            float s = 0.f;
#pragma unroll
            for (int j = 0; j < 4; ++j) s += (v[j][0] + v[j][1]) + (v[j][2] + v[j][3]);
            const float mean = wave_sum(s) * (1.f / DM); float s2 = 0.f;
#pragma unroll
            for (int j = 0; j < 4; ++j) { v[j] = v[j] - mean; s2 += (v[j][0] * v[j][0] + v[j][1] * v[j][1]) + (v[j][2] * v[j][2] + v[j][3] * v[j][3]); }
            const float rstd = rsqrtf(wave_sum(s2) * (1.f / DM) + LN_EPS);
            if (row0 + q * NGW < T_TOK) { f32x4* orow = (f32x4*)(F.out + (size_t)rr[q] * DM) + lane;
#pragma unroll
                for (int j = 0; j < 4; ++j) orow[64 * j] = v[j] * rstd * lg[j] + lb[j]; }
        }
    }
}

constexpr int N_PHASES = 10;
__global__ void __launch_bounds__(NTHREADS, 2) fwd_kernel(Args args) {
    extern __shared__ __attribute__((aligned(16))) unsigned char lds_raw[];
    Frame F;
    F.lds = lds_raw; F.G = gridDim.x; F.blk = blockIdx.x;
    F.out = args.out; F.ws = args.ws;
    LAS unsigned char* lds3 = (LAS unsigned char*)lds_raw;
    const int lo = args.ph_lo, hi = args.ph_hi;
#if ONE_LAUNCH
    if (threadIdx.x < 2) ((LAS unsigned*)(lds3 + LDS_BARST))[threadIdx.x] = 0u;
    __syncthreads();
    XcdBarrier xbar = xcd_barrier_post(WSP(unsigned, WS_CTL) + CW_BAR, (volatile LAS unsigned*)(lds3 + LDS_BARST));
#define SEAM(k) do { if (lo <= (k) && (k) + 1 < hi) xcd_barrier(xbar); } while (0)
#else
#define SEAM(k) do { } while (0)
#endif
#ifndef PHASE_MASK
#define PHASE_MASK 0x3ff
#endif
#define IN(k) (((PHASE_MASK >> (k)) & 1) && lo <= (k) && (k) < hi)
#define REPS(k) 1
#if ONE_LAUNCH
#define REPSYNC() xcd_barrier(xbar)
#else
#define REPSYNC() do { } while (0)
#endif
    if (IN(0)) { for (int rep = 0; rep < REPS(0); ++rep) { if (rep) REPSYNC(); phase0(F); } SEAM(0); }
    if (IN(1)) {
        for (int rep = 0; rep < REPS(1); ++rep) { if (rep) REPSYNC();
        pg8::DenseSched S{(const char*)WSP(bf16_t, WS_XB), (const char*)WSP(bf16_t, WS_WIN), T_TOK / 256, HPW / 256, 1024, F.blk, F.G};
        pg8::EpiStore E{WSP(bf16_t, WS_HP), HPW};
        pg8::gemm_phase<false>(lds3, 1024, S, E); }
        SEAM(1);
    }
    if (IN(2)) {
        for (int rep = 0; rep < REPS(2); ++rep) { if (rep) REPSYNC();
        for (int u = F.blk; u < 2048 + 512; u += F.G) { if (u < 2048) { if (!(args.flags & 4)) dn_prep_unit(F, u); } else if (!(args.flags & 8)) kv_unit(F, u - 2048); } }
        SEAM(2);
    }
    if (IN(3)) { for (int rep = 0; rep < REPS(3); ++rep) { if (rep) { REPSYNC(); if (F.blk == 0 && threadIdx.x == 0) __hip_atomic_store(WSP(unsigned, WS_CTL) + 64, 0u, __ATOMIC_RELAXED, __HIP_MEMORY_SCOPE_AGENT); REPSYNC(); } phase3(F, args.flags); } SEAM(3); }
    if (IN(4)) { for (int rep = 0; rep < REPS(4); ++rep) { if (rep) REPSYNC(); phase4(F); } SEAM(4); }
    if (IN(5)) {
        for (int rep = 0; rep < REPS(5); ++rep) { if (rep) REPSYNC();
        pg8::DenseSched S{(const char*)WSP(bf16_t, WS_MIX), (const char*)WSP(bf16_t, WS_WOUT), T_TOK / 256, DM / 256, 1024, F.blk, F.G};
        pg8::EpiResid E{WSP(bf16_t, WS_X1), WSP(const bf16_t, WS_XB)};
        pg8::gemm_phase<false>(lds3, 1024, S, E); }
        SEAM(5);
    }
    if (IN(6)) { phase6(F); SEAM(6); }
    if (IN(7)) {
        build_tpre(F, 8, 512);
        for (int rep = 0; rep < REPS(7); ++rep) { if (rep) REPSYNC();
        { pg8::MoeSched<true> S{(const char*)WSP(unsigned char, WS_X1F), (const char*)WSP(unsigned char, WS_WGU), (size_t)2048 * 1024, WSP(const int, WS_LTOK), (const LAS int*)(lds3 + ULIST_OFF), 1024, (const char*)WSP(unsigned char, WS_WPG)};
          pg8::EpiActSig E{{WSP(unsigned char, WS_ACT), inptr(13)}, {WSP(bf16_t, WS_PLE), inptr(17)}};
          pg8::gemm_phase<true>(lds3, 1024, S, E); } }
        SEAM(7);
    }
    if (IN(8)) {
        build_tpre(F, 4);
        for (int rep = 0; rep < REPS(8); ++rep) { if (rep) REPSYNC();
        { pg8::MoeSched<false> S{(const char*)WSP(unsigned char, WS_ACT), (const char*)WSP(unsigned char, WS_WD), (size_t)1024 * 1024, nullptr, (const LAS int*)(lds3 + ULIST_OFF), 1024, nullptr};
          pg8::EpiDown E{WSP(unsigned char, WS_YB), inptr(15), WSP(const float, WS_LGATE)};
          pg8::gemm_phase<true>(lds3, 1024, S, E); } }
        { pg8::DenseSched S{(const char*)WSP(bf16_t, WS_PB), (const char*)WSP(bf16_t, WS_WPP), T_TOK / 256, DM / 256, 256, F.blk, F.G};
          pg8::EpiMul E{WSP(bf16_t, WS_PLE)};
          pg8::gemm_phase<false>(lds3, 256, S, E); }
        SEAM(8);
    }
    if (IN(9)) { for (int rep = 0; rep < REPS(9); ++rep) { if (rep) REPSYNC(); phase9(F); } }

}

extern "C" void kernel_launch(void* const* d_in, const int* in_sizes, int n_in, void* d_out, int out_size, void* d_ws, size_t ws_size, hipStream_t stream) {
    static int grid = 0;
    if (grid == 0) {
        if (n_in != 21 || out_size != T_TOK * DM || ws_size < WS_END) { fprintf(stderr, "kernel_launch: unexpected problem (n_in %d, out %d, ws %zu)\n", n_in, out_size, ws_size); grid = -1; return; }
        int dev = 0, cus = 0, per_cu = 0;
        (void)hipGetDevice(&dev); (void)hipDeviceGetAttribute(&cus, hipDeviceAttributeMultiprocessorCount, dev);
        if (hipFuncSetAttribute((const void*)fwd_kernel, hipFuncAttributeMaxDynamicSharedMemorySize, LDS_BYTES) != hipSuccess) { fprintf(stderr, "kernel_launch: hipFuncSetAttribute failed\n"); grid = -1; return; }
        (void)hipOccupancyMaxActiveBlocksPerMultiprocessor(&per_cu, (const void*)fwd_kernel, NTHREADS, LDS_BYTES);
        (void)hipGetLastError();
        if (per_cu < 1) { fprintf(stderr, "kernel_launch: occupancy query says %d workgroups per CU: cannot make the grid resident\n", per_cu); grid = -1; return; }
        grid = cus;
        if (cus != 256) fprintf(stderr, "kernel_launch: built for a 256-CU device (got %d CUs)\n", cus);
    }
    if (grid < 0) return;
    (void)hipMemsetAsync((char*)d_ws + WS_CTL, 0, 32768, stream);
    Args a{};
    for (int i = 0; i < 21; ++i) a.in[i] = (const float*)d_in[i];
    a.out = (float*)d_out; a.ws = (unsigned char*)d_ws;
#if ONE_LAUNCH
    a.ph_lo = 0; a.ph_hi = N_PHASES;
    void* kargs[] = {&a};
    hipError_t e = hipLaunchCooperativeKernel((const void*)fwd_kernel, dim3(grid), dim3(NTHREADS), kargs, LDS_BYTES, stream);
    if (e != hipSuccess) fprintf(stderr, "cooperative launch failed: %s (grid %d)\n", hipGetErrorString(e), grid);
#else
    for (int ph = 0; ph < N_PHASES; ++ph) { a.ph_lo = ph; a.ph_hi = ph + 1; hipLaunchKernelGGL(fwd_kernel, dim3(grid), dim3(NTHREADS), LDS_BYTES, stream, a);
        if (ph == (PROBE_PH)) { a.flags = PROBE_FLAGS; if (ph == 3) (void)hipMemsetAsync((char*)d_ws + WS_CTL + 4096, 0, 2048, stream); hipLaunchKernelGGL(fwd_kernel, dim3(grid), dim3(NTHREADS), LDS_BYTES, stream, a); a.flags = 0; } }
#endif
}
```

```cpp
#include <hip/hip_runtime.h>
#include <cstdio>
#include <cstdint>

#ifndef PROBE_PH
#define PROBE_PH -1
#endif
#ifndef PROBE_FLAGS
#define PROBE_FLAGS 0
#endif
#ifndef ONE_LAUNCH
#define ONE_LAUNCH 1
#endif

#define LAS __attribute__((address_space(3)))
typedef unsigned short bf16_t;
typedef short bf16x8 __attribute__((ext_vector_type(8)));
typedef float f32x4 __attribute__((ext_vector_type(4)));
typedef float f32x16 __attribute__((ext_vector_type(16)));
typedef unsigned u32x4 __attribute__((ext_vector_type(4)));
typedef unsigned u32x2 __attribute__((ext_vector_type(2)));
typedef float f32x2_t __attribute__((ext_vector_type(2)));
typedef __bf16 bf16x2_t __attribute__((ext_vector_type(2)));

constexpr int T_TOK = 32768, DM = 1024, SEQ = 2048, NBATCH = 16;
constexpr int HPW = 3584, INCOLS = 3592;
__device__ __forceinline__ size_t hp_off(size_t row, int col) { return (((row >> 4) * (HPW / 32) + (col >> 5)) * 16 + (row & 15)) * 32 + (col & 31); }
constexpr int NEXP = 32, LCAP = 32768;
constexpr float ALPHA = 1.189207115002721f;
constexpr float LN_EPS = 1e-5f;
constexpr int NWAVES = 8, NTHREADS = 512;
constexpr int LDS_BYTES = 163840;
constexpr int LDS_MISC = 147456;

constexpr size_t MiB = 1u << 20;
constexpr size_t WS_CTL = 0;
constexpr size_t WS_WGU = 1 * MiB;
constexpr size_t WS_WD = 129 * MiB;
constexpr size_t WS_WIN = 193 * MiB;
constexpr size_t WS_WOUT = 200 * MiB;
constexpr size_t WS_WPG = 202 * MiB;
constexpr size_t WS_WPP = 204 * MiB;
constexpr size_t WS_WRT = 205 * MiB;
constexpr size_t WS_BA = 206 * MiB;
constexpr size_t WS_ROUTE = 207 * MiB;
constexpr size_t WS_LTOK = 208 * MiB;
constexpr size_t WS_LGATE = 212 * MiB;
constexpr size_t WS_X1 = 216 * MiB;
constexpr size_t WS_PLE = 280 * MiB;
constexpr size_t WS_PB = 344 * MiB;
constexpr size_t WS_MIX = 360 * MiB;
constexpr size_t WS_XB = 424 * MiB;
constexpr size_t WS_HP = 488 * MiB;
constexpr size_t WS_DN = 712 * MiB;
constexpr size_t WS_EG = 888 * MiB;
constexpr size_t WS_VT = 889 * MiB;
constexpr size_t WS_KF = 216 * MiB;
constexpr size_t WS_ORAW = 985 * MiB;
constexpr size_t WS_ACT = 360 * MiB;
constexpr size_t WS_X1F = 632 * MiB;
constexpr size_t WS_YB = 672 * MiB;
constexpr size_t WS_PLE8 = 500 * MiB;
constexpr size_t WS_END = 1017 * MiB;
constexpr size_t DN_WN = 0, DN_QD = 16384, DN_AT = 32768, DN_KD = 40960, DN_U = 57344, DN_STRIDE = 73728;

__device__ __forceinline__ unsigned cvtpk(float lo, float hi) { f32x2_t v = {lo, hi}; bf16x2_t b = __builtin_convertvector(v, bf16x2_t); return __builtin_bit_cast(unsigned, b); }
typedef int v8i __attribute__((ext_vector_type(8)));
__device__ __forceinline__ unsigned pk4_fp8(float a, float b, float c, float d) { int w = __builtin_amdgcn_cvt_pk_fp8_f32(a, b, 0, false); w = __builtin_amdgcn_cvt_pk_fp8_f32(c, d, w, true); return (unsigned)w; }
__device__ __forceinline__ float bflo(unsigned u) { return __uint_as_float(u << 16); }
__device__ __forceinline__ float bfhi(unsigned u) { return __uint_as_float(u & 0xffff0000u); }
__device__ __forceinline__ bf16_t f2bf(float f) { return (bf16_t)(cvtpk(f, 0.f) & 0xffffu); }
__device__ __forceinline__ float bf2f(bf16_t h) { return __uint_as_float((unsigned)h << 16); }
__device__ __forceinline__ float sigm(float x) { return __builtin_amdgcn_rcpf(1.f + __expf(-x)); }
__device__ __forceinline__ int crow(int r, int hi) { return (r & 3) + 8 * (r >> 2) + 4 * hi; }
__device__ __forceinline__ int kperm(int k) { return (k & ~12) | ((k & 4) << 1) | ((k & 8) >> 1); }
__device__ __forceinline__ bf16x8 pack8(const f32x16& x, int b) {
    u32x4 w; w.x = cvtpk(x[b], x[b + 1]); w.y = cvtpk(x[b + 2], x[b + 3]); w.z = cvtpk(x[b + 4], x[b + 5]); w.w = cvtpk(x[b + 6], x[b + 7]);
    return __builtin_bit_cast(bf16x8, w);
}
template <int CTRL> __device__ __forceinline__ float dppf(float x) { return __builtin_bit_cast(float, __builtin_amdgcn_mov_dpp(__builtin_bit_cast(int, x), CTRL, 0xf, 0xf, true)); }
__device__ __forceinline__ float sum_x16(float a, float b) { auto s = __builtin_amdgcn_permlane16_swap(__float_as_uint(a), __float_as_uint(b), false, false); return __uint_as_float(s[0]) + __uint_as_float(s[1]); }
__device__ __forceinline__ float sum_x32(float a, float b) { auto s = __builtin_amdgcn_permlane32_swap(__float_as_uint(a), __float_as_uint(b), false, false); return __uint_as_float(s[0]) + __uint_as_float(s[1]); }
__device__ __forceinline__ float wave_sum(float v) {
    v += dppf<0xB1>(v); v += dppf<0x4E>(v); v += dppf<0x141>(v); v += dppf<0x128>(v);
    v = sum_x16(v, v); return sum_x32(v, v);
}

namespace pg8 {
constexpr int BM = 256, BK = 64, HALF = 128, HTB = HALF * BK * 2, STAGE_BYTES = 8 * HTB;
__device__ __forceinline__ int lds_byte(int r, int c) { const int st = (r >> 4) * 2 + (c >> 5), rr = r & 15, cc = c & 31, ob = rr * 64 + cc * 2; return st * 1024 + (ob ^ (((ob >> 9) & 1) << 5)); }
__device__ __forceinline__ void stage_rc(int b, int& R, int& C) { const int st = b / 1024, sb = b % 1024, swz = sb ^ (((sb >> 9) & 1) << 5); R = (st >> 1) * 16 + swz / 64; C = (st & 1) * 32 + (swz % 64) / 2; }
__device__ __forceinline__ int perm32(int rho) { const int n = rho >> 4, i = rho & 15; return 8 * (i >> 2) + 4 * n + (i & 3); }

struct Unit { const char* A; const char* B; int pm, pn, e, rows, pl; };

__device__ __forceinline__ int unit_index(int i, int c, int G, int total) {
    if (G % 8 != 0) { const int L = i * G + c; return L < total ? L : -1; }
    const int x = c & 7, per = G >> 3, li = i * per + (c >> 3), q = total >> 3, r = total & 7;
    const int start = x * q + (x < r ? x : r), size = q + (x < r ? 1 : 0);
    return li < size ? start + li : -1;
}

struct DenseSched {
    const char* Abase; const char* Bbase; int nM, nN, K, c, G;
    __device__ __forceinline__ bool next(int i, Unit& u) const {
        const int L = unit_index(i, c, G, nM * nN); if (L < 0) return false;
        const int nig = 8 * nN, gid = L / nig, fm = gid * 8, gsz = (nM - fm) < 8 ? (nM - fm) : 8, w = L - gid * nig;
        u.pn = w / gsz; u.pm = fm + w % gsz; u.e = 0; u.rows = 256; u.pl = u.pm;
        u.A = Abase + (size_t)u.pm * 256 * K * 2; u.B = Bbase + (size_t)u.pn * 256 * K * 2; return true;
    }
    static constexpr bool GATHER = false;
    __device__ __forceinline__ size_t hstepA() const { return (size_t)128 * K * 2; }
    __device__ __forceinline__ void tokload(const Unit&, const int (&)[2], unsigned (&)[2][2]) const {}
    __device__ __forceinline__ unsigned offs(const Unit&, unsigned, int, int, int) const { return 0u; }
    __device__ __forceinline__ void avoff(const Unit& u, const int (&R)[2], const int (&C)[2], unsigned (&vo)[2][2]) const {
#pragma unroll
        for (int h = 0; h < 2; ++h)
#pragma unroll
            for (int i = 0; i < 2; ++i) vo[h][i] = (unsigned)(R[i] * K + C[i]) * 2u;
    }
};
template <bool GATHER_> struct MoeSched {
    static constexpr bool GATHER = GATHER_;
    __device__ __forceinline__ size_t hstepA() const { return GATHER_ ? (size_t)0 : (size_t)128 * K; }
    const char* Abase; const char* Bbase; size_t Bstride; const int* ltok; const LAS int* ulist; int K; const char* Bdense;
    __device__ __forceinline__ bool next(int i, Unit& u) const {
        const int w0 = __builtin_amdgcn_readfirstlane(ulist[4 * i]), w1 = __builtin_amdgcn_readfirstlane(ulist[4 * i + 1]), w2 = __builtin_amdgcn_readfirstlane(ulist[4 * i + 2]), w3 = __builtin_amdgcn_readfirstlane(ulist[4 * i + 3]);
        if (w3 == 0) return false;
        u.e = w0 & 255; u.pn = w0 >> 8; u.pl = w1; u.pm = w2; u.rows = w3;
        u.A = GATHER_ ? Abase : Abase + (size_t)u.pm * 256 * K; u.B = (u.e == 255 ? Bdense : Bbase + (size_t)u.e * Bstride) + (size_t)u.pn * 256 * K; return true;
    }
    __device__ __forceinline__ void tokload(const Unit& u, const int (&R)[2], unsigned (&tk)[2][2]) const {
#pragma unroll
        for (int h = 0; h < 2; ++h)
#pragma unroll
            for (int i = 0; i < 2; ++i) { const int r = h * 128 + R[i], rc = r < u.rows ? r : u.rows - 1;
                const int* p = (u.e == 255) ? ltok + rc : ltok + (size_t)u.e * LCAP + u.pl * 256 + rc;
                asm volatile("global_load_dword %0, %1, off" : "=v"(tk[h][i]) : "v"(p) : "memory"); }
    }
    __device__ __forceinline__ unsigned offs(const Unit& u, unsigned tk, int h, int Ri, int Ci) const { const unsigned tok = (u.e == 255) ? (unsigned)(u.pm * 256 + h * 128 + Ri) : tk; return tok * (unsigned)K + (unsigned)(Ci * 2); }
    __device__ __forceinline__ void avoff(const Unit& u, const int (&R)[2], const int (&C)[2], unsigned (&vo)[2][2]) const {
#pragma unroll
        for (int h = 0; h < 2; ++h)
#pragma unroll
            for (int i = 0; i < 2; ++i) {
                if (GATHER_) { const int r = h * 128 + R[i]; int tok = 0; if (u.e == 255) tok = u.pm * 256 + r; else if (r < u.rows) tok = ltok[(size_t)u.e * LCAP + u.pl * 256 + r]; vo[h][i] = (unsigned)(tok * K + C[i] * 2); }
                else vo[h][i] = (unsigned)(R[i] * K + C[i] * 2);
            }
    }
};

typedef f32x4 Acc[2][2][4][2];

template <bool FP8, class Epi, class Sched>
__device__ __forceinline__ void gemm_phase(LAS unsigned char* lds, const int K, const Sched& S, const Epi& E) {
    const int tid = threadIdx.x, wid = __builtin_amdgcn_readfirstlane(tid >> 6), lane = tid & 63, wr = wid >> 2, wc = wid & 3, fr = lane & 15, fq = lane >> 4;
    const int RB = FP8 ? K : 2 * K;
    const int nt = RB / 128;
    int RA[2], CA[2]; unsigned voffB[2];
#pragma unroll
    for (int i = 0; i < 2; ++i) { int R, C; stage_rc(tid * 16 + i * 8192, R, C); RA[i] = R; CA[i] = C; const int Rb = (R & ~31) + perm32(R & 31); voffB[i] = (unsigned)(Rb * RB + C * 2); }
    const size_t kstep = (size_t)(BK * 2);
    const size_t hstepB = (size_t)HALF * RB, hstepA = S.hstepA();
    const unsigned ldsw = (unsigned)wid * 1024u;
    const int aoff = lds_byte(wr * 64 + fr, fq * 8), boff = lds_byte(wc * 32 + fr, fq * 8);
#define PG8_SA(b, h) (((b) * 2 + (h)) * HTB)
#define PG8_SB(b, h) ((4 + (b) * 2 + (h)) * HTB)
#define PG8_GL(gptr, ldsoff) __builtin_amdgcn_global_load_lds((const unsigned*)(gptr), (LAS unsigned*)(lds + (ldsoff)), 16, 0, 0)
#define PG8_STAGE_B(bufoff, gbase) do { PG8_GL((const char*)(gbase) + voffB[0], (bufoff) + ldsw); PG8_GL((const char*)(gbase) + voffB[1], (bufoff) + ldsw + 8192); } while (0)
#define PG8_STAGE_A(bufoff, gbase, o0, o1) do { PG8_GL((const char*)(gbase) + (o0), (bufoff) + ldsw); PG8_GL((const char*)(gbase) + (o1), (bufoff) + ldsw + 8192); } while (0)
#define PG8_LDA(dst, b, h) do { _Pragma("unroll") for (int m = 0; m < 4; ++m) { \
        if constexpr (FP8) { const u32x4 l_ = *(const LAS u32x4*)(lds + PG8_SA(b, h) + aoff + m * 2048), h_ = *(const LAS u32x4*)(lds + PG8_SA(b, h) + aoff + m * 2048 + 1024); \
            dst##8[m] = (v8i){(int)l_.x, (int)l_.y, (int)l_.z, (int)l_.w, (int)h_.x, (int)h_.y, (int)h_.z, (int)h_.w}; } \
        else { _Pragma("unroll") for (int k = 0; k < 2; ++k) dst[m][k] = *(const LAS bf16x8*)(lds + PG8_SA(b, h) + aoff + m * 2048 + k * 1024); } } } while (0)
#define PG8_LDB(dst, b, h) do { _Pragma("unroll") for (int n = 0; n < 2; ++n) { \
        if constexpr (FP8) { const u32x4 l_ = *(const LAS u32x4*)(lds + PG8_SB(b, h) + boff + n * 2048), h_ = *(const LAS u32x4*)(lds + PG8_SB(b, h) + boff + n * 2048 + 1024); \
            dst##8[n] = (v8i){(int)l_.x, (int)l_.y, (int)l_.z, (int)l_.w, (int)h_.x, (int)h_.y, (int)h_.z, (int)h_.w}; } \
        else { _Pragma("unroll") for (int k = 0; k < 2; ++k) dst[n][k] = *(const LAS bf16x8*)(lds + PG8_SB(b, h) + boff + n * 2048 + k * 1024); } } } while (0)
#define PG8_MMA(ai, bj, At, Bt) do { __builtin_amdgcn_s_setprio(1); \
        if constexpr (FP8) { _Pragma("unroll") for (int m = 0; m < 4; ++m) _Pragma("unroll") for (int n = 0; n < 2; ++n) \
            asm volatile("s_nop 1\n\tv_mfma_scale_f32_16x16x128_f8f6f4 %0, %1, %2, %0, %3, %4 op_sel_hi:[0,0,0]" : "+v"(acc[ai][bj][m][n]) : "v"(Bt##8[n]), "v"(At##8[m]), "v"(sc_w), "v"(sc_a)); } \
        else { _Pragma("unroll") for (int m = 0; m < 4; ++m) _Pragma("unroll") for (int n = 0; n < 2; ++n) _Pragma("unroll") for (int k = 0; k < 2; ++k) \
            acc[ai][bj][m][n] = __builtin_amdgcn_mfma_f32_16x16x32_bf16(Bt[n][k], At[m][k], acc[ai][bj][m][n], 0, 0, 0); } \
        __builtin_amdgcn_s_setprio(0); } while (0)
#define PG8_WAIT_V(n) asm volatile("s_waitcnt vmcnt(" #n ")" ::: "memory")
#define PG8_WAIT_L(n) asm volatile("s_waitcnt lgkmcnt(" #n ")" ::: "memory")
#define PG8_BAR __builtin_amdgcn_s_barrier()
#define PG8_SCHED __builtin_amdgcn_sched_barrier(0)
    Unit cur, nxt; int ui = 0;
    if (!S.next(0, cur)) return;
    unsigned vc[2][2], vn[2][2];
    if constexpr (Sched::GATHER) {
        unsigned t0k[2][2]; S.tokload(cur, RA, t0k); asm volatile("s_waitcnt vmcnt(0)" ::: "memory");
#pragma unroll
        for (int h = 0; h < 2; ++h)
#pragma unroll
            for (int i = 0; i < 2; ++i) { asm volatile("" : "+v"(t0k[h][i])); vc[h][i] = S.offs(cur, t0k[h][i], h, RA[i], CA[i]); }
    } else S.avoff(cur, RA, CA, vc);
    Acc acc;
#pragma unroll
    for (int a = 0; a < 2; ++a)
#pragma unroll
        for (int b = 0; b < 2; ++b)
#pragma unroll
            for (int m = 0; m < 4; ++m)
#pragma unroll
                for (int n = 0; n < 2; ++n) acc[a][b][m][n] = (f32x4){0.f, 0.f, 0.f, 0.f};
    const int sc_w = 122, sc_a = 127;
    bf16x8 At[4][2], B0[2][2], B1[2][2]; v8i At8[4], B08[2], B18[2];
    const char* cA = cur.A; const char* cB = cur.B;
    E.pre(cur, 0, wid, lane);
    PG8_STAGE_B(PG8_SB(0, 0), cB); PG8_STAGE_B(PG8_SB(0, 1), cB + hstepB); PG8_STAGE_A(PG8_SA(0, 0), cA, vc[0][0], vc[0][1]); PG8_STAGE_A(PG8_SA(0, 1), cA + hstepA, vc[1][0], vc[1][1]);
    if (wr == 1) PG8_BAR;
    PG8_WAIT_V(2); PG8_BAR;
    PG8_STAGE_B(PG8_SB(1, 0), cB + kstep); PG8_STAGE_A(PG8_SA(1, 0), cA + kstep, vc[0][0], vc[0][1]); PG8_STAGE_B(PG8_SB(1, 1), cB + hstepB + kstep);
    PG8_WAIT_V(6); PG8_BAR;
    for (;;) {
        const bool has_next = S.next(ui + 1, nxt);
        unsigned tk[2][2] = {{0u, 0u}, {0u, 0u}};
        if (Sched::GATHER && has_next) S.tokload(nxt, RA, tk);
#pragma unroll
        for (int h = 0; h < 2; ++h)
#pragma unroll
            for (int i = 0; i < 2; ++i) vn[h][i] = vc[h][i];
        const char* nA = has_next ? nxt.A : cA; const char* nB = has_next ? nxt.B : cB;
#pragma unroll 1
        for (int t = 0; t < nt; t += 2) {
            const bool last = (t == nt - 2);
            if constexpr (Sched::GATHER) {
#pragma unroll
                for (int h = 0; h < 2; ++h)
#pragma unroll
                    for (int i = 0; i < 2; ++i) { asm volatile("" : "+v"(tk[h][i])); vn[h][i] = has_next ? S.offs(nxt, tk[h][i], h, RA[i], CA[i]) : vc[h][i]; }
            }
            const char* a1 = cA + (size_t)(t + 1) * kstep;
            const char* a2 = last ? nA : cA + (size_t)(t + 2) * kstep; const char* b2 = last ? nB : cB + (size_t)(t + 2) * kstep;
            const char* a3 = a2 + kstep; const char* b3 = b2 + kstep;
            const unsigned o00 = last ? vn[0][0] : vc[0][0], o01 = last ? vn[0][1] : vc[0][1], o10 = last ? vn[1][0] : vc[1][0], o11 = last ? vn[1][1] : vc[1][1];
            PG8_LDB(B0, 0, 0); PG8_LDB(B1, 0, 1); PG8_SCHED; PG8_LDA(At, 0, 0); PG8_STAGE_A(PG8_SA(1, 1), a1 + hstepA, vc[1][0], vc[1][1]);
            PG8_WAIT_V(8); PG8_WAIT_L(0); PG8_BAR; PG8_MMA(0, 0, At, B0); PG8_MMA(0, 1, At, B1); PG8_BAR; PG8_SCHED;
            PG8_LDA(At, 0, 1); PG8_STAGE_B(PG8_SB(0, 0), b2); PG8_STAGE_B(PG8_SB(0, 1), b2 + hstepB); PG8_STAGE_A(PG8_SA(0, 0), a2, o00, o01);
            PG8_WAIT_V(8); PG8_WAIT_L(0); PG8_BAR; PG8_MMA(1, 0, At, B0); PG8_MMA(1, 1, At, B1); PG8_BAR; PG8_SCHED;
            PG8_LDB(B0, 1, 0); PG8_LDB(B1, 1, 1); PG8_SCHED; PG8_LDA(At, 1, 0); PG8_STAGE_A(PG8_SA(0, 1), a2 + hstepA, o10, o11);
            PG8_WAIT_V(8); PG8_WAIT_L(0); PG8_BAR; PG8_MMA(0, 0, At, B0); PG8_MMA(0, 1, At, B1); PG8_BAR; PG8_SCHED;
            PG8_LDA(At, 1, 1); PG8_STAGE_B(PG8_SB(1, 0), b3); PG8_STAGE_B(PG8_SB(1, 1), b3 + hstepB); PG8_STAGE_A(PG8_SA(1, 0), a3, o00, o01);
            PG8_WAIT_V(8); PG8_WAIT_L(0); PG8_BAR; PG8_MMA(1, 0, At, B0); PG8_MMA(1, 1, At, B1); PG8_BAR; PG8_SCHED;
        }
        if (wr == 0) PG8_BAR;
        if constexpr (FP8) asm volatile("s_nop 15\n\ts_nop 15" ::: "memory");
        E(acc, cur, wr, wc, fr, fq, ui & 1);
        if (!has_next) break;
#pragma unroll
        for (int a = 0; a < 2; ++a)
#pragma unroll
            for (int b = 0; b < 2; ++b)
#pragma unroll
                for (int m = 0; m < 4; ++m)
#pragma unroll
                    for (int n = 0; n < 2; ++n) acc[a][b][m][n] = (f32x4){0.f, 0.f, 0.f, 0.f};
        cur = nxt; cA = nA; cB = nB; ++ui;
        E.pre(cur, ui & 1, wid, lane);
#pragma unroll
        for (int h = 0; h < 2; ++h)
#pragma unroll
            for (int i = 0; i < 2; ++i) vc[h][i] = vn[h][i];
        if (wr == 1) PG8_BAR;
    }
    PG8_WAIT_V(0);
    PG8_BAR;
#undef PG8_SA
#undef PG8_SB
#undef PG8_GL
#undef PG8_STAGE_A
#undef PG8_STAGE_B
#undef PG8_LDA
#undef PG8_LDB
#undef PG8_MMA
#undef PG8_WAIT_V
#undef PG8_WAIT_L
#undef PG8_BAR
#undef PG8_SCHED
}

__device__ __forceinline__ u32x4 pack_row8(const f32x4& v0, const f32x4& v1) { u32x4 w; w.x = cvtpk(v0[0], v0[1]); w.y = cvtpk(v0[2], v0[3]); w.z = cvtpk(v1[0], v1[1]); w.w = cvtpk(v1[2], v1[3]); return w; }
__device__ __forceinline__ void unpack8(const u32x4& w, f32x4& a, f32x4& b) { a = (f32x4){bflo(w.x), bfhi(w.x), bflo(w.y), bfhi(w.y)}; b = (f32x4){bflo(w.z), bfhi(w.z), bflo(w.w), bfhi(w.w)}; }

struct EpiStore {
    bf16_t* O; int ldc;
    __device__ __forceinline__ void pre(const Unit&, int, int, int) const {}
    __device__ __forceinline__ void operator()(const Acc& acc, const Unit& u, int wr, int wc, int fr, int fq, int par) const {
        const int row0 = u.pm * BM + wr * 64 + fr, col0 = u.pn * BM + wc * 32 + 8 * fq;
#pragma unroll
        for (int ai = 0; ai < 2; ++ai)
#pragma unroll
            for (int m = 0; m < 4; ++m) { bf16_t* rowp = O + (size_t)(row0 + ai * HALF + m * 16) * ldc + col0;
#pragma unroll
                for (int bj = 0; bj < 2; ++bj) *(u32x4*)(rowp + bj * HALF) = pack_row8(acc[ai][bj][m][0], acc[ai][bj][m][1]); }
    }
};
struct EpiStoreBlk {
    bf16_t* O;
    __device__ __forceinline__ void pre(const Unit&, int, int, int) const {}
    __device__ __forceinline__ void operator()(const Acc& acc, const Unit& u, int wr, int wc, int fr, int fq, int par) const {
        bf16_t* base = O + ((size_t)(u.pm * 16 + wr * 4) * (HPW / 32) + u.pn * 8 + wc) * 512 + fr * 32 + fq * 8;
#pragma unroll
        for (int ai = 0; ai < 2; ++ai)
#pragma unroll
            for (int m = 0; m < 4; ++m)
#pragma unroll
                for (int bj = 0; bj < 2; ++bj) *(u32x4*)(base + ((size_t)(ai * 8 + m) * (HPW / 32) + bj * 4) * 512) = pack_row8(acc[ai][bj][m][0], acc[ai][bj][m][1]);
    }
};
struct EpiResid {
    bf16_t* O; const bf16_t* X;
    __device__ __forceinline__ void pre(const Unit&, int, int, int) const {}
    __device__ __forceinline__ void operator()(const Acc& acc, const Unit& u, int wr, int wc, int fr, int fq, int par) const {
        const int row0 = u.pm * BM + wr * 64 + fr, col0 = u.pn * BM + wc * 32 + 8 * fq;
        u32x4 xw[2][4][2];
#pragma unroll
        for (int ai = 0; ai < 2; ++ai)
#pragma unroll
            for (int m = 0; m < 4; ++m)
#pragma unroll
                for (int bj = 0; bj < 2; ++bj) xw[ai][m][bj] = *(const u32x4*)(X + (size_t)(row0 + ai * HALF + m * 16) * DM + col0 + bj * HALF);
#pragma unroll
        for (int ai = 0; ai < 2; ++ai)
#pragma unroll
            for (int m = 0; m < 4; ++m) { const size_t off = (size_t)(row0 + ai * HALF + m * 16) * DM + col0;
#pragma unroll
                for (int bj = 0; bj < 2; ++bj) { f32x4 xa, xb; unpack8(xw[ai][m][bj], xa, xb);
                    *(u32x4*)(O + off + bj * HALF) = pack_row8(xa * ALPHA + acc[ai][bj][m][0], xb * ALPHA + acc[ai][bj][m][1]); } }
    }
};
struct EpiAct {
    unsigned char* O; const float* bgu; LAS unsigned char* bl;
    __device__ __forceinline__ void pre(const Unit& u, int par, int wid, int lane) const {
        if (wid == 0) { const float* src = bgu + (size_t)u.e * 2048 + u.pn * HALF + (lane & 31) * 4 + (lane >> 5) * 1024;
            __builtin_amdgcn_global_load_lds((const unsigned*)src, (LAS unsigned*)(bl + par * 2048), 16, 0, 0); }
    }
    __device__ __forceinline__ void operator()(const Acc& acc, const Unit& u, int wr, int wc, int fr, int fq, int par) const {
        int frx = fr, fqx = fq; asm volatile("" : "+v"(frx), "+v"(fqx));
        const int cl = u.pn * HALF + wc * 32 + 8 * fqx;
        const LAS float* bg = (const LAS float*)(bl + par * 2048) + wc * 32 + 8 * fqx;
        const f32x4 g0 = *(const LAS f32x4*)bg, g1 = *(const LAS f32x4*)(bg + 4), u0 = *(const LAS f32x4*)(bg + 128), u1 = *(const LAS f32x4*)(bg + 132);
        unsigned char* obase = O + (size_t)(u.pm * BM + wr * 64 + frx) * DM + cl;
        const int rl0 = wr * 64 + frx;
#pragma unroll
        for (int ai = 0; ai < 2; ++ai)
#pragma unroll
            for (int m = 0; m < 4; ++m) { const int rl = ai * HALF + m * 16 + rl0;
                unsigned w[2];
#pragma unroll
                for (int n = 0; n < 2; ++n) { const f32x4 hg = acc[ai][0][m][n] + (n ? g1 : g0), hu = acc[ai][1][m][n] + (n ? u1 : u0); float o4[4];
#pragma unroll
                    for (int j = 0; j < 4; ++j) { const float g = fminf(hg[j], 7.f), up = fminf(fmaxf(hu[j], -7.f), 7.f);
                        o4[j] = (up + 1.f) * g * __builtin_amdgcn_rcpf(1.f + __builtin_amdgcn_exp2f(-2.4554669595930157f * g)); }
                    w[n] = pk4_fp8(o4[0], o4[1], o4[2], o4[3]); asm volatile("" : "+v"(w[n])); }
                if (rl < u.rows) *(u32x2*)(obase + (size_t)(ai * HALF + m * 16) * DM) = (u32x2){w[0], w[1]};
                asm volatile("" ::: "memory"); }
    }
};
struct EpiDown {
    unsigned char* O; const float* bd; const float* lgate; LAS unsigned char* st; LAS unsigned char* bl;
    __device__ __forceinline__ void pre(const Unit& u, int par, int wid, int lane) const {
        if (wid == 0) __builtin_amdgcn_global_load_lds((const unsigned*)(bd + (size_t)u.e * DM + u.pn * BM + lane * 4), (LAS unsigned*)(bl + par * 2048), 16, 0, 0);
        if (wid == 1) __builtin_amdgcn_global_load_lds((const unsigned*)(lgate + (size_t)u.e * LCAP + u.pl * BM + lane * 4), (LAS unsigned*)(bl + par * 2048 + 1024), 16, 0, 0);
    }
    __device__ __forceinline__ void operator()(const Acc& acc, const Unit& u, int wr, int wc, int fr, int fq, int par) const {
        const LAS float* bp = (const LAS float*)(bl + par * 2048) + wc * 32 + 8 * fq;
        f32x4 bv[2][2]; float gt[2][4];
#pragma unroll
        for (int bj = 0; bj < 2; ++bj) { bv[bj][0] = *(const LAS f32x4*)(bp + bj * HALF); bv[bj][1] = *(const LAS f32x4*)(bp + bj * HALF + 4); }
        const LAS float* gp = (const LAS float*)(bl + par * 2048 + 1024) + wr * 64 + fr;
#pragma unroll
        for (int ai = 0; ai < 2; ++ai)
#pragma unroll
            for (int m = 0; m < 4; ++m) gt[ai][m] = gp[ai * HALF + m * 16];
        int frx = fr, fqx = fq; asm volatile("" : "+v"(frx), "+v"(fqx));
        const int lane = fqx * 16 + frx, wid = wr * 4 + wc;
        const unsigned wbase = (unsigned)(wc * 2 + (fqx >> 1)), wsub = (unsigned)((fqx & 1) * 8);
        const int rrow = wid * 8 + (lane >> 4), rch = lane & 15;
        unsigned char* og = O + (size_t)(u.pm * BM) * DM + u.pn * BM + rch * 16;
#pragma unroll
        for (int r = 0; r < 4; ++r) { const int ai = r >> 1, mh = r & 1;
#pragma unroll
            for (int mm = 0; mm < 2; ++mm) { const int m = 2 * mh + mm; const float g = gt[ai][m]; const unsigned row = (unsigned)(wr * 32 + mm * 16 + frx);
#pragma unroll
                for (int bj = 0; bj < 2; ++bj) { const f32x4 a = (acc[ai][bj][m][0] + bv[bj][0]) * g, b = (acc[ai][bj][m][1] + bv[bj][1]) * g;
                    const unsigned ch = (unsigned)(bj * 8) + wbase;
                    *(LAS u32x2*)(st + row * 256u + ((ch ^ (row & 15u)) << 4) + wsub) = (u32x2){pk4_fp8(a[0], a[1], a[2], a[3]), pk4_fp8(b[0], b[1], b[2], b[3])}; } }
            asm volatile("s_waitcnt lgkmcnt(0)" ::: "memory"); __builtin_amdgcn_s_barrier();
#pragma unroll
            for (int i = 0; i < 2; ++i) { const unsigned lr = (unsigned)(rrow + 4 * i); const int rl = ai * HALF + (int)(lr >> 5) * 64 + mh * 32 + (int)(lr & 31u);
                const u32x4 v = *(const LAS u32x4*)(st + lr * 256u + (((unsigned)rch ^ (lr & 15u)) << 4));
                if (rl < u.rows) *(u32x4*)(og + (size_t)rl * DM) = v; }
            if (r < 3) { asm volatile("s_waitcnt lgkmcnt(0)" ::: "memory"); __builtin_amdgcn_s_barrier(); }
        }
    }
};
struct EpiSig {
    bf16_t* O; const float* bias; LAS unsigned char* bl;
    __device__ __forceinline__ void pre(const Unit& u, int par, int wid, int lane) const {
        if (wid == 0) __builtin_amdgcn_global_load_lds((const unsigned*)(bias + u.pn * BM + lane * 4), (LAS unsigned*)(bl + par * 2048), 16, 0, 0);
    }
    __device__ __forceinline__ void operator()(const Acc& acc, const Unit& u, int wr, int wc, int fr, int fq, int par) const {
        const int row0 = u.pm * BM + wr * 64 + fr, col0 = u.pn * BM + wc * 32 + 8 * fq;
        f32x4 bv[2][2];
#pragma unroll
        for (int bj = 0; bj < 2; ++bj)
#pragma unroll
            for (int n = 0; n < 2; ++n) bv[bj][n] = *(const LAS f32x4*)((const LAS float*)(bl + par * 2048) + wc * 32 + 8 * fq + bj * HALF + 4 * n);
        bf16_t* base = O + ((size_t)(u.pm * 16 + wr * 4) * 32 + u.pn * 8 + wc) * 512 + fr * 32 + fq * 8;
#pragma unroll
        for (int ai = 0; ai < 2; ++ai)
#pragma unroll
            for (int m = 0; m < 4; ++m) {
#pragma unroll
                for (int bj = 0; bj < 2; ++bj) { f32x4 a = acc[ai][bj][m][0] + bv[bj][0], b = acc[ai][bj][m][1] + bv[bj][1];
#pragma unroll
                    for (int j = 0; j < 4; ++j) { a[j] = sigm(a[j]); b[j] = sigm(b[j]); }
                    *(u32x4*)(base + ((size_t)(ai * 8 + m) * 32 + bj * 4) * 512) = pack_row8(a, b); }
                asm volatile("" ::: "memory"); }
    }
};
struct EpiActSig {
    EpiAct a; EpiSig g;
    __device__ __forceinline__ void pre(const Unit& u, int par, int wid, int lane) const { if (u.e == 255) g.pre(u, par, wid, lane); else a.pre(u, par, wid, lane); }
    __device__ __forceinline__ void operator()(const Acc& acc, const Unit& u, int wr, int wc, int fr, int fq, int par) const { if (u.e == 255) g(acc, u, wr, wc, fr, fq, par); else a(acc, u, wr, wc, fr, fq, par); }
};
struct EpiMul {
    const bf16_t* G; unsigned char* O;
    __device__ __forceinline__ void pre(const Unit&, int, int, int) const {}
    __device__ __forceinline__ void operator()(const Acc& acc, const Unit& u, int wr, int wc, int fr, int fq, int par) const {
        const size_t blk0 = (size_t)(u.pm * 16 + wr * 4) * 32 + u.pn * 8 + wc;
        const bf16_t* gbase = G + blk0 * 512 + fr * 32 + fq * 8; unsigned char* obase = O + blk0 * 512 + fr * 32 + fq * 8;
        u32x4 gw[2][4][2];
#pragma unroll
        for (int ai = 0; ai < 2; ++ai)
#pragma unroll
            for (int m = 0; m < 4; ++m)
#pragma unroll
                for (int bj = 0; bj < 2; ++bj) gw[ai][m][bj] = *(const u32x4*)(gbase + ((size_t)(ai * 8 + m) * 32 + bj * 4) * 512);
#pragma unroll
        for (int ai = 0; ai < 2; ++ai)
#pragma unroll
            for (int m = 0; m < 4; ++m)
#pragma unroll
                for (int bj = 0; bj < 2; ++bj) { f32x4 ga, gb; unpack8(gw[ai][m][bj], ga, gb); ga = ga * acc[ai][bj][m][0] * 8.f; gb = gb * acc[ai][bj][m][1] * 8.f;
                    *(u32x2*)(obase + ((size_t)(ai * 8 + m) * 32 + bj * 4) * 512) = (u32x2){pk4_fp8(ga[0], ga[1], ga[2], ga[3]), pk4_fp8(gb[0], gb[1], gb[2], gb[3])}; }
    }
};
}

#define XB_TMO      128
#define XB_XCNT(j)  (256  + 64 * (j))
#define XB_XSUB(j)  (1280 + 64 * (j))
#define XB_XGEN(j)  (2304 + 64 * (j))
#define XB_TOP      3328
#define XB_TOPGEN   3392
#define XCD_BAR_WORDS 3456
#define XB_SPIN_CAP (1u << 22)
constexpr int CW_BAR = 4096;
constexpr int LDS_BARST = LDS_MISC + 2048;
__device__ __forceinline__ unsigned xb_ld(unsigned* p)              { return __hip_atomic_load(p, __ATOMIC_RELAXED, __HIP_MEMORY_SCOPE_AGENT); }
__device__ __forceinline__ unsigned xb_add(unsigned* p, unsigned v) { return __hip_atomic_fetch_add(p, v, __ATOMIC_RELAXED, __HIP_MEMORY_SCOPE_AGENT); }
__device__ __forceinline__ unsigned xb_xcc_id() { return (unsigned)__builtin_amdgcn_s_getreg((3 << 11) | 20) & 0xFu; }
#define XB_SPIN(cond, bar) do { unsigned _sp = 0; while (cond) { __builtin_amdgcn_s_sleep(1); \
    if ((++_sp & 255u) == 0u) { if (xb_ld(&(bar)[XB_TMO])) break; if (_sp > XB_SPIN_CAP) { atomicAdd(&(bar)[XB_TMO], 1u); break; } } } } while (0)
struct XcdBarrier { unsigned* bar; unsigned x; volatile LAS unsigned* st; };
__device__ __forceinline__ XcdBarrier xcd_barrier_post(unsigned* bar, volatile LAS unsigned* st) {
    XcdBarrier b; b.bar = bar; b.x = xb_xcc_id(); b.st = st;
    if (threadIdx.x == 0) (void)xb_add(&bar[XB_XCNT(b.x)], 1u);
    return b;
}
__device__ __forceinline__ void xcd_barrier_complete(unsigned* bar, unsigned x, unsigned& nloc, unsigned& nx) {
    const unsigned G = gridDim.x * gridDim.y * gridDim.z;
    unsigned sum, cnt, mine, sp = 0u;
    for (;;) {
        sum = 0u; cnt = 0u; mine = 0u;
#pragma unroll
        for (unsigned j = 0; j < 16; ++j) { const unsigned c = xb_ld(&bar[XB_XCNT(j)]); sum += c; cnt += (c > 0u) ? 1u : 0u; mine = (j == x) ? c : mine; }
        if (sum == G) break;
        __builtin_amdgcn_s_sleep(1);
        if ((++sp & 255u) == 0u) { if (xb_ld(&bar[XB_TMO])) break; if (sp > XB_SPIN_CAP) { atomicAdd(&bar[XB_TMO], 1u); break; } }
    }
    nloc = mine > 0u ? mine : 1u; nx = cnt > 0u ? cnt : 1u;
}
__device__ __forceinline__ void xcd_barrier(const XcdBarrier& b) {
    asm volatile("s_waitcnt vmcnt(0)" ::: "memory");
    __syncthreads();
    if (threadIdx.x == 0) {
        unsigned* bar = b.bar;
        __builtin_amdgcn_s_waitcnt(0);
        unsigned nloc = b.st[0], nx = b.st[1];
        if (nloc == 0u) { xcd_barrier_complete(bar, b.x, nloc, nx); b.st[0] = nloc; b.st[1] = nx; }
        const unsigned old = xb_add(&bar[XB_XSUB(b.x)], 1u);
        const unsigned gen = old / nloc;
        if (old + 1u == (gen + 1u) * nloc) {
            __builtin_amdgcn_fence(__ATOMIC_RELEASE, "agent");
            asm volatile("s_waitcnt vmcnt(0)" ::: "memory");
            const unsigned og = xb_add(&bar[XB_TOP], 1u);
            const unsigned tg = og / nx;
            if (og + 1u == (tg + 1u) * nx) xb_add(&bar[XB_TOPGEN], 1u);
            else XB_SPIN(xb_ld(&bar[XB_TOPGEN]) == tg, bar);
            xb_add(&bar[XB_XGEN(b.x)], 1u);
            __builtin_amdgcn_fence(__ATOMIC_ACQUIRE, "agent");
            asm volatile("s_waitcnt vmcnt(0)" ::: "memory");
        } else {
            XB_SPIN(xb_ld(&bar[XB_XGEN(b.x)]) == gen, bar);
            __builtin_amdgcn_fence(__ATOMIC_ACQUIRE, "agent");
            asm volatile("s_waitcnt vmcnt(0)" ::: "memory");
        }
    }
    __syncthreads();
}

struct Args { const float* in[21]; float* out; unsigned char* ws; int ph_lo, ph_hi; int flags, pad; };
#define THREAD_IDS() int tid = threadIdx.x; asm volatile("" : "+v"(tid)); const int lane = tid & 63; const int wave = __builtin_amdgcn_readfirstlane(tid >> 6); (void)lane; (void)wave
struct Frame {
    unsigned char* lds; int G, blk;
    float* out; unsigned char* ws;
};
__device__ __forceinline__ const float* inptr(int k) {
    const char* ka = (const char*)__builtin_amdgcn_kernarg_segment_ptr(); asm volatile("" : "+s"(ka));
    return *(const float* const*)(ka + 8 * k);
}
#define WSP(T, off) ((T*)(F.ws + (off)))

constexpr int MOE_TILES = NEXP * 16 * 32 + NEXP * 16 * 16;
struct WTile { const float* src; unsigned char* dst; int ldn; };
__device__ __forceinline__ WTile moe_tile_addr(const Frame& F, int r, const float* w_gate_up, const float* w_down, int lane) {
    constexpr int I_GU = NEXP * 16 * 32; const int q4 = lane >> 4, c = lane & 15; WTile t;
    if (r < I_GU) { const int e = r / 512, q = r % 512, kb = q / 32, nb = q % 32, n0 = 64 * nb;
        const int j0 = n0 & 1023, drow0 = 256 * (j0 >> 7) + (j0 & 127) + ((n0 >= 1024) ? 128 : 0);
        t.src = w_gate_up + (size_t)e * 1024 * 2048 + (size_t)(64 * kb + 16 * q4) * 2048 + n0 + 4 * c; t.ldn = 2048;
        t.dst = WSP(unsigned char, WS_WGU) + (size_t)e * 2048 * 1024 + (size_t)(drow0 + 4 * c) * 1024 + 64 * kb + 16 * q4; }
    else { r -= I_GU; const int e = r / 256, q = r % 256, kb = q / 16, nb = q % 16;
        t.src = w_down + (size_t)e * 1024 * 1024 + (size_t)(64 * kb + 16 * q4) * 1024 + 64 * nb + 4 * c; t.ldn = 1024;
        t.dst = WSP(unsigned char, WS_WD) + (size_t)e * 1024 * 1024 + (size_t)(64 * nb + 4 * c) * 1024 + 64 * kb + 16 * q4; }
    return t;
}
__device__ __forceinline__ void wtile_load(f32x4 (&v)[16], const WTile& t) {
#pragma unroll
    for (int i = 0; i < 16; ++i) v[i] = *(const f32x4*)(t.src + (size_t)i * t.ldn);
}
__device__ __forceinline__ void wtile_store(const f32x4 (&v)[16], const WTile& t) {
#pragma unroll
    for (int j = 0; j < 4; ++j) {
        u32x4 o;
        o.x = pk4_fp8(v[0][j] * 32.f, v[1][j] * 32.f, v[2][j] * 32.f, v[3][j] * 32.f); o.y = pk4_fp8(v[4][j] * 32.f, v[5][j] * 32.f, v[6][j] * 32.f, v[7][j] * 32.f);
        o.z = pk4_fp8(v[8][j] * 32.f, v[9][j] * 32.f, v[10][j] * 32.f, v[11][j] * 32.f); o.w = pk4_fp8(v[12][j] * 32.f, v[13][j] * 32.f, v[14][j] * 32.f, v[15][j] * 32.f);
        *(u32x4*)(t.dst + (size_t)j * 1024) = o;
    }
}
__device__ __forceinline__ void moe_weight_batch3(const Frame& F, int r0, int stride, const float* w_gate_up, const float* w_down, int lane) {
    const WTile t0 = moe_tile_addr(F, r0, w_gate_up, w_down, lane), t1 = moe_tile_addr(F, r0 + stride, w_gate_up, w_down, lane), t2 = moe_tile_addr(F, r0 + 2 * stride, w_gate_up, w_down, lane);
    f32x4 va[16], vb[16];
    wtile_load(va, t0); wtile_load(vb, t1);
    wtile_store(va, t0); wtile_load(va, t2);
    wtile_store(vb, t1); wtile_store(va, t2);
}

__device__ __forceinline__ void p0_transpose_tile(const float* W, int ldn, int k0, int n0, bf16_t* WT, int Kd, int drow0, int lane) {
    const int q = lane >> 4, c = lane & 15;
    const float* src = W + (size_t)(k0 + 16 * q) * ldn + n0 + 4 * c;
    f32x4 v[16];
#pragma unroll
    for (int i = 0; i < 16; ++i) v[i] = *(const f32x4*)(src + (size_t)i * ldn);
    bf16_t* dst = WT + (size_t)(drow0 + 4 * c) * Kd + k0 + 16 * q;
#pragma unroll
    for (int j = 0; j < 4; ++j) {
        u32x4 o0, o1;
        o0.x = cvtpk(v[0][j], v[1][j]); o0.y = cvtpk(v[2][j], v[3][j]); o0.z = cvtpk(v[4][j], v[5][j]); o0.w = cvtpk(v[6][j], v[7][j]);
        o1.x = cvtpk(v[8][j], v[9][j]); o1.y = cvtpk(v[10][j], v[11][j]); o1.z = cvtpk(v[12][j], v[13][j]); o1.w = cvtpk(v[14][j], v[15][j]);
        *(u32x4*)(dst + (size_t)j * Kd) = o0; *(u32x4*)(dst + (size_t)j * Kd + 8) = o1;
    }
}
__device__ __forceinline__ void phase0(const Frame& F) {
    THREAD_IDS();
    const float* in_x = inptr(0); const float* in_p = inptr(1); const float* in_w_in = inptr(2); const float* in_w_out = inptr(7); const float* in_w_router = inptr(10); const float* in_w_ple_gate = inptr(16); const float* in_w_ple_proj = inptr(18);
    float* wba = (float*)F.lds;
    { float t[16];
#pragma unroll
        for (int k = 0; k < 16; ++k) { const int i = tid + k * NTHREADS; t[k] = in_w_in[(size_t)(i >> 3) * INCOLS + HPW + (i & 7)]; }
#pragma unroll
        for (int k = 0; k < 16; ++k) { const int i = tid + k * NTHREADS; wba[(i & 7) * 1024 + (i >> 3)] = t[k]; } }
    __syncthreads();
    const int gw = F.blk * NWAVES + wave, NGW = F.G * NWAVES;
    bf16_t* XB = WSP(bf16_t, WS_XB); float* BA = WSP(float, WS_BA);
    for (int row = gw; row < T_TOK; row += NGW) {
        const f32x4* xr = (const f32x4*)(in_x + (size_t)row * DM) + lane;
        f32x4 v[4];
#pragma unroll
        for (int j = 0; j < 4; ++j) v[j] = xr[64 * j];
        u32x2* o8 = (u32x2*)(XB + (size_t)row * DM) + lane;
#pragma unroll
        for (int j = 0; j < 4; ++j) { u32x2 w; w.x = cvtpk(v[j][0], v[j][1]); w.y = cvtpk(v[j][2], v[j][3]); o8[64 * j] = w; }
        float a8[8];
#pragma unroll
        for (int q = 0; q < 8; ++q) { float a = 0.f;
#pragma unroll
            for (int j = 0; j < 4; ++j) { const f32x4 w = *(const f32x4*)(wba + q * 1024 + 4 * lane + 256 * j); a += v[j][0] * w[0] + v[j][1] * w[1] + v[j][2] * w[2] + v[j][3] * w[3]; }
            a8[q] = a; }
        float r4[4], r2[2], r1;
#pragma unroll
        for (int k = 0; k < 4; ++k) r4[k] = sum_x32(a8[k], a8[k + 4]);
#pragma unroll
        for (int k = 0; k < 2; ++k) r2[k] = sum_x16(r4[k], r4[k + 2]);
        { const bool up = (lane & 8) != 0; const float keep = up ? r2[1] : r2[0], send = up ? r2[0] : r2[1]; r1 = keep + dppf<0x128>(send); }
        r1 += dppf<0x141>(r1); r1 += dppf<0x4E>(r1); r1 += dppf<0xB1>(r1);
        if ((lane & 7) == 0) BA[(size_t)row * 8 + ((lane >> 5) & 1) * 4 + ((lane >> 4) & 1) * 2 + ((lane >> 3) & 1)] = r1;
    }
    { const f32x4* src = (const f32x4*)in_p; u32x2* dst = WSP(u32x2, WS_PB);
        const int step = F.G * NTHREADS;
        for (int i0 = F.blk * NTHREADS + tid; i0 < T_TOK * 256 / 4; i0 += 8 * step) { f32x4 v[8];
#pragma unroll
            for (int k = 0; k < 8; ++k) { const int i = i0 + k * step; v[k] = src[i < T_TOK * 256 / 4 ? i : i0]; }
#pragma unroll
            for (int k = 0; k < 8; ++k) { const int i = i0 + k * step; if (i < T_TOK * 256 / 4) { u32x2 w; w.x = cvtpk(v[k][0], v[k][1]); w.y = cvtpk(v[k][2], v[k][3]); dst[i] = w; } } } }
    { float* wrt = WSP(float, WS_WRT); for (int i = F.blk * NTHREADS + tid; i < 32768; i += F.G * NTHREADS) wrt[(i & 31) * 1024 + (i >> 5)] = in_w_router[i]; }
    constexpr int I_IN = 16 * 56, I_OUT = 16 * 16, I_PG = 16 * 16, I_PP = 4 * 16;
    constexpr int NITEMS = I_IN + I_OUT + I_PG + I_PP;
    for (int it = gw; it < NITEMS; it += NGW) {
        int r = it;
        if (r < I_IN) { const int kb = r / 56, nb = r % 56; p0_transpose_tile(in_w_in, INCOLS, 64 * kb, 64 * nb, WSP(bf16_t, WS_WIN), 1024, 64 * nb, lane); continue; } r -= I_IN;
        if (r < I_OUT) { const int kb = r / 16, nb = r % 16; p0_transpose_tile(in_w_out, 1024, 64 * kb, 64 * nb, WSP(bf16_t, WS_WOUT), 1024, 64 * nb, lane); continue; } r -= I_OUT;
        if (r < I_PG) { const int kb = r / 16, nb = r % 16, q4 = lane >> 4, c = lane & 15; WTile t; f32x4 v[16];
            t.src = in_w_ple_gate + (size_t)(64 * kb + 16 * q4) * 1024 + 64 * nb + 4 * c; t.ldn = 1024; t.dst = WSP(unsigned char, WS_WPG) + (size_t)(64 * nb + 4 * c) * 1024 + 64 * kb + 16 * q4;
            wtile_load(v, t); wtile_store(v, t); continue; } r -= I_PG;
        { const int kb = r / 16, nb = r % 16; p0_transpose_tile(in_w_ple_proj, 1024, 64 * kb, 64 * nb, WSP(bf16_t, WS_WPP), 256, 64 * nb, lane); }
    }
}
__device__ __forceinline__ void moe_weight_stream(const Frame& F, int cw, int ncw, int lane) {
    const float* w_gate_up = inptr(12); const float* w_down = inptr(14);
    f32x4 va[16], vb[16];
    int r = cw; if (r >= MOE_TILES) return;
    WTile ta = moe_tile_addr(F, r, w_gate_up, w_down, lane); wtile_load(va, ta);
#pragma unroll 1
    for (;;) {
        const int r1 = r + ncw; WTile tb{}; const bool hb = r1 < MOE_TILES;
        if (hb) { tb = moe_tile_addr(F, r1, w_gate_up, w_down, lane); wtile_load(vb, tb); }
        wtile_store(va, ta);
        if (!hb) break;
        const int r2 = r1 + ncw; const bool ha = r2 < MOE_TILES;
        if (ha) { ta = moe_tile_addr(F, r2, w_gate_up, w_down, lane); wtile_load(va, ta); }
        wtile_store(vb, tb);
        if (!ha) break;
        r = r2;
    }
}
#define MFMA32(a, b, c) __builtin_amdgcn_mfma_f32_32x32x16_bf16((a), (b), (c), 0, 0, 0)
constexpr int QR_S = 136, KT_S = 72, NM_S = 68;
constexpr int L_QR = 0, L_KR = 17408, L_KT = 34816, L_VT = 53248, L_NM = 71680, L_TM = 89088, L_PM = 106496, L_TU = 111104, L_TW = 120320, L_SC = 129536, L_CW = 131072;
struct DnPre { u32x4 a[7], b[7]; float bl, al, alog; };
__device__ __forceinline__ void dn_load(const Frame& F, int ch, DnPre& P) {
    int tid = threadIdx.x; asm volatile("" : "+v"(tid));
    const float* in_a_log = inptr(4); const float* in_dt_bias = inptr(5);
    const int b = ch >> 7, h = (ch >> 5) & 3, n = ch & 31;
    const bf16_t* HP = WSP(const bf16_t, WS_HP);
    const int t0 = 64 * n; const size_t rowb = (size_t)b * SEQ;
    const int tg = (tid & 255) >> 4, d0 = (tid & 15) * 8, c30 = tid >> 8;
#pragma unroll
    for (int r = 0; r < 7; ++r) { const int t = t0 + 4 * tg - 3 + r; const int tc = t < 0 ? 0 : t; P.a[r] = *(const u32x4*)(HP + hp_off(rowb + tc, 1536 + c30 * 512 + h * 128 + d0)); }
    if (tid < 256) {
#pragma unroll
        for (int r = 0; r < 7; ++r) { const int t = t0 + 4 * tg - 3 + r; const int tc = t < 0 ? 0 : t; P.b[r] = *(const u32x4*)(HP + hp_off(rowb + tc, 1536 + 1024 + h * 128 + d0)); }
    }
    if (tid < 64) { const float* BA = WSP(const float, WS_BA) + (rowb + t0 + tid) * 8; P.bl = BA[h]; P.al = BA[4 + h] + in_dt_bias[h]; P.alog = in_a_log[h]; }
}
__device__ __forceinline__ void dn_prep_unit(const Frame& F, int ch, int& hcur, int chn, DnPre& P) {
    int tid = threadIdx.x; asm volatile("" : "+v"(tid));
    const int lane = tid & 63, wave = __builtin_amdgcn_readfirstlane(tid >> 6), r32 = lane & 31, hi = lane >> 5;
    const float* in_conv_w = inptr(3); const float* in_a_log = inptr(4); const float* in_dt_bias = inptr(5);
    const int b = ch >> 7, h = (ch >> 5) & 3, n = ch & 31;
    bf16_t* Qr = (bf16_t*)(F.lds + L_QR); bf16_t* Kr = (bf16_t*)(F.lds + L_KR); bf16_t* KT = (bf16_t*)(F.lds + L_KT); bf16_t* VT = (bf16_t*)(F.lds + L_VT);
    float* Nm = (float*)(F.lds + L_NM); float* Tm = (float*)(F.lds + L_TM); float* Pm = (float*)(F.lds + L_PM);
    bf16_t* Tu = (bf16_t*)(F.lds + L_TU); bf16_t* Tw = (bf16_t*)(F.lds + L_TW);
    float* beta_s = (float*)(F.lds + L_SC); float* gc_s = beta_s + 64; float* egc_s = gc_s + 64; float* begc_s = egc_s + 64;
    const bf16_t* HP = WSP(const bf16_t, WS_HP);
    const int t0 = 64 * n; const size_t rowb = (size_t)b * SEQ;
    unsigned char* dnb = F.ws + WS_DN + (size_t)ch * DN_STRIDE;
    if (h != hcur) {
        float* cwt = (float*)(F.lds + L_CW);
        for (int i = tid; i < 1536; i += NTHREADS) cwt[i] = in_conv_w[(size_t)((i >> 7) & 3) * 1536 + (i >> 9) * 512 + h * 128 + (i & 127)];
        hcur = h; __syncthreads();
    }
    const int tg = (tid & 255) >> 4, d0 = (tid & 15) * 8, c30 = tid >> 8;
    const bool has_v = tid < 256;
    const u32x4 (&xr0)[7] = P.a; const u32x4 (&xr1)[7] = P.b;
    const float bl = P.bl, al = P.al, alog = P.alog;
    auto s1_item = [&](const int c3, const u32x4 (&xr)[7]) {
        const float* cwl = (const float*)(F.lds + L_CW) + c3 * 512 + d0;
        f32x4 cw[4][2];
#pragma unroll
        for (int j = 0; j < 4; ++j) { cw[j][0] = *(const f32x4*)(cwl + j * 128); cw[j][1] = *(const f32x4*)(cwl + j * 128 + 4); }
        float y[4][8];
#pragma unroll
        for (int q = 0; q < 4; ++q)
#pragma unroll
            for (int c = 0; c < 8; ++c) y[q][c] = 0.f;
#pragma unroll
        for (int r = 0; r < 7; ++r) { const int t = t0 + 4 * tg - 3 + r; const float msk = t < 0 ? 0.f : 1.f; f32x4 xa, xb; pg8::unpack8(xr[r], xa, xb); xa = xa * msk; xb = xb * msk;
#pragma unroll
            for (int q = 0; q < 4; ++q) { const int j = r - q; if (j >= 0 && j < 4) {
#pragma unroll
                for (int c = 0; c < 4; ++c) { y[q][c] += xa[c] * cw[j][0][c]; y[q][4 + c] += xb[c] * cw[j][1][c]; } } } }
        unsigned pk[4][4];
#pragma unroll
        for (int q = 0; q < 4; ++q) { float ss = 0.f;
#pragma unroll
            for (int c = 0; c < 8; ++c) { y[q][c] = y[q][c] * sigm(y[q][c]); ss += y[q][c] * y[q][c]; }
            ss += dppf<0xB1>(ss); ss += dppf<0x4E>(ss); ss += dppf<0x141>(ss); ss += dppf<0x128>(ss);
            const float sc = (c3 == 2) ? 1.f : rsqrtf(ss + 1e-6f) * (c3 == 0 ? 0.08838834764831845f : 1.f);
#pragma unroll
            for (int c = 0; c < 4; ++c) pk[q][c] = cvtpk(y[q][2 * c] * sc, y[q][2 * c + 1] * sc); }
        const int i0 = 4 * tg;
        if (c3 < 2) { bf16_t* dst = (c3 == 0 ? Qr : Kr) + i0 * QR_S + d0;
#pragma unroll
            for (int q = 0; q < 4; ++q) *(u32x4*)(dst + q * QR_S) = (u32x4){pk[q][0], pk[q][1], pk[q][2], pk[q][3]}; }
        if (c3 >= 1) { bf16_t* dt = (c3 == 1 ? KT : VT) + d0 * KT_S + i0;
#pragma unroll
            for (int c = 0; c < 4; ++c) {
                u32x2 lo, hi2; lo.x = (pk[0][c] & 0xffffu) | (pk[1][c] << 16); lo.y = (pk[2][c] & 0xffffu) | (pk[3][c] << 16);
                hi2.x = (pk[0][c] >> 16) | (pk[1][c] & 0xffff0000u); hi2.y = (pk[2][c] >> 16) | (pk[3][c] & 0xffff0000u);
                *(u32x2*)(dt + (2 * c) * KT_S) = lo; *(u32x2*)(dt + (2 * c + 1) * KT_S) = hi2; } }
    };
    s1_item(c30, xr0);
    if (has_v) s1_item(2, xr1);
    float bl_c = bl, al_c = al, alog_c = alog;
    if (chn >= 0) dn_load(F, chn, P);
    if (tid < 64) {
        const float sp = fmaxf(al_c, 0.f) + log1pf(__expf(-fabsf(al_c)));
        float g = -__expf(alog_c) * sp;
#pragma unroll
        for (int o = 1; o < 64; o <<= 1) { const float up = __shfl_up(g, o); if (tid >= o) g += up; }
        const float bt = sigm(bl_c), eg = __expf(g);
        beta_s[tid] = bt; gc_s[tid] = g; egc_s[tid] = eg; begc_s[tid] = bt * eg;
        if (tid == 63) WSP(float, WS_EG)[ch] = eg;
    }
    __syncthreads();
    {
        const int sel = wave >> 2, tq = wave & 3, mt = (tq == 0) ? 0 : 1, nt = (tq == 3) ? 1 : (tq == 2 ? 1 : 0);
        const int amt = sel ? ((tq == 1) ? 0 : mt) : mt, ant = sel ? ((tq == 1) ? 1 : nt) : nt;
        f32x16 c;
#pragma unroll
        for (int r = 0; r < 16; ++r) c[r] = 0.f;
        if (tq != 3) {
            const bf16_t* ap = Kr + (32 * amt + r32) * QR_S + 8 * hi; const bf16_t* bp = (sel ? Qr : Kr) + (32 * ant + r32) * QR_S + 8 * hi;
#pragma unroll
            for (int s = 0; s < 8; ++s) c = MFMA32(*(const bf16x8*)(ap + 16 * s), *(const bf16x8*)(bp + 16 * s), c);
        }
        if (sel == 0) {
            const int mtt = (tq == 3) ? 0 : mt, ntt = (tq == 3) ? 1 : nt, j = 32 * ntt + r32; const float gj = gc_s[j];
#pragma unroll
            for (int r = 0; r < 16; ++r) { const int i = 32 * mtt + crow(r, hi); Nm[i * NM_S + j] = (j < i) ? beta_s[i] * c[r] * __expf(gc_s[i] - gj) : 0.f; }
        } else {
            const int jt = (tq == 3) ? 1 : amt, itile = (tq == 3) ? 0 : ant, i = 32 * itile + r32; const float gi = gc_s[i];
#pragma unroll
            for (int r = 0; r < 16; ++r) { const int j = 32 * jt + crow(r, hi); c[r] = (j <= i) ? c[r] * __expf(gi - gc_s[j]) : 0.f; }
            bf16_t* AT = (bf16_t*)(dnb + DN_AT);
            *(bf16x8*)(AT + ((itile * 4 + 2 * jt) * 64 + lane) * 8) = pack8(c, 0); *(bf16x8*)(AT + ((itile * 4 + 2 * jt + 1) * 64 + lane) * 8) = pack8(c, 8);
        }
        bf16_t* QD = (bf16_t*)(dnb + DN_QD); bf16_t* KD = (bf16_t*)(dnb + DN_KD); const float glast = gc_s[63];
#pragma unroll
        for (int k2 = 0; k2 < 2; ++k2) { const int f = 2 * wave + k2, m2 = f >> 3, s = f & 7, tok = 32 * m2 + r32; const float e = egc_s[tok];
            const u32x2 lo = *(const u32x2*)(Qr + tok * QR_S + 16 * s + 4 * hi), hi2 = *(const u32x2*)(Qr + tok * QR_S + 16 * s + 8 + 4 * hi);
            u32x4 w; w.x = cvtpk(bflo(lo.x) * e, bfhi(lo.x) * e); w.y = cvtpk(bflo(lo.y) * e, bfhi(lo.y) * e); w.z = cvtpk(bflo(hi2.x) * e, bfhi(hi2.x) * e); w.w = cvtpk(bflo(hi2.y) * e, bfhi(hi2.y) * e);
            *(u32x4*)(QD + (f * 64 + lane) * 8) = w; }
#pragma unroll
        for (int k2 = 0; k2 < 2; ++k2) { const int f = 2 * wave + k2, mt2 = f >> 2, s = f & 3, dk = 32 * mt2 + r32, tk = 16 * s + 4 * hi;
            const u32x2 lo = *(const u32x2*)(KT + dk * KT_S + tk), hi2 = *(const u32x2*)(KT + dk * KT_S + tk + 8);
            float e[8];
#pragma unroll
            for (int q = 0; q < 4; ++q) { e[q] = __expf(glast - gc_s[tk + q]); e[4 + q] = __expf(glast - gc_s[tk + 8 + q]); }
            u32x4 w; w.x = cvtpk(bflo(lo.x) * e[0], bfhi(lo.x) * e[1]); w.y = cvtpk(bflo(lo.y) * e[2], bfhi(lo.y) * e[3]); w.z = cvtpk(bflo(hi2.x) * e[4], bfhi(hi2.x) * e[5]); w.w = cvtpk(bflo(hi2.y) * e[6], bfhi(hi2.y) * e[7]);
            *(u32x4*)(KD + (f * 64 + lane) * 8) = w; }
    }
    __syncthreads();
    if (tid < 64) { const int blk = tid >> 4, col = tid & 15, o = 16 * blk; float x[16];
#pragma unroll
        for (int i = 0; i < 16; ++i) { float a = (i == col) ? 1.f : 0.f;
#pragma unroll
            for (int j = 0; j < i; ++j) a -= Nm[(o + i) * NM_S + o + j] * x[j];
            x[i] = a; }
#pragma unroll
        for (int i = 0; i < 16; ++i) { Tm[(o + i) * NM_S + o + col] = x[i]; if (!(blk & 1)) Tm[(o + i) * NM_S + o + 16 + col] = 0.f; } }
    __syncthreads();
    { const int pb = tid >> 8, r = (tid >> 4) & 15, c = tid & 15, oi = 32 * pb + 16, oj = 32 * pb; float a = 0.f;
#pragma unroll
        for (int k = 0; k < 16; ++k) a += Nm[(oi + r) * NM_S + oj + k] * Tm[(oj + k) * NM_S + oj + c];
        Pm[pb * 272 + r * 17 + c] = a; }
    __syncthreads();
    { const int pb = tid >> 8, r = (tid >> 4) & 15, c = tid & 15, oi = 32 * pb + 16, oj = 32 * pb; float a = 0.f;
#pragma unroll
        for (int k = 0; k < 16; ++k) a -= Tm[(oi + r) * NM_S + oi + k] * Pm[pb * 272 + k * 17 + c];
        Tm[(oi + r) * NM_S + oj + c] = a; }
    __syncthreads();
    { const int r = tid >> 4, c = tid & 15; float a0 = 0.f, a1 = 0.f;
#pragma unroll 8
        for (int k = 0; k < 32; ++k) { const float nv = Nm[(32 + r) * NM_S + k]; a0 += nv * Tm[k * NM_S + c]; a1 += nv * Tm[k * NM_S + c + 16]; }
        Pm[r * 36 + c] = a0; Pm[r * 36 + c + 16] = a1; }
    __syncthreads();
    { const int r = tid >> 4, c = tid & 15; float a0 = 0.f, a1 = 0.f;
#pragma unroll 8
        for (int k = 0; k < 32; ++k) { const float tv = Tm[(32 + r) * NM_S + 32 + k]; a0 -= tv * Pm[k * 36 + c]; a1 -= tv * Pm[k * 36 + c + 16]; }
        Tm[(32 + r) * NM_S + c] = a0; Tm[(32 + r) * NM_S + c + 16] = a1; }
    __syncthreads();
    { const int i = tid >> 3, j0 = (tid & 7) * 8; float tu[8], tw[8];
#pragma unroll
        for (int q = 0; q < 8; ++q) { const int j = j0 + q; const float t = (i < 32 && j >= 32) ? 0.f : Tm[i * NM_S + j]; tu[q] = t * beta_s[j]; tw[q] = t * begc_s[j]; }
        *(u32x4*)(Tu + i * KT_S + j0) = (u32x4){cvtpk(tu[0], tu[1]), cvtpk(tu[2], tu[3]), cvtpk(tu[4], tu[5]), cvtpk(tu[6], tu[7])};
        *(u32x4*)(Tw + i * KT_S + j0) = (u32x4){cvtpk(tw[0], tw[1]), cvtpk(tw[2], tw[3]), cvtpk(tw[4], tw[5]), cvtpk(tw[6], tw[7])}; }
    __syncthreads();
    { const int mt = wave >> 2, nt = wave & 3;
        f32x16 c;
#pragma unroll
        for (int r = 0; r < 16; ++r) c[r] = 0.f;
        const bf16_t* ap = Tu + (32 * mt + r32) * KT_S + 8 * hi; const bf16_t* bp = VT + (32 * nt + r32) * KT_S + 8 * hi;
#pragma unroll
        for (int s = 0; s < 4; ++s) c = MFMA32(*(const bf16x8*)(ap + 16 * s), *(const bf16x8*)(bp + 16 * s), c);
        bf16_t* U = (bf16_t*)(dnb + DN_U);
        *(bf16x8*)(U + ((nt * 4 + mt * 2) * 64 + lane) * 8) = pack8(c, 0); *(bf16x8*)(U + ((nt * 4 + mt * 2 + 1) * 64 + lane) * 8) = pack8(c, 8);
    }
    { const int mt = wave >> 1, nt = wave & 1;
        f32x16 c;
#pragma unroll
        for (int r = 0; r < 16; ++r) c[r] = 0.f;
        const bf16_t* ap = KT + (32 * mt + r32) * KT_S + 8 * hi; const bf16_t* bp = Tw + (32 * nt + r32) * KT_S + 8 * hi;
#pragma unroll
        for (int s = 0; s < 4; ++s) c = MFMA32(*(const bf16x8*)(ap + 16 * s), *(const bf16x8*)(bp + 16 * s), c);
#pragma unroll
        for (int r = 0; r < 16; ++r) c[r] = -c[r];
        bf16_t* WN = (bf16_t*)(dnb + DN_WN);
        *(bf16x8*)(WN + ((nt * 8 + 2 * mt) * 64 + lane) * 8) = pack8(c, 0); *(bf16x8*)(WN + ((nt * 8 + 2 * mt + 1) * 64 + lane) * 8) = pack8(c, 8);
    }
    __syncthreads();
}
__device__ __forceinline__ void kv_unit(const Frame& F, int u) {
    THREAD_IDS();
    const int bh = u >> 2, s0 = (u & 3) * 512, b = bh >> 3, h = bh & 7;
    bf16_t* kt = (bf16_t*)F.lds; bf16_t* vt = kt + 512 * 64;
    const bf16_t* HP = WSP(const bf16_t, WS_HP);
#pragma unroll
    for (int it = 0; it < 8; ++it) { const int idx = it * NTHREADS + tid, r = ((idx >> 2) & 15) + 16 * (idx >> 7), c8 = ((idx & 3) + 4 * ((idx >> 6) & 1)) * 8;
        const bf16_t* src = HP + hp_off((size_t)b * SEQ + s0 + r, h * 64 + c8);
        const int sw = r * 64 + (((c8 >> 3) ^ (r & 7)) << 3);
        *(u32x4*)(kt + sw) = *(const u32x4*)(src + 512 * 16); *(u32x4*)(vt + sw) = *(const u32x4*)(src + 1024 * 16); }
    __syncthreads();
    const int r32 = lane & 31, hi = lane >> 5;
#pragma unroll 1
    for (int it = 0; it < 6; ++it) { const int q = it * NWAVES + wave;
        const int di = q >> 4, bi = q & 15, d = (di == 0) ? 1 : (di == 1 ? 4 : 16), nbd = 64 / d, per = 16 / d;
        const int c = bi / per, nbl = bi % per, nb = (s0 / d) / 32 + nbl;
        const size_t fbase = ((size_t)di * (T_TOK * 512)) + (((size_t)bh * 64 + c * nbd + nb) * 4) * 512 + lane * 8;
        bf16_t* kf = WSP(bf16_t, WS_KF) + fbase; bf16_t* vf = WSP(bf16_t, WS_VT) + fbase;
        const int prow = c + d * (32 * nbl + r32);
#pragma unroll
        for (int d0 = 0; d0 < 4; ++d0) *(u32x4*)(kf + d0 * 512) = *(const u32x4*)(kt + prow * 64 + (((2 * d0 + hi) ^ (prow & 7)) << 3));
#pragma unroll
        for (int eb = 0; eb < 2; ++eb)
#pragma unroll
            for (int ks = 0; ks < 2; ++ks) { unsigned w[4];
#pragma unroll
                for (int jj = 0; jj < 4; ++jj) { const int j0 = 2 * jj, j1 = 2 * jj + 1;
                    const int n0 = 32 * nbl + 16 * ks + 8 * (j0 >> 2) + 4 * hi + (j0 & 3), n1 = 32 * nbl + 16 * ks + 8 * (j1 >> 2) + 4 * hi + (j1 & 3);
                    const int ra = c + d * n0, rb = c + d * n1, ech = 4 * eb + (r32 >> 3);
                    const unsigned lo = vt[ra * 64 + ((ech ^ (ra & 7)) << 3) + (r32 & 7)], hi2 = vt[rb * 64 + ((ech ^ (rb & 7)) << 3) + (r32 & 7)]; w[jj] = lo | (hi2 << 16); }
                *(u32x4*)(vf + (eb * 2 + ks) * 512) = (u32x4){w[0], w[1], w[2], w[3]}; }
    }
    __syncthreads();
}

constexpr int SCAN_BUF = 73728;
__device__ __forceinline__ void scan_stage4(const unsigned char* dnb, int wv, LAS unsigned char* buf, int lane) {
    const unsigned char* src = dnb + wv * 18432 + lane * 16; LAS unsigned char* dst = buf + wv * 18432;
#pragma unroll 1
    for (int f = 0; f < 18; ++f) __builtin_amdgcn_global_load_lds((const unsigned*)(src + f * 1024), (LAS unsigned*)(dst + f * 1024), 16, 0, 0);
}
__device__ __forceinline__ void scan_unit4(const Frame& F, int bh, int sl) {
    THREAD_IDS();
    const int r32 = lane & 31, hi = lane >> 5;
    const int b = bh >> 2, h = bh & 3;
    LAS unsigned char* lds3 = (LAS unsigned char*)F.lds;
    volatile LAS unsigned* sbar = (volatile LAS unsigned*)(lds3 + LDS_MISC + 4096 + 64);
    f32x16 S[4];
#pragma unroll
    for (int mt = 0; mt < 4; ++mt)
#pragma unroll
        for (int r = 0; r < 16; ++r) S[mt][r] = 0.f;
    bf16_t* ORAW = WSP(bf16_t, WS_ORAW);
    const int ch0 = bh * 32;
    scan_stage4(F.ws + WS_DN + (size_t)ch0 * DN_STRIDE, sl, lds3, lane);
#pragma unroll 1
    for (int n = 0; n < 32; ++n) {
        const int ch = ch0 + n;
        LAS unsigned char* buf = lds3 + (n & 1) * SCAN_BUF;
        float eg = WSP(const float, WS_EG)[ch];
        asm volatile("s_waitcnt vmcnt(0) lgkmcnt(0)" : "+v"(eg) :: "memory");
        if (lane == 0) __hip_atomic_fetch_add((LAS unsigned*)sbar, 1u, __ATOMIC_RELAXED, __HIP_MEMORY_SCOPE_WORKGROUP);
        { const unsigned want = 4u * (unsigned)(n + 1); while (*sbar < want) __builtin_amdgcn_s_sleep(1); }
        asm volatile("" ::: "memory");
        if (n + 1 < 32) scan_stage4(F.ws + WS_DN + (size_t)(ch + 1) * DN_STRIDE, sl, lds3 + ((n + 1) & 1) * SCAN_BUF, lane);
        const LAS unsigned char* fb = buf + lane * 16;
        bf16x8 Sb[8];
#pragma unroll
        for (int mt = 0; mt < 4; ++mt) { Sb[2 * mt] = pack8(S[mt], 0); Sb[2 * mt + 1] = pack8(S[mt], 8); }
        f32x16 vn[2], o[2];
#pragma unroll
        for (int m2 = 0; m2 < 2; ++m2) {
#pragma unroll
            for (int r8 = 0; r8 < 2; ++r8) { const u32x4 uu = *(const LAS u32x4*)(fb + 57344 + (sl * 4 + m2 * 2 + r8) * 1024);
                vn[m2][8 * r8] = bflo(uu.x); vn[m2][8 * r8 + 1] = bfhi(uu.x); vn[m2][8 * r8 + 2] = bflo(uu.y); vn[m2][8 * r8 + 3] = bfhi(uu.y);
                vn[m2][8 * r8 + 4] = bflo(uu.z); vn[m2][8 * r8 + 5] = bfhi(uu.z); vn[m2][8 * r8 + 6] = bflo(uu.w); vn[m2][8 * r8 + 7] = bfhi(uu.w); }
#pragma unroll
            for (int s = 0; s < 8; ++s) { const bf16x8 a = *(const LAS bf16x8*)(fb + (m2 * 8 + s) * 1024); vn[m2] = MFMA32(a, Sb[s], vn[m2]); }
            __builtin_amdgcn_sched_barrier(0);
#pragma unroll
            for (int r = 0; r < 16; ++r) o[m2][r] = 0.f;
#pragma unroll
            for (int s = 0; s < 8; ++s) { const bf16x8 a = *(const LAS bf16x8*)(fb + 16384 + (m2 * 8 + s) * 1024); o[m2] = MFMA32(a, Sb[s], o[m2]); }
            __builtin_amdgcn_sched_barrier(0);
        }
        bf16x8 vb[4];
#pragma unroll
        for (int m2 = 0; m2 < 2; ++m2) { vb[2 * m2] = pack8(vn[m2], 0); vb[2 * m2 + 1] = pack8(vn[m2], 8); }
#pragma unroll
        for (int m2 = 0; m2 < 2; ++m2) {
#pragma unroll
            for (int s = 0; s < 4; ++s) { const bf16x8 a = *(const LAS bf16x8*)(fb + 32768 + (m2 * 4 + s) * 1024); o[m2] = MFMA32(a, vb[s], o[m2]); }
#pragma unroll
            for (int r = 0; r < 16; ++r) ORAW[((size_t)b * SEQ + 64 * n + 32 * m2 + crow(r, hi)) * 512 + h * 128 + 32 * sl + r32] = f2bf(o[m2][r]);
            __builtin_amdgcn_sched_barrier(0);
        }
#pragma unroll
        for (int mt = 0; mt < 4; ++mt) {
#pragma unroll
            for (int r = 0; r < 16; ++r) S[mt][r] *= eg;
#pragma unroll
            for (int s = 0; s < 4; ++s) { const bf16x8 a = *(const LAS bf16x8*)(fb + 40960 + (mt * 4 + s) * 1024); S[mt] = MFMA32(a, vb[s], S[mt]); }
            if (mt & 1) __builtin_amdgcn_sched_barrier(0);
        }
    }
    asm volatile("s_waitcnt vmcnt(0) lgkmcnt(0)" ::: "memory");
}
__device__ __forceinline__ void attn_block(const bf16x8 (&kc)[4], const bf16x8 (&vc)[4], const bf16x8 (&qr)[4], f32x16 (&o)[2], float& m_run, float& l_run, int dn0  ) {
    f32x16 s;
#pragma unroll
    for (int r = 0; r < 16; ++r) s[r] = 0.f;
#pragma unroll
    for (int d0 = 0; d0 < 4; ++d0) s = MFMA32(kc[d0], qr[d0], s);
#pragma unroll
    for (int r = 0; r < 16; ++r) { const unsigned dlt = (unsigned)(dn0 - ((r & 3) + 8 * (r >> 2))); s[r] = (dlt <= 128u) ? s[r] : -INFINITY; }
    float mb = fmaxf(fmaxf(s[0], s[1]), fmaxf(s[2], s[3]));
#pragma unroll
    for (int r = 4; r < 16; r += 4) mb = fmaxf(mb, fmaxf(fmaxf(s[r], s[r + 1]), fmaxf(s[r + 2], s[r + 3])));
    { auto rr = __builtin_amdgcn_permlane32_swap(__float_as_uint(mb), __float_as_uint(mb), false, false); mb = fmaxf(__uint_as_float(rr[0]), __uint_as_float(rr[1])); }
    const float mn = fmaxf(m_run, mb);
    {
        const float al = __builtin_amdgcn_exp2f(m_run - mn);
        l_run *= al; m_run = mn;
#pragma unroll
        for (int eb = 0; eb < 2; ++eb)
#pragma unroll
            for (int r = 0; r < 16; ++r) o[eb][r] *= al;
    }
    float ps = 0.f;
#pragma unroll
    for (int r = 0; r < 16; ++r) { s[r] = __builtin_amdgcn_exp2f(s[r] - mn); ps += s[r]; }
    l_run += ps;
    const bf16x8 pb0 = pack8(s, 0), pb1 = pack8(s, 8);
#pragma unroll
    for (int eb = 0; eb < 2; ++eb)
#pragma unroll
        for (int ks = 0; ks < 2; ++ks) o[eb] = MFMA32(vc[eb * 2 + ks], ks ? pb1 : pb0, o[eb]);
}
template <int D_>
__device__ __forceinline__ void attn_branch(const Frame& F, int di, int b, int h, int t0, int jq, const bf16x8 (&qr)[4], f32x16 (&o)[2], float& m_run, float& l_run) {
    THREAD_IDS();
    const int r32 = lane & 31, hi = lane >> 5;
    constexpr int STEP = 16 / D_, NBD = 64 / D_;
    const int c = t0 % D_, a0 = t0 / D_;
    const int nq = a0 + STEP * (32 * jq + r32);
    const int nq_lo = a0 + STEP * (32 * jq), nq_hi = a0 + STEP * (32 * jq + 31);
    const int n_lo = (nq_lo - 128) > 0 ? (nq_lo - 128) : 0;
    const size_t fbase = ((size_t)di * (T_TOK * 512)) + (((size_t)(b * 8 + h) * 64 + c * NBD) * 4) * 512;
    const unsigned char* KF = (const unsigned char*)(WSP(const bf16_t, WS_KF) + fbase); const unsigned char* VF = (const unsigned char*)(WSP(const bf16_t, WS_VT) + fbase);
    const unsigned loff = (unsigned)lane * 16u;
    const int nb0 = n_lo >> 5, nb1 = nq_hi >> 5;
    const int dq = nq - 4 * hi;
#define ATT_LOAD(KX, VX, NB) do { const int nb_ = (NB) < nb1 ? (NB) : nb1; _Pragma("unroll") for (int f = 0; f < 4; ++f) { const unsigned off = (unsigned)nb_ * 4096u + loff + f * 1024; KX[f] = *(const bf16x8*)(KF + off); VX[f] = *(const bf16x8*)(VF + off); } } while (0)
    bf16x8 kA[4], vA[4], kB[4], vB[4], kC[4], vC[4];
    ATT_LOAD(kA, vA, nb0); ATT_LOAD(kB, vB, nb0 + 1);
#pragma unroll 1
    for (int nb = nb0; nb <= nb1; nb += 3) {
        ATT_LOAD(kC, vC, nb + 2);
        attn_block(kA, vA, qr, o, m_run, l_run, dq - 32 * nb);
        if (nb + 1 > nb1) break;
        ATT_LOAD(kA, vA, nb + 3);
        attn_block(kB, vB, qr, o, m_run, l_run, dq - 32 * (nb + 1));
        if (nb + 2 > nb1) break;
        ATT_LOAD(kB, vB, nb + 4);
        attn_block(kC, vC, qr, o, m_run, l_run, dq - 32 * (nb + 2));
    }
#undef ATT_LOAD
}
__device__ __forceinline__ void attn_task(const Frame& F, int a) {
    THREAD_IDS();
    const int r32 = lane & 31, hi = lane >> 5;
    const int x = F.blk & 7, bh = x + 8 * (a >> 6), tw = a & 63, t0 = tw & 15, jq = 3 - (tw >> 4), b = bh >> 3, h = bh & 7;
    const int tq = t0 + 16 * (32 * jq + r32);
    const bf16_t* HP = WSP(const bf16_t, WS_HP);
    bf16x8 qr[4];
#pragma unroll
    for (int d0 = 0; d0 < 4; ++d0) { const u32x4 qw = *(const u32x4*)(HP + hp_off((size_t)b * SEQ + tq, h * 64 + 16 * d0 + 8 * hi));
        constexpr float SCQ = 0.125f * 1.4426950408889634f; u32x4 w;
        w.x = cvtpk(bflo(qw.x) * SCQ, bfhi(qw.x) * SCQ); w.y = cvtpk(bflo(qw.y) * SCQ, bfhi(qw.y) * SCQ); w.z = cvtpk(bflo(qw.z) * SCQ, bfhi(qw.z) * SCQ); w.w = cvtpk(bflo(qw.w) * SCQ, bfhi(qw.w) * SCQ);
        qr[d0] = __builtin_bit_cast(bf16x8, w); }
    f32x16 o[2];
#pragma unroll
    for (int eb = 0; eb < 2; ++eb)
#pragma unroll
        for (int r = 0; r < 16; ++r) o[eb][r] = 0.f;
    float m_run = -1e30f, l_run = 0.f;
    attn_branch<1>(F, 0, b, h, t0, jq, qr, o, m_run, l_run);
    attn_branch<4>(F, 1, b, h, t0, jq, qr, o, m_run, l_run);
    attn_branch<16>(F, 2, b, h, t0, jq, qr, o, m_run, l_run);
    const float lt = sum_x32(l_run, l_run), inv = 1.f / lt;
    bf16_t* dst = WSP(bf16_t, WS_MIX) + ((size_t)b * SEQ + tq) * DM + h * 64;
#pragma unroll
    for (int eb = 0; eb < 2; ++eb)
#pragma unroll
        for (int g = 0; g < 4; ++g) { u32x2 w; w.x = cvtpk(o[eb][4 * g] * inv, o[eb][4 * g + 1] * inv); w.y = cvtpk(o[eb][4 * g + 2] * inv, o[eb][4 * g + 3] * inv);
            *(u32x2*)(dst + 32 * eb + 8 * g + 4 * hi) = w; }
}
__device__ __forceinline__ void phase3(const Frame& F, int flags) {
    THREAD_IDS();
    if (tid == 0) *(volatile LAS unsigned*)((LAS unsigned char*)F.lds + LDS_MISC + 4096 + 64) = 0u;
    __syncthreads();
    if (F.blk < 64 && wave < 4 && !(flags & 1)) { __builtin_amdgcn_s_setprio(3); scan_unit4(F, F.blk, wave); __builtin_amdgcn_s_setprio(0); }
    unsigned* qctr = WSP(unsigned, WS_CTL) + 1024 + (F.blk & 7) * 32;
    if (wave == 7) moe_weight_stream(F, F.blk, F.G, lane);
    if (flags & 2) return;
    for (;;) {
        unsigned a = 0; if (lane == 0) a = atomicAdd(qctr, 1u);
        a = (unsigned)__builtin_amdgcn_readfirstlane((int)a);
        if (a >= 1024u) break;
        attn_task(F, (int)a);
    }
}

__device__ __forceinline__ void phase4(const Frame& F) {
    THREAD_IDS();
    const float* in_gnorm_w = inptr(6);
    const int gw = F.blk * NWAVES + wave, NGW = F.G * NWAVES;
    const bf16_t* ORAW = WSP(const bf16_t, WS_ORAW); const bf16_t* HP = WSP(const bf16_t, WS_HP); bf16_t* MIX = WSP(bf16_t, WS_MIX);
    const f32x4 gw0 = *(const f32x4*)(in_gnorm_w + (lane & 15) * 8), gw1 = *(const f32x4*)(in_gnorm_w + (lane & 15) * 8 + 4);
    for (int row = gw; row < T_TOK; row += NGW) {
        const u32x4 ow = *(const u32x4*)(ORAW + (size_t)row * 512 + lane * 8), zw = *(const u32x4*)(HP + hp_off(row, 3072 + lane * 8));
        f32x4 oa, ob, za, zb; pg8::unpack8(ow, oa, ob); pg8::unpack8(zw, za, zb);
        float ss = oa[0] * oa[0] + oa[1] * oa[1] + oa[2] * oa[2] + oa[3] * oa[3] + ob[0] * ob[0] + ob[1] * ob[1] + ob[2] * ob[2] + ob[3] * ob[3];
        ss += dppf<0xB1>(ss); ss += dppf<0x4E>(ss); ss += dppf<0x141>(ss); ss += dppf<0x128>(ss);
        const float r = rsqrtf(ss * (1.f / 128.f) + 1e-6f);
        f32x4 ya, yb;
#pragma unroll
        for (int j = 0; j < 4; ++j) { ya[j] = oa[j] * r * gw0[j] * (za[j] * sigm(za[j])); yb[j] = ob[j] * r * gw1[j] * (zb[j] * sigm(zb[j])); }
        *(u32x4*)(MIX + (size_t)row * DM + 512 + lane * 8) = pg8::pack_row8(ya, yb);
    }
}

__device__ __forceinline__ void p6_fill_wrt(const Frame& F) {
    const int tid = threadIdx.x;
    const f32x4* src = WSP(const f32x4, WS_WRT); f32x4* dst = (f32x4*)F.lds; f32x4 t[16];
#pragma unroll
    for (int k = 0; k < 16; ++k) t[k] = src[tid + k * NTHREADS];
#pragma unroll
    for (int k = 0; k < 16; ++k) dst[tid + k * NTHREADS] = t[k];
}
__device__ __forceinline__ void phase6(const Frame& F, bool prefilled) {
    THREAD_IDS();
    const float* in_ln1_g = inptr(8); const float* in_ln1_b = inptr(9); const float* in_b_router = inptr(11);
    float* wrt = (float*)F.lds;
    if (!prefilled) p6_fill_wrt(F);
    __syncthreads();
    const int gw = F.blk * NWAVES + wave, NGW = F.G * NWAVES;
    bf16_t* X1 = WSP(bf16_t, WS_X1);
    unsigned* cnt = WSP(unsigned, WS_CTL); int* rt_e = WSP(int, WS_ROUTE); int* rt_s = rt_e + T_TOK * 4; int* ltok = WSP(int, WS_LTOK); float* lgate = WSP(float, WS_LGATE);
    int* s_cnt = (int*)(F.lds + LDS_MISC + 4096); int* s_base = s_cnt + 32; int* s_e = s_base + 32; float* s_g = (float*)(s_e + 512); int* s_li = (int*)(s_g + 512);
    if (tid < 32) s_cnt[tid] = 0;
    __syncthreads();
    f32x4 lg[4], lb[4];
#pragma unroll
    for (int j = 0; j < 4; ++j) { lg[j] = *(const f32x4*)(in_ln1_g + 4 * lane + 256 * j); lb[j] = *(const f32x4*)(in_ln1_b + 4 * lane + 256 * j); }
    const float brl = in_b_router[((lane >> 5) & 1) * 16 + ((lane >> 4) & 1) * 8 + ((lane >> 3) & 1) * 4 + ((lane >> 2) & 1) * 2 + ((lane >> 1) & 1)];
    const int my_e = ((lane >> 5) & 1) * 16 + ((lane >> 4) & 1) * 8 + ((lane >> 3) & 1) * 4 + ((lane >> 2) & 1) * 2 + ((lane >> 1) & 1);
#pragma unroll 1
    for (int ip = 0; ip < 4; ++ip) {
        f32x4 vr[4][4];
        { u32x2 rw[4][4];
#pragma unroll
            for (int h4 = 0; h4 < 4; ++h4)
#pragma unroll
                for (int j = 0; j < 4; ++j) rw[h4][j] = ((const u32x2*)(X1 + (size_t)(gw + (4 * ip + h4) * NGW) * DM) + lane)[64 * j];
#pragma unroll
            for (int h4 = 0; h4 < 4; ++h4) { f32x4 (&v)[4] = vr[h4]; const int row = gw + (4 * ip + h4) * NGW; float s = 0.f;
#pragma unroll
                for (int j = 0; j < 4; ++j) { const u32x2 w = rw[h4][j]; v[j] = (f32x4){bflo(w.x), bfhi(w.x), bflo(w.y), bfhi(w.y)}; s += (v[j][0] + v[j][1]) + (v[j][2] + v[j][3]); }
                const float mean = wave_sum(s) * (1.f / DM); float s2 = 0.f;
#pragma unroll
                for (int j = 0; j < 4; ++j) { v[j] = v[j] - mean; s2 += (v[j][0] * v[j][0] + v[j][1] * v[j][1]) + (v[j][2] * v[j][2] + v[j][3] * v[j][3]); }
                const float rstd = rsqrtf(wave_sum(s2) * (1.f / DM) + LN_EPS);
#pragma unroll
                for (int j = 0; j < 4; ++j) { v[j] = v[j] * rstd * lg[j] + lb[j]; u32x2 w; w.x = cvtpk(v[j][0], v[j][1]); w.y = cvtpk(v[j][2], v[j][3]); ((u32x2*)(X1 + (size_t)row * DM) + lane)[64 * j] = w;
                    (WSP(unsigned, WS_X1F) + (size_t)row * 256)[lane + 64 * j] = pk4_fp8(v[j][0], v[j][1], v[j][2], v[j][3]); } } }
        f32x2_t vab[2][4][4];
#pragma unroll
        for (int j = 0; j < 4; ++j)
#pragma unroll
            for (int c = 0; c < 4; ++c) { vab[0][j][c] = (f32x2_t){vr[0][j][c], vr[1][j][c]}; vab[1][j][c] = (f32x2_t){vr[2][j][c], vr[3][j][c]}; }
        float q16a[4][16];
        int woff = 4 * lane; asm volatile("" : "+v"(woff));
#pragma unroll
        for (int k = 0; k < 16; ++k) { f32x2_t ac[2][2];
#pragma unroll
            for (int eh = 0; eh < 2; ++eh) { ac[eh][0] = (f32x2_t){0.f, 0.f}; ac[eh][1] = (f32x2_t){0.f, 0.f};
#pragma unroll
                for (int j = 0; j < 4; ++j) { const f32x4 w = *(const f32x4*)(wrt + (k + 16 * eh) * 1024 + 256 * j + woff);
#pragma unroll
                    for (int c = 0; c < 4; ++c) { const f32x2_t ww = (f32x2_t){w[c], w[c]}; ac[eh][0] = __builtin_elementwise_fma(vab[0][j][c], ww, ac[eh][0]); ac[eh][1] = __builtin_elementwise_fma(vab[1][j][c], ww, ac[eh][1]); } }
                asm volatile("" : "+v"(ac[eh][0]), "+v"(ac[eh][1])); }
#pragma unroll
            for (int h4 = 0; h4 < 4; ++h4) q16a[h4][k] = sum_x32(ac[0][h4 >> 1][h4 & 1], ac[1][h4 >> 1][h4 & 1]);
            if ((k & 1) == 1) asm volatile("" ::: "memory"); }
#pragma unroll
        for (int h2 = 0; h2 < 4; ++h2) {
            float q8[8], q4[4], q2[2]; const float (&q16)[16] = q16a[h2];
#pragma unroll
            for (int k = 0; k < 8; ++k) q8[k] = sum_x16(q16[k], q16[k + 8]);
            { const bool up = (lane & 8) != 0;
#pragma unroll
                for (int k = 0; k < 4; ++k) { const float keep = up ? q8[k + 4] : q8[k], send = up ? q8[k] : q8[k + 4]; q4[k] = keep + dppf<0x128>(send); } }
            { const bool up = (lane & 4) != 0;
#pragma unroll
                for (int k = 0; k < 2; ++k) { const float keep = up ? q4[k + 2] : q4[k], send = up ? q4[k] : q4[k + 2]; q2[k] = keep + dppf<0x141>(send); } }
            float lgt;
            { const bool up = (lane & 2) != 0; const float keep = up ? q2[1] : q2[0], send = up ? q2[0] : q2[1]; lgt = keep + dppf<0x4E>(send); }
            lgt += dppf<0xB1>(lgt);
            lgt += brl;
            int rank = 0;
#pragma unroll
            for (int e = 0; e < 32; ++e) { const int src = ((e >> 4) & 1) * 32 + ((e >> 3) & 1) * 16 + ((e >> 2) & 1) * 8 + ((e >> 1) & 1) * 4 + (e & 1) * 2;
                const float ve = __uint_as_float((unsigned)__builtin_amdgcn_readlane((int)__float_as_uint(lgt), src));
                rank += (ve > lgt || (ve == lgt && e < my_e)) ? 1 : 0;
                if ((e & 7) == 7) __builtin_amdgcn_sched_barrier(0); }
            float tv[4]; int te[4];
#pragma unroll
            for (int k = 0; k < 4; ++k) { const unsigned long long mk = __ballot(rank == k && (lane & 1) == 0); const int src = (int)__builtin_ctzll(mk);
                tv[k] = __uint_as_float((unsigned)__builtin_amdgcn_readlane((int)__float_as_uint(lgt), src)); te[k] = __builtin_amdgcn_readlane(my_e, src); }
            const float e1 = __expf(tv[1] - tv[0]), e2 = __expf(tv[2] - tv[0]), e3 = __expf(tv[3] - tv[0]), inv = 1.f / (1.f + e1 + e2 + e3);
            if (lane < 4) { const int ek = lane == 0 ? te[0] : (lane == 1 ? te[1] : (lane == 2 ? te[2] : te[3]));
                const float gk = (lane == 0 ? 1.f : (lane == 1 ? e1 : (lane == 2 ? e2 : e3))) * inv;
                const int li = atomicAdd(s_cnt + ek, 1);
                const int q = (wave * 16 + 4 * ip + h2) * 4 + lane; s_e[q] = ek; s_g[q] = gk; s_li[q] = li; }
            asm volatile("" ::: "memory");
        }
    }
    __syncthreads();
    if (tid < 32) s_base[tid] = (int)atomicAdd(cnt + tid * 32, (unsigned)s_cnt[tid]);
    __syncthreads();
    { const int lr = tid >> 2, k = tid & 3, wv = lr >> 4, i = lr & 15;
        const int row = (F.blk * NWAVES + wv) + i * NGW;
        if (row < T_TOK) { const int ek = s_e[tid], slot = s_base[ek] + s_li[tid];
            ltok[(size_t)ek * LCAP + slot] = row; lgate[(size_t)ek * LCAP + slot] = s_g[tid]; rt_e[row * 4 + k] = ek; rt_s[row * 4 + k] = slot; } }
}
constexpr int ULIST_OFF = LDS_MISC + 1024, ULIST_MAX = 60;
__device__ __forceinline__ void build_tpre(const Frame& F, int nN, int ndense = 0) {
    THREAD_IDS();
    int* tpre = (int*)(F.lds + LDS_MISC); int* cnts = tpre + 64; int* ulist = (int*)(F.lds + ULIST_OFF);
    __syncthreads();
    if (tid < NEXP) {
        const int c = (int)__hip_atomic_load(WSP(const unsigned, WS_CTL) + tid * 32, __ATOMIC_RELAXED, __HIP_MEMORY_SCOPE_AGENT);
        const int t = (c + 255) >> 8; int incl = t;
#pragma unroll
        for (int o = 1; o < NEXP; o <<= 1) { const int up = __shfl_up(incl, o); if (tid >= o) incl += up; }
        tpre[tid] = incl - t; cnts[tid] = c; if (tid == NEXP - 1) tpre[NEXP] = incl;
    }
    __syncthreads();
    if (nN > 0 && tid <= ULIST_MAX) {
        const int i = tid, totale = tpre[NEXP] * nN, total = totale + ndense;
        const int L = i < ULIST_MAX ? pg8::unit_index(i, F.blk, F.G, total) : -1;
        if (L < 0) ulist[4 * i + 3] = 0;
        else if (L >= totale) { const int l = L - totale, gid = l / 32, w = l - gid * 32;
            ulist[4 * i] = 255 | ((w / 8) << 8); ulist[4 * i + 1] = gid * 8 + w % 8; ulist[4 * i + 2] = gid * 8 + w % 8; ulist[4 * i + 3] = 256; }
        else {
            int e = 0; for (int k = 1; k < NEXP; ++k) if (L >= tpre[k] * nN) e = k;
            const int tp0 = tpre[e], tiles = tpre[e + 1] - tp0, l = L - tp0 * nN, nig = 8 * nN, gid = l / nig, fm = gid * 8, gsz = (tiles - fm) < 8 ? (tiles - fm) : 8, w = l - gid * nig;
            const int pn = w / gsz, pl = fm + w % gsz, rr = cnts[e] - 256 * pl;
            ulist[4 * i] = e | (pn << 8); ulist[4 * i + 1] = pl; ulist[4 * i + 2] = tp0 + pl; ulist[4 * i + 3] = rr < 256 ? rr : 256; }
    }
    __syncthreads();
}

__device__ __forceinline__ void phase9(const Frame& F, bool have_tpre) {
    THREAD_IDS();
    const float* in_ln2_g = inptr(19); const float* in_ln2_b = inptr(20);
    if (!have_tpre) build_tpre(F, 0);
    const int* tpre = (const int*)(F.lds + LDS_MISC);
    const int gw = F.blk * NWAVES + wave, NGW = F.G * NWAVES;
    const bf16_t* X1 = WSP(const bf16_t, WS_X1); const unsigned char* PLE = WSP(const unsigned char, WS_PLE8); const unsigned char* YB = WSP(const unsigned char, WS_YB);
    const int* rt_e = WSP(const int, WS_ROUTE); const int* rt_s = rt_e + T_TOK * 4;
    f32x4 lg[4], lb[4];
#pragma unroll
    for (int j = 0; j < 4; ++j) { lg[j] = *(const f32x4*)(in_ln2_g + 4 * lane + 256 * j); lb[j] = *(const f32x4*)(in_ln2_b + 4 * lane + 256 * j); }
#pragma unroll 1
    for (int row0 = 4 * gw; row0 < T_TOK; row0 += 4 * NGW) {
        int rr[4]; size_t R[4][4];
#pragma unroll
        for (int q = 0; q < 4; ++q) { rr[q] = row0 + q;
#pragma unroll
            for (int k = 0; k < 4; ++k) { const int e = rt_e[rr[q] * 4 + k], sl = rt_s[rr[q] * 4 + k]; R[q][k] = (size_t)tpre[e] * 256 + sl; } }
        u32x2 xw[4][4]; unsigned pw[4][4]; unsigned yw[4][4][4];
#pragma unroll
        for (int q = 0; q < 4; ++q) { const u32x2* xr = (const u32x2*)(X1 + (size_t)rr[q] * DM) + lane; const unsigned* pr = (const unsigned*)(PLE + (((size_t)(rr[q] >> 4) * 32 + (lane >> 3)) * 16 + (rr[q] & 15)) * 32 + (lane & 7) * 4);
#pragma unroll
            for (int j = 0; j < 4; ++j) { xw[q][j] = xr[64 * j]; pw[q][j] = pr[1024 * j]; }
#pragma unroll
            for (int k = 0; k < 4; ++k) { const unsigned* yr = (const unsigned*)(YB + R[q][k] * DM) + lane;
#pragma unroll
                for (int j = 0; j < 4; ++j) yw[q][k][j] = yr[64 * j]; } }
#pragma unroll
        for (int q = 0; q < 4; ++q) {
            f32x4 v[4];
#pragma unroll
            for (int j = 0; j < 4; ++j) { const u32x2 w = xw[q][j]; const int p8 = (int)pw[q][j]; const f32x2_t pl0 = __builtin_amdgcn_cvt_pk_f32_fp8(p8, false), ph0 = __builtin_amdgcn_cvt_pk_f32_fp8(p8, true);
                v[j] = (f32x4){bflo(w.x), bfhi(w.x), bflo(w.y), bfhi(w.y)} * ALPHA + (f32x4){pl0[0], pl0[1], ph0[0], ph0[1]} * 0.125f;
#pragma unroll
                for (int k = 0; k < 4; ++k) { const int yv = (int)yw[q][k][j]; const f32x2_t lo = __builtin_amdgcn_cvt_pk_f32_fp8(yv, false), hi2 = __builtin_amdgcn_cvt_pk_f32_fp8(yv, true); v[j] = v[j] + (f32x4){lo[0], lo[1], hi2[0], hi2[1]}; } }
            float s = 0.f;
#pragma unroll
            for (int j = 0; j < 4; ++j) s += (v[j][0] + v[j][1]) + (v[j][2] + v[j][3]);
            const float mean = wave_sum(s) * (1.f / DM); float s2 = 0.f;
#pragma unroll
            for (int j = 0; j < 4; ++j) { v[j] = v[j] - mean; s2 += (v[j][0] * v[j][0] + v[j][1] * v[j][1]) + (v[j][2] * v[j][2] + v[j][3] * v[j][3]); }
            const float rstd = rsqrtf(wave_sum(s2) * (1.f / DM) + LN_EPS);
            { f32x4* orow = (f32x4*)(F.out + (size_t)rr[q] * DM) + lane;
#pragma unroll
                for (int j = 0; j < 4; ++j) orow[64 * j] = v[j] * rstd * lg[j] + lb[j]; }
        }
    }
}

constexpr int N_PHASES = 10;
__global__ void __launch_bounds__(NTHREADS, 2) fwd_kernel(Args args) {
    extern __shared__ __attribute__((aligned(16))) unsigned char lds_raw[];
    Frame F;
    F.lds = lds_raw; F.G = gridDim.x; F.blk = blockIdx.x;
    F.out = args.out; F.ws = args.ws;
    LAS unsigned char* lds3 = (LAS unsigned char*)lds_raw;
    const int lo = args.ph_lo, hi = args.ph_hi;
#if ONE_LAUNCH
    if (threadIdx.x < 2) ((LAS unsigned*)(lds3 + LDS_BARST))[threadIdx.x] = 0u;
    __syncthreads();
    XcdBarrier xbar = xcd_barrier_post(WSP(unsigned, WS_CTL) + CW_BAR, (volatile LAS unsigned*)(lds3 + LDS_BARST));
#define SEAM(k) do { if (lo <= (k) && (k) + 1 < hi) xcd_barrier(xbar); } while (0)
#else
#define SEAM(k) do { } while (0)
#endif
#ifndef PHASE_MASK
#define PHASE_MASK 0x3ff
#endif
#define IN(k) (((PHASE_MASK >> (k)) & 1) && lo <= (k) && (k) < hi)
    int hcur = -1;
    const bool pre2 = ONE_LAUNCH && IN(1) && IN(2), pre6 = ONE_LAUNCH && IN(5) && IN(6), pre8 = ONE_LAUNCH && IN(7) && IN(8), pre9 = ONE_LAUNCH && IN(8) && IN(9);
#define REPS(k) 1
#if ONE_LAUNCH
#define REPSYNC() xcd_barrier(xbar)
#else
#define REPSYNC() do { } while (0)
#endif
    if (IN(0)) { for (int rep = 0; rep < REPS(0); ++rep) { if (rep) REPSYNC(); phase0(F); } SEAM(0); }
    if (IN(1)) {
        for (int rep = 0; rep < REPS(1); ++rep) { if (rep) REPSYNC();
        pg8::DenseSched S{(const char*)WSP(bf16_t, WS_XB), (const char*)WSP(bf16_t, WS_WIN), T_TOK / 256, HPW / 256, 1024, F.blk, F.G};
        pg8::EpiStoreBlk E{WSP(bf16_t, WS_HP)};
        pg8::gemm_phase<false>(lds3, 1024, S, E); }
        if (pre2 && F.blk < 2048) {
            const float* in_conv_w = inptr(3); const int h0 = (F.blk >> 5) & 3; float* cwt = (float*)(F.lds + L_CW);
            for (int i = threadIdx.x; i < 1536; i += NTHREADS) cwt[i] = in_conv_w[(size_t)((i >> 7) & 3) * 1536 + (i >> 9) * 512 + h0 * 128 + (i & 127)];
            hcur = h0; }
        SEAM(1);
    }
    if (IN(2)) {
        for (int rep = 0; rep < REPS(2); ++rep) { if (rep) REPSYNC();
        DnPre dnp; bool dnv = false;
        const int nk = (2048 + 512 - F.blk + F.G - 1) / F.G; const bool kvf = ((F.blk >> 3) & 1) != 0 && nk > 2;
#pragma unroll 1
        for (int i = 0; i < nk; ++i) { int k = i; if (kvf) { k = i + nk - 2; if (k >= nk) k -= nk; }
            const int u = F.blk + k * F.G;
            if (u < 2048) { if (!dnv) { dn_load(F, u, dnp); dnv = true; } const int un = u + F.G; dn_prep_unit(F, u, hcur, un < 2048 ? un : -1, dnp); } else if (!(args.flags & 8)) kv_unit(F, u - 2048); } }
        SEAM(2);
    }
    if (IN(3)) { for (int rep = 0; rep < REPS(3); ++rep) { if (rep) { REPSYNC(); if (F.blk == 0 && threadIdx.x == 0) __hip_atomic_store(WSP(unsigned, WS_CTL) + 64, 0u, __ATOMIC_RELAXED, __HIP_MEMORY_SCOPE_AGENT); REPSYNC(); } phase3(F, args.flags); } SEAM(3); }
    if (IN(4)) { for (int rep = 0; rep < REPS(4); ++rep) { if (rep) REPSYNC(); phase4(F); } SEAM(4); }
    if (IN(5)) {
        for (int rep = 0; rep < REPS(5); ++rep) { if (rep) REPSYNC();
        pg8::DenseSched S{(const char*)WSP(bf16_t, WS_MIX), (const char*)WSP(bf16_t, WS_WOUT), T_TOK / 256, DM / 256, 1024, F.blk, F.G};
        pg8::EpiResid E{WSP(bf16_t, WS_X1), WSP(const bf16_t, WS_XB)};
        pg8::gemm_phase<false>(lds3, 1024, S, E); }
        if (pre6) p6_fill_wrt(F);
        SEAM(5);
    }
    if (IN(6)) { phase6(F, pre6); SEAM(6); }
    if (IN(7)) {
        build_tpre(F, 8, 512);
        for (int rep = 0; rep < REPS(7); ++rep) { if (rep) REPSYNC();
        { pg8::MoeSched<true> S{(const char*)WSP(unsigned char, WS_X1F), (const char*)WSP(unsigned char, WS_WGU), (size_t)2048 * 1024, WSP(const int, WS_LTOK), (const LAS int*)(lds3 + ULIST_OFF), 1024, (const char*)WSP(unsigned char, WS_WPG)};
          pg8::EpiActSig E{{WSP(unsigned char, WS_ACT), inptr(13), lds3 + LDS_MISC + 8192}, {WSP(bf16_t, WS_PLE), inptr(17), lds3 + LDS_MISC + 8192}};
          pg8::gemm_phase<true>(lds3, 1024, S, E); } }
        if (pre8) build_tpre(F, 4);
        SEAM(7);
    }
    if (IN(8)) {
        if (!pre8) build_tpre(F, 4);
        for (int rep = 0; rep < REPS(8); ++rep) { if (rep) REPSYNC();
        { pg8::MoeSched<false> S{(const char*)WSP(unsigned char, WS_ACT), (const char*)WSP(unsigned char, WS_WD), (size_t)1024 * 1024, nullptr, (const LAS int*)(lds3 + ULIST_OFF), 1024, nullptr};
          pg8::EpiDown E{WSP(unsigned char, WS_YB), inptr(15), WSP(const float, WS_LGATE), lds3 + 131072, lds3 + LDS_MISC + 8192};
          pg8::gemm_phase<true>(lds3, 1024, S, E); } }
        { pg8::DenseSched S{(const char*)WSP(bf16_t, WS_PB), (const char*)WSP(bf16_t, WS_WPP), T_TOK / 256, DM / 256, 256, F.blk, F.G};
          pg8::EpiMul E{WSP(const bf16_t, WS_PLE), WSP(unsigned char, WS_PLE8)};
          pg8::gemm_phase<false>(lds3, 256, S, E); }
        SEAM(8);
    }
    if (IN(9)) { for (int rep = 0; rep < REPS(9); ++rep) { if (rep) REPSYNC(); phase9(F, pre9); } }

}

extern "C" void kernel_launch(void* const* d_in, const int* in_sizes, int n_in, void* d_out, int out_size, void* d_ws, size_t ws_size, hipStream_t stream) {
    static int grid = 0;
    if (grid == 0) {
        if (n_in != 21 || out_size != T_TOK * DM || ws_size < WS_END) { fprintf(stderr, "kernel_launch: unexpected problem (n_in %d, out %d, ws %zu)\n", n_in, out_size, ws_size); grid = -1; return; }
        int dev = 0, cus = 0, per_cu = 0;
        (void)hipGetDevice(&dev); (void)hipDeviceGetAttribute(&cus, hipDeviceAttributeMultiprocessorCount, dev);
        if (hipFuncSetAttribute((const void*)fwd_kernel, hipFuncAttributeMaxDynamicSharedMemorySize, LDS_BYTES) != hipSuccess) { fprintf(stderr, "kernel_launch: hipFuncSetAttribute failed\n"); grid = -1; return; }
        (void)hipOccupancyMaxActiveBlocksPerMultiprocessor(&per_cu, (const void*)fwd_kernel, NTHREADS, LDS_BYTES);
        (void)hipGetLastError();
        if (per_cu < 1) { fprintf(stderr, "kernel_launch: occupancy query says %d workgroups per CU: cannot make the grid resident\n", per_cu); grid = -1; return; }
        grid = cus;
        if (cus != 256) fprintf(stderr, "kernel_launch: built for a 256-CU device (got %d CUs)\n", cus);
    }
    if (grid < 0) return;
    (void)hipMemsetAsync((char*)d_ws + WS_CTL, 0, 32768, stream);
    Args a{};
    for (int i = 0; i < 21; ++i) a.in[i] = (const float*)d_in[i];
    a.out = (float*)d_out; a.ws = (unsigned char*)d_ws;
#if ONE_LAUNCH
    a.ph_lo = 0; a.ph_hi = N_PHASES;
    void* kargs[] = {&a};
    hipError_t e = hipLaunchCooperativeKernel((const void*)fwd_kernel, dim3(grid), dim3(NTHREADS), kargs, LDS_BYTES, stream);
    if (e != hipSuccess) fprintf(stderr, "cooperative launch failed: %s (grid %d)\n", hipGetErrorString(e), grid);
#else
    for (int ph = 0; ph < N_PHASES; ++ph) { a.ph_lo = ph; a.ph_hi = ph + 1; hipLaunchKernelGGL(fwd_kernel, dim3(grid), dim3(NTHREADS), LDS_BYTES, stream, a);
        if (ph == (PROBE_PH)) { a.flags = PROBE_FLAGS; if (ph == 3) (void)hipMemsetAsync((char*)d_ws + WS_CTL + 4096, 0, 2048, stream); hipLaunchKernelGGL(fwd_kernel, dim3(grid), dim3(NTHREADS), LDS_BYTES, stream, a); a.flags = 0; } }
#endif
}
```
